# Optimizing an MI355X kernel written in HIP

```python
import jax, jax.numpy as jnp
from jax import lax
import numpy as np

D_MODEL = 4096
BATCH = 2
SEQ = 8192
DEPTH = 2

HEAD_DIM = 128
ROPE_THETA = 10000.0
LN_EPS = 1e-5
DIL_GROUPS = ((128, 1), (512, 4), (2048, 16))
N_DIL_GROUPS = 3
DIL_HEADS = D_MODEL // HEAD_DIM // 2
BAND_BLOCK = 128
A_WIDTH = 3 * N_DIL_GROUPS * DIL_HEADS * HEAD_DIM
DSA_HEADS = D_MODEL // HEAD_DIM
DSA_KV_HEADS = DSA_HEADS // 4
DSA_GROUP = DSA_HEADS // DSA_KV_HEADS
IDX_HEADS = 32
IDX_DIM = HEAD_DIM
TOPK_MAX = 256
QUERY_BLOCK = 128
B_Q = DSA_HEADS * HEAD_DIM
B_KV = DSA_KV_HEADS * HEAD_DIM
B_QI = IDX_HEADS * IDX_DIM
B_WIDTH = B_Q + 2 * B_KV + B_QI + IDX_DIM + IDX_HEADS
D_FF = -(-8 * D_MODEL // (3 * 256)) * 256
DEEPNORM_ALPHA = (2 * DEPTH) ** 0.25
DEEPNORM_BETA = (8 * DEPTH) ** -0.25

kernel_name = "hybrid_dilated_dsa_block"


def rope_tables(positions):
    inv = ROPE_THETA ** (-jnp.arange(0, HEAD_DIM, 2, dtype=jnp.float32) / HEAD_DIM)
    ang = positions.astype(jnp.float32)[..., None] * inv
    return jnp.cos(ang), jnp.sin(ang)


def apply_rope(x, cos, sin):
    xf = x.astype(jnp.float32)
    x1, x2 = jnp.split(xf, 2, axis=-1)
    c = cos[:, :, None, :]
    s = sin[:, :, None, :]
    return jnp.concatenate([x1 * c - x2 * s, x2 * c + x1 * s], axis=-1).astype(x.dtype)


def layer_norm(x, gain, bias):
    xf = x.astype(jnp.float32)
    mu = jnp.mean(xf, axis=-1, keepdims=True)
    var = jnp.mean(jnp.square(xf - mu), axis=-1, keepdims=True)
    y = (xf - mu) * lax.rsqrt(var + LN_EPS)
    return (y * gain.astype(jnp.float32) + bias.astype(jnp.float32)).astype(x.dtype)


def banded_window_attention(q, k, v, window):
    N, L, H, Dh = q.shape
    nb = -(-L // BAND_BLOCK)
    Lp = nb * BAND_BLOCK
    pad = Lp - L
    qb = jnp.pad(q, ((0, 0), (0, pad), (0, 0), (0, 0))).reshape(N, nb, BAND_BLOCK, H, Dh)

    def key_blocks(t):
        tp = jnp.pad(t, ((0, 0), (BAND_BLOCK, pad), (0, 0), (0, 0)))
        tp = tp.reshape(N, nb + 1, BAND_BLOCK, H, Dh)
        return jnp.concatenate([tp[:, :-1], tp[:, 1:]], axis=2)

    kb = key_blocks(k)
    vb = key_blocks(v)
    s = jnp.einsum('nbqhd,nbkhd->nbhqk', qb, kb).astype(jnp.float32) * (Dh ** -0.5)
    qi = jnp.arange(nb)[:, None] * BAND_BLOCK + jnp.arange(BAND_BLOCK)[None, :]
    ki = (jnp.arange(nb)[:, None] - 1) * BAND_BLOCK + jnp.arange(2 * BAND_BLOCK)[None, :]
    dist = qi[:, :, None] - ki[:, None, :]
    mask = (dist >= 0) & (dist <= window) & (ki[:, None, :] >= 0)
    s = jnp.where(mask[None, :, None], s, -jnp.inf)
    lse = jax.nn.logsumexp(s, axis=-1)
    p = jnp.exp(s - lse[..., None]).astype(v.dtype)
    o = jnp.einsum('nbhqk,nbkhd->nbqhd', p, vb).reshape(N, Lp, H, Dh)[:, :L]
    lse = lse.transpose(0, 1, 3, 2).reshape(N, Lp, H)[:, :L]
    return o, lse


def dilated_attention(q, k, v, window, dilation):
    B, S, H, Dh = q.shape
    Ls = S // dilation

    def to_sub(t):
        return t.reshape(B, Ls, dilation, H, Dh).transpose(0, 2, 1, 3, 4).reshape(B * dilation, Ls, H, Dh)

    o, lse = banded_window_attention(to_sub(q), to_sub(k), to_sub(v), window // dilation)
    o = o.reshape(B, dilation, Ls, H, Dh).transpose(0, 2, 1, 3, 4).reshape(B, S, H, Dh)
    lse = lse.reshape(B, dilation, Ls, H).transpose(0, 2, 1, 3).reshape(B, S, H)
    return o, lse


def mixer_dilated(x, w_in, w_out, cos, sin):
    B, S, _ = x.shape
    proj = (x @ w_in).reshape(B, S, 3, N_DIL_GROUPS, DIL_HEADS, HEAD_DIM)
    outs, lses = [], []
    for g, (window, dilation) in enumerate(DIL_GROUPS):
        q = apply_rope(proj[:, :, 0, g], cos, sin)
        k = apply_rope(proj[:, :, 1, g], cos, sin)
        v = proj[:, :, 2, g]
        o, lse = dilated_attention(q, k, v, window, dilation)
        outs.append(o)
        lses.append(lse)
    wts = jax.nn.softmax(jnp.stack(lses), axis=0)
    o = jnp.einsum('gbsh,gbshd->bshd', wts.astype(x.dtype), jnp.stack(outs))
    return o.reshape(B, S, DIL_HEADS * HEAD_DIM) @ w_out


def mixer_dsa(x, w_in, k_idx_gain, k_idx_bias, w_out, cos, sin):
    B, S, _ = x.shape
    proj = x @ w_in
    o0 = B_Q
    o1 = o0 + B_KV
    o2 = o1 + B_KV
    o3 = o2 + B_QI
    o4 = o3 + IDX_DIM
    q = apply_rope(proj[..., :o0].reshape(B, S, DSA_HEADS, HEAD_DIM), cos, sin)
    k = apply_rope(proj[..., o0:o1].reshape(B, S, DSA_KV_HEADS, HEAD_DIM), cos, sin)
    v = proj[..., o1:o2].reshape(B, S, DSA_KV_HEADS, HEAD_DIM)
    qi = apply_rope(proj[..., o2:o3].reshape(B, S, IDX_HEADS, IDX_DIM), cos, sin)
    ki = layer_norm(proj[..., o3:o4], k_idx_gain, k_idx_bias)
    ki = apply_rope(ki[:, :, None, :], cos, sin)[:, :, 0]
    wi = proj[..., o4:] * (IDX_HEADS ** -0.5 * IDX_DIM ** -0.5)

    n_sel = min(TOPK_MAX, S // 4)
    nqb = S // QUERY_BLOCK

    def to_blocks(t):
        return jnp.moveaxis(t.reshape((B, nqb, QUERY_BLOCK) + t.shape[2:]), 1, 0)

    starts = jnp.arange(nqb, dtype=jnp.int32) * QUERY_BLOCK
    key_pos = jnp.arange(S, dtype=jnp.int32)

    def block(args):
        qb, qib, wib, start = args
        t = start + jnp.arange(QUERY_BLOCK, dtype=jnp.int32)
        rel = jax.nn.relu(jnp.einsum('bqhd,bsd->bqhs', qib, ki))
        score = jnp.einsum('bqhs,bqh->bqs', rel, wib).astype(jnp.float32)
        causal = key_pos[None, :] <= t[:, None]
        score = jnp.where(causal[None], score, -jnp.inf)
        _, idx = lax.top_k(score, n_sel)
        valid = idx <= t[None, :, None]
        kg = jax.vmap(lambda kk, ii: kk[ii])(k, idx)
        vg = jax.vmap(lambda vv, ii: vv[ii])(v, idx)
        qg = qb.reshape(B, QUERY_BLOCK, DSA_KV_HEADS, DSA_GROUP, HEAD_DIM)
        s = jnp.einsum('bqkgd,bqnkd->bqkgn', qg, kg).astype(jnp.float32) * (HEAD_DIM ** -0.5)
        s = jnp.where(valid[:, :, None, None, :], s, -jnp.inf)
        p = jax.nn.softmax(s, axis=-1).astype(vg.dtype)
        o = jnp.einsum('bqkgn,bqnkd->bqkgd', p, vg)
        return o.reshape(B, QUERY_BLOCK, DSA_HEADS * HEAD_DIM)

    o = lax.map(block, (to_blocks(q), to_blocks(qi), to_blocks(wi), starts))
    o = jnp.moveaxis(o, 0, 1).reshape(B, S, DSA_HEADS * HEAD_DIM)
    return o @ w_out


def swiglu(x, w_gate, w_up, w_down):
    return (jax.nn.silu(x @ w_gate) * (x @ w_up)) @ w_down


def setup_inputs(seed: int = 0) -> dict:
    key = jax.random.key(seed)
    ks = jax.random.split(key, 32)
    f32 = jnp.float32
    sd = D_MODEL ** -0.5

    def nrm(k, shape, scale):
        return jax.random.normal(k, shape, f32) * scale

    x = jax.random.normal(ks[0], (BATCH, SEQ, D_MODEL), f32)
    start = jax.random.randint(ks[1], (BATCH, 1), 0, 4096, dtype=jnp.int32)
    positions = start + jnp.arange(SEQ, dtype=jnp.int32)[None, :]

    col_scale = jnp.array([1.0, 1.0, DEEPNORM_BETA], f32)[None, :, None]
    l0_attn_w_in = (nrm(ks[2], (D_MODEL, 3, A_WIDTH // 3), sd) * col_scale).reshape(D_MODEL, A_WIDTH)
    l0_attn_w_out = nrm(ks[3], (DIL_HEADS * HEAD_DIM, D_MODEL), (DIL_HEADS * HEAD_DIM) ** -0.5 * DEEPNORM_BETA)

    l1_attn_w_in = jnp.concatenate([
        nrm(ks[4], (D_MODEL, B_Q), sd),
        nrm(ks[5], (D_MODEL, B_KV), sd),
        nrm(ks[6], (D_MODEL, B_KV), sd * DEEPNORM_BETA),
        nrm(ks[7], (D_MODEL, B_QI), sd),
        nrm(ks[8], (D_MODEL, IDX_DIM), sd),
        nrm(ks[9], (D_MODEL, IDX_HEADS), sd),
    ], axis=1)
    l1_k_idx_gain = 1.0 + nrm(ks[10], (IDX_DIM,), 0.02)
    l1_k_idx_bias = nrm(ks[11], (IDX_DIM,), 0.02)
    l1_attn_w_out = nrm(ks[12], (B_Q, D_MODEL), B_Q ** -0.5 * DEEPNORM_BETA)

    out = {"x": x, "positions": positions,
           "l0_attn_w_in": l0_attn_w_in, "l0_attn_w_out": l0_attn_w_out,
           "l1_attn_w_in": l1_attn_w_in, "l1_k_idx_gain": l1_k_idx_gain,
           "l1_k_idx_bias": l1_k_idx_bias, "l1_attn_w_out": l1_attn_w_out}
    for i in range(2):
        b = 13 + 9 * i
        out[f"l{i}_ln_mix_gain"] = 1.0 + nrm(ks[b], (D_MODEL,), 0.02)
        out[f"l{i}_ln_mix_bias"] = nrm(ks[b + 1], (D_MODEL,), 0.02)
        out[f"l{i}_ffn_gate"] = nrm(ks[b + 2], (D_MODEL, D_FF), sd)
        out[f"l{i}_ffn_up"] = nrm(ks[b + 3], (D_MODEL, D_FF), sd * DEEPNORM_BETA)
        out[f"l{i}_ffn_down"] = nrm(ks[b + 4], (D_FF, D_MODEL), D_FF ** -0.5 * DEEPNORM_BETA)
        out[f"l{i}_ln_ffn_gain"] = 1.0 + nrm(ks[b + 5], (D_MODEL,), 0.02)
        out[f"l{i}_ln_ffn_bias"] = nrm(ks[b + 6], (D_MODEL,), 0.02)
    return out


def reference(x, positions, l0_attn_w_in, l0_attn_w_out, l1_attn_w_in, l1_k_idx_gain,
              l1_k_idx_bias, l1_attn_w_out,
              l0_ln_mix_gain, l0_ln_mix_bias, l0_ffn_gate, l0_ffn_up, l0_ffn_down,
              l0_ln_ffn_gain, l0_ln_ffn_bias,
              l1_ln_mix_gain, l1_ln_mix_bias, l1_ffn_gate, l1_ffn_up, l1_ffn_down,
              l1_ln_ffn_gain, l1_ln_ffn_bias):
    cos, sin = rope_tables(positions)
    mix_norms = ((l0_ln_mix_gain, l0_ln_mix_bias), (l1_ln_mix_gain, l1_ln_mix_bias))
    ffns = ((l0_ffn_gate, l0_ffn_up, l0_ffn_down), (l1_ffn_gate, l1_ffn_up, l1_ffn_down))
    ffn_norms = ((l0_ln_ffn_gain, l0_ln_ffn_bias), (l1_ln_ffn_gain, l1_ln_ffn_bias))
    for i in range(DEPTH):
        if i % 2 == 0:
            m = mixer_dilated(x, l0_attn_w_in, l0_attn_w_out, cos, sin)
        else:
            m = mixer_dsa(x, l1_attn_w_in, l1_k_idx_gain, l1_k_idx_bias, l1_attn_w_out, cos, sin)
        x = layer_norm(DEEPNORM_ALPHA * x + m, *mix_norms[i])
        x = layer_norm(DEEPNORM_ALPHA * x + swiglu(x, *ffns[i]), *ffn_norms[i])
    return x
```

```cpp
#include <hip/hip_runtime.h>
#include <cstdio>
#include <cstdint>
namespace pg8 {
#define PG8_LAS __attribute__((address_space(3)))
typedef unsigned short bf16_t;
typedef short bf16x8 __attribute__((ext_vector_type(8)));
typedef float f32x4 __attribute__((ext_vector_type(4)));
typedef unsigned u32x4 __attribute__((ext_vector_type(4)));
constexpr int BM = 256, BK = 64, HALF = 128, HTB = HALF * BK * 2  , STAGE_BYTES = 8 * HTB, NXCD = 8, WGM = 8;

__host__ __device__ __forceinline__ int lds_byte(int r, int c) { const int st = (r >> 4) * 2 + (c >> 5), rr = r & 15, cc = c & 31, ob = rr * 64 + cc * 2; return st * 1024 + (ob ^ (((ob >> 9) & 1) << 5)); }
__host__ __device__ __forceinline__ void stage_rc(int b, int& R, int& C) { const int st = b / 1024, sb = b % 1024, swz = sb ^ (((sb >> 9) & 1) << 5); R = (st >> 1) * 16 + swz / 64; C = (st & 1) * 32 + (swz % 64) / 2; }
__host__ __device__ __forceinline__ int perm32(int rho) { const int n = rho >> 4, i = rho & 15; return 8 * (i >> 2) + 4 * n + (i & 3); }

struct Unit { int pm, pn; };
struct Gemm { const bf16_t* A; const bf16_t* Bt; int M, N, K; };

struct StaticOrder {
    int nM, nN, nwg, G, c;
    __host__ __device__ void init(int M, int N, int G_, int c_) { nM = M / BM; nN = N / BM; nwg = nM * nN; G = G_; c = c_; }
    __host__ __device__ bool next(int i, Unit& u) const {
        const long L = (long)i * G + c; if (L >= nwg) return false;
        int wgid = (int)L; { const int q = nwg / NXCD, r = nwg % NXCD, xcd = wgid % NXCD, off = wgid / NXCD; wgid = (xcd < r ? xcd * (q + 1) : r * (q + 1) + (xcd - r) * q) + off; }
        const int nig = WGM * nN, gid = wgid / nig, fm = gid * WGM, gsz = (nM - fm) < WGM ? (nM - fm) : WGM;
        u.pm = fm + ((wgid % nig) % gsz); u.pn = (wgid % nig) / gsz; return true;
    }
    __device__ __forceinline__ void a_ready(const Unit&) const {}
    __device__ __forceinline__ void done(const Unit&) const {}
};
__device__ __forceinline__ unsigned cvt_pk_bf16(float lo, float hi) { unsigned r; asm volatile("v_cvt_pk_bf16_f32 %0, %1, %2" : "=v"(r) : "v"(lo), "v"(hi)); return r; }
typedef _Float16 f16x2_t __attribute__((ext_vector_type(2)));
__device__ __forceinline__ unsigned cvt_pk_f16(float lo, float hi) { f16x2_t h; h.x = (_Float16)lo; h.y = (_Float16)hi; return __builtin_bit_cast(unsigned, h); }

struct RopeTab { const float* cs; const float* sn; };

__device__ __forceinline__ void rope_pair(f32x4& v0, f32x4& v1, const f32x4 c, const f32x4 s) {
    const f32x4 a = v0 * c - v1 * s, b = v1 * c + v0 * s; v0 = a; v1 = b;
}

struct EpiY {
    static constexpr bool PERM = false, AFTER_DRAIN = false;
    const float* X; float* Y; int ldc; float alpha;
    __device__ __forceinline__ void operator()(const f32x4 (&acc)[2][2][4][2], const Unit& u, int wr, int wc, int fr, int fq) const {
        const int row0 = u.pm * BM + wr * 64 + fr, col0 = u.pn * BM + wc * 32 + 4 * fq;
#pragma unroll
        for (int ai = 0; ai < 2; ++ai)
#pragma unroll
            for (int m = 0; m < 4; ++m) { const size_t off = (size_t)(row0 + ai * HALF + m * 16) * ldc + col0;
#pragma unroll
                for (int bj = 0; bj < 2; ++bj)
#pragma unroll
                    for (int n = 0; n < 2; ++n) { const f32x4 xv = *(const f32x4*)(X + off + bj * HALF + n * 16); *(f32x4*)(Y + off + bj * HALF + n * 16) = xv * alpha + acc[ai][bj][m][n]; }
                asm volatile("" ::: "memory"); }
    }
};

struct EpiSwiGLU {
    static constexpr bool PERM = true, AFTER_DRAIN = false;
    bf16_t* Hh; int ldh;
    __device__ __forceinline__ void operator()(const f32x4 (&acc)[2][2][4][2], const Unit& u, int wr, int wc, int fr, int fq) const {
        const int row0 = u.pm * BM + wr * 64 + fr, col0 = u.pn * HALF + wc * 32 + 8 * fq;
#pragma unroll
        for (int ai = 0; ai < 2; ++ai)
#pragma unroll
            for (int m = 0; m < 4; ++m) { bf16_t* rowp = Hh + (size_t)(row0 + ai * HALF + m * 16) * ldh + col0;
                float h[8];
#pragma unroll
                for (int n = 0; n < 2; ++n)
#pragma unroll
                    for (int i = 0; i < 4; ++i) { const float g = acc[ai][0][m][n][i], up = acc[ai][1][m][n][i];
                        const float e = __builtin_amdgcn_exp2f(-g * 1.44269504089f); h[n * 4 + i] = g * __builtin_amdgcn_rcpf(1.0f + e) * up; }
                u32x4 w; w.x = cvt_pk_bf16(h[0], h[1]); w.y = cvt_pk_bf16(h[2], h[3]); w.z = cvt_pk_bf16(h[4], h[5]); w.w = cvt_pk_bf16(h[6], h[7]);
                *(u32x4*)rowp = w; }
    }
};

struct EpiQKV0 {
    static constexpr bool PERM = true, AFTER_DRAIN = false;
    bf16_t* O; RopeTab rt;
    __device__ __forceinline__ void operator()(const f32x4 (&acc)[2][2][4][2], const Unit& u, int wr, int wc, int fr, int fq) const {
        const int sg = u.pn >> 3, colin = (u.pn & 7) * BM + wc * 32 + 8 * fq; const bool rope = sg < 6;
        bf16_t* base = O + (size_t)sg * ((size_t)16384 * 2048);
        const int row0 = u.pm * BM + wr * 64 + fr, f0 = 16 * wc + 4 * fq;
#pragma unroll
        for (int ai = 0; ai < 2; ++ai)
#pragma unroll
            for (int m = 0; m < 4; ++m) { const int row = row0 + ai * HALF + m * 16; bf16_t* rowp = base + (size_t)row * 2048 + colin;
                f32x4 c = {1.f, 1.f, 1.f, 1.f}, s = {0.f, 0.f, 0.f, 0.f};
                if (rope) { c = *(const f32x4*)(rt.cs + (size_t)row * 64 + f0); s = *(const f32x4*)(rt.sn + (size_t)row * 64 + f0); }
#pragma unroll
                for (int bj = 0; bj < 2; ++bj) { f32x4 v0 = acc[ai][bj][m][0], v1 = acc[ai][bj][m][1];
                    rope_pair(v0, v1, c, s);
                    u32x4 w; w.x = cvt_pk_bf16(v0[0], v0[1]); w.y = cvt_pk_bf16(v0[2], v0[3]); w.z = cvt_pk_bf16(v1[0], v1[1]); w.w = cvt_pk_bf16(v1[2], v1[3]);
                    *(u32x4*)(rowp + bj * HALF) = w; } }
    }
};

struct EpiQKV1 {
    static constexpr bool PERM = true, AFTER_DRAIN = false;
    bf16_t* Q; bf16_t* Kc; bf16_t* Vc; unsigned short* QI; float* KIR; float* WI; RopeTab rt;
    __device__ __forceinline__ void operator()(const f32x4 (&acc)[2][2][4][2], const Unit& u, int wr, int wc, int fr, int fq) const {
        const int pn = u.pn; const int row0 = u.pm * BM + wr * 64 + fr, f0 = 16 * wc + 4 * fq, cw = wc * 32 + 8 * fq;
        const bool rope = (pn < 20) || (pn >= 24 && pn < 40);
#pragma unroll
        for (int ai = 0; ai < 2; ++ai)
#pragma unroll
            for (int m = 0; m < 4; ++m) { const int row = row0 + ai * HALF + m * 16;
                f32x4 c = {1.f, 1.f, 1.f, 1.f}, s = {0.f, 0.f, 0.f, 0.f};
                if (rope) { c = *(const f32x4*)(rt.cs + (size_t)row * 64 + f0); s = *(const f32x4*)(rt.sn + (size_t)row * 64 + f0); }
#pragma unroll
                for (int bj = 0; bj < 2; ++bj) { f32x4 v0 = acc[ai][bj][m][0], v1 = acc[ai][bj][m][1];
                    if (pn < 40) {
                        rope_pair(v0, v1, c, s);
                        u32x4 w;
                        if (pn >= 24) { w.x = cvt_pk_f16(v0[0], v0[1]); w.y = cvt_pk_f16(v0[2], v0[3]); w.z = cvt_pk_f16(v1[0], v1[1]); w.w = cvt_pk_f16(v1[2], v1[3]); }
                        else { w.x = cvt_pk_bf16(v0[0], v0[1]); w.y = cvt_pk_bf16(v0[2], v0[3]); w.z = cvt_pk_bf16(v1[0], v1[1]); w.w = cvt_pk_bf16(v1[2], v1[3]); }
                        if (pn < 16) *(u32x4*)(Q + (size_t)row * 4096 + pn * BM + bj * HALF + cw) = w;
                        else if (pn < 24) { const int kvh = ((pn - 16) & 3) * 2 + bj; bf16_t* dst = (pn < 20 ? Kc : Vc) + ((size_t)((row >> 13) * 8 + kvh) * 8192 + (row & 8191)) * 128 + cw; *(u32x4*)dst = w; }
                        else *(u32x4*)(QI + (size_t)row * 4096 + (pn - 24) * BM + bj * HALF + cw) = w;
                    } else {
                        if (bj == 0) { *(f32x4*)(KIR + (size_t)row * 128 + cw) = v0; *(f32x4*)(KIR + (size_t)row * 128 + cw + 4) = v1; }
                        else if (wc == 0) { *(f32x4*)(WI + (size_t)row * 32 + cw) = v0 * 0.015625f; *(f32x4*)(WI + (size_t)row * 32 + cw + 4) = v1 * 0.015625f; }
                    } } }
    }
};

template <class Epi, class Sched, bool ALIGN_EPI = false, bool SP2 = false>
__device__ __forceinline__ void gemm_phase(PG8_LAS unsigned char* lds, const Gemm g, const Sched& S, const Epi& E) {
    const int tid = threadIdx.x, wid = __builtin_amdgcn_readfirstlane(tid >> 6), lane = tid & 63, wr = wid >> 2, wc = wid & 3, fr = lane & 15, fq = lane >> 4;
    const int K = g.K, nt = K / BK;
    unsigned voffA[2], voffB[2];
#pragma unroll
    for (int i = 0; i < 2; ++i) { int R, C; stage_rc(tid * 16 + i * 8192, R, C); const int Rb = Epi::PERM ? ((R & ~31) + perm32(R & 31)) : R;
        voffA[i] = (unsigned)(R * K + C) * 2u; voffB[i] = (unsigned)(Rb * K + C) * 2u; }
    const size_t kstep = (size_t)(BK * 2);
    const size_t hstep = (size_t)HALF * K * 2;
    const size_t tstep = 2 * hstep;
    const unsigned ldsw = (unsigned)wid * 1024u;
    const int aoff = lds_byte(wr * 64 + fr, fq * 8), boff = lds_byte(wc * 32 + fr, fq * 8);
#define PG8_SA(b, h) (((b) * 2 + (h)) * HTB)
#define PG8_SB(b, h) ((4 + (b) * 2 + (h)) * HTB)
#define PG8_STAGE(bufoff, gbase, voff) do { _Pragma("unroll") for (int _i = 0; _i < 2; ++_i) \
        __builtin_amdgcn_global_load_lds((const unsigned*)((const char*)(gbase) + (voff)[_i]), (PG8_LAS unsigned*)(lds + (bufoff) + ldsw + _i * 8192), 16, 0, 0); } while (0)
#define PG8_LDA(dst, b, h) do { _Pragma("unroll") for (int m = 0; m < 4; ++m) _Pragma("unroll") for (int k = 0; k < 2; ++k) dst[m][k] = *(const PG8_LAS bf16x8*)(lds + PG8_SA(b, h) + aoff + m * 2048 + k * 1024); } while (0)
#define PG8_LDB(dst, b, h) do { _Pragma("unroll") for (int n = 0; n < 2; ++n) _Pragma("unroll") for (int k = 0; k < 2; ++k) dst[n][k] = *(const PG8_LAS bf16x8*)(lds + PG8_SB(b, h) + boff + n * 2048 + k * 1024); } while (0)
#define PG8_MMA(ai, bj, At, Bt) do { __builtin_amdgcn_s_setprio(1); _Pragma("unroll") for (int m = 0; m < 4; ++m) _Pragma("unroll") for (int n = 0; n < 2; ++n) _Pragma("unroll") for (int k = 0; k < 2; ++k) \
        acc[ai][bj][m][n] = __builtin_amdgcn_mfma_f32_16x16x32_bf16(Bt[n][k], At[m][k], acc[ai][bj][m][n], 0, 0, 0); __builtin_amdgcn_s_setprio(0); } while (0)
#define PG8_WAIT_V(n) asm volatile("s_waitcnt vmcnt(" #n ")" ::: "memory")
#define PG8_WAIT_L(n) asm volatile("s_waitcnt lgkmcnt(" #n ")" ::: "memory")
#define PG8_BAR __builtin_amdgcn_s_barrier()
#define PG8_SCHED __builtin_amdgcn_sched_barrier(0)
    Unit cur, nxt; int ui = 0;
    if (!S.next(0, cur)) return;
    f32x4 acc[2][2][4][2];
#pragma unroll
    for (int a = 0; a < 2; ++a)
#pragma unroll
        for (int b = 0; b < 2; ++b)
#pragma unroll
            for (int m = 0; m < 4; ++m)
#pragma unroll
                for (int n = 0; n < 2; ++n) acc[a][b][m][n] = (f32x4){0.f, 0.f, 0.f, 0.f};
    bf16x8 At[4][2], B0[2][2], B1[2][2];
    const char* cA = (const char*)g.A + (size_t)cur.pm * tstep; const char* cB = (const char*)g.Bt + (size_t)cur.pn * tstep;
    S.a_ready(cur);
    if constexpr (SP2) {
        PG8_STAGE(PG8_SB(0, 0), cB, voffB); PG8_STAGE(PG8_SB(0, 1), cB + hstep, voffB); PG8_STAGE(PG8_SA(0, 0), cA, voffA); PG8_STAGE(PG8_SA(0, 1), cA + hstep, voffA);
        if (wr == 1) PG8_BAR;
        PG8_WAIT_V(2); PG8_BAR;
        PG8_STAGE(PG8_SB(1, 0), cB + kstep, voffB); PG8_STAGE(PG8_SA(1, 0), cA + kstep, voffA); PG8_STAGE(PG8_SB(1, 1), cB + hstep + kstep, voffB);
        PG8_WAIT_V(6); PG8_BAR;
    } else {
        PG8_STAGE(PG8_SB(0, 0), cB, voffB); PG8_STAGE(PG8_SA(0, 0), cA, voffA); PG8_STAGE(PG8_SB(0, 1), cB + hstep, voffB); PG8_STAGE(PG8_SA(0, 1), cA + hstep, voffA);
        if (wr == 1) PG8_BAR;
        PG8_WAIT_V(4); PG8_BAR;
        PG8_STAGE(PG8_SB(1, 0), cB + kstep, voffB); PG8_STAGE(PG8_SA(1, 0), cA + kstep, voffA); PG8_STAGE(PG8_SB(1, 1), cB + hstep + kstep, voffB);
        PG8_WAIT_V(6); PG8_BAR;
    }
    for (;;) {
        const bool has_next = S.next(ui + 1, nxt);
        const char* nA = has_next ? (const char*)g.A + (size_t)nxt.pm * tstep : cA; const char* nB = has_next ? (const char*)g.Bt + (size_t)nxt.pn * tstep : cB;
        for (int t = 0; t < nt; t += 2) {
            const bool last = (t == nt - 2);
            const char* a1 = cA + (size_t)(t + 1) * kstep;
            const char* a2 = last ? nA : cA + (size_t)(t + 2) * kstep; const char* b2 = last ? nB : cB + (size_t)(t + 2) * kstep;
            const char* a3 = a2 + kstep; const char* b3 = b2 + kstep;
            if (last && has_next) S.a_ready(nxt);
            if constexpr (SP2) {
            PG8_LDB(B0, 0, 0); PG8_LDB(B1, 0, 1); PG8_SCHED; PG8_LDA(At, 0, 0); PG8_STAGE(PG8_SA(1, 1), a1 + hstep, voffA);
            PG8_WAIT_V(8); PG8_WAIT_L(0); PG8_BAR; PG8_MMA(0, 0, At, B0); PG8_MMA(0, 1, At, B1); PG8_BAR; PG8_SCHED;
            PG8_LDA(At, 0, 1); PG8_STAGE(PG8_SB(0, 0), b2, voffB); PG8_STAGE(PG8_SB(0, 1), b2 + hstep, voffB); PG8_STAGE(PG8_SA(0, 0), a2, voffA);
            PG8_WAIT_V(8); PG8_WAIT_L(0); PG8_BAR; PG8_MMA(1, 0, At, B0); PG8_MMA(1, 1, At, B1); PG8_BAR; PG8_SCHED;
            PG8_LDB(B0, 1, 0); PG8_LDB(B1, 1, 1); PG8_SCHED; PG8_LDA(At, 1, 0); PG8_STAGE(PG8_SA(0, 1), a2 + hstep, voffA);
            PG8_WAIT_V(8); PG8_WAIT_L(0); PG8_BAR; PG8_MMA(0, 0, At, B0); PG8_MMA(0, 1, At, B1); PG8_BAR; PG8_SCHED;
            PG8_LDA(At, 1, 1); PG8_STAGE(PG8_SB(1, 0), b3, voffB); PG8_STAGE(PG8_SB(1, 1), b3 + hstep, voffB); PG8_STAGE(PG8_SA(1, 0), a3, voffA);
            PG8_WAIT_V(8); PG8_WAIT_L(0); PG8_BAR; PG8_MMA(1, 0, At, B0); PG8_MMA(1, 1, At, B1); PG8_BAR; PG8_SCHED;
            } else {
            PG8_LDB(B0, 0, 0); PG8_SCHED; PG8_LDA(At, 0, 0); PG8_STAGE(PG8_SA(1, 1), a1 + hstep, voffA);
            PG8_WAIT_L(8); PG8_BAR; PG8_WAIT_L(0); PG8_MMA(0, 0, At, B0); PG8_BAR; PG8_SCHED;
            PG8_LDB(B1, 0, 1); PG8_STAGE(PG8_SB(0, 0), b2, voffB);
            PG8_BAR; PG8_WAIT_L(0); PG8_MMA(0, 1, At, B1); PG8_BAR;
            PG8_LDA(At, 0, 1); PG8_STAGE(PG8_SA(0, 0), a2, voffA);
            PG8_BAR; PG8_WAIT_L(0); PG8_MMA(1, 0, At, B0); PG8_BAR; PG8_SCHED;
            PG8_STAGE(PG8_SB(0, 1), b2 + hstep, voffB);
            PG8_WAIT_V(6); PG8_BAR; PG8_MMA(1, 1, At, B1); PG8_BAR;
            PG8_LDB(B0, 1, 0); PG8_SCHED; PG8_LDA(At, 1, 0); PG8_STAGE(PG8_SA(0, 1), a2 + hstep, voffA);
            PG8_WAIT_L(8); PG8_BAR; PG8_WAIT_L(0); PG8_MMA(0, 0, At, B0); PG8_BAR; PG8_SCHED;
            PG8_LDB(B1, 1, 1); PG8_STAGE(PG8_SB(1, 0), b3, voffB);
            PG8_BAR; PG8_WAIT_L(0); PG8_MMA(0, 1, At, B1); PG8_BAR;
            PG8_LDA(At, 1, 1); PG8_STAGE(PG8_SA(1, 0), a3, voffA);
            PG8_BAR; PG8_WAIT_L(0); PG8_MMA(1, 0, At, B0); PG8_BAR; PG8_SCHED;
            PG8_STAGE(PG8_SB(1, 1), b3 + hstep, voffB);
            PG8_WAIT_V(6); PG8_BAR; PG8_MMA(1, 1, At, B1); PG8_BAR;
            }
        }
        if constexpr (ALIGN_EPI) { if (wr == 0) PG8_BAR; }
        if constexpr (!Epi::AFTER_DRAIN) { E(acc, cur, wr, wc, fr, fq); S.done(cur); }
        if (!has_next) break;
#pragma unroll
        for (int a = 0; a < 2; ++a)
#pragma unroll
            for (int b = 0; b < 2; ++b)
#pragma unroll
                for (int m = 0; m < 4; ++m)
#pragma unroll
                    for (int n = 0; n < 2; ++n) acc[a][b][m][n] = (f32x4){0.f, 0.f, 0.f, 0.f};
        cur = nxt; cA = nA; cB = nB; ++ui;
        if constexpr (ALIGN_EPI) { if (wr == 1) PG8_BAR; }
    }
    PG8_WAIT_V(0);
    if constexpr (!ALIGN_EPI) { if (wr == 0) PG8_BAR; }
    PG8_BAR;
    if constexpr (Epi::AFTER_DRAIN) { E.fused(acc, cur, wr, wc, fr, fq, lds, wid, lane); S.done(cur); }
#undef PG8_SA
#undef PG8_SB
#undef PG8_STAGE
#undef PG8_LDA
#undef PG8_LDB
#undef PG8_MMA
#undef PG8_WAIT_V
#undef PG8_WAIT_L
#undef PG8_BAR
#undef PG8_SCHED
}
}
#define XB_TMO      128
#define XB_XCNT(j)  (256  + 64 * (j))
#define XB_XSUB(j)  (1280 + 64 * (j))
#define XB_XGEN(j)  (2304 + 64 * (j))
#define XB_TOP      3328
#define XB_TOPGEN   3392
#define XCD_BAR_WORDS 3456
#define XB_SPIN_CAP (1u << 18)
#define LAS __attribute__((address_space(3)))

__device__ __forceinline__ unsigned xb_ld(unsigned* p)              { return __hip_atomic_load(p, __ATOMIC_RELAXED, __HIP_MEMORY_SCOPE_AGENT); }
__device__ __forceinline__ unsigned xb_add(unsigned* p, unsigned v) { return __hip_atomic_fetch_add(p, v, __ATOMIC_RELAXED, __HIP_MEMORY_SCOPE_AGENT); }
__device__ __forceinline__ unsigned xb_xcc_id() { return (unsigned)__builtin_amdgcn_s_getreg((3 << 11) | 20) & 0xFu; }
#define XB_SPIN(cond, bar) do { unsigned _sp = 0; while (cond) { __builtin_amdgcn_s_sleep(1); \
    if ((++_sp & 255u) == 0u) { if (xb_ld(&(bar)[XB_TMO])) break; if (_sp > XB_SPIN_CAP) { atomicAdd(&(bar)[XB_TMO], 1u); break; } } } } while (0)

struct XcdBarrier {
    unsigned* bar; unsigned x;
    volatile LAS unsigned* st;
};

__device__ __forceinline__ XcdBarrier xcd_barrier_post(unsigned* bar, volatile LAS unsigned* st) {
    XcdBarrier b; b.bar = bar; b.x = xb_xcc_id(); b.st = st;
    if (threadIdx.x == 0) (void)xb_add(&bar[XB_XCNT(b.x)], 1u);
    return b;
}
__device__ __forceinline__ void xcd_barrier_complete(unsigned* bar, unsigned x, unsigned& nloc, unsigned& nx) {
    const unsigned G = gridDim.x * gridDim.y * gridDim.z;
    unsigned sum, cnt, mine, sp = 0u;
    for (;;) {
        sum = 0u; cnt = 0u; mine = 0u;
#pragma unroll
        for (unsigned j = 0; j < 16; ++j) { const unsigned c = xb_ld(&bar[XB_XCNT(j)]); sum += c; cnt += (c > 0u) ? 1u : 0u; mine = (j == x) ? c : mine; }
        if (sum == G) break;
        __builtin_amdgcn_s_sleep(1);
        if ((++sp & 255u) == 0u) { if (xb_ld(&bar[XB_TMO])) break; if (sp > XB_SPIN_CAP) { atomicAdd(&bar[XB_TMO], 1u); break; } }
    }
    nloc = mine > 0u ? mine : 1u; nx = cnt > 0u ? cnt : 1u;
}

__device__ __forceinline__ void xcd_barrier(const XcdBarrier& b) {
    asm volatile("s_waitcnt vmcnt(0)" ::: "memory");
    __syncthreads();
    if (threadIdx.x == 0) {
        unsigned* bar = b.bar;
        __builtin_amdgcn_s_waitcnt(0);
        unsigned nloc = b.st[0], nx = b.st[1];
        if (nloc == 0u) { xcd_barrier_complete(bar, b.x, nloc, nx); b.st[0] = nloc; b.st[1] = nx; }
        const unsigned old = xb_add(&bar[XB_XSUB(b.x)], 1u);
        const unsigned gen = old / nloc;
        if (old + 1u == (gen + 1u) * nloc) {
            __builtin_amdgcn_fence(__ATOMIC_RELEASE, "agent");
            asm volatile("s_waitcnt vmcnt(0)" ::: "memory");
            const unsigned og = xb_add(&bar[XB_TOP], 1u);
            const unsigned tg = og / nx;
            if (og + 1u == (tg + 1u) * nx) xb_add(&bar[XB_TOPGEN], 1u);
            else XB_SPIN(xb_ld(&bar[XB_TOPGEN]) == tg, bar);
            __builtin_amdgcn_fence(__ATOMIC_ACQUIRE, "agent");
            xb_add(&bar[XB_XGEN(b.x)], 1u);
            asm volatile("s_waitcnt vmcnt(0)" ::: "memory");
        } else {
            XB_SPIN(xb_ld(&bar[XB_XGEN(b.x)]) == gen, bar);
            __builtin_amdgcn_fence(__ATOMIC_ACQUIRE, "agent");
            asm volatile("s_waitcnt vmcnt(0)" ::: "memory");
        }
    }
    __syncthreads();
}


using pg8::bf16_t; using pg8::bf16x8; using pg8::f32x4; using pg8::u32x4;
typedef _Float16 f16x8 __attribute__((ext_vector_type(8)));
typedef float f32x16 __attribute__((ext_vector_type(16)));
typedef unsigned u32x2 __attribute__((ext_vector_type(2)));
#define DI __device__ __forceinline__

constexpr int NWAVES = 8, NTHR = 512;
constexpr int SEQ = 8192, MTOK = 16384, DM = 4096, DFF = 11008;
constexpr int N_A = 18432, N_B = 10400, N_BP = 10496;
constexpr float LN_EPS = 1e-5f;
constexpr float ALPHA = 1.41421356237309515f;
constexpr float SM_C = 0.08838834764831845f * 1.4426950408889634f;
constexpr float SM_SCALE = 0.08838834764831845f;

constexpr size_t MiB = (size_t)1 << 20;
constexpr size_t WS_CTL = 0, CTL_ZERO_BYTES = 1 * MiB;
constexpr size_t WS_COS = 1 * MiB, WS_SIN = 5 * MiB;
constexpr size_t WS_W = 9 * MiB;
constexpr size_t W0IN = WS_W, W0OUT = WS_W + 144 * MiB, W0GU = WS_W + 160 * MiB, W0DN = WS_W + 332 * MiB;
constexpr size_t W1IN = WS_W, W1OUT = WS_W + 82 * MiB, W1GU = WS_W + 114 * MiB, W1DN = WS_W + 286 * MiB;
constexpr size_t WS_XB = 427 * MiB, WS_XA = 555 * MiB, WS_BIG = 811 * MiB, WS_END = (811 + 835) * MiB;
constexpr size_t B_QKV0 = WS_BIG, B_OG = WS_BIG + 576 * MiB, B_LSE = WS_BIG + 768 * MiB, B_AO0 = WS_BIG + 771 * MiB;
constexpr size_t B_Y = WS_BIG + 360 * MiB, B_H = WS_BIG;
constexpr size_t B_Q1 = WS_BIG, B_K1 = WS_BIG + 128 * MiB, B_V1 = WS_BIG + 160 * MiB, B_QI = WS_BIG + 192 * MiB, B_KIR = WS_BIG + 320 * MiB, B_KI16 = WS_BIG + 328 * MiB,
                 B_WI = WS_BIG + 332 * MiB, B_SC = WS_BIG + 334 * MiB, B_IDX = WS_BIG + 594 * MiB, B_AO1 = WS_BIG + 640 * MiB;
constexpr int LDS_BYTES = 147456, MISC_OFF = 131072;

DI float wave_sum(float v) { v += __shfl_xor(v, 1); v += __shfl_xor(v, 2); v += __shfl_xor(v, 4); v += __shfl_xor(v, 8); v += __shfl_xor(v, 16); v += __shfl_xor(v, 32); return v; }
DI int sigma_inv(int d) { return 32 * ((d >> 4) & 3) + 8 * ((d >> 2) & 3) + 4 * (d >> 6) + (d & 3); }

struct MapId { DI long operator()(int c) const { return c; } };
struct MapA  { DI long operator()(int c) const { const int d = c & 127; return (c < 2 * 6144) ? (long)(c - d + sigma_inv(d)) : (long)c; } };
struct MapB  { DI long operator()(int c) const { const int d = c & 127; const bool rp = (c < 5120) || (c >= 6144 && c < 10240); return rp ? (long)(c - d + sigma_inv(d)) : (long)c; } };
struct MapGU { int up; DI long operator()(int c) const { return (long)((c >> 7) * 256 + up * 128 + (c & 127)); } };

template <class Map>
DI void wt_item(const float* __restrict__ W, int K, int N, bf16_t* __restrict__ WT, int item, const Map map, LAS float* scr, int tid) {
    const int nct = (N + 255) >> 8; const int kt = item / nct, ct = item - kt * nct; const int k0 = kt * 64, c0 = ct * 256;
    const int cq = tid & 63, kr0 = tid >> 6;
    f32x4 v[8]; const bool cok = (c0 + 4 * cq) < N;
#pragma unroll
    for (int i = 0; i < 8; ++i) v[i] = cok ? *(const f32x4*)(W + (size_t)(k0 + kr0 + 8 * i) * N + c0 + 4 * cq) : (f32x4){0.f, 0.f, 0.f, 0.f};
    __syncthreads();
#pragma unroll
    for (int i = 0; i < 8; ++i) *(LAS f32x4*)(scr + (kr0 + 8 * i) * 260 + 4 * cq) = v[i];
    __syncthreads();
    const int c = tid >> 1, kc = tid & 1;
    if (c0 + c < N) {
        bf16_t* dst = WT + (size_t)map(c0 + c) * K + k0 + 32 * kc;
#pragma unroll
        for (int q = 0; q < 4; ++q) { float f[8];
#pragma unroll
            for (int j = 0; j < 8; ++j) f[j] = scr[(32 * kc + 8 * q + j) * 260 + c];
            u32x4 o; o.x = pg8::cvt_pk_bf16(f[0], f[1]); o.y = pg8::cvt_pk_bf16(f[2], f[3]); o.z = pg8::cvt_pk_bf16(f[4], f[5]); o.w = pg8::cvt_pk_bf16(f[6], f[7]);
            *(u32x4*)(dst + 8 * q) = o; }
    }
}
template <class Map>
DI void wt_matrix(const float* W, int K, int N, bf16_t* WT, const Map map, LAS float* scr, int tid, int bid, int G) {
    const int nitems = (K >> 6) * ((N + 255) >> 8);
    for (int it = bid; it < nitems; it += G) wt_item(W, K, N, WT, it, map, scr, tid);
}

DI void rope_sincos(int pos, int f, float& cs, float& sn) {
    const double r1 = 0.8659643233600653; double inv = 1.0, rp = r1;
#pragma unroll
    for (int b = 0; b < 6; ++b) { if ((f >> b) & 1) inv *= rp; rp *= rp; }
    const double ang = (double)pos * inv;
    const double q = __builtin_rint(ang * 0.63661977236758134308);
    double r = __builtin_fma(-q, 1.57079632679489655800e+00, ang); r = __builtin_fma(-q, 6.12323399573676603587e-17, r);
    const double z = r * r;
    const double ps = r + r * z * (-1.66666666666666324348e-01 + z * (8.33333333332248946124e-03 + z * (-1.98412698298579493134e-04 + z * (2.75573137070700676789e-06 + z * (-2.50507602534068634195e-08 + z * 1.58969099521155010221e-10)))));
    const double pc = 1.0 - 0.5 * z + z * z * (4.16666666666666019037e-02 + z * (-1.38888888888741095749e-03 + z * (2.48015872894767294178e-05 + z * (-2.75573143513906633035e-07 + z * (2.08757232129817482790e-09 + z * -1.13596475577881948265e-11)))));
    const int qi = ((int)(long long)q) & 3;
    const double s = (qi == 0) ? ps : (qi == 1) ? pc : (qi == 2) ? -ps : -pc;
    const double c = (qi == 0) ? pc : (qi == 1) ? -ps : (qi == 2) ? -pc : ps;
    cs = (float)c; sn = (float)s;
}

DI void cvt_x_phase(const float* X, bf16_t* XB, int tid, int bid, int G) {
    const size_t n8 = (size_t)MTOK * DM / 8;
    for (size_t i = (size_t)bid * NTHR + tid; i < n8; i += (size_t)G * NTHR) {
        const f32x4 a = *(const f32x4*)(X + i * 8), b = *(const f32x4*)(X + i * 8 + 4);
        u32x4 o; o.x = pg8::cvt_pk_bf16(a[0], a[1]); o.y = pg8::cvt_pk_bf16(a[2], a[3]); o.z = pg8::cvt_pk_bf16(b[0], b[1]); o.w = pg8::cvt_pk_bf16(b[2], b[3]);
        *(u32x4*)(XB + i * 8) = o; }
}
DI void rope_tab_phase(const int* pos, float* CS, float* SN, int tid, int bid, int G) {
    for (int e = bid * NTHR + tid; e < MTOK * 64; e += G * NTHR) { float c, s; rope_sincos(pos[e >> 6], e & 63, c, s); CS[e] = c; SN[e] = s; }
}

DI void ln_phase(const float* Y, const float* gain, const float* bias, float* Xo, bf16_t* XBo, int tid, int bid, int G) {
    const int lane = tid & 63, gw = bid * NWAVES + (tid >> 6), nw = G * NWAVES;
    for (int row = gw; row < MTOK; row += nw) {
        const float* yr = Y + (size_t)row * DM; f32x4 v[16]; float s = 0.f;
#pragma unroll
        for (int j = 0; j < 16; ++j) { v[j] = *(const f32x4*)(yr + (j * 64 + lane) * 4); s += (v[j][0] + v[j][1]) + (v[j][2] + v[j][3]); }
        const float mean = wave_sum(s) * (1.0f / DM); float q = 0.f;
#pragma unroll
        for (int j = 0; j < 16; ++j) { v[j] = v[j] - mean; q += (v[j][0] * v[j][0] + v[j][1] * v[j][1]) + (v[j][2] * v[j][2] + v[j][3] * v[j][3]); }
        const float rstd = 1.0f / sqrtf(wave_sum(q) * (1.0f / DM) + LN_EPS);
#pragma unroll
        for (int j = 0; j < 16; ++j) { const int c = (j * 64 + lane) * 4; const f32x4 g = *(const f32x4*)(gain + c), b = *(const f32x4*)(bias + c); const f32x4 o = v[j] * rstd * g + b;
            *(f32x4*)(Xo + (size_t)row * DM + c) = o;
            if (XBo) { u32x2 w; w.x = pg8::cvt_pk_bf16(o[0], o[1]); w.y = pg8::cvt_pk_bf16(o[2], o[3]); *(u32x2*)(XBo + (size_t)row * DM + c) = w; } }
    }
}

DI bf16x8 ldg_bf16x8(const bf16_t* p) { return *(const bf16x8*)p; }
constexpr int VT_ROWB = 528;
DI void attn0_phase(const bf16_t* QKV, bf16_t* OG, float* LSE, LAS unsigned char* lds, int tid, int bid, int G) {
    const int lane = tid & 63, w = __builtin_amdgcn_readfirstlane(tid >> 6), n = lane & 15, g4 = lane >> 4;
    LAS unsigned char* vt = lds;
    const size_t GS = (size_t)MTOK * 2048;
    for (int u = bid; u < 6144; u += G) {
        const int h = u & 15, blk = (u >> 4) & 63, b = (u >> 10) & 1, grp = u >> 11;
        const int dsh = 2 * grp, d = 1 << dsh, r = blk >> (6 - dsh), nb = blk & ((64 >> dsh) - 1);
        const bf16_t* Qg = QKV + (size_t)(0 + grp) * GS; const bf16_t* Kg = QKV + (size_t)(3 + grp) * GS; const bf16_t* Vg = QKV + (size_t)(6 + grp) * GS;
        const size_t tok0 = (size_t)b * SEQ + r;
        __syncthreads();
        {
            const int kp = tid & 127, qd = tid >> 7; const int l0 = (nb - 1) * 128 + 2 * kp;
            u32x4 va[4], vb[4];
            if (l0 >= 0) { const bf16_t* p0 = Vg + (tok0 + (size_t)l0 * d) * 2048 + h * 128 + 32 * qd; const bf16_t* p1 = p0 + (size_t)d * 2048;
#pragma unroll
                for (int i = 0; i < 4; ++i) { va[i] = *(const u32x4*)(p0 + 8 * i); vb[i] = *(const u32x4*)(p1 + 8 * i); } }
            else {
#pragma unroll
                for (int i = 0; i < 4; ++i) { va[i] = (u32x4){0u, 0u, 0u, 0u}; vb[i] = (u32x4){0u, 0u, 0u, 0u}; } }
#pragma unroll
            for (int i = 0; i < 4; ++i)
#pragma unroll
                for (int e = 0; e < 4; ++e) { const unsigned a = va[i][e], bb = vb[i][e]; const int dim = 32 * qd + 8 * i + 2 * e;
                    *(LAS unsigned*)(vt + dim * VT_ROWB + kp * 4) = (a & 0xffffu) | (bb << 16);
                    *(LAS unsigned*)(vt + (dim + 1) * VT_ROWB + kp * 4) = (a >> 16) | (bb & 0xffff0000u); }
        }
        __syncthreads();
        const int iq = 16 * w + n, lq = nb * 128 + iq;
        const size_t qtok = tok0 + (size_t)lq * d;
        bf16x8 qf[4];
        { const bf16_t* qp = Qg + qtok * 2048 + h * 128 + 8 * g4;
#pragma unroll
          for (int ks = 0; ks < 4; ++ks) qf[ks] = ldg_bf16x8(qp + 32 * ks); }
        f32x4 s[9];
#pragma unroll
        for (int tt = 0; tt < 9; ++tt) {
            const int kf = 16 * (w + tt) + n, lk = (nb - 1) * 128 + kf;
            bf16x8 kfr[4];
            if (lk >= 0) { const bf16_t* kp_ = Kg + (tok0 + (size_t)lk * d) * 2048 + h * 128 + 8 * g4;
#pragma unroll
                for (int ks = 0; ks < 4; ++ks) kfr[ks] = ldg_bf16x8(kp_ + 32 * ks); }
            else {
#pragma unroll
                for (int ks = 0; ks < 4; ++ks) kfr[ks] = (bf16x8){0, 0, 0, 0, 0, 0, 0, 0}; }
            f32x4 a = {0.f, 0.f, 0.f, 0.f};
#pragma unroll
            for (int ks = 0; ks < 4; ++ks) a = __builtin_amdgcn_mfma_f32_16x16x32_bf16(kfr[ks], qf[ks], a, 0, 0, 0);
            s[tt] = a;
        }
        float mx = -__builtin_inff();
#pragma unroll
        for (int tt = 0; tt < 9; ++tt)
#pragma unroll
            for (int j = 0; j < 4; ++j) { const int kf = 16 * (w + tt) + 4 * g4 + j; const bool ok = (kf >= iq) && (kf <= iq + 128) && (nb > 0 || kf >= 128);
                const float x = ok ? s[tt][j] : -__builtin_inff(); s[tt][j] = x; mx = fmaxf(mx, x); }
        mx = fmaxf(mx, __shfl_xor(mx, 16)); mx = fmaxf(mx, __shfl_xor(mx, 32));
        const float msc = mx * SM_C; float lsum = 0.f;
#pragma unroll
        for (int tt = 0; tt < 9; ++tt)
#pragma unroll
            for (int j = 0; j < 4; ++j) { const float p = __builtin_amdgcn_exp2f(s[tt][j] * SM_C - msc); s[tt][j] = p; lsum += p; }
        lsum += __shfl_xor(lsum, 16); lsum += __shfl_xor(lsum, 32);
        f32x4 o[8];
#pragma unroll
        for (int dt = 0; dt < 8; ++dt) o[dt] = (f32x4){0.f, 0.f, 0.f, 0.f};
#pragma unroll
        for (int kk = 0; kk < 5; ++kk) {
            const int t0 = 2 * kk, t1 = 2 * kk + 1;
            u32x4 pw; pw.x = pg8::cvt_pk_bf16(s[t0][0], s[t0][1]); pw.y = pg8::cvt_pk_bf16(s[t0][2], s[t0][3]);
            if (t1 < 9) { pw.z = pg8::cvt_pk_bf16(s[t1 < 9 ? t1 : 8][0], s[t1 < 9 ? t1 : 8][1]); pw.w = pg8::cvt_pk_bf16(s[t1 < 9 ? t1 : 8][2], s[t1 < 9 ? t1 : 8][3]); } else { pw.z = 0u; pw.w = 0u; }
            const bf16x8 pf = __builtin_bit_cast(bf16x8, pw);
            int T1 = w + t1; T1 = T1 > 15 ? 15 : T1;
            const int off0 = (16 * (w + t0) + 4 * g4) * 2, off1 = (16 * T1 + 4 * g4) * 2;
#pragma unroll
            for (int dt = 0; dt < 8; ++dt) { const LAS unsigned char* rowp = vt + (16 * dt + n) * VT_ROWB;
                const u32x2 lo = *(const LAS u32x2*)(rowp + off0), hi = *(const LAS u32x2*)(rowp + off1);
                u32x4 vv; vv.x = lo.x; vv.y = lo.y; vv.z = hi.x; vv.w = hi.y;
                o[dt] = __builtin_amdgcn_mfma_f32_16x16x32_bf16(__builtin_bit_cast(bf16x8, vv), pf, o[dt], 0, 0, 0); }
        }
        const float inv = 1.0f / lsum;
        bf16_t* op = OG + (size_t)grp * GS + qtok * 2048 + h * 128 + 4 * g4;
#pragma unroll
        for (int dt = 0; dt < 8; ++dt) { u32x2 wv; wv.x = pg8::cvt_pk_bf16(o[dt][0] * inv, o[dt][1] * inv); wv.y = pg8::cvt_pk_bf16(o[dt][2] * inv, o[dt][3] * inv); *(u32x2*)(op + 16 * dt) = wv; }
        if (g4 == 0) LSE[(size_t)grp * (MTOK * 16) + qtok * 16 + h] = mx * SM_SCALE + __logf(lsum);
    }
}

DI void merge_phase(const bf16_t* OG, const float* LSE, bf16_t* AO, int tid, int bid, int G) {
    const int lane = tid & 63, gw = bid * NWAVES + (tid >> 6), nw = G * NWAVES; const size_t GS = (size_t)MTOK * 2048;
    for (int tok = gw; tok < MTOK; tok += nw) {
#pragma unroll
        for (int it = 0; it < 4; ++it) { const int e = it * 512 + lane * 8, h = e >> 7;
            const float l0 = LSE[(size_t)tok * 16 + h], l1 = LSE[(size_t)(MTOK * 16) + (size_t)tok * 16 + h], l2 = LSE[(size_t)(2 * MTOK * 16) + (size_t)tok * 16 + h];
            const float mx = fmaxf(l0, fmaxf(l1, l2)); const float e0 = __expf(l0 - mx), e1 = __expf(l1 - mx), e2 = __expf(l2 - mx); const float inv = 1.0f / (e0 + e1 + e2);
            const float w0 = e0 * inv, w1 = e1 * inv, w2 = e2 * inv;
            const u32x4 a = *(const u32x4*)(OG + (size_t)tok * 2048 + e), b = *(const u32x4*)(OG + GS + (size_t)tok * 2048 + e), c = *(const u32x4*)(OG + 2 * GS + (size_t)tok * 2048 + e);
            u32x4 o;
#pragma unroll
            for (int k = 0; k < 4; ++k) { const float lo = w0 * __uint_as_float(a[k] << 16) + w1 * __uint_as_float(b[k] << 16) + w2 * __uint_as_float(c[k] << 16);
                const float hi = w0 * __uint_as_float(a[k] & 0xffff0000u) + w1 * __uint_as_float(b[k] & 0xffff0000u) + w2 * __uint_as_float(c[k] & 0xffff0000u);
                o[k] = pg8::cvt_pk_bf16(lo, hi); }
            *(u32x4*)(AO + (size_t)tok * 2048 + e) = o; }
    }
}

DI void kidx_phase(const float* KIR, const float* gain, const float* bias, const float* CS, const float* SN, unsigned short* KI16, int tid, int bid, int G) {
    const int lane = tid & 63, gw = bid * NWAVES + (tid >> 6), nw = G * NWAVES;
    const float g1 = gain[lane], g2 = gain[lane + 64], b1 = bias[lane], b2 = bias[lane + 64];
    const int j1 = sigma_inv(lane);
    for (int tok = gw; tok < MTOK; tok += nw) {
        const float x1 = KIR[(size_t)tok * 128 + lane], x2 = KIR[(size_t)tok * 128 + 64 + lane];
        const float mean = wave_sum(x1 + x2) * (1.0f / 128.0f); const float d1 = x1 - mean, d2 = x2 - mean;
        const float rstd = 1.0f / sqrtf(wave_sum(d1 * d1 + d2 * d2) * (1.0f / 128.0f) + LN_EPS);
        const float y1 = d1 * rstd * g1 + b1, y2 = d2 * rstd * g2 + b2;
        const float c = CS[(size_t)tok * 64 + lane], s = SN[(size_t)tok * 64 + lane];
        const _Float16 o1 = (_Float16)(y1 * c - y2 * s), o2 = (_Float16)(y2 * c + y1 * s);
        KI16[(size_t)tok * 128 + j1] = __builtin_bit_cast(unsigned short, o1); KI16[(size_t)tok * 128 + j1 + 4] = __builtin_bit_cast(unsigned short, o2);
    }
}

constexpr int KT_ROWB = 272, KT_BYTES = 64 * KT_ROWB;
DI size_t sc_row_off(int b, int s) { const int qb = s >> 7; return ((size_t)(b * 2080 + ((qb * (qb + 1)) >> 1))) * 16384 + (size_t)(s & 127) * ((qb + 1) * 128); }
DI void indexer_phase(const unsigned short* QI, const unsigned short* KI16, const float* WI, float* SC, LAS unsigned char* lds, int tid, int bid, int G) {
    const int lane = tid & 63, w = __builtin_amdgcn_readfirstlane(tid >> 6), r32 = lane & 31, h2 = lane >> 5;
    for (int v = bid; v < 256; v += G) {
        for (int it = 0; it < 4; ++it) {
            const int b = it >> 1, gi = (it & 1) ? (511 - v) : v; const int tb = 16 * gi;
            const int ntiles = ((tb + 15) >> 6) + 1;
            f16x8 af[2][8]; f32x4 wv[2][4];
#pragma unroll
            for (int tq = 0; tq < 2; ++tq) { const size_t tg = (size_t)b * SEQ + tb + 2 * w + tq;
#pragma unroll
                for (int ks = 0; ks < 8; ++ks) af[tq][ks] = *(const f16x8*)(QI + tg * 4096 + r32 * 128 + 16 * ks + 8 * h2);
#pragma unroll
                for (int q = 0; q < 4; ++q) wv[tq][q] = *(const f32x4*)(WI + tg * 32 + 8 * q + 4 * h2); }
            const unsigned short* KIb = KI16 + (size_t)b * SEQ * 128;
            const int key0 = tid >> 4, ch = tid & 15;
            u32x4 st0, st1;
            st0 = *(const u32x4*)(KIb + (size_t)key0 * 128 + ch * 8); st1 = *(const u32x4*)(KIb + (size_t)(key0 + 32) * 128 + ch * 8);
            __syncthreads();
            for (int kt = 0; kt < ntiles; ++kt) {
                LAS unsigned char* buf = lds + (kt & 1) * KT_BYTES;
                *(LAS u32x4*)(buf + key0 * KT_ROWB + ch * 16) = st0; *(LAS u32x4*)(buf + (key0 + 32) * KT_ROWB + ch * 16) = st1;
                __syncthreads();
                if (kt + 1 < ntiles) { const unsigned short* src = KIb + (size_t)((kt + 1) * 64 + key0) * 128 + ch * 8; st0 = *(const u32x4*)src; st1 = *(const u32x4*)(src + 32 * 128); }
#pragma unroll
                for (int sub = 0; sub < 2; ++sub) {
                    f16x8 bfr[8];
#pragma unroll
                    for (int ks = 0; ks < 8; ++ks) bfr[ks] = *(const LAS f16x8*)(buf + (32 * sub + r32) * KT_ROWB + (16 * ks + 8 * h2) * 2);
#pragma unroll
                    for (int tq = 0; tq < 2; ++tq) {
                        f32x16 c;
#pragma unroll
                        for (int i = 0; i < 16; ++i) c[i] = 0.f;
#pragma unroll
                        for (int ks = 0; ks < 8; ++ks) c = __builtin_amdgcn_mfma_f32_32x32x16_f16(af[tq][ks], bfr[ks], c, 0, 0, 0);
                        float sc = 0.f;
#pragma unroll
                        for (int q = 0; q < 4; ++q)
#pragma unroll
                            for (int e = 0; e < 4; ++e) sc += wv[tq][q][e] * fmaxf(c[4 * q + e], 0.f);
                        sc += __shfl_xor(sc, 32);
                        if (h2 == 0) SC[sc_row_off(b, tb + 2 * w + tq) + kt * 64 + 32 * sub + r32] = sc;
                    }
                }
            }
        }
    }
}

DI unsigned mbcnt64(unsigned long long m) { return __builtin_amdgcn_mbcnt_hi((unsigned)(m >> 32), __builtin_amdgcn_mbcnt_lo((unsigned)m, 0u)); }
DI unsigned f2key(float f) { const unsigned u = __float_as_uint(f); return (u & 0x80000000u) ? ~u : (u | 0x80000000u); }
template <int NV>
DI void topk_row(const float* row, int s, int* out, int lane) {
    unsigned key[NV];
    { const unsigned long long ra = (unsigned long long)row; const unsigned rlo = __builtin_amdgcn_readfirstlane((unsigned)ra), rhi = __builtin_amdgcn_readfirstlane((unsigned)(ra >> 32));
      row = (const float*)(((unsigned long long)rhi << 32) | rlo); }
#pragma unroll
    for (int jo = 0; jo < NV / 16; ++jo) { const float* rb = row + jo * 1024;
#pragma unroll
        for (int ji = 0; ji < 16; ++ji) { const int j = jo * 16 + ji; const unsigned u = f2key(rb[ji * 64 + lane]); key[j] = (j * 64 + lane <= s) ? u : 0u; } }
    unsigned T = 0u;
#pragma unroll 1
    for (int bit = 31; bit >= 0; --bit) {
        const unsigned cand = T | (1u << bit); int cnt = 0;
#pragma unroll
        for (int j = 0; j < NV; ++j) cnt += __builtin_popcountll(__ballot(key[j] >= cand));
        if (cnt >= 256) T = cand;
    }
    int cgt = 0;
#pragma unroll
    for (int j = 0; j < NV; ++j) cgt += __builtin_popcountll(__ballot(key[j] > T));
    int bgt = 0, beq = cgt;
    const int nch = (s >> 6) + 1;
#pragma unroll 1
    for (int j = 0; j < nch; ++j) { const int k = j * 64 + lane; const unsigned u = (k <= s) ? f2key(row[k]) : 0u;
        const bool sg = u > T, se = u == T; const unsigned long long mg = __ballot(sg), me = __ballot(se);
        const int pg = bgt + (int)mbcnt64(mg), pe = beq + (int)mbcnt64(me);
        if (sg) out[pg] = k; else if (se && pe < 256) out[pe] = k;
        bgt += __builtin_popcountll(mg); beq += __builtin_popcountll(me); }
}
DI void topk_phase(const float* SC, int* IDX, int tid, int bid, int G) {
    const int lane = tid & 63, gw = bid * NWAVES + (tid >> 6), nw = G * NWAVES;
    for (int t = gw; t < MTOK; t += nw) {
        const int b = t >> 13, s = t & 8191; int* out = IDX + (size_t)t * 256;
        if (s < 256) {
#pragma unroll
            for (int i = 0; i < 4; ++i) { const int j = lane + 64 * i; out[j] = (j <= s) ? j : 0; }
        } else {
            const float* row = SC + sc_row_off(b, s);
            if (s < 2048) topk_row<32>(row, s, out, lane);
            else if (s < 4096) topk_row<64>(row, s, out, lane);
            else if (s < 6144) topk_row<96>(row, s, out, lane);
            else topk_row<128>(row, s, out, lane);
        }
    }
}

DI void dsa_attn_phase(const bf16_t* Q1, const bf16_t* K1, const bf16_t* V1, const int* IDX, bf16_t* AO, LAS unsigned char* lds, int tid, int bid, int G) {
    const int lane = tid & 63, w = __builtin_amdgcn_readfirstlane(tid >> 6), n = lane & 15, g4 = lane >> 4;
    LAS float* pw = (LAS float*)(lds + w * 5120); LAS int* iw = (LAS int*)(lds + w * 5120 + 4096);
    const bool xm = (G & 7) == 0;
    const int start = xm ? ((bid >> 3) * NWAVES + w) : (bid * NWAVES + w), step = xm ? ((G >> 3) * NWAVES) : (G * NWAVES), total = xm ? MTOK : MTOK * 8;
    for (int it = start; it < total; it += step) {
        const int kvh = xm ? (bid & 7) : (it & 7), t = xm ? it : (it >> 3);
        const int b = t >> 13, s = t & 8191; const int nvalid = s + 1 < 256 ? s + 1 : 256;
        const int* ip = IDX + (size_t)t * 256;
#pragma unroll
        for (int i = 0; i < 4; ++i) iw[lane + 64 * i] = ip[lane + 64 * i];
        int kidx[16];
#pragma unroll
        for (int tt = 0; tt < 16; ++tt) kidx[tt] = ip[16 * tt + n];
        const bf16_t* Kb = K1 + (size_t)(b * 8 + kvh) * SEQ * 128; const bf16_t* Vb = V1 + (size_t)(b * 8 + kvh) * SEQ * 128;
        bf16x8 qf[4];
#pragma unroll
        for (int ks = 0; ks < 4; ++ks) qf[ks] = (n < 4) ? ldg_bf16x8(Q1 + (size_t)t * 4096 + (4 * kvh + n) * 128 + 32 * ks + 8 * g4) : (bf16x8){0, 0, 0, 0, 0, 0, 0, 0};
        f32x4 sa[16];
#pragma unroll
        for (int tt = 0; tt < 16; ++tt) { const bf16_t* kp = Kb + (size_t)kidx[tt] * 128 + 8 * g4; f32x4 a = {0.f, 0.f, 0.f, 0.f};
#pragma unroll
            for (int ks = 0; ks < 4; ++ks) a = __builtin_amdgcn_mfma_f32_16x16x32_bf16(ldg_bf16x8(kp + 32 * ks), qf[ks], a, 0, 0, 0);
            sa[tt] = a; }
        float mx = -__builtin_inff();
#pragma unroll
        for (int tt = 0; tt < 16; ++tt)
#pragma unroll
            for (int j = 0; j < 4; ++j) { const int kk = 16 * tt + 4 * g4 + j; const float x = (kk < nvalid) ? sa[tt][j] : -__builtin_inff(); sa[tt][j] = x; mx = fmaxf(mx, x); }
        mx = fmaxf(mx, __shfl_xor(mx, 16)); mx = fmaxf(mx, __shfl_xor(mx, 32));
        const float msc = mx * SM_C; float lsum = 0.f;
#pragma unroll
        for (int tt = 0; tt < 16; ++tt)
#pragma unroll
            for (int j = 0; j < 4; ++j) { const float p = __builtin_amdgcn_exp2f(sa[tt][j] * SM_C - msc); lsum += p; if (n < 4) pw[(16 * tt + 4 * g4 + j) * 4 + n] = p; }
        lsum += __shfl_xor(lsum, 16); lsum += __shfl_xor(lsum, 32);
        float acc[4][2];
#pragma unroll
        for (int hh = 0; hh < 4; ++hh) { acc[hh][0] = 0.f; acc[hh][1] = 0.f; }
        for (int k0 = 0; k0 < 256; k0 += 8) {
            unsigned vv[8];
#pragma unroll
            for (int e = 0; e < 8; ++e) { const int row = iw[k0 + e]; vv[e] = *(const unsigned*)(Vb + (size_t)row * 128 + 2 * lane); }
#pragma unroll
            for (int e = 0; e < 8; ++e) { const f32x4 p4 = *(const LAS f32x4*)(pw + (k0 + e) * 4); const float v0 = __uint_as_float(vv[e] << 16), v1 = __uint_as_float(vv[e] & 0xffff0000u);
#pragma unroll
                for (int hh = 0; hh < 4; ++hh) { acc[hh][0] += p4[hh] * v0; acc[hh][1] += p4[hh] * v1; } }
        }
#pragma unroll
        for (int hh = 0; hh < 4; ++hh) { const float li = 1.0f / __shfl(lsum, hh);
            *(unsigned*)(AO + (size_t)t * 4096 + (4 * kvh + hh) * 128 + 2 * lane) = pg8::cvt_pk_bf16(acc[hh][0] * li, acc[hh][1] * li); }
    }
}

#ifndef MK_ONE_LAUNCH
#define MK_ONE_LAUNCH 0
#endif
constexpr int N_PHASES = 19;
struct Args { const float* in[22]; float* out; unsigned char* ws; int ph_lo, ph_hi; };

__global__ void __launch_bounds__(NTHR, 2) mk_fwd(Args args) {
    extern __shared__ __attribute__((aligned(16))) unsigned char lds_raw[];
    LAS unsigned char* lds = (LAS unsigned char*)lds_raw;
    const int tid = threadIdx.x, bid = blockIdx.x, G = gridDim.x;
    unsigned char* ws = args.ws;
    volatile LAS unsigned* misc = (volatile LAS unsigned*)(lds + MISC_OFF);
    if (tid < 4) misc[tid] = 0u;
    __syncthreads();
    const int lo = args.ph_lo, hi = args.ph_hi;
    XcdBarrier bar; bar.bar = (unsigned*)(ws + WS_CTL); bar.x = 0; bar.st = nullptr;
    if (hi - lo > 1) bar = xcd_barrier_post((unsigned*)(ws + WS_CTL), misc);
#ifndef PH_MASK
#define PH_MASK 0x7ffff
#endif
#define IN(k) ((((PH_MASK) >> (k)) & 1) && lo <= (k) && (k) < hi)
#define SEAM(k) do { if (IN(k) && IN((k) + 1)) xcd_barrier(bar); } while (0)

    const float* x0 = args.in[0]; const int* positions = (const int*)args.in[1];
    float* CS = (float*)(ws + WS_COS); float* SN = (float*)(ws + WS_SIN);
    bf16_t* XB = (bf16_t*)(ws + WS_XB); float* XA = (float*)(ws + WS_XA); float* Y = (float*)(ws + B_Y); bf16_t* Hh = (bf16_t*)(ws + B_H);
    float* OUT = args.out;
    const pg8::RopeTab rt{CS, SN};

    if (IN(0)) {
        LAS float* scr = (LAS float*)lds;
        wt_matrix(args.in[2], DM, N_A, (bf16_t*)(ws + W0IN), MapA{}, scr, tid, bid, G);
        wt_matrix(args.in[3], 2048, DM, (bf16_t*)(ws + W0OUT), MapId{}, scr, tid, bid, G);
        wt_matrix(args.in[10], DM, DFF, (bf16_t*)(ws + W0GU), MapGU{0}, scr, tid, bid, G);
        wt_matrix(args.in[11], DM, DFF, (bf16_t*)(ws + W0GU), MapGU{1}, scr, tid, bid, G);
        wt_matrix(args.in[12], DFF, DM, (bf16_t*)(ws + W0DN), MapId{}, scr, tid, bid, G);
        cvt_x_phase(x0, XB, tid, bid, G);
        rope_tab_phase(positions, CS, SN, tid, bid, G);
    }
    SEAM(0);
    if (IN(1)) {
        pg8::Gemm g{XB, (const bf16_t*)(ws + W0IN), MTOK, N_A, DM}; pg8::StaticOrder S; S.init(MTOK, N_A, G, bid);
        pg8::EpiQKV0 E{(bf16_t*)(ws + B_QKV0), rt};
        pg8::gemm_phase<pg8::EpiQKV0, pg8::StaticOrder, true, true>(lds, g, S, E);
    }
    SEAM(1);
    if (IN(2)) attn0_phase((const bf16_t*)(ws + B_QKV0), (bf16_t*)(ws + B_OG), (float*)(ws + B_LSE), lds, tid, bid, G);
    SEAM(2);
    if (IN(3)) merge_phase((const bf16_t*)(ws + B_OG), (const float*)(ws + B_LSE), (bf16_t*)(ws + B_AO0), tid, bid, G);
    SEAM(3);
    if (IN(4)) {
        pg8::Gemm g{(const bf16_t*)(ws + B_AO0), (const bf16_t*)(ws + W0OUT), MTOK, DM, 2048}; pg8::StaticOrder S; S.init(MTOK, DM, G, bid);
        pg8::EpiY E{x0, Y, DM, ALPHA};
        pg8::gemm_phase<pg8::EpiY, pg8::StaticOrder, true, true>(lds, g, S, E);
    }
    SEAM(4);
    if (IN(5)) ln_phase(Y, args.in[8], args.in[9], OUT, XB, tid, bid, G);
    SEAM(5);
    if (IN(6)) {
        pg8::Gemm g{XB, (const bf16_t*)(ws + W0GU), MTOK, 2 * DFF, DM}; pg8::StaticOrder S; S.init(MTOK, 2 * DFF, G, bid);
        pg8::EpiSwiGLU E{Hh, DFF};
        pg8::gemm_phase<pg8::EpiSwiGLU, pg8::StaticOrder, true, true>(lds, g, S, E);
    }
    SEAM(6);
    if (IN(7)) {
        pg8::Gemm g{Hh, (const bf16_t*)(ws + W0DN), MTOK, DM, DFF}; pg8::StaticOrder S; S.init(MTOK, DM, G, bid);
        pg8::EpiY E{OUT, Y, DM, ALPHA};
        pg8::gemm_phase<pg8::EpiY, pg8::StaticOrder, true, true>(lds, g, S, E);
    }
    SEAM(7);
    if (IN(8)) {
        ln_phase(Y, args.in[13], args.in[14], XA, XB, tid, bid, G);
        LAS float* scr = (LAS float*)lds;
        wt_matrix(args.in[4], DM, N_B, (bf16_t*)(ws + W1IN), MapB{}, scr, tid, bid, G);
        { u32x4* z = (u32x4*)(ws + W1IN + (size_t)N_B * DM * 2); const int nz = (N_BP - N_B) * DM * 2 / 16; for (int i = bid * NTHR + tid; i < nz; i += G * NTHR) z[i] = (u32x4){0u, 0u, 0u, 0u}; }
        wt_matrix(args.in[7], DM, DM, (bf16_t*)(ws + W1OUT), MapId{}, scr, tid, bid, G);
        wt_matrix(args.in[17], DM, DFF, (bf16_t*)(ws + W1GU), MapGU{0}, scr, tid, bid, G);
        wt_matrix(args.in[18], DM, DFF, (bf16_t*)(ws + W1GU), MapGU{1}, scr, tid, bid, G);
        wt_matrix(args.in[19], DFF, DM, (bf16_t*)(ws + W1DN), MapId{}, scr, tid, bid, G);
    }
    SEAM(8);
    if (IN(9)) {
        pg8::Gemm g{XB, (const bf16_t*)(ws + W1IN), MTOK, N_BP, DM}; pg8::StaticOrder S; S.init(MTOK, N_BP, G, bid);
        pg8::EpiQKV1 E{(bf16_t*)(ws + B_Q1), (bf16_t*)(ws + B_K1), (bf16_t*)(ws + B_V1), (unsigned short*)(ws + B_QI), (float*)(ws + B_KIR), (float*)(ws + B_WI), rt};
        pg8::gemm_phase<pg8::EpiQKV1, pg8::StaticOrder, true, true>(lds, g, S, E);
    }
    SEAM(9);
    if (IN(10)) kidx_phase((const float*)(ws + B_KIR), args.in[5], args.in[6], CS, SN, (unsigned short*)(ws + B_KI16), tid, bid, G);
    SEAM(10);
    if (IN(11)) indexer_phase((const unsigned short*)(ws + B_QI), (const unsigned short*)(ws + B_KI16), (const float*)(ws + B_WI), (float*)(ws + B_SC), lds, tid, bid, G);
    SEAM(11);
    if (IN(12)) topk_phase((const float*)(ws + B_SC), (int*)(ws + B_IDX), tid, bid, G);
    SEAM(12);
    if (IN(13)) dsa_attn_phase((const bf16_t*)(ws + B_Q1), (const bf16_t*)(ws + B_K1), (const bf16_t*)(ws + B_V1), (const int*)(ws + B_IDX), (bf16_t*)(ws + B_AO1), lds, tid, bid, G);
    SEAM(13);
    if (IN(14)) {
        pg8::Gemm g{(const bf16_t*)(ws + B_AO1), (const bf16_t*)(ws + W1OUT), MTOK, DM, DM}; pg8::StaticOrder S; S.init(MTOK, DM, G, bid);
        pg8::EpiY E{XA, Y, DM, ALPHA};
        pg8::gemm_phase<pg8::EpiY, pg8::StaticOrder, true, true>(lds, g, S, E);
    }
    SEAM(14);
    if (IN(15)) ln_phase(Y, args.in[15], args.in[16], OUT, XB, tid, bid, G);
    SEAM(15);
    if (IN(16)) {
        pg8::Gemm g{XB, (const bf16_t*)(ws + W1GU), MTOK, 2 * DFF, DM}; pg8::StaticOrder S; S.init(MTOK, 2 * DFF, G, bid);
        pg8::EpiSwiGLU E{Hh, DFF};
        pg8::gemm_phase<pg8::EpiSwiGLU, pg8::StaticOrder, true, true>(lds, g, S, E);
    }
    SEAM(16);
    if (IN(17)) {
        pg8::Gemm g{Hh, (const bf16_t*)(ws + W1DN), MTOK, DM, DFF}; pg8::StaticOrder S; S.init(MTOK, DM, G, bid);
        pg8::EpiY E{OUT, Y, DM, ALPHA};
        pg8::gemm_phase<pg8::EpiY, pg8::StaticOrder, true, true>(lds, g, S, E);
    }
    SEAM(17);
    if (IN(18)) ln_phase(Y, args.in[20], args.in[21], OUT, nullptr, tid, bid, G);
#undef IN
#undef SEAM
}

extern "C" void kernel_launch(void* const* d_in, const int* in_sizes, int n_in, void* d_out, int out_size, void* d_ws, size_t ws_size, hipStream_t stream) {
    static int grid = 0;
    if (grid == 0) {
        if (n_in != 22 || out_size != MTOK * DM || ws_size < WS_END) { fprintf(stderr, "kernel_launch: unexpected problem (n_in %d, out %d, ws %zu < %zu); nothing launched\n", n_in, out_size, ws_size, (size_t)WS_END); grid = -1; return; }
        int dev = 0, cus = 0, per_cu = 0;
        if (hipGetDevice(&dev) != hipSuccess || hipDeviceGetAttribute(&cus, hipDeviceAttributeMultiprocessorCount, dev) != hipSuccess) { grid = -1; return; }
        if (hipFuncSetAttribute((const void*)mk_fwd, hipFuncAttributeMaxDynamicSharedMemorySize, LDS_BYTES) != hipSuccess) { fprintf(stderr, "kernel_launch: hipFuncSetAttribute failed\n"); grid = -1; return; }
        if (hipOccupancyMaxActiveBlocksPerMultiprocessor(&per_cu, (const void*)mk_fwd, NTHR, LDS_BYTES) != hipSuccess || per_cu < 1) { fprintf(stderr, "kernel_launch: occupancy query reports %d\n", per_cu); (void)hipGetLastError(); per_cu = 1; }
        grid = cus;
    }
    if (grid < 0) return;
    (void)in_sizes;
    if (hipMemsetAsync((char*)d_ws + WS_CTL, 0, CTL_ZERO_BYTES, stream) != hipSuccess) return;
    Args a{};
    for (int i = 0; i < 22; ++i) a.in[i] = (const float*)d_in[i];
    a.out = (float*)d_out; a.ws = (unsigned char*)d_ws;
#if MK_ONE_LAUNCH
    a.ph_lo = 0; a.ph_hi = N_PHASES;
    hipLaunchKernelGGL(mk_fwd, dim3(grid), dim3(NTHR), LDS_BYTES, stream, a);
#else
    for (int p = 0; p < N_PHASES; ++p) { a.ph_lo = p; a.ph_hi = p + 1; hipLaunchKernelGGL(mk_fwd, dim3(grid), dim3(NTHR), LDS_BYTES, stream, a); }
#endif
}
```

```cpp
#include <hip/hip_runtime.h>
#include <cstdio>
#include <cstdint>
namespace pg8 {
#define PG8_LAS __attribute__((address_space(3)))
typedef unsigned short bf16_t;
typedef short bf16x8 __attribute__((ext_vector_type(8)));
typedef float f32x4 __attribute__((ext_vector_type(4)));
typedef unsigned u32x4 __attribute__((ext_vector_type(4)));
constexpr int BM = 256, BK = 64, HALF = 128, HTB = HALF * BK * 2  , STAGE_BYTES = 8 * HTB, NXCD = 8, WGM = 8;

__host__ __device__ __forceinline__ int lds_byte(int r, int c) { const int st = (r >> 4) * 2 + (c >> 5), rr = r & 15, cc = c & 31, ob = rr * 64 + cc * 2; return st * 1024 + (ob ^ (((ob >> 9) & 1) << 5)); }
__host__ __device__ __forceinline__ void stage_rc(int b, int& R, int& C) { const int st = b / 1024, sb = b % 1024, swz = sb ^ (((sb >> 9) & 1) << 5); R = (st >> 1) * 16 + swz / 64; C = (st & 1) * 32 + (swz % 64) / 2; }
__host__ __device__ __forceinline__ int perm32(int rho) { const int n = rho >> 4, i = rho & 15; return 8 * (i >> 2) + 4 * n + (i & 3); }

struct Unit { int pm, pn; };
struct Gemm { const bf16_t* A; const bf16_t* Bt; int M, N, K; };

struct StaticOrder {
    int nM, nN, nwg, G, c;
    __host__ __device__ void init(int M, int N, int G_, int c_) { nM = M / BM; nN = N / BM; nwg = nM * nN; G = G_; c = c_; }
    __host__ __device__ bool next(int i, Unit& u) const {
        const long L = (long)i * G + c; if (L >= nwg) return false;
        int wgid = (int)L; { const int q = nwg / NXCD, r = nwg % NXCD, xcd = wgid % NXCD, off = wgid / NXCD; wgid = (xcd < r ? xcd * (q + 1) : r * (q + 1) + (xcd - r) * q) + off; }
        const int nig = WGM * nN, gid = wgid / nig, fm = gid * WGM, gsz = (nM - fm) < WGM ? (nM - fm) : WGM;
        u.pm = fm + ((wgid % nig) % gsz); u.pn = (wgid % nig) / gsz; return true;
    }
    __device__ __forceinline__ void a_ready(const Unit&) const {}
    __device__ __forceinline__ void done(const Unit&) const {}
};
__device__ __forceinline__ unsigned cvt_pk_bf16(float lo, float hi) { unsigned r; asm volatile("v_cvt_pk_bf16_f32 %0, %1, %2" : "=v"(r) : "v"(lo), "v"(hi)); return r; }
typedef _Float16 f16x2_t __attribute__((ext_vector_type(2)));
__device__ __forceinline__ unsigned cvt_pk_f16(float lo, float hi) { f16x2_t h; h.x = (_Float16)lo; h.y = (_Float16)hi; return __builtin_bit_cast(unsigned, h); }

struct RopeTab { const float* cs; const float* sn; };

__device__ __forceinline__ void rope_pair(f32x4& v0, f32x4& v1, const f32x4 c, const f32x4 s) {
    const f32x4 a = v0 * c - v1 * s, b = v1 * c + v0 * s; v0 = a; v1 = b;
}

struct EpiY {
    static constexpr bool PERM = false, AFTER_DRAIN = false;
    const float* X; float* Y; int ldc; float alpha;
    __device__ __forceinline__ void operator()(const f32x4 (&acc)[2][2][4][2], const Unit& u, int wr, int wc, int fr, int fq) const {
        const int row0 = u.pm * BM + wr * 64 + fr, col0 = u.pn * BM + wc * 32 + 4 * fq;
#pragma unroll
        for (int ai = 0; ai < 2; ++ai)
#pragma unroll
            for (int m = 0; m < 4; ++m) { const size_t off = (size_t)(row0 + ai * HALF + m * 16) * ldc + col0;
#pragma unroll
                for (int bj = 0; bj < 2; ++bj)
#pragma unroll
                    for (int n = 0; n < 2; ++n) { const f32x4 xv = *(const f32x4*)(X + off + bj * HALF + n * 16); *(f32x4*)(Y + off + bj * HALF + n * 16) = xv * alpha + acc[ai][bj][m][n]; }
                asm volatile("" ::: "memory"); }
    }
};

struct EpiSwiGLU {
    static constexpr bool PERM = true, AFTER_DRAIN = false;
    bf16_t* Hh; int ldh;
    __device__ __forceinline__ void operator()(const f32x4 (&acc)[2][2][4][2], const Unit& u, int wr, int wc, int fr, int fq) const {
        const int row0 = u.pm * BM + wr * 64 + fr, col0 = u.pn * HALF + wc * 32 + 8 * fq;
#pragma unroll
        for (int ai = 0; ai < 2; ++ai)
#pragma unroll
            for (int m = 0; m < 4; ++m) { bf16_t* rowp = Hh + (size_t)(row0 + ai * HALF + m * 16) * ldh + col0;
                float h[8];
#pragma unroll
                for (int n = 0; n < 2; ++n)
#pragma unroll
                    for (int i = 0; i < 4; ++i) { const float g = acc[ai][0][m][n][i], up = acc[ai][1][m][n][i];
                        const float e = __builtin_amdgcn_exp2f(-g * 1.44269504089f); h[n * 4 + i] = g * __builtin_amdgcn_rcpf(1.0f + e) * up; }
                u32x4 w; w.x = cvt_pk_bf16(h[0], h[1]); w.y = cvt_pk_bf16(h[2], h[3]); w.z = cvt_pk_bf16(h[4], h[5]); w.w = cvt_pk_bf16(h[6], h[7]);
                *(u32x4*)rowp = w; }
    }
};

struct EpiQKV0 {
    static constexpr bool PERM = true, AFTER_DRAIN = false;
    bf16_t* O; RopeTab rt;
    __device__ __forceinline__ void operator()(const f32x4 (&acc)[2][2][4][2], const Unit& u, int wr, int wc, int fr, int fq) const {
        const int sg = u.pn >> 3, colin = (u.pn & 7) * BM + wc * 32 + 8 * fq; const bool rope = sg < 6;
        bf16_t* base = O + (size_t)sg * ((size_t)16384 * 2048);
        const int row0 = u.pm * BM + wr * 64 + fr, f0 = 16 * wc + 4 * fq;
#pragma unroll
        for (int ai = 0; ai < 2; ++ai)
#pragma unroll
            for (int m = 0; m < 4; ++m) { const int row = row0 + ai * HALF + m * 16; bf16_t* rowp = base + (size_t)row * 2048 + colin;
                f32x4 c = {1.f, 1.f, 1.f, 1.f}, s = {0.f, 0.f, 0.f, 0.f};
                if (rope) { c = *(const f32x4*)(rt.cs + (size_t)row * 64 + f0); s = *(const f32x4*)(rt.sn + (size_t)row * 64 + f0); }
#pragma unroll
                for (int bj = 0; bj < 2; ++bj) { f32x4 v0 = acc[ai][bj][m][0], v1 = acc[ai][bj][m][1];
                    rope_pair(v0, v1, c, s);
                    u32x4 w; w.x = cvt_pk_bf16(v0[0], v0[1]); w.y = cvt_pk_bf16(v0[2], v0[3]); w.z = cvt_pk_bf16(v1[0], v1[1]); w.w = cvt_pk_bf16(v1[2], v1[3]);
                    *(u32x4*)(rowp + bj * HALF) = w; } }
    }
};

struct EpiQKV1 {
    static constexpr bool PERM = true, AFTER_DRAIN = false;
    bf16_t* Q; bf16_t* Kc; bf16_t* Vc; unsigned short* QI; float* KIR; float* WI; RopeTab rt;
    __device__ __forceinline__ void operator()(const f32x4 (&acc)[2][2][4][2], const Unit& u, int wr, int wc, int fr, int fq) const {
        const int pn = u.pn; const int row0 = u.pm * BM + wr * 64 + fr, f0 = 16 * wc + 4 * fq, cw = wc * 32 + 8 * fq;
        const bool rope = (pn < 20) || (pn >= 24 && pn < 40);
#pragma unroll
        for (int ai = 0; ai < 2; ++ai)
#pragma unroll
            for (int m = 0; m < 4; ++m) { const int row = row0 + ai * HALF + m * 16;
                f32x4 c = {1.f, 1.f, 1.f, 1.f}, s = {0.f, 0.f, 0.f, 0.f};
                if (rope) { c = *(const f32x4*)(rt.cs + (size_t)row * 64 + f0); s = *(const f32x4*)(rt.sn + (size_t)row * 64 + f0); }
#pragma unroll
                for (int bj = 0; bj < 2; ++bj) { f32x4 v0 = acc[ai][bj][m][0], v1 = acc[ai][bj][m][1];
                    if (pn < 40) {
                        rope_pair(v0, v1, c, s);
                        u32x4 w;
                        if (pn >= 24) { w.x = cvt_pk_f16(v0[0], v0[1]); w.y = cvt_pk_f16(v0[2], v0[3]); w.z = cvt_pk_f16(v1[0], v1[1]); w.w = cvt_pk_f16(v1[2], v1[3]); }
                        else { w.x = cvt_pk_bf16(v0[0], v0[1]); w.y = cvt_pk_bf16(v0[2], v0[3]); w.z = cvt_pk_bf16(v1[0], v1[1]); w.w = cvt_pk_bf16(v1[2], v1[3]); }
                        if (pn < 16) *(u32x4*)(Q + (size_t)row * 4096 + pn * BM + bj * HALF + cw) = w;
                        else if (pn < 24) { const int kvh = ((pn - 16) & 3) * 2 + bj; bf16_t* dst = (pn < 20 ? Kc : Vc) + ((size_t)((row >> 13) * 8 + kvh) * 8192 + (row & 8191)) * 128 + cw; *(u32x4*)dst = w; }
                        else *(u32x4*)(QI + (size_t)row * 4096 + (pn - 24) * BM + bj * HALF + cw) = w;
                    } else {
                        if (bj == 0) { *(f32x4*)(KIR + (size_t)row * 128 + cw) = v0; *(f32x4*)(KIR + (size_t)row * 128 + cw + 4) = v1; }
                        else if (wc == 0) { *(f32x4*)(WI + (size_t)row * 32 + cw) = v0 * 0.015625f; *(f32x4*)(WI + (size_t)row * 32 + cw + 4) = v1 * 0.015625f; }
                    } } }
    }
};

template <class Epi, class Sched, bool ALIGN_EPI = false, bool SP2 = false>
__device__ __forceinline__ void gemm_phase(PG8_LAS unsigned char* lds, const Gemm g, const Sched& S, const Epi& E) {
    const int tid = threadIdx.x, wid = __builtin_amdgcn_readfirstlane(tid >> 6), lane = tid & 63, wr = wid >> 2, wc = wid & 3, fr = lane & 15, fq = lane >> 4;
    const int K = g.K, nt = K / BK;
    unsigned voffA[2], voffB[2];
#pragma unroll
    for (int i = 0; i < 2; ++i) { int R, C; stage_rc(tid * 16 + i * 8192, R, C); const int Rb = Epi::PERM ? ((R & ~31) + perm32(R & 31)) : R;
        voffA[i] = (unsigned)(R * K + C) * 2u; voffB[i] = (unsigned)(Rb * K + C) * 2u; }
    const size_t kstep = (size_t)(BK * 2);
    const size_t hstep = (size_t)HALF * K * 2;
    const size_t tstep = 2 * hstep;
    const unsigned ldsw = (unsigned)wid * 1024u;
    const int aoff = lds_byte(wr * 64 + fr, fq * 8), boff = lds_byte(wc * 32 + fr, fq * 8);
#define PG8_SA(b, h) (((b) * 2 + (h)) * HTB)
#define PG8_SB(b, h) ((4 + (b) * 2 + (h)) * HTB)
#define PG8_STAGE(bufoff, gbase, voff) do { _Pragma("unroll") for (int _i = 0; _i < 2; ++_i) \
        __builtin_amdgcn_global_load_lds((const unsigned*)((const char*)(gbase) + (voff)[_i]), (PG8_LAS unsigned*)(lds + (bufoff) + ldsw + _i * 8192), 16, 0, 0); } while (0)
#define PG8_LDA(dst, b, h) do { _Pragma("unroll") for (int m = 0; m < 4; ++m) _Pragma("unroll") for (int k = 0; k < 2; ++k) dst[m][k] = *(const PG8_LAS bf16x8*)(lds + PG8_SA(b, h) + aoff + m * 2048 + k * 1024); } while (0)
#define PG8_LDB(dst, b, h) do { _Pragma("unroll") for (int n = 0; n < 2; ++n) _Pragma("unroll") for (int k = 0; k < 2; ++k) dst[n][k] = *(const PG8_LAS bf16x8*)(lds + PG8_SB(b, h) + boff + n * 2048 + k * 1024); } while (0)
#define PG8_MMA(ai, bj, At, Bt) do { __builtin_amdgcn_s_setprio(1); _Pragma("unroll") for (int m = 0; m < 4; ++m) _Pragma("unroll") for (int n = 0; n < 2; ++n) _Pragma("unroll") for (int k = 0; k < 2; ++k) \
        acc[ai][bj][m][n] = __builtin_amdgcn_mfma_f32_16x16x32_bf16(Bt[n][k], At[m][k], acc[ai][bj][m][n], 0, 0, 0); __builtin_amdgcn_s_setprio(0); } while (0)
#define PG8_WAIT_V(n) asm volatile("s_waitcnt vmcnt(" #n ")" ::: "memory")
#define PG8_WAIT_L(n) asm volatile("s_waitcnt lgkmcnt(" #n ")" ::: "memory")
#define PG8_BAR __builtin_amdgcn_s_barrier()
#define PG8_SCHED __builtin_amdgcn_sched_barrier(0)
    Unit cur, nxt; int ui = 0;
    if (!S.next(0, cur)) return;
    f32x4 acc[2][2][4][2];
#pragma unroll
    for (int a = 0; a < 2; ++a)
#pragma unroll
        for (int b = 0; b < 2; ++b)
#pragma unroll
            for (int m = 0; m < 4; ++m)
#pragma unroll
                for (int n = 0; n < 2; ++n) acc[a][b][m][n] = (f32x4){0.f, 0.f, 0.f, 0.f};
    bf16x8 At[4][2], B0[2][2], B1[2][2];
    const char* cA = (const char*)g.A + (size_t)cur.pm * tstep; const char* cB = (const char*)g.Bt + (size_t)cur.pn * tstep;
    S.a_ready(cur);
    if constexpr (SP2) {
        PG8_STAGE(PG8_SB(0, 0), cB, voffB); PG8_STAGE(PG8_SB(0, 1), cB + hstep, voffB); PG8_STAGE(PG8_SA(0, 0), cA, voffA); PG8_STAGE(PG8_SA(0, 1), cA + hstep, voffA);
        if (wr == 1) PG8_BAR;
        PG8_WAIT_V(2); PG8_BAR;
        PG8_STAGE(PG8_SB(1, 0), cB + kstep, voffB); PG8_STAGE(PG8_SA(1, 0), cA + kstep, voffA); PG8_STAGE(PG8_SB(1, 1), cB + hstep + kstep, voffB);
        PG8_WAIT_V(6); PG8_BAR;
    } else {
        PG8_STAGE(PG8_SB(0, 0), cB, voffB); PG8_STAGE(PG8_SA(0, 0), cA, voffA); PG8_STAGE(PG8_SB(0, 1), cB + hstep, voffB); PG8_STAGE(PG8_SA(0, 1), cA + hstep, voffA);
        if (wr == 1) PG8_BAR;
        PG8_WAIT_V(4); PG8_BAR;
        PG8_STAGE(PG8_SB(1, 0), cB + kstep, voffB); PG8_STAGE(PG8_SA(1, 0), cA + kstep, voffA); PG8_STAGE(PG8_SB(1, 1), cB + hstep + kstep, voffB);
        PG8_WAIT_V(6); PG8_BAR;
    }
    for (;;) {
        const bool has_next = S.next(ui + 1, nxt);
        const char* nA = has_next ? (const char*)g.A + (size_t)nxt.pm * tstep : cA; const char* nB = has_next ? (const char*)g.Bt + (size_t)nxt.pn * tstep : cB;
        for (int t = 0; t < nt; t += 2) {
            const bool last = (t == nt - 2);
            const char* a1 = cA + (size_t)(t + 1) * kstep;
            const char* a2 = last ? nA : cA + (size_t)(t + 2) * kstep; const char* b2 = last ? nB : cB + (size_t)(t + 2) * kstep;
            const char* a3 = a2 + kstep; const char* b3 = b2 + kstep;
            if (last && has_next) S.a_ready(nxt);
            if constexpr (SP2) {
            PG8_LDB(B0, 0, 0); PG8_LDB(B1, 0, 1); PG8_SCHED; PG8_LDA(At, 0, 0); PG8_STAGE(PG8_SA(1, 1), a1 + hstep, voffA);
            PG8_WAIT_V(8); PG8_WAIT_L(0); PG8_BAR; PG8_MMA(0, 0, At, B0); PG8_MMA(0, 1, At, B1); PG8_BAR; PG8_SCHED;
            PG8_LDA(At, 0, 1); PG8_STAGE(PG8_SB(0, 0), b2, voffB); PG8_STAGE(PG8_SB(0, 1), b2 + hstep, voffB); PG8_STAGE(PG8_SA(0, 0), a2, voffA);
            PG8_WAIT_V(8); PG8_WAIT_L(0); PG8_BAR; PG8_MMA(1, 0, At, B0); PG8_MMA(1, 1, At, B1); PG8_BAR; PG8_SCHED;
            PG8_LDB(B0, 1, 0); PG8_LDB(B1, 1, 1); PG8_SCHED; PG8_LDA(At, 1, 0); PG8_STAGE(PG8_SA(0, 1), a2 + hstep, voffA);
            PG8_WAIT_V(8); PG8_WAIT_L(0); PG8_BAR; PG8_MMA(0, 0, At, B0); PG8_MMA(0, 1, At, B1); PG8_BAR; PG8_SCHED;
            PG8_LDA(At, 1, 1); PG8_STAGE(PG8_SB(1, 0), b3, voffB); PG8_STAGE(PG8_SB(1, 1), b3 + hstep, voffB); PG8_STAGE(PG8_SA(1, 0), a3, voffA);
            PG8_WAIT_V(8); PG8_WAIT_L(0); PG8_BAR; PG8_MMA(1, 0, At, B0); PG8_MMA(1, 1, At, B1); PG8_BAR; PG8_SCHED;
            } else {
            PG8_LDB(B0, 0, 0); PG8_SCHED; PG8_LDA(At, 0, 0); PG8_STAGE(PG8_SA(1, 1), a1 + hstep, voffA);
            PG8_WAIT_L(8); PG8_BAR; PG8_WAIT_L(0); PG8_MMA(0, 0, At, B0); PG8_BAR; PG8_SCHED;
            PG8_LDB(B1, 0, 1); PG8_STAGE(PG8_SB(0, 0), b2, voffB);
            PG8_BAR; PG8_WAIT_L(0); PG8_MMA(0, 1, At, B1); PG8_BAR;
            PG8_LDA(At, 0, 1); PG8_STAGE(PG8_SA(0, 0), a2, voffA);
            PG8_BAR; PG8_WAIT_L(0); PG8_MMA(1, 0, At, B0); PG8_BAR; PG8_SCHED;
            PG8_STAGE(PG8_SB(0, 1), b2 + hstep, voffB);
            PG8_WAIT_V(6); PG8_BAR; PG8_MMA(1, 1, At, B1); PG8_BAR;
            PG8_LDB(B0, 1, 0); PG8_SCHED; PG8_LDA(At, 1, 0); PG8_STAGE(PG8_SA(0, 1), a2 + hstep, voffA);
            PG8_WAIT_L(8); PG8_BAR; PG8_WAIT_L(0); PG8_MMA(0, 0, At, B0); PG8_BAR; PG8_SCHED;
            PG8_LDB(B1, 1, 1); PG8_STAGE(PG8_SB(1, 0), b3, voffB);
            PG8_BAR; PG8_WAIT_L(0); PG8_MMA(0, 1, At, B1); PG8_BAR;
            PG8_LDA(At, 1, 1); PG8_STAGE(PG8_SA(1, 0), a3, voffA);
            PG8_BAR; PG8_WAIT_L(0); PG8_MMA(1, 0, At, B0); PG8_BAR; PG8_SCHED;
            PG8_STAGE(PG8_SB(1, 1), b3 + hstep, voffB);
            PG8_WAIT_V(6); PG8_BAR; PG8_MMA(1, 1, At, B1); PG8_BAR;
            }
        }
        if constexpr (ALIGN_EPI) { if (wr == 0) PG8_BAR; }
        if constexpr (!Epi::AFTER_DRAIN) { E(acc, cur, wr, wc, fr, fq); S.done(cur); }
        if (!has_next) break;
#pragma unroll
        for (int a = 0; a < 2; ++a)
#pragma unroll
            for (int b = 0; b < 2; ++b)
#pragma unroll
                for (int m = 0; m < 4; ++m)
#pragma unroll
                    for (int n = 0; n < 2; ++n) acc[a][b][m][n] = (f32x4){0.f, 0.f, 0.f, 0.f};
        cur = nxt; cA = nA; cB = nB; ++ui;
        if constexpr (ALIGN_EPI) { if (wr == 1) PG8_BAR; }
    }
    PG8_WAIT_V(0);
    if constexpr (!ALIGN_EPI) { if (wr == 0) PG8_BAR; }
    PG8_BAR;
    if constexpr (Epi::AFTER_DRAIN) { E.fused(acc, cur, wr, wc, fr, fq, lds, wid, lane); S.done(cur); }
#undef PG8_SA
#undef PG8_SB
#undef PG8_STAGE
#undef PG8_LDA
#undef PG8_LDB
#undef PG8_MMA
#undef PG8_WAIT_V
#undef PG8_WAIT_L
#undef PG8_BAR
#undef PG8_SCHED
}
}
#define XB_TMO      128
#define XB_XCNT(j)  (256  + 64 * (j))
#define XB_XSUB(j)  (1280 + 64 * (j))
#define XB_XGEN(j)  (2304 + 64 * (j))
#define XB_TOP      3328
#define XB_TOPGEN   3392
#define XCD_BAR_WORDS 3456
#define XB_SPIN_CAP (1u << 18)
#define LAS __attribute__((address_space(3)))

__device__ __forceinline__ unsigned xb_ld(unsigned* p)              { return __hip_atomic_load(p, __ATOMIC_RELAXED, __HIP_MEMORY_SCOPE_AGENT); }
__device__ __forceinline__ unsigned xb_add(unsigned* p, unsigned v) { return __hip_atomic_fetch_add(p, v, __ATOMIC_RELAXED, __HIP_MEMORY_SCOPE_AGENT); }
__device__ __forceinline__ unsigned xb_xcc_id() { return (unsigned)__builtin_amdgcn_s_getreg((3 << 11) | 20) & 0xFu; }
#define XB_SPIN(cond, bar) do { unsigned _sp = 0; while (cond) { __builtin_amdgcn_s_sleep(1); \
    if ((++_sp & 255u) == 0u) { if (xb_ld(&(bar)[XB_TMO])) break; if (_sp > XB_SPIN_CAP) { atomicAdd(&(bar)[XB_TMO], 1u); break; } } } } while (0)

struct XcdBarrier {
    unsigned* bar; unsigned x;
    volatile LAS unsigned* st;
};

__device__ __forceinline__ XcdBarrier xcd_barrier_post(unsigned* bar, volatile LAS unsigned* st) {
    XcdBarrier b; b.bar = bar; b.x = xb_xcc_id(); b.st = st;
    if (threadIdx.x == 0) (void)xb_add(&bar[XB_XCNT(b.x)], 1u);
    return b;
}
__device__ __forceinline__ void xcd_barrier_complete(unsigned* bar, unsigned x, unsigned& nloc, unsigned& nx) {
    const unsigned G = gridDim.x * gridDim.y * gridDim.z;
    unsigned sum, cnt, mine, sp = 0u;
    for (;;) {
        sum = 0u; cnt = 0u; mine = 0u;
#pragma unroll
        for (unsigned j = 0; j < 16; ++j) { const unsigned c = xb_ld(&bar[XB_XCNT(j)]); sum += c; cnt += (c > 0u) ? 1u : 0u; mine = (j == x) ? c : mine; }
        if (sum == G) break;
        __builtin_amdgcn_s_sleep(1);
        if ((++sp & 255u) == 0u) { if (xb_ld(&bar[XB_TMO])) break; if (sp > XB_SPIN_CAP) { atomicAdd(&bar[XB_TMO], 1u); break; } }
    }
    nloc = mine > 0u ? mine : 1u; nx = cnt > 0u ? cnt : 1u;
}

__device__ __forceinline__ void xcd_barrier(const XcdBarrier& b) {
    asm volatile("s_waitcnt vmcnt(0)" ::: "memory");
    __syncthreads();
    if (threadIdx.x == 0) {
        unsigned* bar = b.bar;
        __builtin_amdgcn_s_waitcnt(0);
        unsigned nloc = b.st[0], nx = b.st[1];
        if (nloc == 0u) { xcd_barrier_complete(bar, b.x, nloc, nx); b.st[0] = nloc; b.st[1] = nx; }
        const unsigned old = xb_add(&bar[XB_XSUB(b.x)], 1u);
        const unsigned gen = old / nloc;
        if (old + 1u == (gen + 1u) * nloc) {
            __builtin_amdgcn_fence(__ATOMIC_RELEASE, "agent");
            asm volatile("s_waitcnt vmcnt(0)" ::: "memory");
            const unsigned og = xb_add(&bar[XB_TOP], 1u);
            const unsigned tg = og / nx;
            if (og + 1u == (tg + 1u) * nx) xb_add(&bar[XB_TOPGEN], 1u);
            else XB_SPIN(xb_ld(&bar[XB_TOPGEN]) == tg, bar);
            __builtin_amdgcn_fence(__ATOMIC_ACQUIRE, "agent");
            xb_add(&bar[XB_XGEN(b.x)], 1u);
            asm volatile("s_waitcnt vmcnt(0)" ::: "memory");
        } else {
            XB_SPIN(xb_ld(&bar[XB_XGEN(b.x)]) == gen, bar);
            __builtin_amdgcn_fence(__ATOMIC_ACQUIRE, "agent");
            asm volatile("s_waitcnt vmcnt(0)" ::: "memory");
        }
    }
    __syncthreads();
}


using pg8::bf16_t; using pg8::bf16x8; using pg8::f32x4; using pg8::u32x4;
typedef _Float16 f16x8 __attribute__((ext_vector_type(8)));
typedef float f32x16 __attribute__((ext_vector_type(16)));
typedef unsigned u32x2 __attribute__((ext_vector_type(2)));
#define DI __device__ __forceinline__

constexpr int NWAVES = 8, NTHR = 512;
constexpr int SEQ = 8192, MTOK = 16384, DM = 4096, DFF = 11008;
constexpr int N_A = 18432, N_B = 10400, N_BP = 10496;
constexpr float LN_EPS = 1e-5f;
constexpr float ALPHA = 1.41421356237309515f;
constexpr float SM_C = 0.08838834764831845f * 1.4426950408889634f;
constexpr float SM_SCALE = 0.08838834764831845f;

constexpr size_t MiB = (size_t)1 << 20;
constexpr size_t WS_CTL = 0, CTL_ZERO_BYTES = 1 * MiB;
constexpr size_t WS_COS = 1 * MiB, WS_SIN = 5 * MiB;
constexpr size_t WS_W = 9 * MiB;
constexpr size_t W0IN = WS_W, W0OUT = WS_W + 144 * MiB, W0GU = WS_W + 160 * MiB, W0DN = WS_W + 332 * MiB;
constexpr size_t W1IN = WS_W, W1OUT = WS_W + 82 * MiB, W1GU = WS_W + 114 * MiB, W1DN = WS_W + 286 * MiB;
constexpr size_t WS_XB = 427 * MiB, WS_XA = 555 * MiB, WS_BIG = 811 * MiB, WS_END = (811 + 835) * MiB;
constexpr size_t B_QKV0 = WS_BIG, B_OG = WS_BIG + 576 * MiB, B_LSE = WS_BIG + 768 * MiB, B_AO0 = WS_BIG + 771 * MiB;
constexpr size_t B_Y = WS_BIG + 360 * MiB, B_H = WS_BIG;
constexpr size_t B_Q1 = WS_BIG, B_K1 = WS_BIG + 128 * MiB, B_V1 = WS_BIG + 160 * MiB, B_QI = WS_BIG + 192 * MiB, B_KIR = WS_BIG + 320 * MiB, B_KI16 = WS_BIG + 328 * MiB,
                 B_WI = WS_BIG + 332 * MiB, B_SC = WS_BIG + 334 * MiB, B_IDX = WS_BIG + 594 * MiB, B_AO1 = WS_BIG + 640 * MiB;
constexpr int LDS_BYTES = 147456, MISC_OFF = 131072;

DI float wave_sum(float v) { v += __shfl_xor(v, 1); v += __shfl_xor(v, 2); v += __shfl_xor(v, 4); v += __shfl_xor(v, 8); v += __shfl_xor(v, 16); v += __shfl_xor(v, 32); return v; }
DI int sigma_inv(int d) { return 32 * ((d >> 4) & 3) + 8 * ((d >> 2) & 3) + 4 * (d >> 6) + (d & 3); }

struct MapId { DI long operator()(int c) const { return c; } };
struct MapA  { DI long operator()(int c) const { const int d = c & 127; return (c < 2 * 6144) ? (long)(c - d + sigma_inv(d)) : (long)c; } };
struct MapB  { DI long operator()(int c) const { const int d = c & 127; const bool rp = (c < 5120) || (c >= 6144 && c < 10240); return rp ? (long)(c - d + sigma_inv(d)) : (long)c; } };
struct MapGU { int up; DI long operator()(int c) const { return (long)((c >> 7) * 256 + up * 128 + (c & 127)); } };

template <class Map>
DI void wt_item(const float* __restrict__ W, int K, int N, bf16_t* __restrict__ WT, int item, const Map map, LAS float* scr, int tid) {
    const int nct = (N + 255) >> 8; const int kt = item / nct, ct = item - kt * nct; const int k0 = kt * 64, c0 = ct * 256;
    const int cq = tid & 63, kr0 = tid >> 6;
    f32x4 v[8]; const bool cok = (c0 + 4 * cq) < N;
#pragma unroll
    for (int i = 0; i < 8; ++i) v[i] = cok ? *(const f32x4*)(W + (size_t)(k0 + kr0 + 8 * i) * N + c0 + 4 * cq) : (f32x4){0.f, 0.f, 0.f, 0.f};
    __syncthreads();
#pragma unroll
    for (int i = 0; i < 8; ++i) *(LAS f32x4*)(scr + (kr0 + 8 * i) * 260 + 4 * cq) = v[i];
    __syncthreads();
    const int c = tid >> 1, kc = tid & 1;
    if (c0 + c < N) {
        bf16_t* dst = WT + (size_t)map(c0 + c) * K + k0 + 32 * kc;
#pragma unroll
        for (int q = 0; q < 4; ++q) { float f[8];
#pragma unroll
            for (int j = 0; j < 8; ++j) f[j] = scr[(32 * kc + 8 * q + j) * 260 + c];
            u32x4 o; o.x = pg8::cvt_pk_bf16(f[0], f[1]); o.y = pg8::cvt_pk_bf16(f[2], f[3]); o.z = pg8::cvt_pk_bf16(f[4], f[5]); o.w = pg8::cvt_pk_bf16(f[6], f[7]);
            *(u32x4*)(dst + 8 * q) = o; }
    }
}
template <class Map>
DI void wt_matrix(const float* W, int K, int N, bf16_t* WT, const Map map, LAS float* scr, int tid, int bid, int G) {
    const int nitems = (K >> 6) * ((N + 255) >> 8);
    for (int it = bid; it < nitems; it += G) wt_item(W, K, N, WT, it, map, scr, tid);
}

DI void rope_sincos(int pos, int f, float& cs, float& sn) {
    const double r1 = 0.8659643233600653; double inv = 1.0, rp = r1;
#pragma unroll
    for (int b = 0; b < 6; ++b) { if ((f >> b) & 1) inv *= rp; rp *= rp; }
    const double ang = (double)pos * inv;
    const double q = __builtin_rint(ang * 0.63661977236758134308);
    double r = __builtin_fma(-q, 1.57079632679489655800e+00, ang); r = __builtin_fma(-q, 6.12323399573676603587e-17, r);
    const double z = r * r;
    const double ps = r + r * z * (-1.66666666666666324348e-01 + z * (8.33333333332248946124e-03 + z * (-1.98412698298579493134e-04 + z * (2.75573137070700676789e-06 + z * (-2.50507602534068634195e-08 + z * 1.58969099521155010221e-10)))));
    const double pc = 1.0 - 0.5 * z + z * z * (4.16666666666666019037e-02 + z * (-1.38888888888741095749e-03 + z * (2.48015872894767294178e-05 + z * (-2.75573143513906633035e-07 + z * (2.08757232129817482790e-09 + z * -1.13596475577881948265e-11)))));
    const int qi = ((int)(long long)q) & 3;
    const double s = (qi == 0) ? ps : (qi == 1) ? pc : (qi == 2) ? -ps : -pc;
    const double c = (qi == 0) ? pc : (qi == 1) ? -ps : (qi == 2) ? -pc : ps;
    cs = (float)c; sn = (float)s;
}

DI void cvt_x_phase(const float* X, bf16_t* XB, int tid, int bid, int G) {
    const size_t n8 = (size_t)MTOK * DM / 8;
    for (size_t i = (size_t)bid * NTHR + tid; i < n8; i += (size_t)G * NTHR) {
        const f32x4 a = *(const f32x4*)(X + i * 8), b = *(const f32x4*)(X + i * 8 + 4);
        u32x4 o; o.x = pg8::cvt_pk_bf16(a[0], a[1]); o.y = pg8::cvt_pk_bf16(a[2], a[3]); o.z = pg8::cvt_pk_bf16(b[0], b[1]); o.w = pg8::cvt_pk_bf16(b[2], b[3]);
        *(u32x4*)(XB + i * 8) = o; }
}
DI void rope_tab_phase(const int* pos, float* CS, float* SN, int tid, int bid, int G) {
    for (int e = bid * NTHR + tid; e < MTOK * 64; e += G * NTHR) { float c, s; rope_sincos(pos[e >> 6], e & 63, c, s); CS[e] = c; SN[e] = s; }
}

DI void ln_phase(const float* Y, const float* gain, const float* bias, float* Xo, bf16_t* XBo, int tid, int bid, int G) {
    const int lane = tid & 63, gw = bid * NWAVES + (tid >> 6), nw = G * NWAVES;
    for (int row = gw; row < MTOK; row += nw) {
        const float* yr = Y + (size_t)row * DM; f32x4 v[16]; float s = 0.f;
#pragma unroll
        for (int j = 0; j < 16; ++j) { v[j] = *(const f32x4*)(yr + (j * 64 + lane) * 4); s += (v[j][0] + v[j][1]) + (v[j][2] + v[j][3]); }
        const float mean = wave_sum(s) * (1.0f / DM); float q = 0.f;
#pragma unroll
        for (int j = 0; j < 16; ++j) { v[j] = v[j] - mean; q += (v[j][0] * v[j][0] + v[j][1] * v[j][1]) + (v[j][2] * v[j][2] + v[j][3] * v[j][3]); }
        const float rstd = 1.0f / sqrtf(wave_sum(q) * (1.0f / DM) + LN_EPS);
#pragma unroll
        for (int j = 0; j < 16; ++j) { const int c = (j * 64 + lane) * 4; const f32x4 g = *(const f32x4*)(gain + c), b = *(const f32x4*)(bias + c); const f32x4 o = v[j] * rstd * g + b;
            *(f32x4*)(Xo + (size_t)row * DM + c) = o;
            if (XBo) { u32x2 w; w.x = pg8::cvt_pk_bf16(o[0], o[1]); w.y = pg8::cvt_pk_bf16(o[2], o[3]); *(u32x2*)(XBo + (size_t)row * DM + c) = w; } }
    }
}

DI bf16x8 ldg_bf16x8(const bf16_t* p) { return *(const bf16x8*)p; }
constexpr int VT_ROWB = 528;
DI void attn0_phase(const bf16_t* QKV, bf16_t* OG, float* LSE, LAS unsigned char* lds, int tid, int bid, int G) {
    const int lane = tid & 63, w = __builtin_amdgcn_readfirstlane(tid >> 6), n = lane & 15, g4 = lane >> 4;
    LAS unsigned char* vt = lds;
    const size_t GS = (size_t)MTOK * 2048;
    for (int u = bid; u < 6144; u += G) {
        const int h = u & 15, blk = (u >> 4) & 63, b = (u >> 10) & 1, grp = u >> 11;
        const int dsh = 2 * grp, d = 1 << dsh, r = blk >> (6 - dsh), nb = blk & ((64 >> dsh) - 1);
        const bf16_t* Qg = QKV + (size_t)(0 + grp) * GS; const bf16_t* Kg = QKV + (size_t)(3 + grp) * GS; const bf16_t* Vg = QKV + (size_t)(6 + grp) * GS;
        const size_t tok0 = (size_t)b * SEQ + r;
        __syncthreads();
        {
            const int kp = tid & 127, qd = tid >> 7; const int l0 = (nb - 1) * 128 + 2 * kp;
            u32x4 va[4], vb[4];
            if (l0 >= 0) { const bf16_t* p0 = Vg + (tok0 + (size_t)l0 * d) * 2048 + h * 128 + 32 * qd; const bf16_t* p1 = p0 + (size_t)d * 2048;
#pragma unroll
                for (int i = 0; i < 4; ++i) { va[i] = *(const u32x4*)(p0 + 8 * i); vb[i] = *(const u32x4*)(p1 + 8 * i); } }
            else {
#pragma unroll
                for (int i = 0; i < 4; ++i) { va[i] = (u32x4){0u, 0u, 0u, 0u}; vb[i] = (u32x4){0u, 0u, 0u, 0u}; } }
#pragma unroll
            for (int i = 0; i < 4; ++i)
#pragma unroll
                for (int e = 0; e < 4; ++e) { const unsigned a = va[i][e], bb = vb[i][e]; const int dim = 32 * qd + 8 * i + 2 * e;
                    *(LAS unsigned*)(vt + dim * VT_ROWB + kp * 4) = (a & 0xffffu) | (bb << 16);
                    *(LAS unsigned*)(vt + (dim + 1) * VT_ROWB + kp * 4) = (a >> 16) | (bb & 0xffff0000u); }
        }
        __syncthreads();
        const int iq = 16 * w + n, lq = nb * 128 + iq;
        const size_t qtok = tok0 + (size_t)lq * d;
        bf16x8 qf[4];
        { const bf16_t* qp = Qg + qtok * 2048 + h * 128 + 8 * g4;
#pragma unroll
          for (int ks = 0; ks < 4; ++ks) qf[ks] = ldg_bf16x8(qp + 32 * ks); }
        f32x4 s[9];
#pragma unroll
        for (int tt = 0; tt < 9; ++tt) {
            const int kf = 16 * (w + tt) + n, lk = (nb - 1) * 128 + kf;
            bf16x8 kfr[4];
            if (lk >= 0) { const bf16_t* kp_ = Kg + (tok0 + (size_t)lk * d) * 2048 + h * 128 + 8 * g4;
#pragma unroll
                for (int ks = 0; ks < 4; ++ks) kfr[ks] = ldg_bf16x8(kp_ + 32 * ks); }
            else {
#pragma unroll
                for (int ks = 0; ks < 4; ++ks) kfr[ks] = (bf16x8){0, 0, 0, 0, 0, 0, 0, 0}; }
            f32x4 a = {0.f, 0.f, 0.f, 0.f};
#pragma unroll
            for (int ks = 0; ks < 4; ++ks) a = __builtin_amdgcn_mfma_f32_16x16x32_bf16(kfr[ks], qf[ks], a, 0, 0, 0);
            s[tt] = a;
        }
        float mx = -__builtin_inff();
#pragma unroll
        for (int tt = 0; tt < 9; ++tt)
#pragma unroll
            for (int j = 0; j < 4; ++j) { const int kf = 16 * (w + tt) + 4 * g4 + j; const bool ok = (kf >= iq) && (kf <= iq + 128) && (nb > 0 || kf >= 128);
                const float x = ok ? s[tt][j] : -__builtin_inff(); s[tt][j] = x; mx = fmaxf(mx, x); }
        mx = fmaxf(mx, __shfl_xor(mx, 16)); mx = fmaxf(mx, __shfl_xor(mx, 32));
        const float msc = mx * SM_C; float lsum = 0.f;
#pragma unroll
        for (int tt = 0; tt < 9; ++tt)
#pragma unroll
            for (int j = 0; j < 4; ++j) { const float p = __builtin_amdgcn_exp2f(s[tt][j] * SM_C - msc); s[tt][j] = p; lsum += p; }
        lsum += __shfl_xor(lsum, 16); lsum += __shfl_xor(lsum, 32);
        f32x4 o[8];
#pragma unroll
        for (int dt = 0; dt < 8; ++dt) o[dt] = (f32x4){0.f, 0.f, 0.f, 0.f};
#pragma unroll
        for (int kk = 0; kk < 5; ++kk) {
            const int t0 = 2 * kk, t1 = 2 * kk + 1;
            u32x4 pw; pw.x = pg8::cvt_pk_bf16(s[t0][0], s[t0][1]); pw.y = pg8::cvt_pk_bf16(s[t0][2], s[t0][3]);
            if (t1 < 9) { pw.z = pg8::cvt_pk_bf16(s[t1 < 9 ? t1 : 8][0], s[t1 < 9 ? t1 : 8][1]); pw.w = pg8::cvt_pk_bf16(s[t1 < 9 ? t1 : 8][2], s[t1 < 9 ? t1 : 8][3]); } else { pw.z = 0u; pw.w = 0u; }
            const bf16x8 pf = __builtin_bit_cast(bf16x8, pw);
            int T1 = w + t1; T1 = T1 > 15 ? 15 : T1;
            const int off0 = (16 * (w + t0) + 4 * g4) * 2, off1 = (16 * T1 + 4 * g4) * 2;
#pragma unroll
            for (int dt = 0; dt < 8; ++dt) { const LAS unsigned char* rowp = vt + (16 * dt + n) * VT_ROWB;
                const u32x2 lo = *(const LAS u32x2*)(rowp + off0), hi = *(const LAS u32x2*)(rowp + off1);
                u32x4 vv; vv.x = lo.x; vv.y = lo.y; vv.z = hi.x; vv.w = hi.y;
                o[dt] = __builtin_amdgcn_mfma_f32_16x16x32_bf16(__builtin_bit_cast(bf16x8, vv), pf, o[dt], 0, 0, 0); }
        }
        const float inv = 1.0f / lsum;
        bf16_t* op = OG + (size_t)grp * GS + qtok * 2048 + h * 128 + 4 * g4;
#pragma unroll
        for (int dt = 0; dt < 8; ++dt) { u32x2 wv; wv.x = pg8::cvt_pk_bf16(o[dt][0] * inv, o[dt][1] * inv); wv.y = pg8::cvt_pk_bf16(o[dt][2] * inv, o[dt][3] * inv); *(u32x2*)(op + 16 * dt) = wv; }
        if (g4 == 0) LSE[(size_t)grp * (MTOK * 16) + qtok * 16 + h] = mx * SM_SCALE + __logf(lsum);
    }
}

DI void merge_phase(const bf16_t* OG, const float* LSE, bf16_t* AO, int tid, int bid, int G) {
    const int lane = tid & 63, gw = bid * NWAVES + (tid >> 6), nw = G * NWAVES; const size_t GS = (size_t)MTOK * 2048;
    for (int tok = gw; tok < MTOK; tok += nw) {
#pragma unroll
        for (int it = 0; it < 4; ++it) { const int e = it * 512 + lane * 8, h = e >> 7;
            const float l0 = LSE[(size_t)tok * 16 + h], l1 = LSE[(size_t)(MTOK * 16) + (size_t)tok * 16 + h], l2 = LSE[(size_t)(2 * MTOK * 16) + (size_t)tok * 16 + h];
            const float mx = fmaxf(l0, fmaxf(l1, l2)); const float e0 = __expf(l0 - mx), e1 = __expf(l1 - mx), e2 = __expf(l2 - mx); const float inv = 1.0f / (e0 + e1 + e2);
            const float w0 = e0 * inv, w1 = e1 * inv, w2 = e2 * inv;
            const u32x4 a = *(const u32x4*)(OG + (size_t)tok * 2048 + e), b = *(const u32x4*)(OG + GS + (size_t)tok * 2048 + e), c = *(const u32x4*)(OG + 2 * GS + (size_t)tok * 2048 + e);
            u32x4 o;
#pragma unroll
            for (int k = 0; k < 4; ++k) { const float lo = w0 * __uint_as_float(a[k] << 16) + w1 * __uint_as_float(b[k] << 16) + w2 * __uint_as_float(c[k] << 16);
                const float hi = w0 * __uint_as_float(a[k] & 0xffff0000u) + w1 * __uint_as_float(b[k] & 0xffff0000u) + w2 * __uint_as_float(c[k] & 0xffff0000u);
                o[k] = pg8::cvt_pk_bf16(lo, hi); }
            *(u32x4*)(AO + (size_t)tok * 2048 + e) = o; }
    }
}

DI void kidx_phase(const float* KIR, const float* gain, const float* bias, const float* CS, const float* SN, unsigned short* KI16, int tid, int bid, int G) {
    const int lane = tid & 63, gw = bid * NWAVES + (tid >> 6), nw = G * NWAVES;
    const float g1 = gain[lane], g2 = gain[lane + 64], b1 = bias[lane], b2 = bias[lane + 64];
    const int j1 = sigma_inv(lane);
    for (int tok = gw; tok < MTOK; tok += nw) {
        const float x1 = KIR[(size_t)tok * 128 + lane], x2 = KIR[(size_t)tok * 128 + 64 + lane];
        const float mean = wave_sum(x1 + x2) * (1.0f / 128.0f); const float d1 = x1 - mean, d2 = x2 - mean;
        const float rstd = 1.0f / sqrtf(wave_sum(d1 * d1 + d2 * d2) * (1.0f / 128.0f) + LN_EPS);
        const float y1 = d1 * rstd * g1 + b1, y2 = d2 * rstd * g2 + b2;
        const float c = CS[(size_t)tok * 64 + lane], s = SN[(size_t)tok * 64 + lane];
        const _Float16 o1 = (_Float16)(y1 * c - y2 * s), o2 = (_Float16)(y2 * c + y1 * s);
        KI16[(size_t)tok * 128 + j1] = __builtin_bit_cast(unsigned short, o1); KI16[(size_t)tok * 128 + j1 + 4] = __builtin_bit_cast(unsigned short, o2);
    }
}

constexpr int KT_ROWB = 272, KT_BYTES = 64 * KT_ROWB;
DI size_t sc_row_off(int b, int s) { const int qb = s >> 7; return ((size_t)(b * 2080 + ((qb * (qb + 1)) >> 1))) * 16384 + (size_t)(s & 127) * ((qb + 1) * 128); }
DI void indexer_phase(const unsigned short* QI, const unsigned short* KI16, const float* WI, float* SC, LAS unsigned char* lds, int tid, int bid, int G) {
    const int lane = tid & 63, w = __builtin_amdgcn_readfirstlane(tid >> 6), r32 = lane & 31, h2 = lane >> 5;
    for (int v = bid; v < 256; v += G) {
        for (int it = 0; it < 4; ++it) {
            const int b = it >> 1, gi = (it & 1) ? (511 - v) : v; const int tb = 16 * gi;
            const int ntiles = ((tb + 15) >> 6) + 1;
            f16x8 af[2][8]; f32x4 wv[2][4];
#pragma unroll
            for (int tq = 0; tq < 2; ++tq) { const size_t tg = (size_t)b * SEQ + tb + 2 * w + tq;
#pragma unroll
                for (int ks = 0; ks < 8; ++ks) af[tq][ks] = *(const f16x8*)(QI + tg * 4096 + r32 * 128 + 16 * ks + 8 * h2);
#pragma unroll
                for (int q = 0; q < 4; ++q) wv[tq][q] = *(const f32x4*)(WI + tg * 32 + 8 * q + 4 * h2); }
            const unsigned short* KIb = KI16 + (size_t)b * SEQ * 128;
            const int key0 = tid >> 4, ch = tid & 15;
            u32x4 st0, st1;
            st0 = *(const u32x4*)(KIb + (size_t)key0 * 128 + ch * 8); st1 = *(const u32x4*)(KIb + (size_t)(key0 + 32) * 128 + ch * 8);
            __syncthreads();
            for (int kt = 0; kt < ntiles; ++kt) {
                LAS unsigned char* buf = lds + (kt & 1) * KT_BYTES;
                *(LAS u32x4*)(buf + key0 * KT_ROWB + ch * 16) = st0; *(LAS u32x4*)(buf + (key0 + 32) * KT_ROWB + ch * 16) = st1;
                __syncthreads();
                if (kt + 1 < ntiles) { const unsigned short* src = KIb + (size_t)((kt + 1) * 64 + key0) * 128 + ch * 8; st0 = *(const u32x4*)src; st1 = *(const u32x4*)(src + 32 * 128); }
#pragma unroll
                for (int sub = 0; sub < 2; ++sub) {
                    f16x8 bfr[8];
#pragma unroll
                    for (int ks = 0; ks < 8; ++ks) bfr[ks] = *(const LAS f16x8*)(buf + (32 * sub + r32) * KT_ROWB + (16 * ks + 8 * h2) * 2);
#pragma unroll
                    for (int tq = 0; tq < 2; ++tq) {
                        f32x16 c;
#pragma unroll
                        for (int i = 0; i < 16; ++i) c[i] = 0.f;
#pragma unroll
                        for (int ks = 0; ks < 8; ++ks) c = __builtin_amdgcn_mfma_f32_32x32x16_f16(af[tq][ks], bfr[ks], c, 0, 0, 0);
                        float sc = 0.f;
#pragma unroll
                        for (int q = 0; q < 4; ++q)
#pragma unroll
                            for (int e = 0; e < 4; ++e) sc += wv[tq][q][e] * fmaxf(c[4 * q + e], 0.f);
                        sc += __shfl_xor(sc, 32);
                        if (h2 == 0) SC[sc_row_off(b, tb + 2 * w + tq) + kt * 64 + 32 * sub + r32] = sc;
                    }
                }
            }
        }
    }
}

DI unsigned mbcnt64(unsigned long long m) { return __builtin_amdgcn_mbcnt_hi((unsigned)(m >> 32), __builtin_amdgcn_mbcnt_lo((unsigned)m, 0u)); }
DI unsigned f2key(float f) { const unsigned u = __float_as_uint(f); return (u & 0x80000000u) ? ~u : (u | 0x80000000u); }
template <int NV>
DI void topk_row(const float* row, int s, int* out, int lane) {
    unsigned key[NV];
    { const unsigned long long ra = (unsigned long long)row; const unsigned rlo = __builtin_amdgcn_readfirstlane((unsigned)ra), rhi = __builtin_amdgcn_readfirstlane((unsigned)(ra >> 32));
      row = (const float*)(((unsigned long long)rhi << 32) | rlo); }
#pragma unroll
    for (int jo = 0; jo < NV / 16; ++jo) { const float* rb = row + jo * 1024;
#pragma unroll
        for (int ji = 0; ji < 16; ++ji) { const int j = jo * 16 + ji; const unsigned u = f2key(rb[ji * 64 + lane]); key[j] = (j * 64 + lane <= s) ? u : 0u; } }
    unsigned T = 0u;
#pragma unroll 1
    for (int bit = 31; bit >= 0; --bit) {
        const unsigned cand = T | (1u << bit); int cnt = 0;
#pragma unroll
        for (int j = 0; j < NV; ++j) cnt += __builtin_popcountll(__ballot(key[j] >= cand));
        if (cnt >= 256) T = cand;
    }
    int cgt = 0;
#pragma unroll
    for (int j = 0; j < NV; ++j) cgt += __builtin_popcountll(__ballot(key[j] > T));
    int bgt = 0, beq = cgt;
    const int nch = (s >> 6) + 1;
#pragma unroll 1
    for (int j = 0; j < nch; ++j) { const int k = j * 64 + lane; const unsigned u = (k <= s) ? f2key(row[k]) : 0u;
        const bool sg = u > T, se = u == T; const unsigned long long mg = __ballot(sg), me = __ballot(se);
        const int pg = bgt + (int)mbcnt64(mg), pe = beq + (int)mbcnt64(me);
        if (sg) out[pg] = k; else if (se && pe < 256) out[pe] = k;
        bgt += __builtin_popcountll(mg); beq += __builtin_popcountll(me); }
}
DI void topk_phase(const float* SC, int* IDX, int tid, int bid, int G) {
    const int lane = tid & 63, gw = bid * NWAVES + (tid >> 6), nw = G * NWAVES;
    for (int t = gw; t < MTOK; t += nw) {
        const int b = t >> 13, s = t & 8191; int* out = IDX + (size_t)t * 256;
        if (s < 256) {
#pragma unroll
            for (int i = 0; i < 4; ++i) { const int j = lane + 64 * i; out[j] = (j <= s) ? j : 0; }
        } else {
            const float* row = SC + sc_row_off(b, s);
            if (s < 2048) topk_row<32>(row, s, out, lane);
            else if (s < 4096) topk_row<64>(row, s, out, lane);
            else if (s < 6144) topk_row<96>(row, s, out, lane);
            else topk_row<128>(row, s, out, lane);
        }
    }
}

DI void dsa_attn_phase(const bf16_t* Q1, const bf16_t* K1, const bf16_t* V1, const int* IDX, bf16_t* AO, LAS unsigned char* lds, int tid, int bid, int G) {
    const int lane = tid & 63, w = __builtin_amdgcn_readfirstlane(tid >> 6), n = lane & 15, g4 = lane >> 4;
    LAS float* pw = (LAS float*)(lds + w * 5120); LAS int* iw = (LAS int*)(lds + w * 5120 + 4096);
    const bool xm = (G & 7) == 0;
    const int start = xm ? ((bid >> 3) * NWAVES + w) : (bid * NWAVES + w), step = xm ? ((G >> 3) * NWAVES) : (G * NWAVES), total = xm ? MTOK : MTOK * 8;
    for (int it = start; it < total; it += step) {
        const int kvh = xm ? (bid & 7) : (it & 7), t = xm ? it : (it >> 3);
        const int b = t >> 13, s = t & 8191; const int nvalid = s + 1 < 256 ? s + 1 : 256;
        const int* ip = IDX + (size_t)t * 256;
#pragma unroll
        for (int i = 0; i < 4; ++i) iw[lane + 64 * i] = ip[lane + 64 * i];
        int kidx[16];
#pragma unroll
        for (int tt = 0; tt < 16; ++tt) kidx[tt] = ip[16 * tt + n];
        const bf16_t* Kb = K1 + (size_t)(b * 8 + kvh) * SEQ * 128; const bf16_t* Vb = V1 + (size_t)(b * 8 + kvh) * SEQ * 128;
        bf16x8 qf[4];
#pragma unroll
        for (int ks = 0; ks < 4; ++ks) qf[ks] = (n < 4) ? ldg_bf16x8(Q1 + (size_t)t * 4096 + (4 * kvh + n) * 128 + 32 * ks + 8 * g4) : (bf16x8){0, 0, 0, 0, 0, 0, 0, 0};
        f32x4 sa[16];
#pragma unroll
        for (int tt = 0; tt < 16; ++tt) { const bf16_t* kp = Kb + (size_t)kidx[tt] * 128 + 8 * g4; f32x4 a = {0.f, 0.f, 0.f, 0.f};
#pragma unroll
            for (int ks = 0; ks < 4; ++ks) a = __builtin_amdgcn_mfma_f32_16x16x32_bf16(ldg_bf16x8(kp + 32 * ks), qf[ks], a, 0, 0, 0);
            sa[tt] = a; }
        float mx = -__builtin_inff();
#pragma unroll
        for (int tt = 0; tt < 16; ++tt)
#pragma unroll
            for (int j = 0; j < 4; ++j) { const int kk = 16 * tt + 4 * g4 + j; const float x = (kk < nvalid) ? sa[tt][j] : -__builtin_inff(); sa[tt][j] = x; mx = fmaxf(mx, x); }
        mx = fmaxf(mx, __shfl_xor(mx, 16)); mx = fmaxf(mx, __shfl_xor(mx, 32));
        const float msc = mx * SM_C; float lsum = 0.f;
#pragma unroll
        for (int tt = 0; tt < 16; ++tt)
#pragma unroll
            for (int j = 0; j < 4; ++j) { const float p = __builtin_amdgcn_exp2f(sa[tt][j] * SM_C - msc); lsum += p; if (n < 4) pw[(16 * tt + 4 * g4 + j) * 4 + n] = p; }
        lsum += __shfl_xor(lsum, 16); lsum += __shfl_xor(lsum, 32);
        float acc[4][2];
#pragma unroll
        for (int hh = 0; hh < 4; ++hh) { acc[hh][0] = 0.f; acc[hh][1] = 0.f; }
        for (int k0 = 0; k0 < 256; k0 += 8) {
            unsigned vv[8];
#pragma unroll
            for (int e = 0; e < 8; ++e) { const int row = iw[k0 + e]; vv[e] = *(const unsigned*)(Vb + (size_t)row * 128 + 2 * lane); }
#pragma unroll
            for (int e = 0; e < 8; ++e) { const f32x4 p4 = *(const LAS f32x4*)(pw + (k0 + e) * 4); const float v0 = __uint_as_float(vv[e] << 16), v1 = __uint_as_float(vv[e] & 0xffff0000u);
#pragma unroll
                for (int hh = 0; hh < 4; ++hh) { acc[hh][0] += p4[hh] * v0; acc[hh][1] += p4[hh] * v1; } }
        }
#pragma unroll
        for (int hh = 0; hh < 4; ++hh) { const float li = 1.0f / __shfl(lsum, hh);
            *(unsigned*)(AO + (size_t)t * 4096 + (4 * kvh + hh) * 128 + 2 * lane) = pg8::cvt_pk_bf16(acc[hh][0] * li, acc[hh][1] * li); }
    }
}

#ifndef MK_ONE_LAUNCH
#define MK_ONE_LAUNCH 1
#endif
constexpr int N_PHASES = 19;
struct Args { const float* in[22]; float* out; unsigned char* ws; int ph_lo, ph_hi; };

__global__ void __launch_bounds__(NTHR, 2) mk_fwd(Args args) {
    extern __shared__ __attribute__((aligned(16))) unsigned char lds_raw[];
    LAS unsigned char* lds = (LAS unsigned char*)lds_raw;
    const int tid = threadIdx.x, bid = blockIdx.x, G = gridDim.x;
    unsigned char* ws = args.ws;
    volatile LAS unsigned* misc = (volatile LAS unsigned*)(lds + MISC_OFF);
    if (tid < 4) misc[tid] = 0u;
    __syncthreads();
    const int lo = args.ph_lo, hi = args.ph_hi;
    XcdBarrier bar; bar.bar = (unsigned*)(ws + WS_CTL); bar.x = 0; bar.st = nullptr;
    if (hi - lo > 1) bar = xcd_barrier_post((unsigned*)(ws + WS_CTL), misc);
#ifndef PH_MASK
#define PH_MASK 0x7ffff
#endif
#define IN(k) ((((PH_MASK) >> (k)) & 1) && lo <= (k) && (k) < hi)
#define SEAM(k) do { if (IN(k) && IN((k) + 1)) xcd_barrier(bar); } while (0)

    const float* x0 = args.in[0]; const int* positions = (const int*)args.in[1];
    float* CS = (float*)(ws + WS_COS); float* SN = (float*)(ws + WS_SIN);
    bf16_t* XB = (bf16_t*)(ws + WS_XB); float* XA = (float*)(ws + WS_XA); float* Y = (float*)(ws + B_Y); bf16_t* Hh = (bf16_t*)(ws + B_H);
    float* OUT = args.out;
    const pg8::RopeTab rt{CS, SN};

    if (IN(0)) {
        LAS float* scr = (LAS float*)lds;
        wt_matrix(args.in[2], DM, N_A, (bf16_t*)(ws + W0IN), MapA{}, scr, tid, bid, G);
        wt_matrix(args.in[3], 2048, DM, (bf16_t*)(ws + W0OUT), MapId{}, scr, tid, bid, G);
        wt_matrix(args.in[10], DM, DFF, (bf16_t*)(ws + W0GU), MapGU{0}, scr, tid, bid, G);
        wt_matrix(args.in[11], DM, DFF, (bf16_t*)(ws + W0GU), MapGU{1}, scr, tid, bid, G);
        wt_matrix(args.in[12], DFF, DM, (bf16_t*)(ws + W0DN), MapId{}, scr, tid, bid, G);
        cvt_x_phase(x0, XB, tid, bid, G);
        rope_tab_phase(positions, CS, SN, tid, bid, G);
    }
    SEAM(0);
    if (IN(1)) {
        pg8::Gemm g{XB, (const bf16_t*)(ws + W0IN), MTOK, N_A, DM}; pg8::StaticOrder S; S.init(MTOK, N_A, G, bid);
        pg8::EpiQKV0 E{(bf16_t*)(ws + B_QKV0), rt};
        pg8::gemm_phase<pg8::EpiQKV0, pg8::StaticOrder, true, true>(lds, g, S, E);
    }
    SEAM(1);
    if (IN(2)) attn0_phase((const bf16_t*)(ws + B_QKV0), (bf16_t*)(ws + B_OG), (float*)(ws + B_LSE), lds, tid, bid, G);
    SEAM(2);
    if (IN(3)) merge_phase((const bf16_t*)(ws + B_OG), (const float*)(ws + B_LSE), (bf16_t*)(ws + B_AO0), tid, bid, G);
    SEAM(3);
    if (IN(4)) {
        pg8::Gemm g{(const bf16_t*)(ws + B_AO0), (const bf16_t*)(ws + W0OUT), MTOK, DM, 2048}; pg8::StaticOrder S; S.init(MTOK, DM, G, bid);
        pg8::EpiY E{x0, Y, DM, ALPHA};
        pg8::gemm_phase<pg8::EpiY, pg8::StaticOrder, true, true>(lds, g, S, E);
    }
    SEAM(4);
    if (IN(5)) ln_phase(Y, args.in[8], args.in[9], OUT, XB, tid, bid, G);
    SEAM(5);
    if (IN(6)) {
        pg8::Gemm g{XB, (const bf16_t*)(ws + W0GU), MTOK, 2 * DFF, DM}; pg8::StaticOrder S; S.init(MTOK, 2 * DFF, G, bid);
        pg8::EpiSwiGLU E{Hh, DFF};
        pg8::gemm_phase<pg8::EpiSwiGLU, pg8::StaticOrder, true, true>(lds, g, S, E);
    }
    SEAM(6);
    if (IN(7)) {
        pg8::Gemm g{Hh, (const bf16_t*)(ws + W0DN), MTOK, DM, DFF}; pg8::StaticOrder S; S.init(MTOK, DM, G, bid);
        pg8::EpiY E{OUT, Y, DM, ALPHA};
        pg8::gemm_phase<pg8::EpiY, pg8::StaticOrder, true, true>(lds, g, S, E);
    }
    SEAM(7);
    if (IN(8)) {
        ln_phase(Y, args.in[13], args.in[14], XA, XB, tid, bid, G);
        LAS float* scr = (LAS float*)lds;
        wt_matrix(args.in[4], DM, N_B, (bf16_t*)(ws + W1IN), MapB{}, scr, tid, bid, G);
        { u32x4* z = (u32x4*)(ws + W1IN + (size_t)N_B * DM * 2); const int nz = (N_BP - N_B) * DM * 2 / 16; for (int i = bid * NTHR + tid; i < nz; i += G * NTHR) z[i] = (u32x4){0u, 0u, 0u, 0u}; }
        wt_matrix(args.in[7], DM, DM, (bf16_t*)(ws + W1OUT), MapId{}, scr, tid, bid, G);
        wt_matrix(args.in[17], DM, DFF, (bf16_t*)(ws + W1GU), MapGU{0}, scr, tid, bid, G);
        wt_matrix(args.in[18], DM, DFF, (bf16_t*)(ws + W1GU), MapGU{1}, scr, tid, bid, G);
        wt_matrix(args.in[19], DFF, DM, (bf16_t*)(ws + W1DN), MapId{}, scr, tid, bid, G);
    }
    SEAM(8);
    if (IN(9)) {
        pg8::Gemm g{XB, (const bf16_t*)(ws + W1IN), MTOK, N_BP, DM}; pg8::StaticOrder S; S.init(MTOK, N_BP, G, bid);
        pg8::EpiQKV1 E{(bf16_t*)(ws + B_Q1), (bf16_t*)(ws + B_K1), (bf16_t*)(ws + B_V1), (unsigned short*)(ws + B_QI), (float*)(ws + B_KIR), (float*)(ws + B_WI), rt};
        pg8::gemm_phase<pg8::EpiQKV1, pg8::StaticOrder, true, true>(lds, g, S, E);
    }
    SEAM(9);
    if (IN(10)) kidx_phase((const float*)(ws + B_KIR), args.in[5], args.in[6], CS, SN, (unsigned short*)(ws + B_KI16), tid, bid, G);
    SEAM(10);
    if (IN(11)) indexer_phase((const unsigned short*)(ws + B_QI), (const unsigned short*)(ws + B_KI16), (const float*)(ws + B_WI), (float*)(ws + B_SC), lds, tid, bid, G);
    SEAM(11);
    if (IN(12)) topk_phase((const float*)(ws + B_SC), (int*)(ws + B_IDX), tid, bid, G);
    SEAM(12);
    if (IN(13)) dsa_attn_phase((const bf16_t*)(ws + B_Q1), (const bf16_t*)(ws + B_K1), (const bf16_t*)(ws + B_V1), (const int*)(ws + B_IDX), (bf16_t*)(ws + B_AO1), lds, tid, bid, G);
    SEAM(13);
    if (IN(14)) {
        pg8::Gemm g{(const bf16_t*)(ws + B_AO1), (const bf16_t*)(ws + W1OUT), MTOK, DM, DM}; pg8::StaticOrder S; S.init(MTOK, DM, G, bid);
        pg8::EpiY E{XA, Y, DM, ALPHA};
        pg8::gemm_phase<pg8::EpiY, pg8::StaticOrder, true, true>(lds, g, S, E);
    }
    SEAM(14);
    if (IN(15)) ln_phase(Y, args.in[15], args.in[16], OUT, XB, tid, bid, G);
    SEAM(15);
    if (IN(16)) {
        pg8::Gemm g{XB, (const bf16_t*)(ws + W1GU), MTOK, 2 * DFF, DM}; pg8::StaticOrder S; S.init(MTOK, 2 * DFF, G, bid);
        pg8::EpiSwiGLU E{Hh, DFF};
        pg8::gemm_phase<pg8::EpiSwiGLU, pg8::StaticOrder, true, true>(lds, g, S, E);
    }
    SEAM(16);
    if (IN(17)) {
        pg8::Gemm g{Hh, (const bf16_t*)(ws + W1DN), MTOK, DM, DFF}; pg8::StaticOrder S; S.init(MTOK, DM, G, bid);
        pg8::EpiY E{OUT, Y, DM, ALPHA};
        pg8::gemm_phase<pg8::EpiY, pg8::StaticOrder, true, true>(lds, g, S, E);
    }
    SEAM(17);
    if (IN(18)) ln_phase(Y, args.in[20], args.in[21], OUT, nullptr, tid, bid, G);
#undef IN
#undef SEAM
}

extern "C" void kernel_launch(void* const* d_in, const int* in_sizes, int n_in, void* d_out, int out_size, void* d_ws, size_t ws_size, hipStream_t stream) {
    static int grid = 0;
    if (grid == 0) {
        if (n_in != 22 || out_size != MTOK * DM || ws_size < WS_END) { fprintf(stderr, "kernel_launch: unexpected problem (n_in %d, out %d, ws %zu < %zu); nothing launched\n", n_in, out_size, ws_size, (size_t)WS_END); grid = -1; return; }
        int dev = 0, cus = 0, per_cu = 0;
        if (hipGetDevice(&dev) != hipSuccess || hipDeviceGetAttribute(&cus, hipDeviceAttributeMultiprocessorCount, dev) != hipSuccess) { grid = -1; return; }
        if (hipFuncSetAttribute((const void*)mk_fwd, hipFuncAttributeMaxDynamicSharedMemorySize, LDS_BYTES) != hipSuccess) { fprintf(stderr, "kernel_launch: hipFuncSetAttribute failed\n"); grid = -1; return; }
        if (hipOccupancyMaxActiveBlocksPerMultiprocessor(&per_cu, (const void*)mk_fwd, NTHR, LDS_BYTES) != hipSuccess || per_cu < 1) { fprintf(stderr, "kernel_launch: occupancy query reports %d\n", per_cu); (void)hipGetLastError(); per_cu = 1; }
        grid = cus;
    }
    if (grid < 0) return;
    (void)in_sizes;
    if (hipMemsetAsync((char*)d_ws + WS_CTL, 0, CTL_ZERO_BYTES, stream) != hipSuccess) return;
    Args a{};
    for (int i = 0; i < 22; ++i) a.in[i] = (const float*)d_in[i];
    a.out = (float*)d_out; a.ws = (unsigned char*)d_ws;
#if MK_ONE_LAUNCH
    a.ph_lo = 0; a.ph_hi = N_PHASES;
    hipLaunchKernelGGL(mk_fwd, dim3(grid), dim3(NTHR), LDS_BYTES, stream, a);
#else
    for (int p = 0; p < N_PHASES; ++p) { a.ph_lo = p; a.ph_hi = p + 1; hipLaunchKernelGGL(mk_fwd, dim3(grid), dim3(NTHR), LDS_BYTES, stream, a); }
#endif
}
```

```cpp
#define DUP_MASK 0
#include <hip/hip_runtime.h>
#include <cstdio>
#include <cstdint>
namespace pg8 {
#define PG8_LAS __attribute__((address_space(3)))
typedef unsigned short bf16_t;
typedef short bf16x8 __attribute__((ext_vector_type(8)));
typedef float f32x4 __attribute__((ext_vector_type(4)));
typedef unsigned u32x4 __attribute__((ext_vector_type(4)));
constexpr int BM = 256, BK = 64, HALF = 128, HTB = HALF * BK * 2  , STAGE_BYTES = 8 * HTB, NXCD = 8, WGM = 8;

__host__ __device__ __forceinline__ int lds_byte(int r, int c) { const int st = (r >> 4) * 2 + (c >> 5), rr = r & 15, cc = c & 31, ob = rr * 64 + cc * 2; return st * 1024 + (ob ^ (((ob >> 9) & 1) << 5)); }
__host__ __device__ __forceinline__ void stage_rc(int b, int& R, int& C) { const int st = b / 1024, sb = b % 1024, swz = sb ^ (((sb >> 9) & 1) << 5); R = (st >> 1) * 16 + swz / 64; C = (st & 1) * 32 + (swz % 64) / 2; }
__host__ __device__ __forceinline__ int perm32(int rho) { const int n = rho >> 4, i = rho & 15; return 8 * (i >> 2) + 4 * n + (i & 3); }

struct Unit { int pm, pn; };
struct Gemm { const bf16_t* A; const bf16_t* Bt; int M, N, K; };

struct StaticOrder {
    int nM, nN, nwg, G, c;
    __host__ __device__ void init(int M, int N, int G_, int c_) { nM = M / BM; nN = N / BM; nwg = nM * nN; G = G_; c = c_; }
    __host__ __device__ bool next(int i, Unit& u) const {
        const long L = (long)i * G + c; if (L >= nwg) return false;
        int wgid = (int)L; { const int q = nwg / NXCD, r = nwg % NXCD, xcd = wgid % NXCD, off = wgid / NXCD; wgid = (xcd < r ? xcd * (q + 1) : r * (q + 1) + (xcd - r) * q) + off; }
        const int nig = WGM * nN, gid = wgid / nig, fm = gid * WGM, gsz = (nM - fm) < WGM ? (nM - fm) : WGM;
        u.pm = fm + ((wgid % nig) % gsz); u.pn = (wgid % nig) / gsz; return true;
    }
    __device__ __forceinline__ void a_ready(const Unit&) const {}
    __device__ __forceinline__ void done(const Unit&) const {}
};
__device__ __forceinline__ unsigned cvt_pk_bf16(float lo, float hi) { unsigned r; asm volatile("v_cvt_pk_bf16_f32 %0, %1, %2" : "=v"(r) : "v"(lo), "v"(hi)); return r; }
typedef _Float16 f16x2_t __attribute__((ext_vector_type(2)));
__device__ __forceinline__ unsigned cvt_pk_f16(float lo, float hi) { f16x2_t h; h.x = (_Float16)lo; h.y = (_Float16)hi; return __builtin_bit_cast(unsigned, h); }

struct RopeTab { const float* cs; const float* sn; };

__device__ __forceinline__ void rope_pair(f32x4& v0, f32x4& v1, const f32x4 c, const f32x4 s) {
    const f32x4 a = v0 * c - v1 * s, b = v1 * c + v0 * s; v0 = a; v1 = b;
}

struct EpiY {
    static constexpr bool PERM = false, AFTER_DRAIN = false;
    const float* X; float* Y; int ldc; float alpha;
    __device__ __forceinline__ void operator()(const f32x4 (&acc)[2][2][4][2], const Unit& u, int wr, int wc, int fr, int fq) const {
        const int row0 = u.pm * BM + wr * 64 + fr, col0 = u.pn * BM + wc * 32 + 4 * fq;
#pragma unroll
        for (int ai = 0; ai < 2; ++ai) {
            f32x4 xv[4][2][2];
#pragma unroll
            for (int m = 0; m < 4; ++m) { const size_t off = (size_t)(row0 + ai * HALF + m * 16) * ldc + col0;
#pragma unroll
                for (int bj = 0; bj < 2; ++bj)
#pragma unroll
                    for (int n = 0; n < 2; ++n) xv[m][bj][n] = *(const f32x4*)(X + off + bj * HALF + n * 16); }
#pragma unroll
            for (int m = 0; m < 4; ++m) { const size_t off = (size_t)(row0 + ai * HALF + m * 16) * ldc + col0;
#pragma unroll
                for (int bj = 0; bj < 2; ++bj)
#pragma unroll
                    for (int n = 0; n < 2; ++n) *(f32x4*)(Y + off + bj * HALF + n * 16) = xv[m][bj][n] * alpha + acc[ai][bj][m][n]; }
            asm volatile("" ::: "memory"); }
    }
};

struct EpiSwiGLU {
    static constexpr bool PERM = true, AFTER_DRAIN = false;
    bf16_t* Hh; int ldh;
    __device__ __forceinline__ void operator()(const f32x4 (&acc)[2][2][4][2], const Unit& u, int wr, int wc, int fr, int fq) const {
        const int row0 = u.pm * BM + wr * 64 + fr, col0 = u.pn * HALF + wc * 32 + 8 * fq;
#pragma unroll
        for (int ai = 0; ai < 2; ++ai)
#pragma unroll
            for (int m = 0; m < 4; ++m) { bf16_t* rowp = Hh + (size_t)(row0 + ai * HALF + m * 16) * ldh + col0;
                float h[8];
#pragma unroll
                for (int n = 0; n < 2; ++n)
#pragma unroll
                    for (int i = 0; i < 4; ++i) { const float g = acc[ai][0][m][n][i], up = acc[ai][1][m][n][i];
                        const float e = __builtin_amdgcn_exp2f(-g * 1.44269504089f); h[n * 4 + i] = g * __builtin_amdgcn_rcpf(1.0f + e) * up; }
                u32x4 w; w.x = cvt_pk_bf16(h[0], h[1]); w.y = cvt_pk_bf16(h[2], h[3]); w.z = cvt_pk_bf16(h[4], h[5]); w.w = cvt_pk_bf16(h[6], h[7]);
                *(u32x4*)rowp = w; }
    }
};

struct EpiQKV0 {
    static constexpr bool PERM = true, AFTER_DRAIN = false;
    bf16_t* O; RopeTab rt;
    __device__ __forceinline__ void operator()(const f32x4 (&acc)[2][2][4][2], const Unit& u, int wr, int wc, int fr, int fq) const {
        const int sg = u.pn >> 3, colin = (u.pn & 7) * BM + wc * 32 + 8 * fq; const bool rope = sg < 6;
        bf16_t* base = O + (size_t)sg * ((size_t)16384 * 2048);
        const int row0 = u.pm * BM + wr * 64 + fr, f0 = 16 * wc + 4 * fq;
#pragma unroll
        for (int ai = 0; ai < 2; ++ai)
#pragma unroll
            for (int m = 0; m < 4; ++m) { const int row = row0 + ai * HALF + m * 16; bf16_t* rowp = base + (size_t)row * 2048 + colin;
                f32x4 c = {1.f, 1.f, 1.f, 1.f}, s = {0.f, 0.f, 0.f, 0.f};
                if (rope) { c = *(const f32x4*)(rt.cs + (size_t)row * 64 + f0); s = *(const f32x4*)(rt.sn + (size_t)row * 64 + f0); }
#pragma unroll
                for (int bj = 0; bj < 2; ++bj) { f32x4 v0 = acc[ai][bj][m][0], v1 = acc[ai][bj][m][1];
                    rope_pair(v0, v1, c, s);
                    u32x4 w; w.x = cvt_pk_bf16(v0[0], v0[1]); w.y = cvt_pk_bf16(v0[2], v0[3]); w.z = cvt_pk_bf16(v1[0], v1[1]); w.w = cvt_pk_bf16(v1[2], v1[3]);
                    *(u32x4*)(rowp + bj * HALF) = w; } }
    }
};

struct EpiQKV1 {
    static constexpr bool PERM = true, AFTER_DRAIN = false;
    bf16_t* Q; bf16_t* Kc; bf16_t* Vc; unsigned short* QI; float* KIR; float* WI; RopeTab rt;
    __device__ __forceinline__ void operator()(const f32x4 (&acc)[2][2][4][2], const Unit& u, int wr, int wc, int fr, int fq) const {
        const int pn = u.pn; const int row0 = u.pm * BM + wr * 64 + fr, f0 = 16 * wc + 4 * fq, cw = wc * 32 + 8 * fq;
        const bool rope = (pn < 20) || (pn >= 24 && pn < 40);
#pragma unroll
        for (int ai = 0; ai < 2; ++ai)
#pragma unroll
            for (int m = 0; m < 4; ++m) { const int row = row0 + ai * HALF + m * 16;
                f32x4 c = {1.f, 1.f, 1.f, 1.f}, s = {0.f, 0.f, 0.f, 0.f};
                if (rope) { c = *(const f32x4*)(rt.cs + (size_t)row * 64 + f0); s = *(const f32x4*)(rt.sn + (size_t)row * 64 + f0); }
#pragma unroll
                for (int bj = 0; bj < 2; ++bj) { f32x4 v0 = acc[ai][bj][m][0], v1 = acc[ai][bj][m][1];
                    if (pn < 40) {
                        rope_pair(v0, v1, c, s);
                        u32x4 w;
                        if (pn >= 24) { w.x = cvt_pk_f16(v0[0], v0[1]); w.y = cvt_pk_f16(v0[2], v0[3]); w.z = cvt_pk_f16(v1[0], v1[1]); w.w = cvt_pk_f16(v1[2], v1[3]); }
                        else { w.x = cvt_pk_bf16(v0[0], v0[1]); w.y = cvt_pk_bf16(v0[2], v0[3]); w.z = cvt_pk_bf16(v1[0], v1[1]); w.w = cvt_pk_bf16(v1[2], v1[3]); }
                        if (pn < 16) *(u32x4*)(Q + (size_t)row * 4096 + pn * BM + bj * HALF + cw) = w;
                        else if (pn < 24) { const int kvh = ((pn - 16) & 3) * 2 + bj; bf16_t* dst = (pn < 20 ? Kc : Vc) + ((size_t)((row >> 13) * 8 + kvh) * 8192 + (row & 8191)) * 128 + cw; *(u32x4*)dst = w; }
                        else *(u32x4*)(QI + (size_t)row * 4096 + (pn - 24) * BM + bj * HALF + cw) = w;
                    } else {
                        if (bj == 0) { *(f32x4*)(KIR + (size_t)row * 128 + cw) = v0; *(f32x4*)(KIR + (size_t)row * 128 + cw + 4) = v1; }
                        else if (wc == 0) { *(f32x4*)(WI + (size_t)row * 32 + cw) = v0 * 0.015625f; *(f32x4*)(WI + (size_t)row * 32 + cw + 4) = v1 * 0.015625f; }
                    } } }
    }
};

template <class Epi, class Sched, bool ALIGN_EPI = false, bool SP2 = false>
__device__ __forceinline__ void gemm_phase(PG8_LAS unsigned char* lds, const Gemm g, const Sched& S, const Epi& E) {
    const int tid = threadIdx.x, wid = __builtin_amdgcn_readfirstlane(tid >> 6), lane = tid & 63, wr = wid >> 2, wc = wid & 3, fr = lane & 15, fq = lane >> 4;
    const int K = g.K, nt = K / BK;
    unsigned voffA[2], voffB[2];
#pragma unroll
    for (int i = 0; i < 2; ++i) { int R, C; stage_rc(tid * 16 + i * 8192, R, C); const int Rb = Epi::PERM ? ((R & ~31) + perm32(R & 31)) : R;
        voffA[i] = (unsigned)(R * K + C) * 2u; voffB[i] = (unsigned)(Rb * K + C) * 2u; }
    const size_t kstep = (size_t)(BK * 2);
    const size_t hstep = (size_t)HALF * K * 2;
    const size_t tstep = 2 * hstep;
    const unsigned ldsw = (unsigned)wid * 1024u;
    const int aoff = lds_byte(wr * 64 + fr, fq * 8), boff = lds_byte(wc * 32 + fr, fq * 8);
#define PG8_SA(b, h) (((b) * 2 + (h)) * HTB)
#define PG8_SB(b, h) ((4 + (b) * 2 + (h)) * HTB)
#define PG8_STAGE(bufoff, gbase, voff) do { _Pragma("unroll") for (int _i = 0; _i < 2; ++_i) \
        __builtin_amdgcn_global_load_lds((const unsigned*)((const char*)(gbase) + (voff)[_i]), (PG8_LAS unsigned*)(lds + (bufoff) + ldsw + _i * 8192), 16, 0, 0); } while (0)
#define PG8_LDA(dst, b, h) do { _Pragma("unroll") for (int m = 0; m < 4; ++m) _Pragma("unroll") for (int k = 0; k < 2; ++k) dst[m][k] = *(const PG8_LAS bf16x8*)(lds + PG8_SA(b, h) + aoff + m * 2048 + k * 1024); } while (0)
#define PG8_LDB(dst, b, h) do { _Pragma("unroll") for (int n = 0; n < 2; ++n) _Pragma("unroll") for (int k = 0; k < 2; ++k) dst[n][k] = *(const PG8_LAS bf16x8*)(lds + PG8_SB(b, h) + boff + n * 2048 + k * 1024); } while (0)
#define PG8_MMA(ai, bj, At, Bt) do { __builtin_amdgcn_s_setprio(1); _Pragma("unroll") for (int m = 0; m < 4; ++m) _Pragma("unroll") for (int n = 0; n < 2; ++n) _Pragma("unroll") for (int k = 0; k < 2; ++k) \
        acc[ai][bj][m][n] = __builtin_amdgcn_mfma_f32_16x16x32_bf16(Bt[n][k], At[m][k], acc[ai][bj][m][n], 0, 0, 0); __builtin_amdgcn_s_setprio(0); } while (0)
#define PG8_WAIT_V(n) asm volatile("s_waitcnt vmcnt(" #n ")" ::: "memory")
#define PG8_WAIT_L(n) asm volatile("s_waitcnt lgkmcnt(" #n ")" ::: "memory")
#define PG8_BAR __builtin_amdgcn_s_barrier()
#define PG8_SCHED __builtin_amdgcn_sched_barrier(0)
    Unit cur, nxt; int ui = 0;
    if (!S.next(0, cur)) return;
    f32x4 acc[2][2][4][2];
#pragma unroll
    for (int a = 0; a < 2; ++a)
#pragma unroll
        for (int b = 0; b < 2; ++b)
#pragma unroll
            for (int m = 0; m < 4; ++m)
#pragma unroll
                for (int n = 0; n < 2; ++n) acc[a][b][m][n] = (f32x4){0.f, 0.f, 0.f, 0.f};
    bf16x8 At[4][2], B0[2][2], B1[2][2];
    const char* cA = (const char*)g.A + (size_t)cur.pm * tstep; const char* cB = (const char*)g.Bt + (size_t)cur.pn * tstep;
    S.a_ready(cur);
    if constexpr (SP2) {
        PG8_STAGE(PG8_SB(0, 0), cB, voffB); PG8_STAGE(PG8_SB(0, 1), cB + hstep, voffB); PG8_STAGE(PG8_SA(0, 0), cA, voffA); PG8_STAGE(PG8_SA(0, 1), cA + hstep, voffA);
        if (wr == 1) PG8_BAR;
        PG8_WAIT_V(2); PG8_BAR;
        PG8_STAGE(PG8_SB(1, 0), cB + kstep, voffB); PG8_STAGE(PG8_SA(1, 0), cA + kstep, voffA); PG8_STAGE(PG8_SB(1, 1), cB + hstep + kstep, voffB);
        PG8_WAIT_V(6); PG8_BAR;
    } else {
        PG8_STAGE(PG8_SB(0, 0), cB, voffB); PG8_STAGE(PG8_SA(0, 0), cA, voffA); PG8_STAGE(PG8_SB(0, 1), cB + hstep, voffB); PG8_STAGE(PG8_SA(0, 1), cA + hstep, voffA);
        if (wr == 1) PG8_BAR;
        PG8_WAIT_V(4); PG8_BAR;
        PG8_STAGE(PG8_SB(1, 0), cB + kstep, voffB); PG8_STAGE(PG8_SA(1, 0), cA + kstep, voffA); PG8_STAGE(PG8_SB(1, 1), cB + hstep + kstep, voffB);
        PG8_WAIT_V(6); PG8_BAR;
    }
    for (;;) {
        const bool has_next = S.next(ui + 1, nxt);
        const char* nA = has_next ? (const char*)g.A + (size_t)nxt.pm * tstep : cA; const char* nB = has_next ? (const char*)g.Bt + (size_t)nxt.pn * tstep : cB;
        for (int t = 0; t < nt; t += 2) {
            const bool last = (t == nt - 2);
            const char* a1 = cA + (size_t)(t + 1) * kstep;
            const char* a2 = last ? nA : cA + (size_t)(t + 2) * kstep; const char* b2 = last ? nB : cB + (size_t)(t + 2) * kstep;
            const char* a3 = a2 + kstep; const char* b3 = b2 + kstep;
            if (last && has_next) S.a_ready(nxt);
            if constexpr (SP2) {
            PG8_LDB(B0, 0, 0); PG8_LDB(B1, 0, 1); PG8_SCHED; PG8_LDA(At, 0, 0); PG8_STAGE(PG8_SA(1, 1), a1 + hstep, voffA);
            PG8_WAIT_V(8); PG8_WAIT_L(0); PG8_BAR; PG8_MMA(0, 0, At, B0); PG8_MMA(0, 1, At, B1); PG8_BAR; PG8_SCHED;
            PG8_LDA(At, 0, 1); PG8_STAGE(PG8_SB(0, 0), b2, voffB); PG8_STAGE(PG8_SB(0, 1), b2 + hstep, voffB); PG8_STAGE(PG8_SA(0, 0), a2, voffA);
            PG8_WAIT_V(8); PG8_WAIT_L(0); PG8_BAR; PG8_MMA(1, 0, At, B0); PG8_MMA(1, 1, At, B1); PG8_BAR; PG8_SCHED;
            PG8_LDB(B0, 1, 0); PG8_LDB(B1, 1, 1); PG8_SCHED; PG8_LDA(At, 1, 0); PG8_STAGE(PG8_SA(0, 1), a2 + hstep, voffA);
            PG8_WAIT_V(8); PG8_WAIT_L(0); PG8_BAR; PG8_MMA(0, 0, At, B0); PG8_MMA(0, 1, At, B1); PG8_BAR; PG8_SCHED;
            PG8_LDA(At, 1, 1); PG8_STAGE(PG8_SB(1, 0), b3, voffB); PG8_STAGE(PG8_SB(1, 1), b3 + hstep, voffB); PG8_STAGE(PG8_SA(1, 0), a3, voffA);
            PG8_WAIT_V(8); PG8_WAIT_L(0); PG8_BAR; PG8_MMA(1, 0, At, B0); PG8_MMA(1, 1, At, B1); PG8_BAR; PG8_SCHED;
            } else {
            PG8_LDB(B0, 0, 0); PG8_SCHED; PG8_LDA(At, 0, 0); PG8_STAGE(PG8_SA(1, 1), a1 + hstep, voffA);
            PG8_WAIT_L(8); PG8_BAR; PG8_WAIT_L(0); PG8_MMA(0, 0, At, B0); PG8_BAR; PG8_SCHED;
            PG8_LDB(B1, 0, 1); PG8_STAGE(PG8_SB(0, 0), b2, voffB);
            PG8_BAR; PG8_WAIT_L(0); PG8_MMA(0, 1, At, B1); PG8_BAR;
            PG8_LDA(At, 0, 1); PG8_STAGE(PG8_SA(0, 0), a2, voffA);
            PG8_BAR; PG8_WAIT_L(0); PG8_MMA(1, 0, At, B0); PG8_BAR; PG8_SCHED;
            PG8_STAGE(PG8_SB(0, 1), b2 + hstep, voffB);
            PG8_WAIT_V(6); PG8_BAR; PG8_MMA(1, 1, At, B1); PG8_BAR;
            PG8_LDB(B0, 1, 0); PG8_SCHED; PG8_LDA(At, 1, 0); PG8_STAGE(PG8_SA(0, 1), a2 + hstep, voffA);
            PG8_WAIT_L(8); PG8_BAR; PG8_WAIT_L(0); PG8_MMA(0, 0, At, B0); PG8_BAR; PG8_SCHED;
            PG8_LDB(B1, 1, 1); PG8_STAGE(PG8_SB(1, 0), b3, voffB);
            PG8_BAR; PG8_WAIT_L(0); PG8_MMA(0, 1, At, B1); PG8_BAR;
            PG8_LDA(At, 1, 1); PG8_STAGE(PG8_SA(1, 0), a3, voffA);
            PG8_BAR; PG8_WAIT_L(0); PG8_MMA(1, 0, At, B0); PG8_BAR; PG8_SCHED;
            PG8_STAGE(PG8_SB(1, 1), b3 + hstep, voffB);
            PG8_WAIT_V(6); PG8_BAR; PG8_MMA(1, 1, At, B1); PG8_BAR;
            }
        }
        if constexpr (ALIGN_EPI) { if (wr == 0) PG8_BAR; }
        if constexpr (!Epi::AFTER_DRAIN) { E(acc, cur, wr, wc, fr, fq); S.done(cur); }
        if (!has_next) break;
#pragma unroll
        for (int a = 0; a < 2; ++a)
#pragma unroll
            for (int b = 0; b < 2; ++b)
#pragma unroll
                for (int m = 0; m < 4; ++m)
#pragma unroll
                    for (int n = 0; n < 2; ++n) acc[a][b][m][n] = (f32x4){0.f, 0.f, 0.f, 0.f};
        cur = nxt; cA = nA; cB = nB; ++ui;
        if constexpr (ALIGN_EPI) { if (wr == 1) PG8_BAR; }
    }
    PG8_WAIT_V(0);
    if constexpr (!ALIGN_EPI) { if (wr == 0) PG8_BAR; }
    PG8_BAR;
    if constexpr (Epi::AFTER_DRAIN) { E.fused(acc, cur, wr, wc, fr, fq, lds, wid, lane); S.done(cur); }
#undef PG8_SA
#undef PG8_SB
#undef PG8_STAGE
#undef PG8_LDA
#undef PG8_LDB
#undef PG8_MMA
#undef PG8_WAIT_V
#undef PG8_WAIT_L
#undef PG8_BAR
#undef PG8_SCHED
}
}
#define XB_TMO      128
#define XB_XCNT(j)  (256  + 64 * (j))
#define XB_XSUB(j)  (1280 + 64 * (j))
#define XB_XGEN(j)  (2304 + 64 * (j))
#define XB_TOP      3328
#define XB_TOPGEN   3392
#define XCD_BAR_WORDS 3456
#define XB_SPIN_CAP (1u << 18)
#define LAS __attribute__((address_space(3)))

__device__ __forceinline__ unsigned xb_ld(unsigned* p)              { return __hip_atomic_load(p, __ATOMIC_RELAXED, __HIP_MEMORY_SCOPE_AGENT); }
__device__ __forceinline__ unsigned xb_add(unsigned* p, unsigned v) { return __hip_atomic_fetch_add(p, v, __ATOMIC_RELAXED, __HIP_MEMORY_SCOPE_AGENT); }
__device__ __forceinline__ unsigned xb_xcc_id() { return (unsigned)__builtin_amdgcn_s_getreg((3 << 11) | 20) & 0xFu; }
#define XB_SPIN(cond, bar) do { unsigned _sp = 0; while (cond) { __builtin_amdgcn_s_sleep(1); \
    if ((++_sp & 255u) == 0u) { if (xb_ld(&(bar)[XB_TMO])) break; if (_sp > XB_SPIN_CAP) { atomicAdd(&(bar)[XB_TMO], 1u); break; } } } } while (0)

struct XcdBarrier {
    unsigned* bar; unsigned x;
    volatile LAS unsigned* st;
};

__device__ __forceinline__ XcdBarrier xcd_barrier_post(unsigned* bar, volatile LAS unsigned* st) {
    XcdBarrier b; b.bar = bar; b.x = xb_xcc_id(); b.st = st;
    if (threadIdx.x == 0) (void)xb_add(&bar[XB_XCNT(b.x)], 1u);
    return b;
}
__device__ __forceinline__ void xcd_barrier_complete(unsigned* bar, unsigned x, unsigned& nloc, unsigned& nx) {
    const unsigned G = gridDim.x * gridDim.y * gridDim.z;
    unsigned sum, cnt, mine, sp = 0u;
    for (;;) {
        sum = 0u; cnt = 0u; mine = 0u;
#pragma unroll
        for (unsigned j = 0; j < 16; ++j) { const unsigned c = xb_ld(&bar[XB_XCNT(j)]); sum += c; cnt += (c > 0u) ? 1u : 0u; mine = (j == x) ? c : mine; }
        if (sum == G) break;
        __builtin_amdgcn_s_sleep(1);
        if ((++sp & 255u) == 0u) { if (xb_ld(&bar[XB_TMO])) break; if (sp > XB_SPIN_CAP) { atomicAdd(&bar[XB_TMO], 1u); break; } }
    }
    nloc = mine > 0u ? mine : 1u; nx = cnt > 0u ? cnt : 1u;
}

__device__ __forceinline__ void xcd_barrier(const XcdBarrier& b) {
    asm volatile("s_waitcnt vmcnt(0)" ::: "memory");
    __syncthreads();
    if (threadIdx.x == 0) {
        unsigned* bar = b.bar;
        __builtin_amdgcn_s_waitcnt(0);
        unsigned nloc = b.st[0], nx = b.st[1];
        if (nloc == 0u) { xcd_barrier_complete(bar, b.x, nloc, nx); b.st[0] = nloc; b.st[1] = nx; }
        const unsigned old = xb_add(&bar[XB_XSUB(b.x)], 1u);
        const unsigned gen = old / nloc;
        if (old + 1u == (gen + 1u) * nloc) {
            __builtin_amdgcn_fence(__ATOMIC_RELEASE, "agent");
            asm volatile("s_waitcnt vmcnt(0)" ::: "memory");
            const unsigned og = xb_add(&bar[XB_TOP], 1u);
            const unsigned tg = og / nx;
            if (og + 1u == (tg + 1u) * nx) xb_add(&bar[XB_TOPGEN], 1u);
            else XB_SPIN(xb_ld(&bar[XB_TOPGEN]) == tg, bar);
            __builtin_amdgcn_fence(__ATOMIC_ACQUIRE, "agent");
            xb_add(&bar[XB_XGEN(b.x)], 1u);
            asm volatile("s_waitcnt vmcnt(0)" ::: "memory");
        } else {
            XB_SPIN(xb_ld(&bar[XB_XGEN(b.x)]) == gen, bar);
            __builtin_amdgcn_fence(__ATOMIC_ACQUIRE, "agent");
            asm volatile("s_waitcnt vmcnt(0)" ::: "memory");
        }
    }
    __syncthreads();
}


using pg8::bf16_t; using pg8::bf16x8; using pg8::f32x4; using pg8::u32x4;
typedef _Float16 f16x8 __attribute__((ext_vector_type(8)));
typedef float f32x16 __attribute__((ext_vector_type(16)));
typedef unsigned u32x2 __attribute__((ext_vector_type(2)));
#define DI __device__ __forceinline__

constexpr int NWAVES = 8, NTHR = 512;
constexpr int SEQ = 8192, MTOK = 16384, DM = 4096, DFF = 11008;
constexpr int N_A = 18432, N_B = 10400, N_BP = 10496;
constexpr float LN_EPS = 1e-5f;
constexpr float ALPHA = 1.41421356237309515f;
constexpr float SM_C = 0.08838834764831845f * 1.4426950408889634f;
constexpr float SM_SCALE = 0.08838834764831845f;

constexpr size_t MiB = (size_t)1 << 20;
constexpr size_t WS_CTL = 0, CTL_ZERO_BYTES = 1 * MiB;
constexpr size_t WS_COS = 1 * MiB, WS_SIN = 5 * MiB;
constexpr size_t WS_W = 9 * MiB;
constexpr size_t W0IN = WS_W, W0OUT = WS_W + 144 * MiB, W0GU = WS_W + 160 * MiB, W0DN = WS_W + 332 * MiB;
constexpr size_t W1IN = WS_W, W1OUT = WS_W + 82 * MiB, W1GU = WS_W + 114 * MiB, W1DN = WS_W + 286 * MiB;
constexpr size_t WS_XB = 427 * MiB, WS_XA = 555 * MiB, WS_BIG = 811 * MiB, WS_END = (811 + 835) * MiB;
constexpr size_t B_QKV0 = WS_BIG, B_OG = WS_BIG + 576 * MiB, B_LSE = WS_BIG + 768 * MiB, B_AO0 = WS_BIG + 771 * MiB;
constexpr size_t B_Y = WS_BIG + 360 * MiB, B_H = WS_BIG;
constexpr size_t B_Q1 = WS_BIG, B_K1 = WS_BIG + 128 * MiB, B_V1 = WS_BIG + 160 * MiB, B_QI = WS_BIG + 192 * MiB, B_KIR = WS_BIG + 320 * MiB, B_KI16 = WS_BIG + 328 * MiB,
                 B_WI = WS_BIG + 332 * MiB, B_SC = WS_BIG + 334 * MiB, B_IDX = WS_BIG + 594 * MiB, B_AO1 = WS_BIG + 640 * MiB;
constexpr int LDS_BYTES = 147456, MISC_OFF = 147456 - 64;

DI float wave_sum(float v) { v += __shfl_xor(v, 1); v += __shfl_xor(v, 2); v += __shfl_xor(v, 4); v += __shfl_xor(v, 8); v += __shfl_xor(v, 16); v += __shfl_xor(v, 32); return v; }
DI int sigma_inv(int d) { return 32 * ((d >> 4) & 3) + 8 * ((d >> 2) & 3) + 4 * (d >> 6) + (d & 3); }

struct MapId { DI long operator()(int c) const { return c; } };
struct MapA  { DI long operator()(int c) const { const int d = c & 127; return (c < 2 * 6144) ? (long)(c - d + sigma_inv(d)) : (long)c; } };
struct MapB  { DI long operator()(int c) const { const int d = c & 127; const bool rp = (c < 5120) || (c >= 6144 && c < 10240); return rp ? (long)(c - d + sigma_inv(d)) : (long)c; } };
struct MapGU { int up; DI long operator()(int c) const { return (long)((c >> 7) * 256 + up * 128 + (c & 127)); } };

DI void wt_load(const float* __restrict__ W, int N, int nct, int item, f32x4 (&v)[8], int tid) {
    const int kt = item / nct, ct = item - kt * nct; const int k0 = kt * 64, c0 = ct * 256; const int cq = tid & 63, kr0 = tid >> 6; const bool cok = (c0 + 4 * cq) < N;
#pragma unroll
    for (int i = 0; i < 8; ++i) v[i] = cok ? *(const f32x4*)(W + (size_t)(k0 + kr0 + 8 * i) * N + c0 + 4 * cq) : (f32x4){0.f, 0.f, 0.f, 0.f};
}
template <class Map>
DI void wt_store(int K, int N, int nct, bf16_t* __restrict__ WT, int item, const Map map, const f32x4 (&v)[8], LAS float* scr, int tid) {
    const int kt = item / nct, ct = item - kt * nct; const int k0 = kt * 64, c0 = ct * 256; const int cq = tid & 63, kr0 = tid >> 6;
    __syncthreads();
#pragma unroll
    for (int i = 0; i < 8; ++i) *(LAS f32x4*)(scr + (kr0 + 8 * i) * 260 + 4 * cq) = v[i];
    __syncthreads();
    const int c = tid >> 1, kc = tid & 1;
    if (c0 + c < N) {
        bf16_t* dst = WT + (size_t)map(c0 + c) * K + k0 + 32 * kc;
#pragma unroll
        for (int q = 0; q < 4; ++q) { float f[8];
#pragma unroll
            for (int j = 0; j < 8; ++j) f[j] = scr[(32 * kc + 8 * q + j) * 260 + c];
            u32x4 o; o.x = pg8::cvt_pk_bf16(f[0], f[1]); o.y = pg8::cvt_pk_bf16(f[2], f[3]); o.z = pg8::cvt_pk_bf16(f[4], f[5]); o.w = pg8::cvt_pk_bf16(f[6], f[7]);
            *(u32x4*)(dst + 8 * q) = o; }
    }
}
template <class Map>
DI void wt_matrix(const float* W, int K, int N, bf16_t* WT, const Map map, LAS float* scr, int tid, int bid, int G) {
    const int nct = (N + 255) >> 8, nitems = (K >> 6) * nct;
    f32x4 va[8], vb[8];
    int it = bid;
    if (it < nitems) wt_load(W, N, nct, it, va, tid);
    for (; it < nitems; it += 2 * G) {
        if (it + G < nitems) wt_load(W, N, nct, it + G, vb, tid);
        wt_store(K, N, nct, WT, it, map, va, scr, tid);
        if (it + G >= nitems) break;
        if (it + 2 * G < nitems) wt_load(W, N, nct, it + 2 * G, va, tid);
        wt_store(K, N, nct, WT, it + G, map, vb, scr, tid);
    }
}

DI void rope_sincos(int pos, int f, float& cs, float& sn) {
    const double r1 = 0.8659643233600653; double inv = 1.0, rp = r1;
#pragma unroll
    for (int b = 0; b < 6; ++b) { if ((f >> b) & 1) inv *= rp; rp *= rp; }
    const double ang = (double)pos * inv;
    const double q = __builtin_rint(ang * 0.63661977236758134308);
    double r = __builtin_fma(-q, 1.57079632679489655800e+00, ang); r = __builtin_fma(-q, 6.12323399573676603587e-17, r);
    const double z = r * r;
    const double ps = r + r * z * (-1.66666666666666324348e-01 + z * (8.33333333332248946124e-03 + z * (-1.98412698298579493134e-04 + z * (2.75573137070700676789e-06 + z * (-2.50507602534068634195e-08 + z * 1.58969099521155010221e-10)))));
    const double pc = 1.0 - 0.5 * z + z * z * (4.16666666666666019037e-02 + z * (-1.38888888888741095749e-03 + z * (2.48015872894767294178e-05 + z * (-2.75573143513906633035e-07 + z * (2.08757232129817482790e-09 + z * -1.13596475577881948265e-11)))));
    const int qi = ((int)(long long)q) & 3;
    const double s = (qi == 0) ? ps : (qi == 1) ? pc : (qi == 2) ? -ps : -pc;
    const double c = (qi == 0) ? pc : (qi == 1) ? -ps : (qi == 2) ? -pc : ps;
    cs = (float)c; sn = (float)s;
}

DI void cvt_x_phase(const float* X, bf16_t* XB, int tid, int bid, int G) {
    const size_t n8 = (size_t)MTOK * DM / 8;
    for (size_t i = (size_t)bid * NTHR + tid; i < n8; i += (size_t)G * NTHR) {
        const f32x4 a = *(const f32x4*)(X + i * 8), b = *(const f32x4*)(X + i * 8 + 4);
        u32x4 o; o.x = pg8::cvt_pk_bf16(a[0], a[1]); o.y = pg8::cvt_pk_bf16(a[2], a[3]); o.z = pg8::cvt_pk_bf16(b[0], b[1]); o.w = pg8::cvt_pk_bf16(b[2], b[3]);
        *(u32x4*)(XB + i * 8) = o; }
}
DI void rope_tab_phase(const int* pos, float* CS, float* SN, int tid, int bid, int G) {
    for (int e = bid * NTHR + tid; e < MTOK * 64; e += G * NTHR) { float c, s; rope_sincos(pos[e >> 6], e & 63, c, s); CS[e] = c; SN[e] = s; }
}

DI void ln_phase(const float* Y, const float* gain, const float* bias, float* Xo, bf16_t* XBo, int tid, int bid, int G) {
    const int lane = tid & 63, gw = bid * NWAVES + (tid >> 6), nw = G * NWAVES;
    for (int row = gw; row < MTOK; row += nw) {
        const float* yr = Y + (size_t)row * DM; f32x4 v[16]; float s = 0.f;
#pragma unroll
        for (int j = 0; j < 16; ++j) { v[j] = *(const f32x4*)(yr + (j * 64 + lane) * 4); s += (v[j][0] + v[j][1]) + (v[j][2] + v[j][3]); }
        const float mean = wave_sum(s) * (1.0f / DM); float q = 0.f;
#pragma unroll
        for (int j = 0; j < 16; ++j) { v[j] = v[j] - mean; q += (v[j][0] * v[j][0] + v[j][1] * v[j][1]) + (v[j][2] * v[j][2] + v[j][3] * v[j][3]); }
        const float rstd = 1.0f / sqrtf(wave_sum(q) * (1.0f / DM) + LN_EPS);
#pragma unroll
        for (int j = 0; j < 16; ++j) { const int c = (j * 64 + lane) * 4; const f32x4 g = *(const f32x4*)(gain + c), b = *(const f32x4*)(bias + c); const f32x4 o = v[j] * rstd * g + b;
            *(f32x4*)(Xo + (size_t)row * DM + c) = o;
            if (XBo) { u32x2 w; w.x = pg8::cvt_pk_bf16(o[0], o[1]); w.y = pg8::cvt_pk_bf16(o[2], o[3]); *(u32x2*)(XBo + (size_t)row * DM + c) = w; } }
    }
}

DI bf16x8 ldg_bf16x8(const bf16_t* p) { return *(const bf16x8*)p; }
constexpr int VT_ROWB = 528;
DI void attn0_phase(const bf16_t* QKV, bf16_t* OG, float* LSE, LAS unsigned char* lds, int tid, int bid, int G) {
    const int lane = tid & 63, w = __builtin_amdgcn_readfirstlane(tid >> 6), n = lane & 15, g4 = lane >> 4;
    LAS unsigned char* vt = lds;
    const size_t GS = (size_t)MTOK * 2048;
    for (int u = bid; u < 6144; u += G) {
        const int h = u & 15, blk = (u >> 4) & 63, b = (u >> 10) & 1, grp = u >> 11;
        const int dsh = 2 * grp, d = 1 << dsh, r = blk >> (6 - dsh), nb = blk & ((64 >> dsh) - 1);
        const bf16_t* Qg = QKV + (size_t)(0 + grp) * GS; const bf16_t* Kg = QKV + (size_t)(3 + grp) * GS; const bf16_t* Vg = QKV + (size_t)(6 + grp) * GS;
        const size_t tok0 = (size_t)b * SEQ + r;
        __syncthreads();
        {
            const int kp = tid & 127, qd = tid >> 7; const int l0 = (nb - 1) * 128 + 2 * kp;
            u32x4 va[4], vb[4];
            if (l0 >= 0) { const bf16_t* p0 = Vg + (tok0 + (size_t)l0 * d) * 2048 + h * 128 + 32 * qd; const bf16_t* p1 = p0 + (size_t)d * 2048;
#pragma unroll
                for (int i = 0; i < 4; ++i) { va[i] = *(const u32x4*)(p0 + 8 * i); vb[i] = *(const u32x4*)(p1 + 8 * i); } }
            else {
#pragma unroll
                for (int i = 0; i < 4; ++i) { va[i] = (u32x4){0u, 0u, 0u, 0u}; vb[i] = (u32x4){0u, 0u, 0u, 0u}; } }
#pragma unroll
            for (int i = 0; i < 4; ++i)
#pragma unroll
                for (int e = 0; e < 4; ++e) { const unsigned a = va[i][e], bb = vb[i][e]; const int dim = 32 * qd + 8 * i + 2 * e;
                    *(LAS unsigned*)(vt + dim * VT_ROWB + kp * 4) = (a & 0xffffu) | (bb << 16);
                    *(LAS unsigned*)(vt + (dim + 1) * VT_ROWB + kp * 4) = (a >> 16) | (bb & 0xffff0000u); }
        }
        __syncthreads();
        const int iq = 16 * w + n, lq = nb * 128 + iq;
        const size_t qtok = tok0 + (size_t)lq * d;
        bf16x8 qf[4];
        { const bf16_t* qp = Qg + qtok * 2048 + h * 128 + 8 * g4;
#pragma unroll
          for (int ks = 0; ks < 4; ++ks) qf[ks] = ldg_bf16x8(qp + 32 * ks); }
        f32x4 s[9];
#pragma unroll
        for (int tt = 0; tt < 9; ++tt) {
            const int kf = 16 * (w + tt) + n, lk = (nb - 1) * 128 + kf;
            bf16x8 kfr[4];
            if (lk >= 0) { const bf16_t* kp_ = Kg + (tok0 + (size_t)lk * d) * 2048 + h * 128 + 8 * g4;
#pragma unroll
                for (int ks = 0; ks < 4; ++ks) kfr[ks] = ldg_bf16x8(kp_ + 32 * ks); }
            else {
#pragma unroll
                for (int ks = 0; ks < 4; ++ks) kfr[ks] = (bf16x8){0, 0, 0, 0, 0, 0, 0, 0}; }
            f32x4 a = {0.f, 0.f, 0.f, 0.f};
#pragma unroll
            for (int ks = 0; ks < 4; ++ks) a = __builtin_amdgcn_mfma_f32_16x16x32_bf16(kfr[ks], qf[ks], a, 0, 0, 0);
            s[tt] = a;
        }
        float mx = -__builtin_inff();
#pragma unroll
        for (int tt = 0; tt < 9; ++tt)
#pragma unroll
            for (int j = 0; j < 4; ++j) { const int kf = 16 * (w + tt) + 4 * g4 + j; const bool ok = (kf >= iq) && (kf <= iq + 128) && (nb > 0 || kf >= 128);
                const float x = ok ? s[tt][j] : -__builtin_inff(); s[tt][j] = x; mx = fmaxf(mx, x); }
        mx = fmaxf(mx, __shfl_xor(mx, 16)); mx = fmaxf(mx, __shfl_xor(mx, 32));
        const float msc = mx * SM_C; float lsum = 0.f;
#pragma unroll
        for (int tt = 0; tt < 9; ++tt)
#pragma unroll
            for (int j = 0; j < 4; ++j) { const float p = __builtin_amdgcn_exp2f(s[tt][j] * SM_C - msc); s[tt][j] = p; lsum += p; }
        lsum += __shfl_xor(lsum, 16); lsum += __shfl_xor(lsum, 32);
        f32x4 o[8];
#pragma unroll
        for (int dt = 0; dt < 8; ++dt) o[dt] = (f32x4){0.f, 0.f, 0.f, 0.f};
#pragma unroll
        for (int kk = 0; kk < 5; ++kk) {
            const int t0 = 2 * kk, t1 = 2 * kk + 1;
            u32x4 pw; pw.x = pg8::cvt_pk_bf16(s[t0][0], s[t0][1]); pw.y = pg8::cvt_pk_bf16(s[t0][2], s[t0][3]);
            if (t1 < 9) { pw.z = pg8::cvt_pk_bf16(s[t1 < 9 ? t1 : 8][0], s[t1 < 9 ? t1 : 8][1]); pw.w = pg8::cvt_pk_bf16(s[t1 < 9 ? t1 : 8][2], s[t1 < 9 ? t1 : 8][3]); } else { pw.z = 0u; pw.w = 0u; }
            const bf16x8 pf = __builtin_bit_cast(bf16x8, pw);
            int T1 = w + t1; T1 = T1 > 15 ? 15 : T1;
            const int off0 = (16 * (w + t0) + 4 * g4) * 2, off1 = (16 * T1 + 4 * g4) * 2;
#pragma unroll
            for (int dt = 0; dt < 8; ++dt) { const LAS unsigned char* rowp = vt + (16 * dt + n) * VT_ROWB;
                const u32x2 lo = *(const LAS u32x2*)(rowp + off0), hi = *(const LAS u32x2*)(rowp + off1);
                u32x4 vv; vv.x = lo.x; vv.y = lo.y; vv.z = hi.x; vv.w = hi.y;
                o[dt] = __builtin_amdgcn_mfma_f32_16x16x32_bf16(__builtin_bit_cast(bf16x8, vv), pf, o[dt], 0, 0, 0); }
        }
        const float inv = 1.0f / lsum;
        bf16_t* op = OG + (size_t)grp * GS + qtok * 2048 + h * 128 + 4 * g4;
#pragma unroll
        for (int dt = 0; dt < 8; ++dt) { u32x2 wv; wv.x = pg8::cvt_pk_bf16(o[dt][0] * inv, o[dt][1] * inv); wv.y = pg8::cvt_pk_bf16(o[dt][2] * inv, o[dt][3] * inv); *(u32x2*)(op + 16 * dt) = wv; }
        if (g4 == 0) LSE[(size_t)grp * (MTOK * 16) + qtok * 16 + h] = mx * SM_SCALE + __logf(lsum);
    }
}

DI void merge_phase(const bf16_t* OG, const float* LSE, bf16_t* AO, int tid, int bid, int G) {
    const int lane = tid & 63, gw = bid * NWAVES + (tid >> 6), nw = G * NWAVES; const size_t GS = (size_t)MTOK * 2048;
    for (int tok = gw; tok < MTOK; tok += nw) {
#pragma unroll
        for (int it = 0; it < 4; ++it) { const int e = it * 512 + lane * 8, h = e >> 7;
            const float l0 = LSE[(size_t)tok * 16 + h], l1 = LSE[(size_t)(MTOK * 16) + (size_t)tok * 16 + h], l2 = LSE[(size_t)(2 * MTOK * 16) + (size_t)tok * 16 + h];
            const float mx = fmaxf(l0, fmaxf(l1, l2)); const float e0 = __expf(l0 - mx), e1 = __expf(l1 - mx), e2 = __expf(l2 - mx); const float inv = 1.0f / (e0 + e1 + e2);
            const float w0 = e0 * inv, w1 = e1 * inv, w2 = e2 * inv;
            const u32x4 a = *(const u32x4*)(OG + (size_t)tok * 2048 + e), b = *(const u32x4*)(OG + GS + (size_t)tok * 2048 + e), c = *(const u32x4*)(OG + 2 * GS + (size_t)tok * 2048 + e);
            u32x4 o;
#pragma unroll
            for (int k = 0; k < 4; ++k) { const float lo = w0 * __uint_as_float(a[k] << 16) + w1 * __uint_as_float(b[k] << 16) + w2 * __uint_as_float(c[k] << 16);
                const float hi = w0 * __uint_as_float(a[k] & 0xffff0000u) + w1 * __uint_as_float(b[k] & 0xffff0000u) + w2 * __uint_as_float(c[k] & 0xffff0000u);
                o[k] = pg8::cvt_pk_bf16(lo, hi); }
            *(u32x4*)(AO + (size_t)tok * 2048 + e) = o; }
    }
}

DI void kidx_phase(const float* KIR, const float* gain, const float* bias, const float* CS, const float* SN, unsigned short* KI16, int tid, int bid, int G) {
    const int lane = tid & 63, gw = bid * NWAVES + (tid >> 6), nw = G * NWAVES;
    const float g1 = gain[lane], g2 = gain[lane + 64], b1 = bias[lane], b2 = bias[lane + 64];
    const int j1 = sigma_inv(lane);
    for (int tok = gw; tok < MTOK; tok += nw) {
        const float x1 = KIR[(size_t)tok * 128 + lane], x2 = KIR[(size_t)tok * 128 + 64 + lane];
        const float mean = wave_sum(x1 + x2) * (1.0f / 128.0f); const float d1 = x1 - mean, d2 = x2 - mean;
        const float rstd = 1.0f / sqrtf(wave_sum(d1 * d1 + d2 * d2) * (1.0f / 128.0f) + LN_EPS);
        const float y1 = d1 * rstd * g1 + b1, y2 = d2 * rstd * g2 + b2;
        const float c = CS[(size_t)tok * 64 + lane], s = SN[(size_t)tok * 64 + lane];
        const _Float16 o1 = (_Float16)(y1 * c - y2 * s), o2 = (_Float16)(y2 * c + y1 * s);
        KI16[(size_t)tok * 128 + j1] = __builtin_bit_cast(unsigned short, o1); KI16[(size_t)tok * 128 + j1 + 4] = __builtin_bit_cast(unsigned short, o2);
    }
}

constexpr int KT_ROWB = 272, KT_BYTES = 64 * KT_ROWB;
DI size_t sc_row_off(int b, int s) { const int qb = s >> 7; return ((size_t)(b * 2080 + ((qb * (qb + 1)) >> 1))) * 16384 + (size_t)(s & 127) * ((qb + 1) * 128); }
DI void indexer_tile(const LAS unsigned char* buf, const f16x8 (&af)[2][8], const f32x4 (&wv)[2][4], float* sc0, float* sc1, int kt, int r32, int h2) {
#pragma unroll
    for (int sub = 0; sub < 2; ++sub) {
        f16x8 bfr[8];
#pragma unroll
        for (int ks = 0; ks < 8; ++ks) bfr[ks] = *(const LAS f16x8*)(buf + (32 * sub + r32) * KT_ROWB + (16 * ks + 8 * h2) * 2);
        f32x16 c0, c1;
#pragma unroll
        for (int i = 0; i < 16; ++i) { c0[i] = 0.f; c1[i] = 0.f; }
#pragma unroll
        for (int ks = 0; ks < 8; ++ks) { c0 = __builtin_amdgcn_mfma_f32_32x32x16_f16(af[0][ks], bfr[ks], c0, 0, 0, 0); c1 = __builtin_amdgcn_mfma_f32_32x32x16_f16(af[1][ks], bfr[ks], c1, 0, 0, 0); }
        float s0 = 0.f, s1 = 0.f;
#pragma unroll
        for (int q = 0; q < 4; ++q)
#pragma unroll
            for (int e = 0; e < 4; ++e) { s0 += wv[0][q][e] * fmaxf(c0[4 * q + e], 0.f); s1 += wv[1][q][e] * fmaxf(c1[4 * q + e], 0.f); }
        s0 += __shfl_xor(s0, 32); s1 += __shfl_xor(s1, 32);
        if (h2 == 0) { sc0[kt * 64 + 32 * sub + r32] = s0; sc1[kt * 64 + 32 * sub + r32] = s1; }
    }
}
DI void indexer_phase(const unsigned short* QI, const unsigned short* KI16, const float* WI, float* SC, LAS unsigned char* lds, int tid, int bid, int G) {
    const int lane = tid & 63, w = __builtin_amdgcn_readfirstlane(tid >> 6), r32 = lane & 31, h2 = lane >> 5;
    LAS unsigned char* buf0 = lds; LAS unsigned char* buf1 = lds + KT_BYTES;
    const int key0 = tid >> 4, ch = tid & 15;
    for (int v = bid; v < 256; v += G) {
        for (int it = 0; it < 4; ++it) {
            const int b = it >> 1, gi = (it & 1) ? (511 - v) : v; const int tb = 16 * gi;
            const int nt = ((tb + 15) >> 6) + 1;
            f16x8 af[2][8]; f32x4 wv[2][4];
#pragma unroll
            for (int tq = 0; tq < 2; ++tq) { const size_t tg = (size_t)b * SEQ + tb + 2 * w + tq;
#pragma unroll
                for (int ks = 0; ks < 8; ++ks) af[tq][ks] = *(const f16x8*)(QI + tg * 4096 + r32 * 128 + 16 * ks + 8 * h2);
#pragma unroll
                for (int q = 0; q < 4; ++q) wv[tq][q] = *(const f32x4*)(WI + tg * 32 + 8 * q + 4 * h2); }
            float* sc0 = SC + sc_row_off(b, tb + 2 * w); float* sc1 = SC + sc_row_off(b, tb + 2 * w + 1);
            const unsigned short* src = KI16 + (size_t)b * SEQ * 128 + (size_t)key0 * 128 + ch * 8;
            u32x4 a0, a1, b0 = {0u, 0u, 0u, 0u}, b1 = {0u, 0u, 0u, 0u};
            a0 = *(const u32x4*)src; a1 = *(const u32x4*)(src + 32 * 128);
            if (nt > 1) { b0 = *(const u32x4*)(src + 64 * 128); b1 = *(const u32x4*)(src + 96 * 128); }
            __syncthreads();
            *(LAS u32x4*)(buf0 + key0 * KT_ROWB + ch * 16) = a0; *(LAS u32x4*)(buf0 + (key0 + 32) * KT_ROWB + ch * 16) = a1;
            __syncthreads();
            for (int kt = 0; kt < nt; kt += 2) {
                if (kt + 2 < nt) { const unsigned short* p = src + (size_t)(kt + 2) * 64 * 128; a0 = *(const u32x4*)p; a1 = *(const u32x4*)(p + 32 * 128); }
                indexer_tile(buf0, af, wv, sc0, sc1, kt, r32, h2);
                if (kt + 1 < nt) { *(LAS u32x4*)(buf1 + key0 * KT_ROWB + ch * 16) = b0; *(LAS u32x4*)(buf1 + (key0 + 32) * KT_ROWB + ch * 16) = b1; }
                __syncthreads();
                if (kt + 1 >= nt) break;
                if (kt + 3 < nt) { const unsigned short* p = src + (size_t)(kt + 3) * 64 * 128; b0 = *(const u32x4*)p; b1 = *(const u32x4*)(p + 32 * 128); }
                indexer_tile(buf1, af, wv, sc0, sc1, kt + 1, r32, h2);
                if (kt + 2 < nt) { *(LAS u32x4*)(buf0 + key0 * KT_ROWB + ch * 16) = a0; *(LAS u32x4*)(buf0 + (key0 + 32) * KT_ROWB + ch * 16) = a1; }
                __syncthreads();
            }
        }
    }
}

DI unsigned mbcnt64(unsigned long long m) { return __builtin_amdgcn_mbcnt_hi((unsigned)(m >> 32), __builtin_amdgcn_mbcnt_lo((unsigned)m, 0u)); }
DI unsigned f2key(float f) { const unsigned u = __float_as_uint(f); return (u & 0x80000000u) ? ~u : (u | 0x80000000u); }
DI int wave_sum_i(int v) {
    v += __builtin_amdgcn_update_dpp(0, v, 0xB1, 0xF, 0xF, true);
    v += __builtin_amdgcn_update_dpp(0, v, 0x4E, 0xF, 0xF, true);
    v += __builtin_amdgcn_update_dpp(0, v, 0x141, 0xF, 0xF, true);
    v += __builtin_amdgcn_update_dpp(0, v, 0x140, 0xF, 0xF, true);
    return __builtin_amdgcn_readlane(v, 0) + __builtin_amdgcn_readlane(v, 16) + __builtin_amdgcn_readlane(v, 32) + __builtin_amdgcn_readlane(v, 48);
}
template <int NV>
DI void topk_row(const float* row, int s, LAS int* lst, int lane) {
    unsigned key[NV];
    { const unsigned long long ra = (unsigned long long)row; const unsigned rlo = __builtin_amdgcn_readfirstlane((unsigned)ra), rhi = __builtin_amdgcn_readfirstlane((unsigned)(ra >> 32));
      row = (const float*)(((unsigned long long)rhi << 32) | rlo); }
#pragma unroll
    for (int jo = 0; jo < NV / 16; ++jo) { const float* rb = row + jo * 1024;
#pragma unroll
        for (int ji = 0; ji < 16; ++ji) { const int j = jo * 16 + ji; const unsigned u = f2key(rb[ji * 64 + lane]); key[j] = (j * 64 + lane <= s) ? u : 0u; } }
    unsigned T = 0u;
#pragma unroll 1
    for (int bit = 31; bit >= 0; --bit) {
        const unsigned cand = T | (1u << bit); int c = 0;
#pragma unroll
        for (int j = 0; j < NV; ++j) asm volatile("v_cmp_le_u32 vcc, %2, %1\n\tv_addc_co_u32 %0, vcc, 0, %0, vcc" : "+v"(c) : "v"(key[j]), "s"(cand) : "vcc");
        if (wave_sum_i(c) >= 256) T = cand;
    }
    int bgt = 0;
#pragma unroll
    for (int j = 0; j < NV; ++j) { const bool sg = key[j] > T; const unsigned long long mg = __ballot(sg); if (sg) lst[bgt + (int)mbcnt64(mg)] = j * 64 + lane; bgt += __builtin_popcountll(mg); }
#pragma unroll
    for (int j = 0; j < NV; ++j) { const bool se = key[j] == T; const unsigned long long me = __ballot(se); const int pe = bgt + (int)mbcnt64(me); if (se && pe < 256) lst[pe] = j * 64 + lane; bgt += __builtin_popcountll(me); }
}
DI void topk_phase(const float* SC, int* IDX, LAS unsigned char* lds, int tid, int bid, int G) {
    const int lane = tid & 63, w = __builtin_amdgcn_readfirstlane(tid >> 6), gw = bid * NWAVES + w, nw = G * NWAVES;
    LAS int* lst = (LAS int*)(lds + w * 1024);
    for (int t = gw; t < MTOK; t += nw) {
        const int b = t >> 13, s = t & 8191; int* out = IDX + (size_t)t * 256;
        if (s < 256) {
#pragma unroll
            for (int i = 0; i < 4; ++i) { const int j = lane + 64 * i; out[j] = (j <= s) ? j : 0; }
        } else {
            const float* row = SC + sc_row_off(b, s);
            if (s < 2048) topk_row<32>(row, s, lst, lane);
            else if (s < 4096) topk_row<64>(row, s, lst, lane);
            else if (s < 6144) topk_row<96>(row, s, lst, lane);
            else topk_row<128>(row, s, lst, lane);
#pragma unroll
            for (int i = 0; i < 4; ++i) out[lane + 64 * i] = lst[lane + 64 * i];
        }
    }
}

typedef short s16x4 __attribute__((ext_vector_type(4)));
constexpr int DSA_WB = 17408;
DI void dsa_attn_phase(const bf16_t* Q1, const bf16_t* K1, const bf16_t* V1, const int* IDX, bf16_t* AO, LAS unsigned char* lds, int tid, int bid, int G) {
    const int lane = tid & 63, w = __builtin_amdgcn_readfirstlane(tid >> 6), n = lane & 15, g4 = lane >> 4, q4 = n >> 2, p4 = n & 3;
    LAS unsigned char* vb = lds + w * DSA_WB; LAS int* iw = (LAS int*)(lds + w * DSA_WB + 16384);
    const bool xm = (G & 7) == 0;
    const int start = xm ? ((bid >> 3) * NWAVES + w) : (bid * NWAVES + w), step = xm ? ((G >> 3) * NWAVES) : (G * NWAVES), total = xm ? MTOK : MTOK * 8;
    const int tr_base = (4 * g4 + q4) * 256 + 8 * (p4 & 1);
    for (int it = start; it < total; it += step) {
        const int kvh = xm ? (bid & 7) : (it & 7), t = xm ? it : (it >> 3);
        const int b = t >> 13, s = t & 8191; const int nvalid = s + 1 < 256 ? s + 1 : 256;
        const int* ip = IDX + (size_t)t * 256;
#pragma unroll
        for (int i = 0; i < 4; ++i) iw[lane + 64 * i] = ip[lane + 64 * i];
        const bf16_t* Kb = K1 + (size_t)(b * 8 + kvh) * SEQ * 128; const bf16_t* Vb = V1 + (size_t)(b * 8 + kvh) * SEQ * 128;
        u32x4 vst[16];
#pragma unroll
        for (int i = 0; i < 16; ++i) { const int row = iw[4 * i + g4]; vst[i] = *(const u32x4*)(Vb + (size_t)row * 128 + n * 8); }
        bf16x8 qf[4];
#pragma unroll
        for (int ks = 0; ks < 4; ++ks) qf[ks] = (n < 4) ? ldg_bf16x8(Q1 + (size_t)t * 4096 + (4 * kvh + n) * 128 + 32 * ks + 8 * g4) : (bf16x8){0, 0, 0, 0, 0, 0, 0, 0};
        f32x4 sa[16];
#pragma unroll
        for (int tt = 0; tt < 16; ++tt) { const int row = iw[16 * tt + n]; const bf16_t* kp = Kb + (size_t)row * 128 + 8 * g4; f32x4 a = {0.f, 0.f, 0.f, 0.f};
#pragma unroll
            for (int ks = 0; ks < 4; ++ks) a = __builtin_amdgcn_mfma_f32_16x16x32_bf16(ldg_bf16x8(kp + 32 * ks), qf[ks], a, 0, 0, 0);
            sa[tt] = a; }
        float mx = -__builtin_inff();
#pragma unroll
        for (int tt = 0; tt < 16; ++tt)
#pragma unroll
            for (int j = 0; j < 4; ++j) { const int kk = 16 * tt + 4 * g4 + j; const float x = (kk < nvalid) ? sa[tt][j] : -__builtin_inff(); sa[tt][j] = x; mx = fmaxf(mx, x); }
        mx = fmaxf(mx, __shfl_xor(mx, 16)); mx = fmaxf(mx, __shfl_xor(mx, 32));
        const float msc = mx * SM_C; float lsum = 0.f;
        unsigned pk[16][2];
#pragma unroll
        for (int tt = 0; tt < 16; ++tt) { float p[4];
#pragma unroll
            for (int j = 0; j < 4; ++j) { p[j] = __builtin_amdgcn_exp2f(sa[tt][j] * SM_C - msc); lsum += p[j]; }
            pk[tt][0] = pg8::cvt_pk_bf16(p[0], p[1]); pk[tt][1] = pg8::cvt_pk_bf16(p[2], p[3]); }
        lsum += __shfl_xor(lsum, 16); lsum += __shfl_xor(lsum, 32);
        f32x4 o[8];
#pragma unroll
        for (int dt = 0; dt < 8; ++dt) o[dt] = (f32x4){0.f, 0.f, 0.f, 0.f};
#pragma unroll
        for (int c = 0; c < 4; ++c) {
#pragma unroll
            for (int i = 0; i < 16; ++i) { const int kl = 4 * i + g4; *(LAS u32x4*)(vb + kl * 256 + ((n ^ (2 * (kl & 3))) * 16)) = vst[i]; }
            if (c < 3) {
#pragma unroll
                for (int i = 0; i < 16; ++i) { const int row = iw[(c + 1) * 64 + 4 * i + g4]; vst[i] = *(const u32x4*)(Vb + (size_t)row * 128 + n * 8); } }
#pragma unroll
            for (int ks2 = 0; ks2 < 2; ++ks2) {
                const int t0 = 4 * c + 2 * ks2;
                u32x4 pw; pw.x = pk[t0][0]; pw.y = pk[t0][1]; pw.z = pk[t0 + 1][0]; pw.w = pk[t0 + 1][1];
                const bf16x8 pf = __builtin_bit_cast(bf16x8, pw);
#pragma unroll
                for (int dt = 0; dt < 8; ++dt) {
                    const int choff = ((2 * dt + (p4 >> 1)) ^ (2 * q4)) * 16;
                    const s16x4 lo = __builtin_amdgcn_ds_read_tr16_b64_v4i16((LAS s16x4*)(vb + tr_base + (32 * ks2) * 256 + choff));
                    const s16x4 hi = __builtin_amdgcn_ds_read_tr16_b64_v4i16((LAS s16x4*)(vb + tr_base + (32 * ks2 + 16) * 256 + choff));
                    const bf16x8 vf = __builtin_shufflevector(lo, hi, 0, 1, 2, 3, 4, 5, 6, 7);
                    o[dt] = __builtin_amdgcn_mfma_f32_16x16x32_bf16(vf, pf, o[dt], 0, 0, 0);
                }
            }
        }
        if (n < 4) { const float li = 1.0f / lsum; bf16_t* op = AO + (size_t)t * 4096 + (4 * kvh + n) * 128 + 4 * g4;
#pragma unroll
            for (int dt = 0; dt < 8; ++dt) { u32x2 wv; wv.x = pg8::cvt_pk_bf16(o[dt][0] * li, o[dt][1] * li); wv.y = pg8::cvt_pk_bf16(o[dt][2] * li, o[dt][3] * li); *(u32x2*)(op + 16 * dt) = wv; } }
    }
}

#ifndef MK_ONE_LAUNCH
#define MK_ONE_LAUNCH 1
#endif
constexpr int N_PHASES = 19;
struct Args { const float* in[22]; float* out; unsigned char* ws; int ph_lo, ph_hi; };

__global__ void __launch_bounds__(NTHR, 2) mk_fwd(Args args) {
    extern __shared__ __attribute__((aligned(16))) unsigned char lds_raw[];
    LAS unsigned char* lds = (LAS unsigned char*)lds_raw;
    const int tid = threadIdx.x, bid = blockIdx.x, G = gridDim.x;
    unsigned char* ws = args.ws;
    volatile LAS unsigned* misc = (volatile LAS unsigned*)(lds + MISC_OFF);
    if (tid < 4) misc[tid] = 0u;
    __syncthreads();
    const int lo = args.ph_lo, hi = args.ph_hi;
    XcdBarrier bar; bar.bar = (unsigned*)(ws + WS_CTL); bar.x = 0; bar.st = nullptr;
    if (hi - lo > 1) bar = xcd_barrier_post((unsigned*)(ws + WS_CTL), misc);
#ifndef PH_MASK
#define PH_MASK 0x7ffff
#endif
#define IN(k) ((((PH_MASK) >> (k)) & 1) && lo <= (k) && (k) < hi)
#define SEAM(k) do { if (IN(k) && IN((k) + 1)) xcd_barrier(bar); } while (0)
#ifndef DUP_MASK
#define DUP_MASK 0
#endif
#define REP(k) _Pragma("unroll 1") for (int rep_ = 0; rep_ < ((((DUP_MASK) >> (k)) & 1) ? 2 : 1); ++rep_)

    const float* x0 = args.in[0]; const int* positions = (const int*)args.in[1];
    float* CS = (float*)(ws + WS_COS); float* SN = (float*)(ws + WS_SIN);
    bf16_t* XB = (bf16_t*)(ws + WS_XB); float* XA = (float*)(ws + WS_XA); float* Y = (float*)(ws + B_Y); bf16_t* Hh = (bf16_t*)(ws + B_H);
    float* OUT = args.out;
    const pg8::RopeTab rt{CS, SN};

    if (IN(0)) REP(0) {
        LAS float* scr = (LAS float*)lds;
        wt_matrix(args.in[2], DM, N_A, (bf16_t*)(ws + W0IN), MapA{}, scr, tid, bid, G);
        wt_matrix(args.in[3], 2048, DM, (bf16_t*)(ws + W0OUT), MapId{}, scr, tid, bid, G);
        wt_matrix(args.in[10], DM, DFF, (bf16_t*)(ws + W0GU), MapGU{0}, scr, tid, bid, G);
        wt_matrix(args.in[11], DM, DFF, (bf16_t*)(ws + W0GU), MapGU{1}, scr, tid, bid, G);
        wt_matrix(args.in[12], DFF, DM, (bf16_t*)(ws + W0DN), MapId{}, scr, tid, bid, G);
        cvt_x_phase(x0, XB, tid, bid, G);
        rope_tab_phase(positions, CS, SN, tid, bid, G);
    }
    SEAM(0);
    if (IN(1)) REP(1) {
        pg8::Gemm g{XB, (const bf16_t*)(ws + W0IN), MTOK, N_A, DM}; pg8::StaticOrder S; S.init(MTOK, N_A, G, bid);
        pg8::EpiQKV0 E{(bf16_t*)(ws + B_QKV0), rt};
        pg8::gemm_phase<pg8::EpiQKV0, pg8::StaticOrder, true, true>(lds, g, S, E);
    }
    SEAM(1);
    if (IN(2)) REP(2) attn0_phase((const bf16_t*)(ws + B_QKV0), (bf16_t*)(ws + B_OG), (float*)(ws + B_LSE), lds, tid, bid, G);
    SEAM(2);
    if (IN(3)) REP(3) merge_phase((const bf16_t*)(ws + B_OG), (const float*)(ws + B_LSE), (bf16_t*)(ws + B_AO0), tid, bid, G);
    SEAM(3);
    if (IN(4)) REP(4) {
        pg8::Gemm g{(const bf16_t*)(ws + B_AO0), (const bf16_t*)(ws + W0OUT), MTOK, DM, 2048}; pg8::StaticOrder S; S.init(MTOK, DM, G, bid);
        pg8::EpiY E{x0, Y, DM, ALPHA};
        pg8::gemm_phase<pg8::EpiY, pg8::StaticOrder, true, true>(lds, g, S, E);
    }
    SEAM(4);
    if (IN(5)) REP(5) ln_phase(Y, args.in[8], args.in[9], OUT, XB, tid, bid, G);
    SEAM(5);
    if (IN(6)) REP(6) {
        pg8::Gemm g{XB, (const bf16_t*)(ws + W0GU), MTOK, 2 * DFF, DM}; pg8::StaticOrder S; S.init(MTOK, 2 * DFF, G, bid);
        pg8::EpiSwiGLU E{Hh, DFF};
        pg8::gemm_phase<pg8::EpiSwiGLU, pg8::StaticOrder, true, true>(lds, g, S, E);
    }
    SEAM(6);
    if (IN(7)) REP(7) {
        pg8::Gemm g{Hh, (const bf16_t*)(ws + W0DN), MTOK, DM, DFF}; pg8::StaticOrder S; S.init(MTOK, DM, G, bid);
        pg8::EpiY E{OUT, Y, DM, ALPHA};
        pg8::gemm_phase<pg8::EpiY, pg8::StaticOrder, true, true>(lds, g, S, E);
    }
    SEAM(7);
    if (IN(8)) REP(8) {
        ln_phase(Y, args.in[13], args.in[14], XA, XB, tid, bid, G);
        LAS float* scr = (LAS float*)lds;
        wt_matrix(args.in[4], DM, N_B, (bf16_t*)(ws + W1IN), MapB{}, scr, tid, bid, G);
        { u32x4* z = (u32x4*)(ws + W1IN + (size_t)N_B * DM * 2); const int nz = (N_BP - N_B) * DM * 2 / 16; for (int i = bid * NTHR + tid; i < nz; i += G * NTHR) z[i] = (u32x4){0u, 0u, 0u, 0u}; }
        wt_matrix(args.in[7], DM, DM, (bf16_t*)(ws + W1OUT), MapId{}, scr, tid, bid, G);
        wt_matrix(args.in[17], DM, DFF, (bf16_t*)(ws + W1GU), MapGU{0}, scr, tid, bid, G);
        wt_matrix(args.in[18], DM, DFF, (bf16_t*)(ws + W1GU), MapGU{1}, scr, tid, bid, G);
        wt_matrix(args.in[19], DFF, DM, (bf16_t*)(ws + W1DN), MapId{}, scr, tid, bid, G);
    }
    SEAM(8);
    if (IN(9)) REP(9) {
        pg8::Gemm g{XB, (const bf16_t*)(ws + W1IN), MTOK, N_BP, DM}; pg8::StaticOrder S; S.init(MTOK, N_BP, G, bid);
        pg8::EpiQKV1 E{(bf16_t*)(ws + B_Q1), (bf16_t*)(ws + B_K1), (bf16_t*)(ws + B_V1), (unsigned short*)(ws + B_QI), (float*)(ws + B_KIR), (float*)(ws + B_WI), rt};
        pg8::gemm_phase<pg8::EpiQKV1, pg8::StaticOrder, true, true>(lds, g, S, E);
    }
    SEAM(9);
    if (IN(10)) REP(10) kidx_phase((const float*)(ws + B_KIR), args.in[5], args.in[6], CS, SN, (unsigned short*)(ws + B_KI16), tid, bid, G);
    SEAM(10);
    if (IN(11)) REP(11) indexer_phase((const unsigned short*)(ws + B_QI), (const unsigned short*)(ws + B_KI16), (const float*)(ws + B_WI), (float*)(ws + B_SC), lds, tid, bid, G);
    SEAM(11);
    if (IN(12)) REP(12) topk_phase((const float*)(ws + B_SC), (int*)(ws + B_IDX), lds, tid, bid, G);
    SEAM(12);
    if (IN(13)) REP(13) dsa_attn_phase((const bf16_t*)(ws + B_Q1), (const bf16_t*)(ws + B_K1), (const bf16_t*)(ws + B_V1), (const int*)(ws + B_IDX), (bf16_t*)(ws + B_AO1), lds, tid, bid, G);
    SEAM(13);
    if (IN(14)) REP(14) {
        pg8::Gemm g{(const bf16_t*)(ws + B_AO1), (const bf16_t*)(ws + W1OUT), MTOK, DM, DM}; pg8::StaticOrder S; S.init(MTOK, DM, G, bid);
        pg8::EpiY E{XA, Y, DM, ALPHA};
        pg8::gemm_phase<pg8::EpiY, pg8::StaticOrder, true, true>(lds, g, S, E);
    }
    SEAM(14);
    if (IN(15)) REP(15) ln_phase(Y, args.in[15], args.in[16], OUT, XB, tid, bid, G);
    SEAM(15);
    if (IN(16)) REP(16) {
        pg8::Gemm g{XB, (const bf16_t*)(ws + W1GU), MTOK, 2 * DFF, DM}; pg8::StaticOrder S; S.init(MTOK, 2 * DFF, G, bid);
        pg8::EpiSwiGLU E{Hh, DFF};
        pg8::gemm_phase<pg8::EpiSwiGLU, pg8::StaticOrder, true, true>(lds, g, S, E);
    }
    SEAM(16);
    if (IN(17)) REP(17) {
        pg8::Gemm g{Hh, (const bf16_t*)(ws + W1DN), MTOK, DM, DFF}; pg8::StaticOrder S; S.init(MTOK, DM, G, bid);
        pg8::EpiY E{OUT, Y, DM, ALPHA};
        pg8::gemm_phase<pg8::EpiY, pg8::StaticOrder, true, true>(lds, g, S, E);
    }
    SEAM(17);
    if (IN(18)) REP(18) ln_phase(Y, args.in[20], args.in[21], OUT, nullptr, tid, bid, G);
#undef IN
#undef SEAM
#undef REP
}

extern "C" void kernel_launch(void* const* d_in, const int* in_sizes, int n_in, void* d_out, int out_size, void* d_ws, size_t ws_size, hipStream_t stream) {
    static int grid = 0;
    if (grid == 0) {
        if (n_in != 22 || out_size != MTOK * DM || ws_size < WS_END) { fprintf(stderr, "kernel_launch: unexpected problem (n_in %d, out %d, ws %zu < %zu); nothing launched\n", n_in, out_size, ws_size, (size_t)WS_END); grid = -1; return; }
        int dev = 0, cus = 0, per_cu = 0;
        if (hipGetDevice(&dev) != hipSuccess || hipDeviceGetAttribute(&cus, hipDeviceAttributeMultiprocessorCount, dev) != hipSuccess) { grid = -1; return; }
        if (hipFuncSetAttribute((const void*)mk_fwd, hipFuncAttributeMaxDynamicSharedMemorySize, LDS_BYTES) != hipSuccess) { fprintf(stderr, "kernel_launch: hipFuncSetAttribute failed\n"); grid = -1; return; }
        if (hipOccupancyMaxActiveBlocksPerMultiprocessor(&per_cu, (const void*)mk_fwd, NTHR, LDS_BYTES) != hipSuccess || per_cu < 1) { fprintf(stderr, "kernel_launch: occupancy query reports %d\n", per_cu); (void)hipGetLastError(); per_cu = 1; }
        grid = cus;
    }
    if (grid < 0) return;
    (void)in_sizes;
    if (hipMemsetAsync((char*)d_ws + WS_CTL, 0, CTL_ZERO_BYTES, stream) != hipSuccess) return;
    Args a{};
    for (int i = 0; i < 22; ++i) a.in[i] = (const float*)d_in[i];
    a.out = (float*)d_out; a.ws = (unsigned char*)d_ws;
#if MK_ONE_LAUNCH
    a.ph_lo = 0; a.ph_hi = N_PHASES;
    hipLaunchKernelGGL(mk_fwd, dim3(grid), dim3(NTHR), LDS_BYTES, stream, a);
#else
    for (int p = 0; p < N_PHASES; ++p) { a.ph_lo = p; a.ph_hi = p + 1; hipLaunchKernelGGL(mk_fwd, dim3(grid), dim3(NTHR), LDS_BYTES, stream, a); }
#endif
}
```

```cpp
#include <hip/hip_runtime.h>
#include <cstdio>
#include <cstdint>
namespace pg8 {
#define PG8_LAS __attribute__((address_space(3)))
typedef unsigned short bf16_t;
typedef short bf16x8 __attribute__((ext_vector_type(8)));
typedef float f32x4 __attribute__((ext_vector_type(4)));
typedef unsigned u32x4 __attribute__((ext_vector_type(4)));
constexpr int BM = 256, BK = 64, HALF = 128, HTB = HALF * BK * 2  , STAGE_BYTES = 8 * HTB, NXCD = 8, WGM = 8;

__host__ __device__ __forceinline__ int lds_byte(int r, int c) { const int st = (r >> 4) * 2 + (c >> 5), rr = r & 15, cc = c & 31, ob = rr * 64 + cc * 2; return st * 1024 + (ob ^ (((ob >> 9) & 1) << 5)); }
__host__ __device__ __forceinline__ void stage_rc(int b, int& R, int& C) { const int st = b / 1024, sb = b % 1024, swz = sb ^ (((sb >> 9) & 1) << 5); R = (st >> 1) * 16 + swz / 64; C = (st & 1) * 32 + (swz % 64) / 2; }
__host__ __device__ __forceinline__ int perm32(int rho) { const int n = rho >> 4, i = rho & 15; return 8 * (i >> 2) + 4 * n + (i & 3); }

struct Unit { int pm, pn; };
struct Gemm { const bf16_t* A; const bf16_t* Bt; int M, N, K; };

struct StaticOrder {
    int nM, nN, nwg, G, c, wgm;
    __host__ __device__ void init(int M, int N, int G_, int c_, int wgm_ = WGM) { nM = M / BM; nN = N / BM; nwg = nM * nN; G = G_; c = c_; wgm = wgm_; }
    __host__ __device__ bool next(int i, Unit& u) const {
        const long L = (long)i * G + c; if (L >= nwg) return false;
        int wgid = (int)L; { const int q = nwg / NXCD, r = nwg % NXCD, xcd = wgid % NXCD, off = wgid / NXCD; wgid = (xcd < r ? xcd * (q + 1) : r * (q + 1) + (xcd - r) * q) + off; }
        const int nig = wgm * nN, gid = wgid / nig, fm = gid * wgm, gsz = (nM - fm) < wgm ? (nM - fm) : wgm;
        u.pm = fm + ((wgid % nig) % gsz); u.pn = (wgid % nig) / gsz; return true;
    }
    __device__ __forceinline__ void a_ready(const Unit&) const {}
    __device__ __forceinline__ void done(const Unit&) const {}
};
__device__ __forceinline__ unsigned cvt_pk_bf16(float lo, float hi) { unsigned r; asm volatile("v_cvt_pk_bf16_f32 %0, %1, %2" : "=v"(r) : "v"(lo), "v"(hi)); return r; }
typedef _Float16 f16x2_t __attribute__((ext_vector_type(2)));
__device__ __forceinline__ unsigned cvt_pk_f16(float lo, float hi) { f16x2_t h; h.x = (_Float16)lo; h.y = (_Float16)hi; return __builtin_bit_cast(unsigned, h); }

struct RopeTab { const float* cs; const float* sn; };

__device__ __forceinline__ void rope_pair(f32x4& v0, f32x4& v1, const f32x4 c, const f32x4 s) {
    const f32x4 a = v0 * c - v1 * s, b = v1 * c + v0 * s; v0 = a; v1 = b;
}

struct EpiY {
    static constexpr bool PERM = false, AFTER_DRAIN = false;
    const float* X; float* Y; int ldc; float alpha;
    __device__ __forceinline__ void operator()(const f32x4 (&acc)[2][2][4][2], const Unit& u, int wr, int wc, int fr, int fq) const {
        const int row0 = u.pm * BM + wr * 64 + fr, col0 = u.pn * BM + wc * 32 + 4 * fq;
#pragma unroll
        for (int ai = 0; ai < 2; ++ai) {
            f32x4 xv[4][2][2];
#pragma unroll
            for (int m = 0; m < 4; ++m) { const size_t off = (size_t)(row0 + ai * HALF + m * 16) * ldc + col0;
#pragma unroll
                for (int bj = 0; bj < 2; ++bj)
#pragma unroll
                    for (int n = 0; n < 2; ++n) xv[m][bj][n] = *(const f32x4*)(X + off + bj * HALF + n * 16); }
#pragma unroll
            for (int m = 0; m < 4; ++m) { const size_t off = (size_t)(row0 + ai * HALF + m * 16) * ldc + col0;
#pragma unroll
                for (int bj = 0; bj < 2; ++bj)
#pragma unroll
                    for (int n = 0; n < 2; ++n) *(f32x4*)(Y + off + bj * HALF + n * 16) = xv[m][bj][n] * alpha + acc[ai][bj][m][n]; }
            asm volatile("" ::: "memory"); }
    }
};

struct EpiSwiGLU {
    static constexpr bool PERM = true, AFTER_DRAIN = false;
    bf16_t* Hh; int ldh;
    __device__ __forceinline__ void operator()(const f32x4 (&acc)[2][2][4][2], const Unit& u, int wr, int wc, int fr, int fq) const {
        const int row0 = u.pm * BM + wr * 64 + fr, col0 = u.pn * HALF + wc * 32 + 8 * fq;
#pragma unroll
        for (int ai = 0; ai < 2; ++ai)
#pragma unroll
            for (int m = 0; m < 4; ++m) { bf16_t* rowp = Hh + (size_t)(row0 + ai * HALF + m * 16) * ldh + col0;
                float h[8];
#pragma unroll
                for (int n = 0; n < 2; ++n)
#pragma unroll
                    for (int i = 0; i < 4; ++i) { const float g = acc[ai][0][m][n][i], up = acc[ai][1][m][n][i];
                        const float e = __builtin_amdgcn_exp2f(-g * 1.44269504089f); h[n * 4 + i] = g * __builtin_amdgcn_rcpf(1.0f + e) * up; }
                u32x4 w; w.x = cvt_pk_bf16(h[0], h[1]); w.y = cvt_pk_bf16(h[2], h[3]); w.z = cvt_pk_bf16(h[4], h[5]); w.w = cvt_pk_bf16(h[6], h[7]);
                *(u32x4*)rowp = w; }
    }
};

struct EpiQKV0 {
    static constexpr bool PERM = true, AFTER_DRAIN = false;
    bf16_t* O; RopeTab rt;
    __device__ __forceinline__ void operator()(const f32x4 (&acc)[2][2][4][2], const Unit& u, int wr, int wc, int fr, int fq) const {
        const int sg = u.pn >> 3, cw = wc * 32 + 8 * fq, hd0 = (u.pn & 7) * 2; const bool rope = sg < 6;
        const int dsh = 2 * (sg % 3);
        const int row0 = u.pm * BM + wr * 64 + fr, f0 = 16 * wc + 4 * fq;
#pragma unroll
        for (int ai = 0; ai < 2; ++ai)
#pragma unroll
            for (int m = 0; m < 4; ++m) { const int row = row0 + ai * HALF + m * 16; const int bb = row >> 13, si = row & 8191;
                const size_t rl = (size_t)(si & ((1 << dsh) - 1)) * (8192 >> dsh) + (si >> dsh);
                f32x4 c = {1.f, 1.f, 1.f, 1.f}, s = {0.f, 0.f, 0.f, 0.f};
                if (rope) { c = *(const f32x4*)(rt.cs + (size_t)row * 64 + f0); s = *(const f32x4*)(rt.sn + (size_t)row * 64 + f0); }
#pragma unroll
                for (int bj = 0; bj < 2; ++bj) { f32x4 v0 = acc[ai][bj][m][0], v1 = acc[ai][bj][m][1];
                    rope_pair(v0, v1, c, s);
                    u32x4 w; w.x = cvt_pk_bf16(v0[0], v0[1]); w.y = cvt_pk_bf16(v0[2], v0[3]); w.z = cvt_pk_bf16(v1[0], v1[1]); w.w = cvt_pk_bf16(v1[2], v1[3]);
                    bf16_t* dst = O + ((size_t)((sg * 2 + bb) * 16 + hd0 + bj) * 8192 + rl) * 128 + cw;
                    *(u32x4*)dst = w; } }
    }
};

struct EpiQKV1 {
    static constexpr bool PERM = true, AFTER_DRAIN = false;
    bf16_t* Q; bf16_t* Kc; bf16_t* Vc; unsigned short* QI; float* KIR; float* WI; RopeTab rt;
    __device__ __forceinline__ void operator()(const f32x4 (&acc)[2][2][4][2], const Unit& u, int wr, int wc, int fr, int fq) const {
        const int pn = u.pn; const int row0 = u.pm * BM + wr * 64 + fr, f0 = 16 * wc + 4 * fq, cw = wc * 32 + 8 * fq;
        const bool rope = (pn < 20) || (pn >= 24 && pn < 40);
#pragma unroll
        for (int ai = 0; ai < 2; ++ai)
#pragma unroll
            for (int m = 0; m < 4; ++m) { const int row = row0 + ai * HALF + m * 16;
                f32x4 c = {1.f, 1.f, 1.f, 1.f}, s = {0.f, 0.f, 0.f, 0.f};
                if (rope) { c = *(const f32x4*)(rt.cs + (size_t)row * 64 + f0); s = *(const f32x4*)(rt.sn + (size_t)row * 64 + f0); }
#pragma unroll
                for (int bj = 0; bj < 2; ++bj) { f32x4 v0 = acc[ai][bj][m][0], v1 = acc[ai][bj][m][1];
                    if (pn < 40) {
                        rope_pair(v0, v1, c, s);
                        u32x4 w;
                        if (pn >= 24) { w.x = cvt_pk_f16(v0[0], v0[1]); w.y = cvt_pk_f16(v0[2], v0[3]); w.z = cvt_pk_f16(v1[0], v1[1]); w.w = cvt_pk_f16(v1[2], v1[3]); }
                        else { w.x = cvt_pk_bf16(v0[0], v0[1]); w.y = cvt_pk_bf16(v0[2], v0[3]); w.z = cvt_pk_bf16(v1[0], v1[1]); w.w = cvt_pk_bf16(v1[2], v1[3]); }
                        if (pn < 16) *(u32x4*)(Q + (size_t)row * 4096 + pn * BM + bj * HALF + cw) = w;
                        else if (pn < 24) { const int kvh = ((pn - 16) & 3) * 2 + bj; bf16_t* dst = (pn < 20 ? Kc : Vc) + ((size_t)((row >> 13) * 8 + kvh) * 8192 + (row & 8191)) * 128 + cw; *(u32x4*)dst = w; }
                        else *(u32x4*)(QI + (size_t)row * 4096 + (pn - 24) * BM + bj * HALF + cw) = w;
                    } else {
                        if (bj == 0) { *(f32x4*)(KIR + (size_t)row * 128 + cw) = v0; *(f32x4*)(KIR + (size_t)row * 128 + cw + 4) = v1; }
                        else if (wc == 0) { *(f32x4*)(WI + (size_t)row * 32 + cw) = v0 * 0.015625f; *(f32x4*)(WI + (size_t)row * 32 + cw + 4) = v1 * 0.015625f; }
                    } } }
    }
};

template <class Epi, class Sched, bool ALIGN_EPI = false, bool SP2 = false>
__device__ __forceinline__ void gemm_phase(PG8_LAS unsigned char* lds, const Gemm g, const Sched& S, const Epi& E) {
    const int tid = threadIdx.x, wid = __builtin_amdgcn_readfirstlane(tid >> 6), lane = tid & 63, wr = wid >> 2, wc = wid & 3, fr = lane & 15, fq = lane >> 4;
    const int K = g.K, nt = K / BK;
    unsigned voffA[2], voffB[2];
#pragma unroll
    for (int i = 0; i < 2; ++i) { int R, C; stage_rc(tid * 16 + i * 8192, R, C); const int Rb = Epi::PERM ? ((R & ~31) + perm32(R & 31)) : R;
        voffA[i] = (unsigned)(R * K + C) * 2u; voffB[i] = (unsigned)(Rb * K + C) * 2u; }
    const size_t kstep = (size_t)(BK * 2);
    const size_t hstep = (size_t)HALF * K * 2;
    const size_t tstep = 2 * hstep;
    const unsigned ldsw = (unsigned)wid * 1024u;
    const int aoff = lds_byte(wr * 64 + fr, fq * 8), boff = lds_byte(wc * 32 + fr, fq * 8);
#define PG8_SA(b, h) (((b) * 2 + (h)) * HTB)
#define PG8_SB(b, h) ((4 + (b) * 2 + (h)) * HTB)
#define PG8_STAGE(bufoff, gbase, voff) do { _Pragma("unroll") for (int _i = 0; _i < 2; ++_i) \
        __builtin_amdgcn_global_load_lds((const unsigned*)((const char*)(gbase) + (voff)[_i]), (PG8_LAS unsigned*)(lds + (bufoff) + ldsw + _i * 8192), 16, 0, 0); } while (0)
#define PG8_LDA(dst, b, h) do { _Pragma("unroll") for (int m = 0; m < 4; ++m) _Pragma("unroll") for (int k = 0; k < 2; ++k) dst[m][k] = *(const PG8_LAS bf16x8*)(lds + PG8_SA(b, h) + aoff + m * 2048 + k * 1024); } while (0)
#define PG8_LDB(dst, b, h) do { _Pragma("unroll") for (int n = 0; n < 2; ++n) _Pragma("unroll") for (int k = 0; k < 2; ++k) dst[n][k] = *(const PG8_LAS bf16x8*)(lds + PG8_SB(b, h) + boff + n * 2048 + k * 1024); } while (0)
#define PG8_MMA(ai, bj, At, Bt) do { __builtin_amdgcn_s_setprio(1); _Pragma("unroll") for (int m = 0; m < 4; ++m) _Pragma("unroll") for (int n = 0; n < 2; ++n) _Pragma("unroll") for (int k = 0; k < 2; ++k) \
        acc[ai][bj][m][n] = __builtin_amdgcn_mfma_f32_16x16x32_bf16(Bt[n][k], At[m][k], acc[ai][bj][m][n], 0, 0, 0); __builtin_amdgcn_s_setprio(0); } while (0)
#define PG8_WAIT_V(n) asm volatile("s_waitcnt vmcnt(" #n ")" ::: "memory")
#define PG8_WAIT_L(n) asm volatile("s_waitcnt lgkmcnt(" #n ")" ::: "memory")
#define PG8_BAR __builtin_amdgcn_s_barrier()
#define PG8_SCHED __builtin_amdgcn_sched_barrier(0)
    Unit cur, nxt; int ui = 0;
    if (!S.next(0, cur)) return;
    f32x4 acc[2][2][4][2];
#pragma unroll
    for (int a = 0; a < 2; ++a)
#pragma unroll
        for (int b = 0; b < 2; ++b)
#pragma unroll
            for (int m = 0; m < 4; ++m)
#pragma unroll
                for (int n = 0; n < 2; ++n) acc[a][b][m][n] = (f32x4){0.f, 0.f, 0.f, 0.f};
    bf16x8 At[4][2], B0[2][2], B1[2][2];
    const char* cA = (const char*)g.A + (size_t)cur.pm * tstep; const char* cB = (const char*)g.Bt + (size_t)cur.pn * tstep;
    S.a_ready(cur);
    if constexpr (SP2) {
        PG8_STAGE(PG8_SB(0, 0), cB, voffB); PG8_STAGE(PG8_SB(0, 1), cB + hstep, voffB); PG8_STAGE(PG8_SA(0, 0), cA, voffA); PG8_STAGE(PG8_SA(0, 1), cA + hstep, voffA);
        if (wr == 1) PG8_BAR;
        PG8_WAIT_V(2); PG8_BAR;
        PG8_STAGE(PG8_SB(1, 0), cB + kstep, voffB); PG8_STAGE(PG8_SA(1, 0), cA + kstep, voffA); PG8_STAGE(PG8_SB(1, 1), cB + hstep + kstep, voffB);
        PG8_WAIT_V(6); PG8_BAR;
    } else {
        PG8_STAGE(PG8_SB(0, 0), cB, voffB); PG8_STAGE(PG8_SA(0, 0), cA, voffA); PG8_STAGE(PG8_SB(0, 1), cB + hstep, voffB); PG8_STAGE(PG8_SA(0, 1), cA + hstep, voffA);
        if (wr == 1) PG8_BAR;
        PG8_WAIT_V(4); PG8_BAR;
        PG8_STAGE(PG8_SB(1, 0), cB + kstep, voffB); PG8_STAGE(PG8_SA(1, 0), cA + kstep, voffA); PG8_STAGE(PG8_SB(1, 1), cB + hstep + kstep, voffB);
        PG8_WAIT_V(6); PG8_BAR;
    }
    for (;;) {
        const bool has_next = S.next(ui + 1, nxt);
        const char* nA = has_next ? (const char*)g.A + (size_t)nxt.pm * tstep : cA; const char* nB = has_next ? (const char*)g.Bt + (size_t)nxt.pn * tstep : cB;
        for (int t = 0; t < nt; t += 2) {
            const bool last = (t == nt - 2);
            const char* a1 = cA + (size_t)(t + 1) * kstep;
            const char* a2 = last ? nA : cA + (size_t)(t + 2) * kstep; const char* b2 = last ? nB : cB + (size_t)(t + 2) * kstep;
            const char* a3 = a2 + kstep; const char* b3 = b2 + kstep;
            if (last && has_next) S.a_ready(nxt);
            if constexpr (SP2) {
            PG8_LDB(B0, 0, 0); PG8_LDB(B1, 0, 1); PG8_SCHED; PG8_LDA(At, 0, 0); PG8_STAGE(PG8_SA(1, 1), a1 + hstep, voffA);
            PG8_WAIT_V(8); PG8_WAIT_L(0); PG8_BAR; PG8_MMA(0, 0, At, B0); PG8_MMA(0, 1, At, B1); PG8_BAR; PG8_SCHED;
            PG8_LDA(At, 0, 1); PG8_STAGE(PG8_SB(0, 0), b2, voffB); PG8_STAGE(PG8_SB(0, 1), b2 + hstep, voffB); PG8_STAGE(PG8_SA(0, 0), a2, voffA);
            PG8_WAIT_V(8); PG8_WAIT_L(0); PG8_BAR; PG8_MMA(1, 0, At, B0); PG8_MMA(1, 1, At, B1); PG8_BAR; PG8_SCHED;
            PG8_LDB(B0, 1, 0); PG8_LDB(B1, 1, 1); PG8_SCHED; PG8_LDA(At, 1, 0); PG8_STAGE(PG8_SA(0, 1), a2 + hstep, voffA);
            PG8_WAIT_V(8); PG8_WAIT_L(0); PG8_BAR; PG8_MMA(0, 0, At, B0); PG8_MMA(0, 1, At, B1); PG8_BAR; PG8_SCHED;
            PG8_LDA(At, 1, 1); PG8_STAGE(PG8_SB(1, 0), b3, voffB); PG8_STAGE(PG8_SB(1, 1), b3 + hstep, voffB); PG8_STAGE(PG8_SA(1, 0), a3, voffA);
            PG8_WAIT_V(8); PG8_WAIT_L(0); PG8_BAR; PG8_MMA(1, 0, At, B0); PG8_MMA(1, 1, At, B1); PG8_BAR; PG8_SCHED;
            } else {
            PG8_LDB(B0, 0, 0); PG8_SCHED; PG8_LDA(At, 0, 0); PG8_STAGE(PG8_SA(1, 1), a1 + hstep, voffA);
            PG8_WAIT_L(8); PG8_BAR; PG8_WAIT_L(0); PG8_MMA(0, 0, At, B0); PG8_BAR; PG8_SCHED;
            PG8_LDB(B1, 0, 1); PG8_STAGE(PG8_SB(0, 0), b2, voffB);
            PG8_BAR; PG8_WAIT_L(0); PG8_MMA(0, 1, At, B1); PG8_BAR;
            PG8_LDA(At, 0, 1); PG8_STAGE(PG8_SA(0, 0), a2, voffA);
            PG8_BAR; PG8_WAIT_L(0); PG8_MMA(1, 0, At, B0); PG8_BAR; PG8_SCHED;
            PG8_STAGE(PG8_SB(0, 1), b2 + hstep, voffB);
            PG8_WAIT_V(6); PG8_BAR; PG8_MMA(1, 1, At, B1); PG8_BAR;
            PG8_LDB(B0, 1, 0); PG8_SCHED; PG8_LDA(At, 1, 0); PG8_STAGE(PG8_SA(0, 1), a2 + hstep, voffA);
            PG8_WAIT_L(8); PG8_BAR; PG8_WAIT_L(0); PG8_MMA(0, 0, At, B0); PG8_BAR; PG8_SCHED;
            PG8_LDB(B1, 1, 1); PG8_STAGE(PG8_SB(1, 0), b3, voffB);
            PG8_BAR; PG8_WAIT_L(0); PG8_MMA(0, 1, At, B1); PG8_BAR;
            PG8_LDA(At, 1, 1); PG8_STAGE(PG8_SA(1, 0), a3, voffA);
            PG8_BAR; PG8_WAIT_L(0); PG8_MMA(1, 0, At, B0); PG8_BAR; PG8_SCHED;
            PG8_STAGE(PG8_SB(1, 1), b3 + hstep, voffB);
            PG8_WAIT_V(6); PG8_BAR; PG8_MMA(1, 1, At, B1); PG8_BAR;
            }
        }
        if constexpr (ALIGN_EPI) { if (wr == 0) PG8_BAR; }
        if constexpr (!Epi::AFTER_DRAIN) { E(acc, cur, wr, wc, fr, fq); S.done(cur); }
        if (!has_next) break;
#pragma unroll
        for (int a = 0; a < 2; ++a)
#pragma unroll
            for (int b = 0; b < 2; ++b)
#pragma unroll
                for (int m = 0; m < 4; ++m)
#pragma unroll
                    for (int n = 0; n < 2; ++n) acc[a][b][m][n] = (f32x4){0.f, 0.f, 0.f, 0.f};
        cur = nxt; cA = nA; cB = nB; ++ui;
        if constexpr (ALIGN_EPI) { if (wr == 1) PG8_BAR; }
    }
    PG8_WAIT_V(0);
    if constexpr (!ALIGN_EPI) { if (wr == 0) PG8_BAR; }
    PG8_BAR;
    if constexpr (Epi::AFTER_DRAIN) { E.fused(acc, cur, wr, wc, fr, fq, lds, wid, lane); S.done(cur); }
#undef PG8_SA
#undef PG8_SB
#undef PG8_STAGE
#undef PG8_LDA
#undef PG8_LDB
#undef PG8_MMA
#undef PG8_WAIT_V
#undef PG8_WAIT_L
#undef PG8_BAR
#undef PG8_SCHED
}
}
#define XB_TMO      128
#define XB_XCNT(j)  (256  + 64 * (j))
#define XB_XSUB(j)  (1280 + 64 * (j))
#define XB_XGEN(j)  (2304 + 64 * (j))
#define XB_TOP      3328
#define XB_TOPGEN   3392
#define XCD_BAR_WORDS 3456
#define XB_SPIN_CAP (1u << 18)
#define LAS __attribute__((address_space(3)))

__device__ __forceinline__ unsigned xb_ld(unsigned* p)              { return __hip_atomic_load(p, __ATOMIC_RELAXED, __HIP_MEMORY_SCOPE_AGENT); }
__device__ __forceinline__ unsigned xb_add(unsigned* p, unsigned v) { return __hip_atomic_fetch_add(p, v, __ATOMIC_RELAXED, __HIP_MEMORY_SCOPE_AGENT); }
__device__ __forceinline__ unsigned xb_xcc_id() { return (unsigned)__builtin_amdgcn_s_getreg((3 << 11) | 20) & 0xFu; }
#define XB_SPIN(cond, bar) do { unsigned _sp = 0; while (cond) { __builtin_amdgcn_s_sleep(1); \
    if ((++_sp & 255u) == 0u) { if (xb_ld(&(bar)[XB_TMO])) break; if (_sp > XB_SPIN_CAP) { atomicAdd(&(bar)[XB_TMO], 1u); break; } } } } while (0)

struct XcdBarrier {
    unsigned* bar; unsigned x;
    volatile LAS unsigned* st;
};

__device__ __forceinline__ XcdBarrier xcd_barrier_post(unsigned* bar, volatile LAS unsigned* st) {
    XcdBarrier b; b.bar = bar; b.x = xb_xcc_id(); b.st = st;
    if (threadIdx.x == 0) (void)xb_add(&bar[XB_XCNT(b.x)], 1u);
    return b;
}
__device__ __forceinline__ void xcd_barrier_complete(unsigned* bar, unsigned x, unsigned& nloc, unsigned& nx) {
    const unsigned G = gridDim.x * gridDim.y * gridDim.z;
    unsigned sum, cnt, mine, sp = 0u;
    for (;;) {
        sum = 0u; cnt = 0u; mine = 0u;
#pragma unroll
        for (unsigned j = 0; j < 16; ++j) { const unsigned c = xb_ld(&bar[XB_XCNT(j)]); sum += c; cnt += (c > 0u) ? 1u : 0u; mine = (j == x) ? c : mine; }
        if (sum == G) break;
        __builtin_amdgcn_s_sleep(1);
        if ((++sp & 255u) == 0u) { if (xb_ld(&bar[XB_TMO])) break; if (sp > XB_SPIN_CAP) { atomicAdd(&bar[XB_TMO], 1u); break; } }
    }
    nloc = mine > 0u ? mine : 1u; nx = cnt > 0u ? cnt : 1u;
}

__device__ __forceinline__ void xcd_barrier(const XcdBarrier& b) {
    asm volatile("s_waitcnt vmcnt(0)" ::: "memory");
    __syncthreads();
    if (threadIdx.x == 0) {
        unsigned* bar = b.bar;
        __builtin_amdgcn_s_waitcnt(0);
        unsigned nloc = b.st[0], nx = b.st[1];
        if (nloc == 0u) { xcd_barrier_complete(bar, b.x, nloc, nx); b.st[0] = nloc; b.st[1] = nx; }
        const unsigned old = xb_add(&bar[XB_XSUB(b.x)], 1u);
        const unsigned gen = old / nloc;
        if (old + 1u == (gen + 1u) * nloc) {
            __builtin_amdgcn_fence(__ATOMIC_RELEASE, "agent");
            asm volatile("s_waitcnt vmcnt(0)" ::: "memory");
            const unsigned og = xb_add(&bar[XB_TOP], 1u);
            const unsigned tg = og / nx;
            if (og + 1u == (tg + 1u) * nx) xb_add(&bar[XB_TOPGEN], 1u);
            else XB_SPIN(xb_ld(&bar[XB_TOPGEN]) == tg, bar);
            __builtin_amdgcn_fence(__ATOMIC_ACQUIRE, "agent");
            xb_add(&bar[XB_XGEN(b.x)], 1u);
            asm volatile("s_waitcnt vmcnt(0)" ::: "memory");
        } else {
            XB_SPIN(xb_ld(&bar[XB_XGEN(b.x)]) == gen, bar);
            __builtin_amdgcn_fence(__ATOMIC_ACQUIRE, "agent");
            asm volatile("s_waitcnt vmcnt(0)" ::: "memory");
        }
    }
    __syncthreads();
}


using pg8::bf16_t; using pg8::bf16x8; using pg8::f32x4; using pg8::u32x4;
typedef _Float16 f16x8 __attribute__((ext_vector_type(8)));
typedef float f32x16 __attribute__((ext_vector_type(16)));
typedef unsigned u32x2 __attribute__((ext_vector_type(2)));
#define DI __device__ __forceinline__

constexpr int NWAVES = 8, NTHR = 512;
constexpr int SEQ = 8192, MTOK = 16384, DM = 4096, DFF = 11008;
constexpr int N_A = 18432, N_B = 10400, N_BP = 10496;
constexpr float LN_EPS = 1e-5f;
constexpr float ALPHA = 1.41421356237309515f;
constexpr float SM_C = 0.08838834764831845f * 1.4426950408889634f;
constexpr float SM_SCALE = 0.08838834764831845f;

constexpr size_t MiB = (size_t)1 << 20;
constexpr size_t WS_CTL = 0, CTL_ZERO_BYTES = 1 * MiB;
constexpr size_t WS_COS = 1 * MiB, WS_SIN = 5 * MiB;
constexpr size_t WS_W = 9 * MiB;
constexpr size_t W0IN = WS_W, W0OUT = WS_W + 144 * MiB, W0GU = WS_W + 160 * MiB, W0DN = WS_W + 332 * MiB;
constexpr size_t W1IN = WS_W, W1OUT = WS_W + 82 * MiB, W1GU = WS_W + 114 * MiB, W1DN = WS_W + 286 * MiB;
constexpr size_t WS_XB = 427 * MiB, WS_XA = 555 * MiB, WS_BIG = 811 * MiB, WS_END = (811 + 835) * MiB;
constexpr size_t B_QKV0 = WS_BIG, B_OG = WS_BIG + 576 * MiB, B_LSE = WS_BIG + 768 * MiB, B_AO0 = WS_BIG + 771 * MiB;
constexpr size_t B_Y = WS_BIG + 360 * MiB, B_H = WS_BIG;
constexpr size_t B_Q1 = WS_BIG, B_K1 = WS_BIG + 128 * MiB, B_V1 = WS_BIG + 160 * MiB, B_QI = WS_BIG + 192 * MiB, B_KIR = WS_BIG + 320 * MiB, B_KI16 = WS_BIG + 328 * MiB,
                 B_WI = WS_BIG + 332 * MiB, B_SC = WS_BIG + 334 * MiB, B_IDX = WS_BIG + 594 * MiB, B_AO1 = WS_BIG + 640 * MiB;
constexpr int LDS_BYTES = 147456, MISC_OFF = 147456 - 64;

DI float wave_sum(float v) { v += __shfl_xor(v, 1); v += __shfl_xor(v, 2); v += __shfl_xor(v, 4); v += __shfl_xor(v, 8); v += __shfl_xor(v, 16); v += __shfl_xor(v, 32); return v; }
DI int sigma_inv(int d) { return 32 * ((d >> 4) & 3) + 8 * ((d >> 2) & 3) + 4 * (d >> 6) + (d & 3); }

struct MapId { DI long operator()(int c) const { return c; } };
struct MapA  { DI long operator()(int c) const { const int d = c & 127; return (c < 2 * 6144) ? (long)(c - d + sigma_inv(d)) : (long)c; } };
struct MapB  { DI long operator()(int c) const { const int d = c & 127; const bool rp = (c < 5120) || (c >= 6144 && c < 10240); return rp ? (long)(c - d + sigma_inv(d)) : (long)c; } };
struct MapGU { int up; DI long operator()(int c) const { return (long)((c >> 7) * 256 + up * 128 + (c & 127)); } };

DI void wt_load(const float* __restrict__ W, int N, int nct, int item, f32x4 (&v)[8], int tid) {
    const int kt = item / nct, ct = item - kt * nct; const int k0 = kt * 64, c0 = ct * 256; const int cq = tid & 63, kr0 = tid >> 6; const bool cok = (c0 + 4 * cq) < N;
#pragma unroll
    for (int i = 0; i < 8; ++i) v[i] = cok ? *(const f32x4*)(W + (size_t)(k0 + kr0 + 8 * i) * N + c0 + 4 * cq) : (f32x4){0.f, 0.f, 0.f, 0.f};
}
template <class Map>
DI void wt_store(int K, int N, int nct, bf16_t* __restrict__ WT, int item, const Map map, const f32x4 (&v)[8], LAS float* scr, int tid) {
    const int kt = item / nct, ct = item - kt * nct; const int k0 = kt * 64, c0 = ct * 256; const int cq = tid & 63, kr0 = tid >> 6;
    __syncthreads();
#pragma unroll
    for (int i = 0; i < 8; ++i) *(LAS f32x4*)(scr + (kr0 + 8 * i) * 260 + 4 * cq) = v[i];
    __syncthreads();
    const int c = tid >> 1, kc = tid & 1;
    if (c0 + c < N) {
        bf16_t* dst = WT + (size_t)map(c0 + c) * K + k0 + 32 * kc;
#pragma unroll
        for (int q = 0; q < 4; ++q) { float f[8];
#pragma unroll
            for (int j = 0; j < 8; ++j) f[j] = scr[(32 * kc + 8 * q + j) * 260 + c];
            u32x4 o; o.x = pg8::cvt_pk_bf16(f[0], f[1]); o.y = pg8::cvt_pk_bf16(f[2], f[3]); o.z = pg8::cvt_pk_bf16(f[4], f[5]); o.w = pg8::cvt_pk_bf16(f[6], f[7]);
            *(u32x4*)(dst + 8 * q) = o; }
    }
}
template <class Map>
DI void wt_matrix(const float* W, int K, int N, bf16_t* WT, const Map map, LAS float* scr, int tid, int bid, int G) {
    const int nct = (N + 255) >> 8, nitems = (K >> 6) * nct;
    f32x4 va[8], vb[8];
    int it = bid;
    if (it < nitems) wt_load(W, N, nct, it, va, tid);
    for (; it < nitems; it += 2 * G) {
        if (it + G < nitems) wt_load(W, N, nct, it + G, vb, tid);
        wt_store(K, N, nct, WT, it, map, va, scr, tid);
        if (it + G >= nitems) break;
        if (it + 2 * G < nitems) wt_load(W, N, nct, it + 2 * G, va, tid);
        wt_store(K, N, nct, WT, it + G, map, vb, scr, tid);
    }
}

DI void rope_sincos(int pos, int f, float& cs, float& sn) {
    const double r1 = 0.8659643233600653; double inv = 1.0, rp = r1;
#pragma unroll
    for (int b = 0; b < 6; ++b) { if ((f >> b) & 1) inv *= rp; rp *= rp; }
    const double ang = (double)pos * inv;
    const double q = __builtin_rint(ang * 0.63661977236758134308);
    double r = __builtin_fma(-q, 1.57079632679489655800e+00, ang); r = __builtin_fma(-q, 6.12323399573676603587e-17, r);
    const double z = r * r;
    const double ps = r + r * z * (-1.66666666666666324348e-01 + z * (8.33333333332248946124e-03 + z * (-1.98412698298579493134e-04 + z * (2.75573137070700676789e-06 + z * (-2.50507602534068634195e-08 + z * 1.58969099521155010221e-10)))));
    const double pc = 1.0 - 0.5 * z + z * z * (4.16666666666666019037e-02 + z * (-1.38888888888741095749e-03 + z * (2.48015872894767294178e-05 + z * (-2.75573143513906633035e-07 + z * (2.08757232129817482790e-09 + z * -1.13596475577881948265e-11)))));
    const int qi = ((int)(long long)q) & 3;
    const double s = (qi == 0) ? ps : (qi == 1) ? pc : (qi == 2) ? -ps : -pc;
    const double c = (qi == 0) ? pc : (qi == 1) ? -ps : (qi == 2) ? -pc : ps;
    cs = (float)c; sn = (float)s;
}

DI void cvt_x_phase(const float* X, bf16_t* XB, int tid, int bid, int G) {
    const size_t n8 = (size_t)MTOK * DM / 8;
    for (size_t i = (size_t)bid * NTHR + tid; i < n8; i += (size_t)G * NTHR) {
        const f32x4 a = *(const f32x4*)(X + i * 8), b = *(const f32x4*)(X + i * 8 + 4);
        u32x4 o; o.x = pg8::cvt_pk_bf16(a[0], a[1]); o.y = pg8::cvt_pk_bf16(a[2], a[3]); o.z = pg8::cvt_pk_bf16(b[0], b[1]); o.w = pg8::cvt_pk_bf16(b[2], b[3]);
        *(u32x4*)(XB + i * 8) = o; }
}
DI void rope_tab_phase(const int* pos, float* CS, float* SN, int tid, int bid, int G) {
    for (int e = bid * NTHR + tid; e < MTOK * 64; e += G * NTHR) { float c, s; rope_sincos(pos[e >> 6], e & 63, c, s); CS[e] = c; SN[e] = s; }
}

DI void ln_phase(const float* Y, const float* gain, const float* bias, float* Xo, bf16_t* XBo, int tid, int bid, int G) {
    const int lane = tid & 63, gw = bid * NWAVES + (tid >> 6), nw = G * NWAVES;
    for (int row = gw; row < MTOK; row += nw) {
        const float* yr = Y + (size_t)row * DM; f32x4 v[16]; float s = 0.f;
#pragma unroll
        for (int j = 0; j < 16; ++j) { v[j] = *(const f32x4*)(yr + (j * 64 + lane) * 4); s += (v[j][0] + v[j][1]) + (v[j][2] + v[j][3]); }
        const float mean = wave_sum(s) * (1.0f / DM); float q = 0.f;
#pragma unroll
        for (int j = 0; j < 16; ++j) { v[j] = v[j] - mean; q += (v[j][0] * v[j][0] + v[j][1] * v[j][1]) + (v[j][2] * v[j][2] + v[j][3] * v[j][3]); }
        const float rstd = 1.0f / sqrtf(wave_sum(q) * (1.0f / DM) + LN_EPS);
#pragma unroll
        for (int j = 0; j < 16; ++j) { const int c = (j * 64 + lane) * 4; const f32x4 g = *(const f32x4*)(gain + c), b = *(const f32x4*)(bias + c); const f32x4 o = v[j] * rstd * g + b;
            *(f32x4*)(Xo + (size_t)row * DM + c) = o;
            if (XBo) { u32x2 w; w.x = pg8::cvt_pk_bf16(o[0], o[1]); w.y = pg8::cvt_pk_bf16(o[2], o[3]); *(u32x2*)(XBo + (size_t)row * DM + c) = w; } }
    }
}

DI bf16x8 ldg_bf16x8(const bf16_t* p) { return *(const bf16x8*)p; }
typedef short s16x4 __attribute__((ext_vector_type(4)));
struct A0Unit { int h, b, grp, d, r, nb; };
DI A0Unit a0_decode(int u) { A0Unit x; x.h = u & 15; const int blk = (u >> 4) & 63; x.b = (u >> 10) & 1; x.grp = u >> 11; const int dsh = 2 * x.grp; x.d = 1 << dsh; x.r = blk >> (6 - dsh); x.nb = blk & ((64 >> dsh) - 1); return x; }
DI size_t a0_sub(int sq, const A0Unit& x) { return ((size_t)(((sq * 3 + x.grp) * 2 + x.b) * 16 + x.h) * 8192 + (size_t)x.r * (8192 >> (2 * x.grp))) * 128; }
DI void a0_load_v(const bf16_t* QKV, const A0Unit& x, u32x4 (&vpre)[8], int tid) {
    const bf16_t* Vg = QKV + a0_sub(2, x) + (tid & 15) * 8;
#pragma unroll
    for (int i = 0; i < 8; ++i) { const int l = (x.nb - 1) * 128 + (tid >> 4) + 32 * i;
        vpre[i] = (l >= 0) ? *(const u32x4*)(Vg + (ptrdiff_t)l * 128) : (u32x4){0u, 0u, 0u, 0u}; }
}
DI void attn0_phase(const bf16_t* QKV, bf16_t* OG, float* LSE, LAS unsigned char* lds, int tid, int bid, int G) {
    const int lane = tid & 63, w = __builtin_amdgcn_readfirstlane(tid >> 6), n = lane & 15, g4 = lane >> 4, q4 = n >> 2, p4 = n & 3;
    LAS unsigned char* vt = lds;
    const size_t GS = (size_t)MTOK * 2048;
    const int tr_base = (4 * g4 + q4) * 256 + 8 * (p4 & 1);
    u32x4 vpre[8];
    int u = bid;
    if (u < 6144) { const A0Unit x = a0_decode(u); a0_load_v(QKV, x, vpre, tid); }
    for (; u < 6144; u += G) {
        const A0Unit x = a0_decode(u);
        const int h = x.h, d = x.d, nb = x.nb, grp = x.grp;
        const bf16_t* Qg = QKV + a0_sub(0, x); const bf16_t* Kg = QKV + a0_sub(1, x);
        const size_t tok0 = (size_t)x.b * SEQ + x.r;
        const int iq = 16 * w + n, lq = nb * 128 + iq;
        const size_t qtok = tok0 + (size_t)lq * d;
        bf16x8 qf[4], kfr[9][4];
        { const bf16_t* qp = Qg + (size_t)lq * 128 + 8 * g4;
#pragma unroll
          for (int ks = 0; ks < 4; ++ks) qf[ks] = ldg_bf16x8(qp + 32 * ks); }
#pragma unroll
        for (int tt = 0; tt < 9; ++tt) {
            const int kf = 16 * (w + tt) + n, lk = (nb - 1) * 128 + kf;
            if (lk >= 0) { const bf16_t* kp_ = Kg + (size_t)lk * 128 + 8 * g4;
#pragma unroll
                for (int ks = 0; ks < 4; ++ks) kfr[tt][ks] = ldg_bf16x8(kp_ + 32 * ks); }
            else {
#pragma unroll
                for (int ks = 0; ks < 4; ++ks) kfr[tt][ks] = (bf16x8){0, 0, 0, 0, 0, 0, 0, 0}; }
        }
        __syncthreads();
#pragma unroll
        for (int i = 0; i < 8; ++i) { const int key = (tid >> 4) + 32 * i; *(LAS u32x4*)(vt + key * 256 + (((tid & 15) ^ (2 * (key & 3))) * 16)) = vpre[i]; }
        __syncthreads();
        if (u + G < 6144) { const A0Unit xn = a0_decode(u + G); a0_load_v(QKV, xn, vpre, tid); }
        f32x4 s[9];
#pragma unroll
        for (int tt = 0; tt < 9; ++tt) { f32x4 a = {0.f, 0.f, 0.f, 0.f};
#pragma unroll
            for (int ks = 0; ks < 4; ++ks) a = __builtin_amdgcn_mfma_f32_16x16x32_bf16(kfr[tt][ks], qf[ks], a, 0, 0, 0);
            s[tt] = a; }
        float mx = -__builtin_inff();
#pragma unroll
        for (int tt = 0; tt < 9; ++tt)
#pragma unroll
            for (int j = 0; j < 4; ++j) { const int kf = 16 * (w + tt) + 4 * g4 + j; const bool ok = (kf >= iq) && (kf <= iq + 128) && (nb > 0 || kf >= 128);
                const float xx = ok ? s[tt][j] : -__builtin_inff(); s[tt][j] = xx; mx = fmaxf(mx, xx); }
        mx = fmaxf(mx, __shfl_xor(mx, 16)); mx = fmaxf(mx, __shfl_xor(mx, 32));
        const float msc = mx * SM_C; float lsum = 0.f;
#pragma unroll
        for (int tt = 0; tt < 9; ++tt)
#pragma unroll
            for (int j = 0; j < 4; ++j) { const float p = __builtin_amdgcn_exp2f(s[tt][j] * SM_C - msc); s[tt][j] = p; lsum += p; }
        lsum += __shfl_xor(lsum, 16); lsum += __shfl_xor(lsum, 32);
        f32x4 o[8];
#pragma unroll
        for (int dt = 0; dt < 8; ++dt) o[dt] = (f32x4){0.f, 0.f, 0.f, 0.f};
#pragma unroll
        for (int kk = 0; kk < 5; ++kk) {
            const int t0 = 2 * kk, t1 = 2 * kk + 1;
            u32x4 pw; pw.x = pg8::cvt_pk_bf16(s[t0][0], s[t0][1]); pw.y = pg8::cvt_pk_bf16(s[t0][2], s[t0][3]);
            if (t1 < 9) { pw.z = pg8::cvt_pk_bf16(s[t1 < 9 ? t1 : 8][0], s[t1 < 9 ? t1 : 8][1]); pw.w = pg8::cvt_pk_bf16(s[t1 < 9 ? t1 : 8][2], s[t1 < 9 ? t1 : 8][3]); } else { pw.z = 0u; pw.w = 0u; }
            const bf16x8 pf = __builtin_bit_cast(bf16x8, pw);
            int T1 = w + t1; T1 = T1 > 15 ? 15 : T1;
            const int row0 = 16 * (w + t0) * 256, row1 = 16 * T1 * 256;
#pragma unroll
            for (int dt = 0; dt < 8; ++dt) {
                const int choff = ((2 * dt + (p4 >> 1)) ^ (2 * q4)) * 16;
                const s16x4 lo = __builtin_amdgcn_ds_read_tr16_b64_v4i16((LAS s16x4*)(vt + tr_base + row0 + choff));
                const s16x4 hi = __builtin_amdgcn_ds_read_tr16_b64_v4i16((LAS s16x4*)(vt + tr_base + row1 + choff));
                const bf16x8 vf = __builtin_shufflevector(lo, hi, 0, 1, 2, 3, 4, 5, 6, 7);
                o[dt] = __builtin_amdgcn_mfma_f32_16x16x32_bf16(vf, pf, o[dt], 0, 0, 0); }
        }
        const float inv = 1.0f / lsum;
        bf16_t* op = OG + (size_t)grp * GS + qtok * 2048 + h * 128 + 4 * g4;
#pragma unroll
        for (int dt = 0; dt < 8; ++dt) { u32x2 wv; wv.x = pg8::cvt_pk_bf16(o[dt][0] * inv, o[dt][1] * inv); wv.y = pg8::cvt_pk_bf16(o[dt][2] * inv, o[dt][3] * inv); *(u32x2*)(op + 16 * dt) = wv; }
        if (g4 == 0) LSE[(size_t)grp * (MTOK * 16) + qtok * 16 + h] = mx * SM_SCALE + __logf(lsum);
    }
}

DI void merge_phase(const bf16_t* OG, const float* LSE, bf16_t* AO, int tid, int bid, int G) {
    const int lane = tid & 63, gw = bid * NWAVES + (tid >> 6), nw = G * NWAVES; const size_t GS = (size_t)MTOK * 2048;
    for (int tok = gw; tok < MTOK; tok += nw) {
#pragma unroll
        for (int it = 0; it < 4; ++it) { const int e = it * 512 + lane * 8, h = e >> 7;
            const float l0 = LSE[(size_t)tok * 16 + h], l1 = LSE[(size_t)(MTOK * 16) + (size_t)tok * 16 + h], l2 = LSE[(size_t)(2 * MTOK * 16) + (size_t)tok * 16 + h];
            const float mx = fmaxf(l0, fmaxf(l1, l2)); const float e0 = __expf(l0 - mx), e1 = __expf(l1 - mx), e2 = __expf(l2 - mx); const float inv = 1.0f / (e0 + e1 + e2);
            const float w0 = e0 * inv, w1 = e1 * inv, w2 = e2 * inv;
            const u32x4 a = *(const u32x4*)(OG + (size_t)tok * 2048 + e), b = *(const u32x4*)(OG + GS + (size_t)tok * 2048 + e), c = *(const u32x4*)(OG + 2 * GS + (size_t)tok * 2048 + e);
            u32x4 o;
#pragma unroll
            for (int k = 0; k < 4; ++k) { const float lo = w0 * __uint_as_float(a[k] << 16) + w1 * __uint_as_float(b[k] << 16) + w2 * __uint_as_float(c[k] << 16);
                const float hi = w0 * __uint_as_float(a[k] & 0xffff0000u) + w1 * __uint_as_float(b[k] & 0xffff0000u) + w2 * __uint_as_float(c[k] & 0xffff0000u);
                o[k] = pg8::cvt_pk_bf16(lo, hi); }
            *(u32x4*)(AO + (size_t)tok * 2048 + e) = o; }
    }
}

DI void kidx_phase(const float* KIR, const float* gain, const float* bias, const float* CS, const float* SN, unsigned short* KI16, int tid, int bid, int G) {
    const int lane = tid & 63, gw = bid * NWAVES + (tid >> 6), nw = G * NWAVES;
    const float g1 = gain[lane], g2 = gain[lane + 64], b1 = bias[lane], b2 = bias[lane + 64];
    const int j1 = sigma_inv(lane);
    for (int tok = gw; tok < MTOK; tok += nw) {
        const float x1 = KIR[(size_t)tok * 128 + lane], x2 = KIR[(size_t)tok * 128 + 64 + lane];
        const float mean = wave_sum(x1 + x2) * (1.0f / 128.0f); const float d1 = x1 - mean, d2 = x2 - mean;
        const float rstd = 1.0f / sqrtf(wave_sum(d1 * d1 + d2 * d2) * (1.0f / 128.0f) + LN_EPS);
        const float y1 = d1 * rstd * g1 + b1, y2 = d2 * rstd * g2 + b2;
        const float c = CS[(size_t)tok * 64 + lane], s = SN[(size_t)tok * 64 + lane];
        const _Float16 o1 = (_Float16)(y1 * c - y2 * s), o2 = (_Float16)(y2 * c + y1 * s);
        KI16[(size_t)tok * 128 + j1] = __builtin_bit_cast(unsigned short, o1); KI16[(size_t)tok * 128 + j1 + 4] = __builtin_bit_cast(unsigned short, o2);
    }
}

constexpr int KT_ROWB = 272, KT_BYTES = 64 * KT_ROWB;
DI size_t sc_row_off(int b, int s) { const int qb = s >> 7; return ((size_t)(b * 2080 + ((qb * (qb + 1)) >> 1))) * 16384 + (size_t)(s & 127) * ((qb + 1) * 128); }
DI void indexer_tile(const LAS unsigned char* buf, const f16x8 (&af)[2][8], const f32x4 (&wv)[2][4], float* sc0, float* sc1, int kt, int r32, int h2) {
#pragma unroll
    for (int sub = 0; sub < 2; ++sub) {
        f16x8 bfr[8];
#pragma unroll
        for (int ks = 0; ks < 8; ++ks) bfr[ks] = *(const LAS f16x8*)(buf + (32 * sub + r32) * KT_ROWB + (16 * ks + 8 * h2) * 2);
        f32x16 c0, c1;
#pragma unroll
        for (int i = 0; i < 16; ++i) { c0[i] = 0.f; c1[i] = 0.f; }
#pragma unroll
        for (int ks = 0; ks < 8; ++ks) { c0 = __builtin_amdgcn_mfma_f32_32x32x16_f16(af[0][ks], bfr[ks], c0, 0, 0, 0); c1 = __builtin_amdgcn_mfma_f32_32x32x16_f16(af[1][ks], bfr[ks], c1, 0, 0, 0); }
        float s0 = 0.f, s1 = 0.f;
#pragma unroll
        for (int q = 0; q < 4; ++q)
#pragma unroll
            for (int e = 0; e < 4; ++e) { s0 += wv[0][q][e] * fmaxf(c0[4 * q + e], 0.f); s1 += wv[1][q][e] * fmaxf(c1[4 * q + e], 0.f); }
        s0 += __shfl_xor(s0, 32); s1 += __shfl_xor(s1, 32);
        if (h2 == 0) { sc0[kt * 64 + 32 * sub + r32] = s0; sc1[kt * 64 + 32 * sub + r32] = s1; }
    }
}
DI void indexer_phase(const unsigned short* QI, const unsigned short* KI16, const float* WI, float* SC, LAS unsigned char* lds, int tid, int bid, int G) {
    const int lane = tid & 63, w = __builtin_amdgcn_readfirstlane(tid >> 6), r32 = lane & 31, h2 = lane >> 5;
    LAS unsigned char* buf0 = lds; LAS unsigned char* buf1 = lds + KT_BYTES;
    const int key0 = tid >> 4, ch = tid & 15;
    for (int v = bid; v < 256; v += G) {
        for (int it = 0; it < 4; ++it) {
            const int b = it >> 1, gi = (it & 1) ? (511 - v) : v; const int tb = 16 * gi;
            const int nt = ((tb + 15) >> 6) + 1;
            f16x8 af[2][8]; f32x4 wv[2][4];
#pragma unroll
            for (int tq = 0; tq < 2; ++tq) { const size_t tg = (size_t)b * SEQ + tb + 2 * w + tq;
#pragma unroll
                for (int ks = 0; ks < 8; ++ks) af[tq][ks] = *(const f16x8*)(QI + tg * 4096 + r32 * 128 + 16 * ks + 8 * h2);
#pragma unroll
                for (int q = 0; q < 4; ++q) wv[tq][q] = *(const f32x4*)(WI + tg * 32 + 8 * q + 4 * h2); }
            float* sc0 = SC + sc_row_off(b, tb + 2 * w); float* sc1 = SC + sc_row_off(b, tb + 2 * w + 1);
            const unsigned short* src = KI16 + (size_t)b * SEQ * 128 + (size_t)key0 * 128 + ch * 8;
            u32x4 a0, a1, b0 = {0u, 0u, 0u, 0u}, b1 = {0u, 0u, 0u, 0u};
            a0 = *(const u32x4*)src; a1 = *(const u32x4*)(src + 32 * 128);
            if (nt > 1) { b0 = *(const u32x4*)(src + 64 * 128); b1 = *(const u32x4*)(src + 96 * 128); }
            __syncthreads();
            *(LAS u32x4*)(buf0 + key0 * KT_ROWB + ch * 16) = a0; *(LAS u32x4*)(buf0 + (key0 + 32) * KT_ROWB + ch * 16) = a1;
            __syncthreads();
            for (int kt = 0; kt < nt; kt += 2) {
                if (kt + 2 < nt) { const unsigned short* p = src + (size_t)(kt + 2) * 64 * 128; a0 = *(const u32x4*)p; a1 = *(const u32x4*)(p + 32 * 128); }
                indexer_tile(buf0, af, wv, sc0, sc1, kt, r32, h2);
                if (kt + 1 < nt) { *(LAS u32x4*)(buf1 + key0 * KT_ROWB + ch * 16) = b0; *(LAS u32x4*)(buf1 + (key0 + 32) * KT_ROWB + ch * 16) = b1; }
                __syncthreads();
                if (kt + 1 >= nt) break;
                if (kt + 3 < nt) { const unsigned short* p = src + (size_t)(kt + 3) * 64 * 128; b0 = *(const u32x4*)p; b1 = *(const u32x4*)(p + 32 * 128); }
                indexer_tile(buf1, af, wv, sc0, sc1, kt + 1, r32, h2);
                if (kt + 2 < nt) { *(LAS u32x4*)(buf0 + key0 * KT_ROWB + ch * 16) = a0; *(LAS u32x4*)(buf0 + (key0 + 32) * KT_ROWB + ch * 16) = a1; }
                __syncthreads();
            }
        }
    }
}

DI unsigned mbcnt64(unsigned long long m) { return __builtin_amdgcn_mbcnt_hi((unsigned)(m >> 32), __builtin_amdgcn_mbcnt_lo((unsigned)m, 0u)); }
DI unsigned f2key(float f) { const unsigned u = __float_as_uint(f); return (u & 0x80000000u) ? ~u : (u | 0x80000000u); }
DI int wave_sum_i(int v) {
    v += __builtin_amdgcn_update_dpp(0, v, 0xB1, 0xF, 0xF, true);
    v += __builtin_amdgcn_update_dpp(0, v, 0x4E, 0xF, 0xF, true);
    v += __builtin_amdgcn_update_dpp(0, v, 0x141, 0xF, 0xF, true);
    v += __builtin_amdgcn_update_dpp(0, v, 0x140, 0xF, 0xF, true);
    return __builtin_amdgcn_readlane(v, 0) + __builtin_amdgcn_readlane(v, 16) + __builtin_amdgcn_readlane(v, 32) + __builtin_amdgcn_readlane(v, 48);
}
template <int NV>
DI void topk_row(const float* row, int s, LAS int* lst, int lane) {
    unsigned key[NV];
    { const unsigned long long ra = (unsigned long long)row; const unsigned rlo = __builtin_amdgcn_readfirstlane((unsigned)ra), rhi = __builtin_amdgcn_readfirstlane((unsigned)(ra >> 32));
      row = (const float*)(((unsigned long long)rhi << 32) | rlo); }
#pragma unroll
    for (int jo = 0; jo < NV / 16; ++jo) { const float* rb = row + jo * 1024;
#pragma unroll
        for (int ji = 0; ji < 16; ++ji) { const int j = jo * 16 + ji; const unsigned u = f2key(rb[ji * 64 + lane]); key[j] = (j * 64 + lane <= s) ? u : 0u; } }
    unsigned T = 0u;
#pragma unroll 1
    for (int bit = 31; bit >= 0; --bit) {
        const unsigned cand = T | (1u << bit); int c = 0;
#pragma unroll
        for (int j = 0; j < NV; ++j) asm volatile("v_cmp_le_u32 vcc, %2, %1\n\tv_addc_co_u32 %0, vcc, 0, %0, vcc" : "+v"(c) : "v"(key[j]), "s"(cand) : "vcc");
        if (wave_sum_i(c) >= 256) T = cand;
    }
    int bgt = 0;
#pragma unroll
    for (int j = 0; j < NV; ++j) { const bool sg = key[j] > T; const unsigned long long mg = __ballot(sg); if (sg) lst[bgt + (int)mbcnt64(mg)] = j * 64 + lane; bgt += __builtin_popcountll(mg); }
#pragma unroll
    for (int j = 0; j < NV; ++j) { const bool se = key[j] == T; const unsigned long long me = __ballot(se); const int pe = bgt + (int)mbcnt64(me); if (se && pe < 256) lst[pe] = j * 64 + lane; bgt += __builtin_popcountll(me); }
}
DI void topk_phase(const float* SC, unsigned short* IDX, LAS unsigned char* lds, int tid, int bid, int G) {
    const int lane = tid & 63, w = __builtin_amdgcn_readfirstlane(tid >> 6), gw = bid * NWAVES + w, nw = G * NWAVES;
    LAS int* lst = (LAS int*)(lds + w * 1024);
    for (int t = gw; t < MTOK; t += nw) {
        const int b = t >> 13, s = t & 8191; unsigned short* out = IDX + (size_t)t * 256;
        if (s < 256) {
#pragma unroll
            for (int i = 0; i < 4; ++i) { const int j = lane + 64 * i; out[j] = (unsigned short)((j <= s) ? j : 0); }
        } else {
            const float* row = SC + sc_row_off(b, s);
            if (s < 2048) topk_row<32>(row, s, lst, lane);
            else if (s < 4096) topk_row<64>(row, s, lst, lane);
            else if (s < 6144) topk_row<96>(row, s, lst, lane);
            else topk_row<128>(row, s, lst, lane);
#pragma unroll
            for (int i = 0; i < 4; ++i) out[lane + 64 * i] = (unsigned short)lst[lane + 64 * i];
        }
    }
}

typedef unsigned __attribute__((may_alias)) u32_alias_t;
constexpr int DSA_WB = 17408;
DI __amdgpu_buffer_rsrc_t kv_rsrc(const bf16_t* base) { return __builtin_amdgcn_make_buffer_rsrc((void*)base, 0, SEQ * 256, 0x00020000); }
DI __amdgpu_buffer_rsrc_t big_rsrc(const void* base, unsigned bytes) { return __builtin_amdgcn_make_buffer_rsrc((void*)base, 0, (int)bytes, 0x00020000); }
DI void dsa_attn_phase(const bf16_t* Q1, const bf16_t* K1, const bf16_t* V1, const unsigned short* IDX, bf16_t* AO, LAS unsigned char* lds, int tid, int bid, int G) {
    const int lane = tid & 63, w = __builtin_amdgcn_readfirstlane(tid >> 6), n = lane & 15, g4 = lane >> 4, q4 = n >> 2, p4 = n & 3;
    LAS unsigned char* vb = lds + w * DSA_WB; LAS unsigned short* il0 = (LAS unsigned short*)(vb + 16384); LAS unsigned short* il1 = il0 + 256;
    const bool xm = (G & 7) == 0;
    const int start = xm ? ((bid >> 3) * NWAVES + w) : (bid * NWAVES + w), step = xm ? ((G >> 3) * NWAVES) : (G * NWAVES), total = xm ? MTOK : MTOK * 8;
    const int tr_base = (4 * g4 + q4) * 256 + 8 * (p4 & 1);
    const int vvo = 16 * n;
    const __amdgpu_buffer_rsrc_t qr = big_rsrc(Q1, (unsigned)MTOK * 8192u), ir = big_rsrc(IDX, (unsigned)MTOK * 512u), orr = big_rsrc(AO, (unsigned)MTOK * 8192u);
    const int qlo = n * 256 + 16 * g4;
    const int olo = n * 256 + 8 * g4;
    LAS unsigned char* kwb[4]; LAS unsigned char* krb[4]; LAS unsigned char* trb[4];
#pragma unroll
    for (int j = 0; j < 4; ++j) { kwb[j] = vb + g4 * 256 + ((n ^ (4 * j + g4)) * 16);
                                  krb[j] = vb + n * 256 + (((4 * j + g4) ^ n) * 16);
                                  trb[j] = vb + tr_base + 32 * (j ^ q4) + 16 * (p4 >> 1); }
    LAS unsigned char* vwb = vb + g4 * 256 + ((n ^ (2 * g4)) * 16);
    int it = start;
    if (it >= total) return;
#define DSA_ITEM(itv, kvh_, t_) const int kvh_ = xm ? (bid & 7) : ((itv) & 7), t_ = xm ? (itv) : ((itv) >> 3)
    u32x4 vst[8], kst[16]; bf16x8 qf[4];
    {
        DSA_ITEM(it, kvh, t);
#pragma unroll
        for (int i = 0; i < 2; ++i) ((LAS u32_alias_t*)il0)[lane + 64 * i] = __builtin_amdgcn_raw_buffer_load_b32(ir, lane * 4 + 256 * i, t * 512, 0);
        const size_t slice = (size_t)((t >> 13) * 8 + kvh) * SEQ * 128;
        const __amdgpu_buffer_rsrc_t kr = kv_rsrc(K1 + slice), vr = kv_rsrc(V1 + slice);
#pragma unroll
        for (int ks = 0; ks < 4; ++ks) qf[ks] = (n < 4) ? __builtin_bit_cast(bf16x8, __builtin_amdgcn_raw_buffer_load_b128(qr, qlo + 64 * ks, t * 8192 + kvh * 1024, 0)) : (bf16x8){0, 0, 0, 0, 0, 0, 0, 0};
#pragma unroll
        for (int i = 0; i < 16; ++i) kst[i] = __builtin_amdgcn_raw_buffer_load_b128(kr, (int)il0[4 * i + g4] * 256 + vvo, 0, 0);
#pragma unroll
        for (int i = 0; i < 8; ++i) vst[i] = __builtin_amdgcn_raw_buffer_load_b128(vr, (int)il0[4 * i + g4] * 256 + vvo, 0, 0);
    }
    int par = 0;
    for (; it < total; it += step) {
        DSA_ITEM(it, kvh, t);
        LAS unsigned short* ilc = par ? il1 : il0; LAS unsigned short* iln = par ? il0 : il1;
        const bool has_next = (it + step) < total;
        DSA_ITEM(it + step, kvh2, t2);
        const int s = t & 8191; const int nvalid = s + 1 < 256 ? s + 1 : 256;
        const size_t slice = (size_t)((t >> 13) * 8 + kvh) * SEQ * 128;
        const __amdgpu_buffer_rsrc_t kr = kv_rsrc(K1 + slice), vr = kv_rsrc(V1 + slice);
        const size_t slice2 = (size_t)((t2 >> 13) * 8 + kvh2) * SEQ * 128;
        unsigned inext[2] = {0u, 0u};
        if (has_next) {
#pragma unroll
            for (int i = 0; i < 2; ++i) inext[i] = __builtin_amdgcn_raw_buffer_load_b32(ir, lane * 4 + 256 * i, t2 * 512, 0); }
        float mrun = -__builtin_inff(), lsum = 0.f;
        f32x4 o[8];
#pragma unroll
        for (int dt = 0; dt < 8; ++dt) o[dt] = (f32x4){0.f, 0.f, 0.f, 0.f};
#pragma unroll 1
        for (int c = 0; c < 4; ++c) {
#pragma unroll
            for (int i = 0; i < 16; ++i) *(LAS u32x4*)(kwb[i & 3] + i * 1024) = kst[i];
            if (c < 3) {
#pragma unroll
                for (int i = 0; i < 16; ++i) kst[i] = __builtin_amdgcn_raw_buffer_load_b128(kr, (int)ilc[(c + 1) * 64 + 4 * i + g4] * 256 + vvo, 0, 0);
            } else if (has_next) {
#pragma unroll
                for (int i = 0; i < 2; ++i) ((LAS u32_alias_t*)iln)[lane + 64 * i] = inext[i];
                const __amdgpu_buffer_rsrc_t kr2 = kv_rsrc(K1 + slice2);
#pragma unroll
                for (int i = 0; i < 16; ++i) kst[i] = __builtin_amdgcn_raw_buffer_load_b128(kr2, (int)iln[4 * i + g4] * 256 + vvo, 0, 0);
            }
            f32x4 sa[4];
#pragma unroll
            for (int tt = 0; tt < 4; ++tt) { f32x4 a = {0.f, 0.f, 0.f, 0.f};
#pragma unroll
                for (int ks = 0; ks < 4; ++ks) { const bf16x8 kf = *(const LAS bf16x8*)(krb[ks] + tt * 4096);
                    a = __builtin_amdgcn_mfma_f32_16x16x32_bf16(kf, qf[ks], a, 0, 0, 0); }
                sa[tt] = a; asm volatile("" ::: "memory"); }
            if (nvalid < 256) {
#pragma unroll
                for (int tt = 0; tt < 4; ++tt)
#pragma unroll
                    for (int j = 0; j < 4; ++j) { const int kk = 64 * c + 16 * tt + 4 * g4 + j; sa[tt][j] = (kk < nvalid) ? sa[tt][j] : -__builtin_inff(); }
            }
            float cm = fmaxf(fmaxf(fmaxf(sa[0][0], sa[0][1]), fmaxf(sa[0][2], sa[0][3])), fmaxf(fmaxf(sa[1][0], sa[1][1]), fmaxf(sa[1][2], sa[1][3])));
            cm = fmaxf(cm, fmaxf(fmaxf(fmaxf(sa[2][0], sa[2][1]), fmaxf(sa[2][2], sa[2][3])), fmaxf(fmaxf(sa[3][0], sa[3][1]), fmaxf(sa[3][2], sa[3][3]))));
            cm = fmaxf(cm, __shfl_xor(cm, 16)); cm = fmaxf(cm, __shfl_xor(cm, 32));
            const float mnew = fmaxf(mrun, cm); const float alpha = __builtin_amdgcn_exp2f((mrun - mnew) * SM_C); const float msc = mnew * SM_C; mrun = mnew;
            lsum *= alpha;
#pragma unroll
            for (int dt = 0; dt < 8; ++dt) o[dt] = o[dt] * alpha;
            unsigned pk[4][2];
#pragma unroll
            for (int tt = 0; tt < 4; ++tt) { float pp[4];
#pragma unroll
                for (int j = 0; j < 4; ++j) { pp[j] = __builtin_amdgcn_exp2f(sa[tt][j] * SM_C - msc); lsum += pp[j]; }
                pk[tt][0] = pg8::cvt_pk_bf16(pp[0], pp[1]); pk[tt][1] = pg8::cvt_pk_bf16(pp[2], pp[3]); }
            if (c == 3 && has_next) {
#pragma unroll
                for (int ks = 0; ks < 4; ++ks) qf[ks] = (n < 4) ? __builtin_bit_cast(bf16x8, __builtin_amdgcn_raw_buffer_load_b128(qr, qlo + 64 * ks, t2 * 8192 + kvh2 * 1024, 0)) : (bf16x8){0, 0, 0, 0, 0, 0, 0, 0};
            }
#pragma unroll
            for (int hf = 0; hf < 2; ++hf) {
#pragma unroll
                for (int i = 0; i < 8; ++i) *(LAS u32x4*)(vwb + i * 1024) = vst[i];
                if (hf == 0) {
#pragma unroll
                    for (int i = 0; i < 8; ++i) vst[i] = __builtin_amdgcn_raw_buffer_load_b128(vr, (int)ilc[c * 64 + 32 + 4 * i + g4] * 256 + vvo, 0, 0);
                } else if (c < 3) {
#pragma unroll
                    for (int i = 0; i < 8; ++i) vst[i] = __builtin_amdgcn_raw_buffer_load_b128(vr, (int)ilc[(c + 1) * 64 + 4 * i + g4] * 256 + vvo, 0, 0);
                } else if (has_next) {
                    const __amdgpu_buffer_rsrc_t vr2 = kv_rsrc(V1 + slice2);
#pragma unroll
                    for (int i = 0; i < 8; ++i) vst[i] = __builtin_amdgcn_raw_buffer_load_b128(vr2, (int)iln[4 * i + g4] * 256 + vvo, 0, 0);
                }
                u32x4 pw; pw.x = pk[2 * hf][0]; pw.y = pk[2 * hf][1]; pw.z = pk[2 * hf + 1][0]; pw.w = pk[2 * hf + 1][1];
                const bf16x8 pf = __builtin_bit_cast(bf16x8, pw);
#pragma unroll
                for (int dt = 0; dt < 8; ++dt) {
                    const s16x4 lo = __builtin_amdgcn_ds_read_tr16_b64_v4i16((LAS s16x4*)(trb[dt & 3] + 128 * (dt >> 2)));
                    const s16x4 hi = __builtin_amdgcn_ds_read_tr16_b64_v4i16((LAS s16x4*)(trb[dt & 3] + 128 * (dt >> 2) + 16 * 256));
                    const bf16x8 vf = __builtin_shufflevector(lo, hi, 0, 1, 2, 3, 4, 5, 6, 7);
                    o[dt] = __builtin_amdgcn_mfma_f32_16x16x32_bf16(vf, pf, o[dt], 0, 0, 0);
                    if (dt & 1) asm volatile("" ::: "memory");
                }
            }
        }
        lsum += __shfl_xor(lsum, 16); lsum += __shfl_xor(lsum, 32);
        if (n < 4) { const float li = 1.0f / lsum;
#pragma unroll
            for (int dt = 0; dt < 8; ++dt) { u32x2 wv; wv.x = pg8::cvt_pk_bf16(o[dt][0] * li, o[dt][1] * li); wv.y = pg8::cvt_pk_bf16(o[dt][2] * li, o[dt][3] * li);
                __builtin_amdgcn_raw_buffer_store_b64(wv, orr, olo + 32 * dt, t * 8192 + kvh * 1024, 0); } }
        par ^= 1;
    }
#undef DSA_ITEM
}

#ifndef MK_ONE_LAUNCH
#define MK_ONE_LAUNCH 1
#endif
constexpr int N_PHASES = 19;
#ifndef WGM_Y
#define WGM_Y 2
#endif
struct Args { const float* in[22]; float* out; unsigned char* ws; int ph_lo, ph_hi; };

__global__ void __launch_bounds__(NTHR, 2) mk_fwd(Args args) {
    extern __shared__ __attribute__((aligned(16))) unsigned char lds_raw[];
    LAS unsigned char* lds = (LAS unsigned char*)lds_raw;
    const int tid = threadIdx.x, bid = blockIdx.x, G = gridDim.x;
    unsigned char* ws = args.ws;
    const __attribute__((address_space(4))) unsigned char* kargs = (const __attribute__((address_space(4))) unsigned char*)__builtin_amdgcn_kernarg_segment_ptr();
#define ARG_IN(i) (*(const float* const volatile __attribute__((address_space(4)))*)(kargs + 8 * (i)))
    volatile LAS unsigned* misc = (volatile LAS unsigned*)(lds + MISC_OFF);
    if (tid < 4) misc[tid] = 0u;
    __syncthreads();
    const int lo = args.ph_lo, hi = args.ph_hi;
    XcdBarrier bar; bar.bar = (unsigned*)(ws + WS_CTL); bar.x = 0; bar.st = nullptr;
    if (hi - lo > 1) bar = xcd_barrier_post((unsigned*)(ws + WS_CTL), misc);
#ifndef PH_MASK
#define PH_MASK 0x7ffff
#endif
#define IN(k) ((((PH_MASK) >> (k)) & 1) && lo <= (k) && (k) < hi)
#ifndef PROBE_PH
#define PROBE_PH -1
#endif
#ifndef PROBE_PH2
#define PROBE_PH2 -1
#endif
    unsigned long long pr_t0 = (PROBE_PH == 0) ? __builtin_amdgcn_s_memrealtime() : 0ull, pr_acc = 0ull;
#define SEAM(k) do { if (IN(k) && IN((k) + 1)) xcd_barrier(bar); \
        if (PROBE_PH >= 0 && bid == 0) { const unsigned long long now_ = __builtin_amdgcn_s_memrealtime(); if ((k) + 1 == PROBE_PH) pr_t0 = now_; if ((k) == (PROBE_PH2 >= 0 ? PROBE_PH2 : PROBE_PH)) pr_acc = now_ - pr_t0; } } while (0)
#ifndef DUP_MASK
#define DUP_MASK 0
#endif
#define REP(k) _Pragma("unroll 1") for (int rep_ = 0; rep_ < ((((DUP_MASK) >> (k)) & 1) ? 2 : 1); ++rep_)

    float* CS = (float*)(ws + WS_COS); float* SN = (float*)(ws + WS_SIN);
    bf16_t* XB = (bf16_t*)(ws + WS_XB); float* XA = (float*)(ws + WS_XA); float* Y = (float*)(ws + B_Y); bf16_t* Hh = (bf16_t*)(ws + B_H);
    float* OUT = args.out;
    const pg8::RopeTab rt{CS, SN};

    if (IN(0)) REP(0) {
        LAS float* scr = (LAS float*)lds;
        wt_matrix(ARG_IN(2), DM, N_A, (bf16_t*)(ws + W0IN), MapA{}, scr, tid, bid, G);
        wt_matrix(ARG_IN(3), 2048, DM, (bf16_t*)(ws + W0OUT), MapId{}, scr, tid, bid, G);
        wt_matrix(ARG_IN(10), DM, DFF, (bf16_t*)(ws + W0GU), MapGU{0}, scr, tid, bid, G);
        wt_matrix(ARG_IN(11), DM, DFF, (bf16_t*)(ws + W0GU), MapGU{1}, scr, tid, bid, G);
        wt_matrix(ARG_IN(12), DFF, DM, (bf16_t*)(ws + W0DN), MapId{}, scr, tid, bid, G);
        cvt_x_phase(ARG_IN(0), XB, tid, bid, G);
        rope_tab_phase((const int*)ARG_IN(1), CS, SN, tid, bid, G);
    }
    SEAM(0);
    if (IN(1)) REP(1) {
        pg8::Gemm g{XB, (const bf16_t*)(ws + W0IN), MTOK, N_A, DM}; pg8::StaticOrder S; S.init(MTOK, N_A, G, bid);
        pg8::EpiQKV0 E{(bf16_t*)(ws + B_QKV0), rt};
        pg8::gemm_phase<pg8::EpiQKV0, pg8::StaticOrder, true, true>(lds, g, S, E);
    }
    SEAM(1);
    if (IN(2)) REP(2) attn0_phase((const bf16_t*)(ws + B_QKV0), (bf16_t*)(ws + B_OG), (float*)(ws + B_LSE), lds, tid, bid, G);
    SEAM(2);
    if (IN(3)) REP(3) merge_phase((const bf16_t*)(ws + B_OG), (const float*)(ws + B_LSE), (bf16_t*)(ws + B_AO0), tid, bid, G);
    SEAM(3);
    if (IN(4)) REP(4) {
        pg8::Gemm g{(const bf16_t*)(ws + B_AO0), (const bf16_t*)(ws + W0OUT), MTOK, DM, 2048}; pg8::StaticOrder S; S.init(MTOK, DM, G, bid, WGM_Y);
        pg8::EpiY E{ARG_IN(0), Y, DM, ALPHA};
        pg8::gemm_phase<pg8::EpiY, pg8::StaticOrder, true, true>(lds, g, S, E);
    }
    SEAM(4);
    if (IN(5)) REP(5) ln_phase(Y, ARG_IN(8), ARG_IN(9), OUT, XB, tid, bid, G);
    SEAM(5);
    if (IN(6)) REP(6) {
        pg8::Gemm g{XB, (const bf16_t*)(ws + W0GU), MTOK, 2 * DFF, DM}; pg8::StaticOrder S; S.init(MTOK, 2 * DFF, G, bid);
        pg8::EpiSwiGLU E{Hh, DFF};
        pg8::gemm_phase<pg8::EpiSwiGLU, pg8::StaticOrder, true, true>(lds, g, S, E);
    }
    SEAM(6);
    if (IN(7)) REP(7) {
        pg8::Gemm g{Hh, (const bf16_t*)(ws + W0DN), MTOK, DM, DFF}; pg8::StaticOrder S; S.init(MTOK, DM, G, bid, WGM_Y);
        pg8::EpiY E{OUT, Y, DM, ALPHA};
        pg8::gemm_phase<pg8::EpiY, pg8::StaticOrder, true, true>(lds, g, S, E);
    }
    SEAM(7);
    if (IN(8)) REP(8) {
        ln_phase(Y, ARG_IN(13), ARG_IN(14), XA, XB, tid, bid, G);
        LAS float* scr = (LAS float*)lds;
        wt_matrix(ARG_IN(4), DM, N_B, (bf16_t*)(ws + W1IN), MapB{}, scr, tid, bid, G);
        { u32x4* z = (u32x4*)(ws + W1IN + (size_t)N_B * DM * 2); const int nz = (N_BP - N_B) * DM * 2 / 16; for (int i = bid * NTHR + tid; i < nz; i += G * NTHR) z[i] = (u32x4){0u, 0u, 0u, 0u}; }
        wt_matrix(ARG_IN(7), DM, DM, (bf16_t*)(ws + W1OUT), MapId{}, scr, tid, bid, G);
        wt_matrix(ARG_IN(17), DM, DFF, (bf16_t*)(ws + W1GU), MapGU{0}, scr, tid, bid, G);
        wt_matrix(ARG_IN(18), DM, DFF, (bf16_t*)(ws + W1GU), MapGU{1}, scr, tid, bid, G);
        wt_matrix(ARG_IN(19), DFF, DM, (bf16_t*)(ws + W1DN), MapId{}, scr, tid, bid, G);
    }
    SEAM(8);
    if (IN(9)) REP(9) {
        pg8::Gemm g{XB, (const bf16_t*)(ws + W1IN), MTOK, N_BP, DM}; pg8::StaticOrder S; S.init(MTOK, N_BP, G, bid);
        pg8::EpiQKV1 E{(bf16_t*)(ws + B_Q1), (bf16_t*)(ws + B_K1), (bf16_t*)(ws + B_V1), (unsigned short*)(ws + B_QI), (float*)(ws + B_KIR), (float*)(ws + B_WI), rt};
        pg8::gemm_phase<pg8::EpiQKV1, pg8::StaticOrder, true, true>(lds, g, S, E);
    }
    SEAM(9);
    if (IN(10)) REP(10) kidx_phase((const float*)(ws + B_KIR), ARG_IN(5), ARG_IN(6), CS, SN, (unsigned short*)(ws + B_KI16), tid, bid, G);
    SEAM(10);
    if (IN(11)) REP(11) indexer_phase((const unsigned short*)(ws + B_QI), (const unsigned short*)(ws + B_KI16), (const float*)(ws + B_WI), (float*)(ws + B_SC), lds, tid, bid, G);
    SEAM(11);
    if (IN(12)) REP(12) topk_phase((const float*)(ws + B_SC), (unsigned short*)(ws + B_IDX), lds, tid, bid, G);
    SEAM(12);
    if (IN(13)) REP(13) dsa_attn_phase((const bf16_t*)(ws + B_Q1), (const bf16_t*)(ws + B_K1), (const bf16_t*)(ws + B_V1), (const unsigned short*)(ws + B_IDX), (bf16_t*)(ws + B_AO1), lds, tid, bid, G);
    SEAM(13);
    if (IN(14)) REP(14) {
        pg8::Gemm g{(const bf16_t*)(ws + B_AO1), (const bf16_t*)(ws + W1OUT), MTOK, DM, DM}; pg8::StaticOrder S; S.init(MTOK, DM, G, bid, WGM_Y);
        pg8::EpiY E{XA, Y, DM, ALPHA};
        pg8::gemm_phase<pg8::EpiY, pg8::StaticOrder, true, true>(lds, g, S, E);
    }
    SEAM(14);
    if (IN(15)) REP(15) ln_phase(Y, ARG_IN(15), ARG_IN(16), OUT, XB, tid, bid, G);
    SEAM(15);
    if (IN(16)) REP(16) {
        pg8::Gemm g{XB, (const bf16_t*)(ws + W1GU), MTOK, 2 * DFF, DM}; pg8::StaticOrder S; S.init(MTOK, 2 * DFF, G, bid);
        pg8::EpiSwiGLU E{Hh, DFF};
        pg8::gemm_phase<pg8::EpiSwiGLU, pg8::StaticOrder, true, true>(lds, g, S, E);
    }
    SEAM(16);
    if (IN(17)) REP(17) {
        pg8::Gemm g{Hh, (const bf16_t*)(ws + W1DN), MTOK, DM, DFF}; pg8::StaticOrder S; S.init(MTOK, DM, G, bid, WGM_Y);
        pg8::EpiY E{OUT, Y, DM, ALPHA};
        pg8::gemm_phase<pg8::EpiY, pg8::StaticOrder, true, true>(lds, g, S, E);
    }
    SEAM(17);
    if (IN(18)) REP(18) ln_phase(Y, ARG_IN(20), ARG_IN(21), OUT, nullptr, tid, bid, G);
    if (PROBE_PH >= 0 && bid == 0) { const unsigned long long t1_ = __builtin_amdgcn_s_memrealtime(); while (__builtin_amdgcn_s_memrealtime() - t1_ < pr_acc) __builtin_amdgcn_s_sleep(8); }
#undef IN
#undef ARG_IN
#undef SEAM
#undef REP
}

extern "C" void kernel_launch(void* const* d_in, const int* in_sizes, int n_in, void* d_out, int out_size, void* d_ws, size_t ws_size, hipStream_t stream) {
    static int grid = 0;
    if (grid == 0) {
        if (n_in != 22 || out_size != MTOK * DM || ws_size < WS_END) { fprintf(stderr, "kernel_launch: unexpected problem (n_in %d, out %d, ws %zu < %zu); nothing launched\n", n_in, out_size, ws_size, (size_t)WS_END); grid = -1; return; }
        int dev = 0, cus = 0, per_cu = 0;
        if (hipGetDevice(&dev) != hipSuccess || hipDeviceGetAttribute(&cus, hipDeviceAttributeMultiprocessorCount, dev) != hipSuccess) { grid = -1; return; }
        if (hipFuncSetAttribute((const void*)mk_fwd, hipFuncAttributeMaxDynamicSharedMemorySize, LDS_BYTES) != hipSuccess) { fprintf(stderr, "kernel_launch: hipFuncSetAttribute failed\n"); grid = -1; return; }
        if (hipOccupancyMaxActiveBlocksPerMultiprocessor(&per_cu, (const void*)mk_fwd, NTHR, LDS_BYTES) != hipSuccess || per_cu < 1) { fprintf(stderr, "kernel_launch: occupancy query reports %d\n", per_cu); (void)hipGetLastError(); per_cu = 1; }
        grid = cus;
    }
    if (grid < 0) return;
    (void)in_sizes;
    if (hipMemsetAsync((char*)d_ws + WS_CTL, 0, CTL_ZERO_BYTES, stream) != hipSuccess) return;
    Args a{};
    for (int i = 0; i < 22; ++i) a.in[i] = (const float*)d_in[i];
    a.out = (float*)d_out; a.ws = (unsigned char*)d_ws;
#if MK_ONE_LAUNCH
    a.ph_lo = 0; a.ph_hi = N_PHASES;
    hipLaunchKernelGGL(mk_fwd, dim3(grid), dim3(NTHR), LDS_BYTES, stream, a);
#else
    for (int p = 0; p < N_PHASES; ++p) { a.ph_lo = p; a.ph_hi = p + 1; hipLaunchKernelGGL(mk_fwd, dim3(grid), dim3(NTHR), LDS_BYTES, stream, a); }
#endif
}
```

```cpp
#include <hip/hip_runtime.h>
#include <cstdio>
#include <cstdint>
namespace pg8 {
#define PG8_LAS __attribute__((address_space(3)))
typedef unsigned short bf16_t;
typedef short bf16x8 __attribute__((ext_vector_type(8)));
typedef float f32x4 __attribute__((ext_vector_type(4)));
typedef unsigned u32x4 __attribute__((ext_vector_type(4)));
constexpr int BM = 256, BK = 64, HALF = 128, HTB = HALF * BK * 2  , STAGE_BYTES = 8 * HTB, NXCD = 8, WGM = 8;

__host__ __device__ __forceinline__ int lds_byte(int r, int c) { const int st = (r >> 4) * 2 + (c >> 5), rr = r & 15, cc = c & 31, ob = rr * 64 + cc * 2; return st * 1024 + (ob ^ (((ob >> 9) & 1) << 5)); }
__host__ __device__ __forceinline__ void stage_rc(int b, int& R, int& C) { const int st = b / 1024, sb = b % 1024, swz = sb ^ (((sb >> 9) & 1) << 5); R = (st >> 1) * 16 + swz / 64; C = (st & 1) * 32 + (swz % 64) / 2; }
__host__ __device__ __forceinline__ int perm32(int rho) { const int n = rho >> 4, i = rho & 15; return 8 * (i >> 2) + 4 * n + (i & 3); }

struct Unit { int pm, pn; };
struct Gemm { const bf16_t* A; const bf16_t* Bt; int M, N, K; };

struct StaticOrder {
    int nM, nN, nwg, G, c, wgm;
    __host__ __device__ void init(int M, int N, int G_, int c_, int wgm_ = WGM) { nM = M / BM; nN = N / BM; nwg = nM * nN; G = G_; c = c_; wgm = wgm_; }
    __host__ __device__ bool next(int i, Unit& u) const {
        const long L = (long)i * G + c; if (L >= nwg) return false;
        int wgid = (int)L; { const int q = nwg / NXCD, r = nwg % NXCD, xcd = wgid % NXCD, off = wgid / NXCD; wgid = (xcd < r ? xcd * (q + 1) : r * (q + 1) + (xcd - r) * q) + off; }
        const int nig = wgm * nN, gid = wgid / nig, fm = gid * wgm, gsz = (nM - fm) < wgm ? (nM - fm) : wgm;
        u.pm = fm + ((wgid % nig) % gsz); u.pn = (wgid % nig) / gsz; return true;
    }
    __device__ __forceinline__ void a_ready(const Unit&) const {}
    __device__ __forceinline__ void done(const Unit&) const {}
};
__device__ __forceinline__ unsigned cvt_pk_bf16(float lo, float hi) { unsigned r; asm volatile("v_cvt_pk_bf16_f32 %0, %1, %2" : "=v"(r) : "v"(lo), "v"(hi)); return r; }
typedef _Float16 f16x2_t __attribute__((ext_vector_type(2)));
__device__ __forceinline__ unsigned cvt_pk_f16(float lo, float hi) { f16x2_t h; h.x = (_Float16)lo; h.y = (_Float16)hi; return __builtin_bit_cast(unsigned, h); }

struct RopeTab { const float* cs; const float* sn; };

__device__ __forceinline__ void rope_pair(f32x4& v0, f32x4& v1, const f32x4 c, const f32x4 s) {
    const f32x4 a = v0 * c - v1 * s, b = v1 * c + v0 * s; v0 = a; v1 = b;
}

struct EpiY {
    static constexpr bool PERM = false, AFTER_DRAIN = false;
    const float* X; float* Y; int ldc; float alpha;
    __device__ __forceinline__ void operator()(const f32x4 (&acc)[2][2][4][2], const Unit& u, int wr, int wc, int fr, int fq) const {
        const int row0 = u.pm * BM + wr * 64 + fr, col0 = u.pn * BM + wc * 32 + 4 * fq;
#pragma unroll
        for (int ai = 0; ai < 2; ++ai) {
            f32x4 xv[4][2][2];
#pragma unroll
            for (int m = 0; m < 4; ++m) { const size_t off = (size_t)(row0 + ai * HALF + m * 16) * ldc + col0;
#pragma unroll
                for (int bj = 0; bj < 2; ++bj)
#pragma unroll
                    for (int n = 0; n < 2; ++n) xv[m][bj][n] = *(const f32x4*)(X + off + bj * HALF + n * 16); }
#pragma unroll
            for (int m = 0; m < 4; ++m) { const size_t off = (size_t)(row0 + ai * HALF + m * 16) * ldc + col0;
#pragma unroll
                for (int bj = 0; bj < 2; ++bj)
#pragma unroll
                    for (int n = 0; n < 2; ++n) *(f32x4*)(Y + off + bj * HALF + n * 16) = xv[m][bj][n] * alpha + acc[ai][bj][m][n]; }
            asm volatile("" ::: "memory"); }
    }
};

struct EpiSwiGLU {
    static constexpr bool PERM = true, AFTER_DRAIN = false;
    bf16_t* Hh; int ldh;
    __device__ __forceinline__ void operator()(const f32x4 (&acc)[2][2][4][2], const Unit& u, int wr, int wc, int fr, int fq) const {
        const int row0 = u.pm * BM + wr * 64 + fr, col0 = u.pn * HALF + wc * 32 + 8 * fq;
#pragma unroll
        for (int ai = 0; ai < 2; ++ai)
#pragma unroll
            for (int m = 0; m < 4; ++m) { bf16_t* rowp = Hh + (size_t)(row0 + ai * HALF + m * 16) * ldh + col0;
                float h[8];
#pragma unroll
                for (int n = 0; n < 2; ++n)
#pragma unroll
                    for (int i = 0; i < 4; ++i) { const float g = acc[ai][0][m][n][i], up = acc[ai][1][m][n][i];
                        const float e = __builtin_amdgcn_exp2f(-g * 1.44269504089f); h[n * 4 + i] = g * __builtin_amdgcn_rcpf(1.0f + e) * up; }
                u32x4 w; w.x = cvt_pk_bf16(h[0], h[1]); w.y = cvt_pk_bf16(h[2], h[3]); w.z = cvt_pk_bf16(h[4], h[5]); w.w = cvt_pk_bf16(h[6], h[7]);
                *(u32x4*)rowp = w; }
    }
};

struct EpiQKV0 {
    static constexpr bool PERM = true, AFTER_DRAIN = false;
    bf16_t* O; RopeTab rt;
    __device__ __forceinline__ void operator()(const f32x4 (&acc)[2][2][4][2], const Unit& u, int wr, int wc, int fr, int fq) const {
        const int sg = u.pn >> 3, cw = wc * 32 + 8 * fq, hd0 = (u.pn & 7) * 2; const bool rope = sg < 6;
        const int dsh = 2 * (sg % 3);
        const int row0 = u.pm * BM + wr * 64 + fr, f0 = 16 * wc + 4 * fq;
#pragma unroll
        for (int ai = 0; ai < 2; ++ai)
#pragma unroll
            for (int m = 0; m < 4; ++m) { const int row = row0 + ai * HALF + m * 16; const int bb = row >> 13, si = row & 8191;
                const size_t rl = (size_t)(si & ((1 << dsh) - 1)) * (8192 >> dsh) + (si >> dsh);
                f32x4 c = {1.f, 1.f, 1.f, 1.f}, s = {0.f, 0.f, 0.f, 0.f};
                if (rope) { c = *(const f32x4*)(rt.cs + (size_t)row * 64 + f0); s = *(const f32x4*)(rt.sn + (size_t)row * 64 + f0); }
#pragma unroll
                for (int bj = 0; bj < 2; ++bj) { f32x4 v0 = acc[ai][bj][m][0], v1 = acc[ai][bj][m][1];
                    rope_pair(v0, v1, c, s);
                    u32x4 w; w.x = cvt_pk_bf16(v0[0], v0[1]); w.y = cvt_pk_bf16(v0[2], v0[3]); w.z = cvt_pk_bf16(v1[0], v1[1]); w.w = cvt_pk_bf16(v1[2], v1[3]);
                    bf16_t* dst = O + ((size_t)((sg * 2 + bb) * 16 + hd0 + bj) * 8192 + rl) * 128 + cw;
                    *(u32x4*)dst = w; } }
    }
};

struct EpiQKV1 {
    static constexpr bool PERM = true, AFTER_DRAIN = false;
    bf16_t* Q; bf16_t* Kc; bf16_t* Vc; unsigned short* QI; float* KIR; float* WI; RopeTab rt;
    __device__ __forceinline__ void operator()(const f32x4 (&acc)[2][2][4][2], const Unit& u, int wr, int wc, int fr, int fq) const {
        const int pn = u.pn; const int row0 = u.pm * BM + wr * 64 + fr, f0 = 16 * wc + 4 * fq, cw = wc * 32 + 8 * fq;
        const bool rope = (pn < 20) || (pn >= 24 && pn < 40);
#pragma unroll
        for (int ai = 0; ai < 2; ++ai)
#pragma unroll
            for (int m = 0; m < 4; ++m) { const int row = row0 + ai * HALF + m * 16;
                f32x4 c = {1.f, 1.f, 1.f, 1.f}, s = {0.f, 0.f, 0.f, 0.f};
                if (rope) { c = *(const f32x4*)(rt.cs + (size_t)row * 64 + f0); s = *(const f32x4*)(rt.sn + (size_t)row * 64 + f0); }
#pragma unroll
                for (int bj = 0; bj < 2; ++bj) { f32x4 v0 = acc[ai][bj][m][0], v1 = acc[ai][bj][m][1];
                    if (pn < 40) {
                        rope_pair(v0, v1, c, s);
                        u32x4 w;
                        if (pn >= 24) { w.x = cvt_pk_f16(v0[0], v0[1]); w.y = cvt_pk_f16(v0[2], v0[3]); w.z = cvt_pk_f16(v1[0], v1[1]); w.w = cvt_pk_f16(v1[2], v1[3]); }
                        else { w.x = cvt_pk_bf16(v0[0], v0[1]); w.y = cvt_pk_bf16(v0[2], v0[3]); w.z = cvt_pk_bf16(v1[0], v1[1]); w.w = cvt_pk_bf16(v1[2], v1[3]); }
                        if (pn < 16) *(u32x4*)(Q + (size_t)row * 4096 + pn * BM + bj * HALF + cw) = w;
                        else if (pn < 24) { const int kvh = ((pn - 16) & 3) * 2 + bj; bf16_t* dst = (pn < 20 ? Kc : Vc) + ((size_t)((row >> 13) * 8 + kvh) * 8192 + (row & 8191)) * 128 + cw; *(u32x4*)dst = w; }
                        else *(u32x4*)(QI + (size_t)row * 4096 + (pn - 24) * BM + bj * HALF + cw) = w;
                    } else {
                        if (bj == 0) { *(f32x4*)(KIR + (size_t)row * 128 + cw) = v0; *(f32x4*)(KIR + (size_t)row * 128 + cw + 4) = v1; }
                        else if (wc == 0) { *(f32x4*)(WI + (size_t)row * 32 + cw) = v0 * 0.015625f; *(f32x4*)(WI + (size_t)row * 32 + cw + 4) = v1 * 0.015625f; }
                    } } }
    }
};

template <class Epi, class Sched, bool ALIGN_EPI = false, bool SP2 = false>
__device__ __forceinline__ void gemm_phase(PG8_LAS unsigned char* lds, const Gemm g, const Sched& S, const Epi& E) {
    const int tid = threadIdx.x, wid = __builtin_amdgcn_readfirstlane(tid >> 6), lane = tid & 63, wr = wid >> 2, wc = wid & 3, fr = lane & 15, fq = lane >> 4;
    const int K = g.K, nt = K / BK;
    unsigned voffA[2], voffB[2];
#pragma unroll
    for (int i = 0; i < 2; ++i) { int R, C; stage_rc(tid * 16 + i * 8192, R, C); const int Rb = Epi::PERM ? ((R & ~31) + perm32(R & 31)) : R;
        voffA[i] = (unsigned)(R * K + C) * 2u; voffB[i] = (unsigned)(Rb * K + C) * 2u; }
    const size_t kstep = (size_t)(BK * 2);
    const size_t hstep = (size_t)HALF * K * 2;
    const size_t tstep = 2 * hstep;
    const unsigned ldsw = (unsigned)wid * 1024u;
    const int aoff = lds_byte(wr * 64 + fr, fq * 8), boff = lds_byte(wc * 32 + fr, fq * 8);
#define PG8_SA(b, h) (((b) * 2 + (h)) * HTB)
#define PG8_SB(b, h) ((4 + (b) * 2 + (h)) * HTB)
#define PG8_STAGE(bufoff, gbase, voff) do { _Pragma("unroll") for (int _i = 0; _i < 2; ++_i) \
        __builtin_amdgcn_global_load_lds((const unsigned*)((const char*)(gbase) + (voff)[_i]), (PG8_LAS unsigned*)(lds + (bufoff) + ldsw + _i * 8192), 16, 0, 0); } while (0)
#define PG8_LDA(dst, b, h) do { _Pragma("unroll") for (int m = 0; m < 4; ++m) _Pragma("unroll") for (int k = 0; k < 2; ++k) dst[m][k] = *(const PG8_LAS bf16x8*)(lds + PG8_SA(b, h) + aoff + m * 2048 + k * 1024); } while (0)
#define PG8_LDB(dst, b, h) do { _Pragma("unroll") for (int n = 0; n < 2; ++n) _Pragma("unroll") for (int k = 0; k < 2; ++k) dst[n][k] = *(const PG8_LAS bf16x8*)(lds + PG8_SB(b, h) + boff + n * 2048 + k * 1024); } while (0)
#define PG8_MMA(ai, bj, At, Bt) do { __builtin_amdgcn_s_setprio(1); _Pragma("unroll") for (int m = 0; m < 4; ++m) _Pragma("unroll") for (int n = 0; n < 2; ++n) _Pragma("unroll") for (int k = 0; k < 2; ++k) \
        acc[ai][bj][m][n] = __builtin_amdgcn_mfma_f32_16x16x32_bf16(Bt[n][k], At[m][k], acc[ai][bj][m][n], 0, 0, 0); __builtin_amdgcn_s_setprio(0); } while (0)
#define PG8_WAIT_V(n) asm volatile("s_waitcnt vmcnt(" #n ")" ::: "memory")
#define PG8_WAIT_L(n) asm volatile("s_waitcnt lgkmcnt(" #n ")" ::: "memory")
#define PG8_BAR __builtin_amdgcn_s_barrier()
#define PG8_SCHED __builtin_amdgcn_sched_barrier(0)
    Unit cur, nxt; int ui = 0;
    if (!S.next(0, cur)) return;
    f32x4 acc[2][2][4][2];
#pragma unroll
    for (int a = 0; a < 2; ++a)
#pragma unroll
        for (int b = 0; b < 2; ++b)
#pragma unroll
            for (int m = 0; m < 4; ++m)
#pragma unroll
                for (int n = 0; n < 2; ++n) acc[a][b][m][n] = (f32x4){0.f, 0.f, 0.f, 0.f};
    bf16x8 At[4][2], B0[2][2], B1[2][2];
    const char* cA = (const char*)g.A + (size_t)cur.pm * tstep; const char* cB = (const char*)g.Bt + (size_t)cur.pn * tstep;
    S.a_ready(cur);
    if constexpr (SP2) {
        PG8_STAGE(PG8_SB(0, 0), cB, voffB); PG8_STAGE(PG8_SB(0, 1), cB + hstep, voffB); PG8_STAGE(PG8_SA(0, 0), cA, voffA); PG8_STAGE(PG8_SA(0, 1), cA + hstep, voffA);
        if (wr == 1) PG8_BAR;
        PG8_WAIT_V(2); PG8_BAR;
        PG8_STAGE(PG8_SB(1, 0), cB + kstep, voffB); PG8_STAGE(PG8_SA(1, 0), cA + kstep, voffA); PG8_STAGE(PG8_SB(1, 1), cB + hstep + kstep, voffB);
        PG8_WAIT_V(6); PG8_BAR;
    } else {
        PG8_STAGE(PG8_SB(0, 0), cB, voffB); PG8_STAGE(PG8_SA(0, 0), cA, voffA); PG8_STAGE(PG8_SB(0, 1), cB + hstep, voffB); PG8_STAGE(PG8_SA(0, 1), cA + hstep, voffA);
        if (wr == 1) PG8_BAR;
        PG8_WAIT_V(4); PG8_BAR;
        PG8_STAGE(PG8_SB(1, 0), cB + kstep, voffB); PG8_STAGE(PG8_SA(1, 0), cA + kstep, voffA); PG8_STAGE(PG8_SB(1, 1), cB + hstep + kstep, voffB);
        PG8_WAIT_V(6); PG8_BAR;
    }
    for (;;) {
        const bool has_next = S.next(ui + 1, nxt);
        const char* nA = has_next ? (const char*)g.A + (size_t)nxt.pm * tstep : cA; const char* nB = has_next ? (const char*)g.Bt + (size_t)nxt.pn * tstep : cB;
        for (int t = 0; t < nt; t += 2) {
            const bool last = (t == nt - 2);
            const char* a1 = cA + (size_t)(t + 1) * kstep;
            const char* a2 = last ? nA : cA + (size_t)(t + 2) * kstep; const char* b2 = last ? nB : cB + (size_t)(t + 2) * kstep;
            const char* a3 = a2 + kstep; const char* b3 = b2 + kstep;
            if (last && has_next) S.a_ready(nxt);
            if constexpr (SP2) {
            PG8_LDB(B0, 0, 0); PG8_LDB(B1, 0, 1); PG8_SCHED; PG8_LDA(At, 0, 0); PG8_STAGE(PG8_SA(1, 1), a1 + hstep, voffA);
            PG8_WAIT_V(8); PG8_WAIT_L(0); PG8_BAR; PG8_MMA(0, 0, At, B0); PG8_MMA(0, 1, At, B1); PG8_BAR; PG8_SCHED;
            PG8_LDA(At, 0, 1); PG8_STAGE(PG8_SB(0, 0), b2, voffB); PG8_STAGE(PG8_SB(0, 1), b2 + hstep, voffB); PG8_STAGE(PG8_SA(0, 0), a2, voffA);
            PG8_WAIT_V(8); PG8_WAIT_L(0); PG8_BAR; PG8_MMA(1, 0, At, B0); PG8_MMA(1, 1, At, B1); PG8_BAR; PG8_SCHED;
            PG8_LDB(B0, 1, 0); PG8_LDB(B1, 1, 1); PG8_SCHED; PG8_LDA(At, 1, 0); PG8_STAGE(PG8_SA(0, 1), a2 + hstep, voffA);
            PG8_WAIT_V(8); PG8_WAIT_L(0); PG8_BAR; PG8_MMA(0, 0, At, B0); PG8_MMA(0, 1, At, B1); PG8_BAR; PG8_SCHED;
            PG8_LDA(At, 1, 1); PG8_STAGE(PG8_SB(1, 0), b3, voffB); PG8_STAGE(PG8_SB(1, 1), b3 + hstep, voffB); PG8_STAGE(PG8_SA(1, 0), a3, voffA);
            PG8_WAIT_V(8); PG8_WAIT_L(0); PG8_BAR; PG8_MMA(1, 0, At, B0); PG8_MMA(1, 1, At, B1); PG8_BAR; PG8_SCHED;
            } else {
            PG8_LDB(B0, 0, 0); PG8_SCHED; PG8_LDA(At, 0, 0); PG8_STAGE(PG8_SA(1, 1), a1 + hstep, voffA);
            PG8_WAIT_L(8); PG8_BAR; PG8_WAIT_L(0); PG8_MMA(0, 0, At, B0); PG8_BAR; PG8_SCHED;
            PG8_LDB(B1, 0, 1); PG8_STAGE(PG8_SB(0, 0), b2, voffB);
            PG8_BAR; PG8_WAIT_L(0); PG8_MMA(0, 1, At, B1); PG8_BAR;
            PG8_LDA(At, 0, 1); PG8_STAGE(PG8_SA(0, 0), a2, voffA);
            PG8_BAR; PG8_WAIT_L(0); PG8_MMA(1, 0, At, B0); PG8_BAR; PG8_SCHED;
            PG8_STAGE(PG8_SB(0, 1), b2 + hstep, voffB);
            PG8_WAIT_V(6); PG8_BAR; PG8_MMA(1, 1, At, B1); PG8_BAR;
            PG8_LDB(B0, 1, 0); PG8_SCHED; PG8_LDA(At, 1, 0); PG8_STAGE(PG8_SA(0, 1), a2 + hstep, voffA);
            PG8_WAIT_L(8); PG8_BAR; PG8_WAIT_L(0); PG8_MMA(0, 0, At, B0); PG8_BAR; PG8_SCHED;
            PG8_LDB(B1, 1, 1); PG8_STAGE(PG8_SB(1, 0), b3, voffB);
            PG8_BAR; PG8_WAIT_L(0); PG8_MMA(0, 1, At, B1); PG8_BAR;
            PG8_LDA(At, 1, 1); PG8_STAGE(PG8_SA(1, 0), a3, voffA);
            PG8_BAR; PG8_WAIT_L(0); PG8_MMA(1, 0, At, B0); PG8_BAR; PG8_SCHED;
            PG8_STAGE(PG8_SB(1, 1), b3 + hstep, voffB);
            PG8_WAIT_V(6); PG8_BAR; PG8_MMA(1, 1, At, B1); PG8_BAR;
            }
        }
        if constexpr (ALIGN_EPI) { if (wr == 0) PG8_BAR; }
        if constexpr (!Epi::AFTER_DRAIN) { E(acc, cur, wr, wc, fr, fq); S.done(cur); }
        if (!has_next) break;
#pragma unroll
        for (int a = 0; a < 2; ++a)
#pragma unroll
            for (int b = 0; b < 2; ++b)
#pragma unroll
                for (int m = 0; m < 4; ++m)
#pragma unroll
                    for (int n = 0; n < 2; ++n) acc[a][b][m][n] = (f32x4){0.f, 0.f, 0.f, 0.f};
        cur = nxt; cA = nA; cB = nB; ++ui;
        if constexpr (ALIGN_EPI) { if (wr == 1) PG8_BAR; }
    }
    PG8_WAIT_V(0);
    if constexpr (!ALIGN_EPI) { if (wr == 0) PG8_BAR; }
    PG8_BAR;
    if constexpr (Epi::AFTER_DRAIN) { E.fused(acc, cur, wr, wc, fr, fq, lds, wid, lane); S.done(cur); }
#undef PG8_SA
#undef PG8_SB
#undef PG8_STAGE
#undef PG8_LDA
#undef PG8_LDB
#undef PG8_MMA
#undef PG8_WAIT_V
#undef PG8_WAIT_L
#undef PG8_BAR
#undef PG8_SCHED
}
}
#define XB_TMO      128
#define XB_XCNT(j)  (256  + 64 * (j))
#define XB_XSUB(j)  (1280 + 64 * (j))
#define XB_XGEN(j)  (2304 + 64 * (j))
#define XB_TOP      3328
#define XB_TOPGEN   3392
#define XCD_BAR_WORDS 3456
#define XB_SPIN_CAP (1u << 18)
#define LAS __attribute__((address_space(3)))

__device__ __forceinline__ unsigned xb_ld(unsigned* p)              { return __hip_atomic_load(p, __ATOMIC_RELAXED, __HIP_MEMORY_SCOPE_AGENT); }
__device__ __forceinline__ unsigned xb_add(unsigned* p, unsigned v) { return __hip_atomic_fetch_add(p, v, __ATOMIC_RELAXED, __HIP_MEMORY_SCOPE_AGENT); }
__device__ __forceinline__ unsigned xb_xcc_id() { return (unsigned)__builtin_amdgcn_s_getreg((3 << 11) | 20) & 0xFu; }
#define XB_SPIN(cond, bar) do { unsigned _sp = 0; while (cond) { __builtin_amdgcn_s_sleep(1); \
    if ((++_sp & 255u) == 0u) { if (xb_ld(&(bar)[XB_TMO])) break; if (_sp > XB_SPIN_CAP) { atomicAdd(&(bar)[XB_TMO], 1u); break; } } } } while (0)

struct XcdBarrier {
    unsigned* bar; unsigned x;
    volatile LAS unsigned* st;
};

__device__ __forceinline__ XcdBarrier xcd_barrier_post(unsigned* bar, volatile LAS unsigned* st) {
    XcdBarrier b; b.bar = bar; b.x = xb_xcc_id(); b.st = st;
    if (threadIdx.x == 0) (void)xb_add(&bar[XB_XCNT(b.x)], 1u);
    return b;
}
__device__ __forceinline__ void xcd_barrier_complete(unsigned* bar, unsigned x, unsigned& nloc, unsigned& nx) {
    const unsigned G = gridDim.x * gridDim.y * gridDim.z;
    unsigned sum, cnt, mine, sp = 0u;
    for (;;) {
        sum = 0u; cnt = 0u; mine = 0u;
#pragma unroll
        for (unsigned j = 0; j < 16; ++j) { const unsigned c = xb_ld(&bar[XB_XCNT(j)]); sum += c; cnt += (c > 0u) ? 1u : 0u; mine = (j == x) ? c : mine; }
        if (sum == G) break;
        __builtin_amdgcn_s_sleep(1);
        if ((++sp & 255u) == 0u) { if (xb_ld(&bar[XB_TMO])) break; if (sp > XB_SPIN_CAP) { atomicAdd(&bar[XB_TMO], 1u); break; } }
    }
    nloc = mine > 0u ? mine : 1u; nx = cnt > 0u ? cnt : 1u;
}

__device__ __forceinline__ void xcd_barrier(const XcdBarrier& b) {
    asm volatile("s_waitcnt vmcnt(0)" ::: "memory");
    __syncthreads();
    if (threadIdx.x == 0) {
        unsigned* bar = b.bar;
        __builtin_amdgcn_s_waitcnt(0);
        unsigned nloc = b.st[0], nx = b.st[1];
        if (nloc == 0u) { xcd_barrier_complete(bar, b.x, nloc, nx); b.st[0] = nloc; b.st[1] = nx; }
        const unsigned old = xb_add(&bar[XB_XSUB(b.x)], 1u);
        const unsigned gen = old / nloc;
        if (old + 1u == (gen + 1u) * nloc) {
            __builtin_amdgcn_fence(__ATOMIC_RELEASE, "agent");
            asm volatile("s_waitcnt vmcnt(0)" ::: "memory");
            const unsigned og = xb_add(&bar[XB_TOP], 1u);
            const unsigned tg = og / nx;
            if (og + 1u == (tg + 1u) * nx) xb_add(&bar[XB_TOPGEN], 1u);
            else XB_SPIN(xb_ld(&bar[XB_TOPGEN]) == tg, bar);
            __builtin_amdgcn_fence(__ATOMIC_ACQUIRE, "agent");
            xb_add(&bar[XB_XGEN(b.x)], 1u);
            asm volatile("s_waitcnt vmcnt(0)" ::: "memory");
        } else {
            XB_SPIN(xb_ld(&bar[XB_XGEN(b.x)]) == gen, bar);
            __builtin_amdgcn_fence(__ATOMIC_ACQUIRE, "agent");
            asm volatile("s_waitcnt vmcnt(0)" ::: "memory");
        }
    }
    __syncthreads();
}


using pg8::bf16_t; using pg8::bf16x8; using pg8::f32x4; using pg8::u32x4;
typedef _Float16 f16x8 __attribute__((ext_vector_type(8)));
typedef float f32x16 __attribute__((ext_vector_type(16)));
typedef unsigned u32x2 __attribute__((ext_vector_type(2)));
#define DI __device__ __forceinline__

constexpr int NWAVES = 8, NTHR = 512;
constexpr int SEQ = 8192, MTOK = 16384, DM = 4096, DFF = 11008;
constexpr int N_A = 18432, N_B = 10400, N_BP = 10496;
constexpr float LN_EPS = 1e-5f;
constexpr float ALPHA = 1.41421356237309515f;
constexpr float SM_C = 0.08838834764831845f * 1.4426950408889634f;
constexpr float SM_SCALE = 0.08838834764831845f;

constexpr size_t MiB = (size_t)1 << 20;
constexpr size_t WS_CTL = 0, CTL_ZERO_BYTES = 1 * MiB;
constexpr size_t WS_COS = 1 * MiB, WS_SIN = 5 * MiB;
constexpr size_t WS_W = 9 * MiB;
constexpr size_t W0IN = WS_W, W0OUT = WS_W + 144 * MiB, W0GU = WS_W + 160 * MiB, W0DN = WS_W + 332 * MiB;
constexpr size_t W1IN = WS_W, W1OUT = WS_W + 82 * MiB, W1GU = WS_W + 114 * MiB, W1DN = WS_W + 286 * MiB;
constexpr size_t WS_XB = 427 * MiB, WS_XA = 555 * MiB, WS_BIG = 811 * MiB, WS_END = (811 + 835) * MiB;
constexpr size_t B_QKV0 = WS_BIG, B_OG = WS_BIG + 576 * MiB, B_LSE = WS_BIG + 768 * MiB, B_AO0 = WS_BIG + 771 * MiB;
constexpr size_t B_Y = WS_BIG + 360 * MiB, B_H = WS_BIG;
constexpr size_t B_Q1 = WS_BIG, B_K1 = WS_BIG + 128 * MiB, B_V1 = WS_BIG + 160 * MiB, B_QI = WS_BIG + 192 * MiB, B_KIR = WS_BIG + 320 * MiB, B_KI16 = WS_BIG + 328 * MiB,
                 B_WI = WS_BIG + 332 * MiB, B_SC = WS_BIG + 334 * MiB, B_IDX = WS_BIG + 594 * MiB, B_AO1 = WS_BIG + 640 * MiB;
constexpr int LDS_BYTES = 147456, MISC_OFF = 147456 - 64;

DI float wave_sum(float v) { v += __shfl_xor(v, 1); v += __shfl_xor(v, 2); v += __shfl_xor(v, 4); v += __shfl_xor(v, 8); v += __shfl_xor(v, 16); v += __shfl_xor(v, 32); return v; }
DI int sigma_inv(int d) { return 32 * ((d >> 4) & 3) + 8 * ((d >> 2) & 3) + 4 * (d >> 6) + (d & 3); }

struct MapId { DI long operator()(int c) const { return c; } };
struct MapA  { DI long operator()(int c) const { const int d = c & 127; return (c < 2 * 6144) ? (long)(c - d + sigma_inv(d)) : (long)c; } };
struct MapB  { DI long operator()(int c) const { const int d = c & 127; const bool rp = (c < 5120) || (c >= 6144 && c < 10240); return rp ? (long)(c - d + sigma_inv(d)) : (long)c; } };
struct MapGU { int up; DI long operator()(int c) const { return (long)((c >> 7) * 256 + up * 128 + (c & 127)); } };

DI void wt_load(const float* __restrict__ W, int N, int nct, int item, f32x4 (&v)[8], int tid) {
    const int kt = item / nct, ct = item - kt * nct; const int k0 = kt * 64, c0 = ct * 256; const int cq = tid & 63, kr0 = tid >> 6; const bool cok = (c0 + 4 * cq) < N;
#pragma unroll
    for (int i = 0; i < 8; ++i) v[i] = cok ? *(const f32x4*)(W + (size_t)(k0 + kr0 + 8 * i) * N + c0 + 4 * cq) : (f32x4){0.f, 0.f, 0.f, 0.f};
}
template <class Map>
DI void wt_store(int K, int N, int nct, bf16_t* __restrict__ WT, int item, const Map map, const f32x4 (&v)[8], LAS float* scr, int tid) {
    const int kt = item / nct, ct = item - kt * nct; const int k0 = kt * 64, c0 = ct * 256; const int cq = tid & 63, kr0 = tid >> 6;
    __syncthreads();
#pragma unroll
    for (int i = 0; i < 8; ++i) *(LAS f32x4*)(scr + (kr0 + 8 * i) * 260 + 4 * cq) = v[i];
    __syncthreads();
    const int c = tid >> 1, kc = tid & 1;
    if (c0 + c < N) {
        bf16_t* dst = WT + (size_t)map(c0 + c) * K + k0 + 32 * kc;
#pragma unroll
        for (int q = 0; q < 4; ++q) { float f[8];
#pragma unroll
            for (int j = 0; j < 8; ++j) f[j] = scr[(32 * kc + 8 * q + j) * 260 + c];
            u32x4 o; o.x = pg8::cvt_pk_bf16(f[0], f[1]); o.y = pg8::cvt_pk_bf16(f[2], f[3]); o.z = pg8::cvt_pk_bf16(f[4], f[5]); o.w = pg8::cvt_pk_bf16(f[6], f[7]);
            *(u32x4*)(dst + 8 * q) = o; }
    }
}
template <class Map>
DI void wt_matrix(const float* W, int K, int N, bf16_t* WT, const Map map, LAS float* scr, int tid, int bid, int G) {
    const int nct = (N + 255) >> 8, nitems = (K >> 6) * nct;
    f32x4 va[8], vb[8];
    int it = bid;
    if (it < nitems) wt_load(W, N, nct, it, va, tid);
    for (; it < nitems; it += 2 * G) {
        if (it + G < nitems) wt_load(W, N, nct, it + G, vb, tid);
        wt_store(K, N, nct, WT, it, map, va, scr, tid);
        if (it + G >= nitems) break;
        if (it + 2 * G < nitems) wt_load(W, N, nct, it + 2 * G, va, tid);
        wt_store(K, N, nct, WT, it + G, map, vb, scr, tid);
    }
}

DI void rope_sincos(int pos, int f, float& cs, float& sn) {
    const double r1 = 0.8659643233600653; double inv = 1.0, rp = r1;
#pragma unroll
    for (int b = 0; b < 6; ++b) { if ((f >> b) & 1) inv *= rp; rp *= rp; }
    const double ang = (double)pos * inv;
    const double q = __builtin_rint(ang * 0.63661977236758134308);
    double r = __builtin_fma(-q, 1.57079632679489655800e+00, ang); r = __builtin_fma(-q, 6.12323399573676603587e-17, r);
    const double z = r * r;
    const double ps = r + r * z * (-1.66666666666666324348e-01 + z * (8.33333333332248946124e-03 + z * (-1.98412698298579493134e-04 + z * (2.75573137070700676789e-06 + z * (-2.50507602534068634195e-08 + z * 1.58969099521155010221e-10)))));
    const double pc = 1.0 - 0.5 * z + z * z * (4.16666666666666019037e-02 + z * (-1.38888888888741095749e-03 + z * (2.48015872894767294178e-05 + z * (-2.75573143513906633035e-07 + z * (2.08757232129817482790e-09 + z * -1.13596475577881948265e-11)))));
    const int qi = ((int)(long long)q) & 3;
    const double s = (qi == 0) ? ps : (qi == 1) ? pc : (qi == 2) ? -ps : -pc;
    const double c = (qi == 0) ? pc : (qi == 1) ? -ps : (qi == 2) ? -pc : ps;
    cs = (float)c; sn = (float)s;
}

DI void cvt_x_phase(const float* X, bf16_t* XB, int tid, int bid, int G) {
    const size_t n8 = (size_t)MTOK * DM / 8;
    for (size_t i = (size_t)bid * NTHR + tid; i < n8; i += (size_t)G * NTHR) {
        const f32x4 a = *(const f32x4*)(X + i * 8), b = *(const f32x4*)(X + i * 8 + 4);
        u32x4 o; o.x = pg8::cvt_pk_bf16(a[0], a[1]); o.y = pg8::cvt_pk_bf16(a[2], a[3]); o.z = pg8::cvt_pk_bf16(b[0], b[1]); o.w = pg8::cvt_pk_bf16(b[2], b[3]);
        *(u32x4*)(XB + i * 8) = o; }
}
DI void rope_tab_phase(const int* pos, float* CS, float* SN, int tid, int bid, int G) {
    for (int e = bid * NTHR + tid; e < MTOK * 64; e += G * NTHR) { float c, s; rope_sincos(pos[e >> 6], e & 63, c, s); CS[e] = c; SN[e] = s; }
}

DI void ln_phase(const float* Y, const float* gain, const float* bias, float* Xo, bf16_t* XBo, int tid, int bid, int G) {
    const int lane = tid & 63, gw = bid * NWAVES + (tid >> 6), nw = G * NWAVES;
    for (int row = gw; row < MTOK; row += nw) {
        const float* yr = Y + (size_t)row * DM; f32x4 v[16]; float s = 0.f;
#pragma unroll
        for (int j = 0; j < 16; ++j) { v[j] = *(const f32x4*)(yr + (j * 64 + lane) * 4); s += (v[j][0] + v[j][1]) + (v[j][2] + v[j][3]); }
        const float mean = wave_sum(s) * (1.0f / DM); float q = 0.f;
#pragma unroll
        for (int j = 0; j < 16; ++j) { v[j] = v[j] - mean; q += (v[j][0] * v[j][0] + v[j][1] * v[j][1]) + (v[j][2] * v[j][2] + v[j][3] * v[j][3]); }
        const float rstd = 1.0f / sqrtf(wave_sum(q) * (1.0f / DM) + LN_EPS);
#pragma unroll
        for (int j = 0; j < 16; ++j) { const int c = (j * 64 + lane) * 4; const f32x4 g = *(const f32x4*)(gain + c), b = *(const f32x4*)(bias + c); const f32x4 o = v[j] * rstd * g + b;
            *(f32x4*)(Xo + (size_t)row * DM + c) = o;
            if (XBo) { u32x2 w; w.x = pg8::cvt_pk_bf16(o[0], o[1]); w.y = pg8::cvt_pk_bf16(o[2], o[3]); *(u32x2*)(XBo + (size_t)row * DM + c) = w; } }
    }
}

DI bf16x8 ldg_bf16x8(const bf16_t* p) { return *(const bf16x8*)p; }
typedef short s16x4 __attribute__((ext_vector_type(4)));
struct A0Unit { int h, b, grp, d, r, nb; };
DI A0Unit a0_decode(int u) { A0Unit x; x.h = u & 15; const int blk = (u >> 4) & 63; x.b = (u >> 10) & 1; x.grp = u >> 11; const int dsh = 2 * x.grp; x.d = 1 << dsh; x.r = blk >> (6 - dsh); x.nb = blk & ((64 >> dsh) - 1); return x; }
DI size_t a0_sub(int sq, const A0Unit& x) { return ((size_t)(((sq * 3 + x.grp) * 2 + x.b) * 16 + x.h) * 8192 + (size_t)x.r * (8192 >> (2 * x.grp))) * 128; }
DI void a0_load_kv(const bf16_t* QKV, const A0Unit& x, u32x4 (&kpre)[8], u32x4 (&vpre)[8], int tid) {
    const bf16_t* Kg = QKV + a0_sub(1, x) + (tid & 15) * 8; const bf16_t* Vg = QKV + a0_sub(2, x) + (tid & 15) * 8;
#pragma unroll
    for (int i = 0; i < 8; ++i) { const int l = (x.nb - 1) * 128 + (tid >> 4) + 32 * i;
        kpre[i] = (l >= 0) ? *(const u32x4*)(Kg + (ptrdiff_t)l * 128) : (u32x4){0u, 0u, 0u, 0u};
        vpre[i] = (l >= 0) ? *(const u32x4*)(Vg + (ptrdiff_t)l * 128) : (u32x4){0u, 0u, 0u, 0u}; }
}
DI void a0_load_q(const bf16_t* QKV, const A0Unit& x, bf16x8 (&qf)[4], int w, int n, int g4) {
    const bf16_t* qp = QKV + a0_sub(0, x) + (size_t)(x.nb * 128 + 16 * w + n) * 128 + 8 * g4;
#pragma unroll
    for (int ks = 0; ks < 4; ++ks) qf[ks] = ldg_bf16x8(qp + 32 * ks);
}
DI void attn0_phase(const bf16_t* QKV, bf16_t* OG, float* LSE, LAS unsigned char* lds, int tid, int bid, int G) {
    const int lane = tid & 63, w = __builtin_amdgcn_readfirstlane(tid >> 6), n = lane & 15, g4 = lane >> 4, q4 = n >> 2, p4 = n & 3;
    LAS unsigned char* kimg = lds; LAS unsigned char* vt = lds + 65536;
    const size_t GS = (size_t)MTOK * 2048;
    const int tr_base = (4 * g4 + q4) * 256 + 8 * (p4 & 1);
    const int skey = tid >> 4, sch = tid & 15;
    LAS unsigned char* kwr = kimg + skey * 256 + ((sch ^ (skey & 15)) * 16); LAS unsigned char* vwr = vt + skey * 256 + ((sch ^ (2 * (skey & 3))) * 16);
    LAS unsigned char* krb[4];
#pragma unroll
    for (int j = 0; j < 4; ++j) krb[j] = kimg + (16 * w + n) * 256 + (((4 * j + g4) ^ n) * 16);
    u32x4 kpre[8], vpre[8]; bf16x8 qf[4];
    int u = bid;
    if (u < 6144) { const A0Unit x = a0_decode(u); a0_load_kv(QKV, x, kpre, vpre, tid); a0_load_q(QKV, x, qf, w, n, g4); }
    for (; u < 6144; u += G) {
        const A0Unit x = a0_decode(u);
        const int h = x.h, d = x.d, nb = x.nb, grp = x.grp;
        const size_t tok0 = (size_t)x.b * SEQ + x.r;
        const int iq = 16 * w + n, lq = nb * 128 + iq;
        const size_t qtok = tok0 + (size_t)lq * d;
        __syncthreads();
#pragma unroll
        for (int i = 0; i < 8; ++i) { *(LAS u32x4*)(kwr + i * 8192) = kpre[i]; *(LAS u32x4*)(vwr + i * 8192) = vpre[i]; }
        __syncthreads();
        if (u + G < 6144) { const A0Unit xn = a0_decode(u + G); a0_load_kv(QKV, xn, kpre, vpre, tid); }
        f32x4 s[9];
#pragma unroll
        for (int tt = 0; tt < 9; ++tt) { f32x4 a = {0.f, 0.f, 0.f, 0.f};
#pragma unroll
            for (int ks = 0; ks < 4; ++ks) a = __builtin_amdgcn_mfma_f32_16x16x32_bf16(*(const LAS bf16x8*)(krb[ks] + tt * 4096), qf[ks], a, 0, 0, 0);
            s[tt] = a; }
        if (u + G < 6144) { const A0Unit xn = a0_decode(u + G); a0_load_q(QKV, xn, qf, w, n, g4); }
        float mx = -__builtin_inff();
#pragma unroll
        for (int tt = 0; tt < 9; ++tt)
#pragma unroll
            for (int j = 0; j < 4; ++j) { const int kf = 16 * (w + tt) + 4 * g4 + j; const bool ok = (kf >= iq) && (kf <= iq + 128) && (nb > 0 || kf >= 128);
                const float xx = ok ? s[tt][j] : -__builtin_inff(); s[tt][j] = xx; mx = fmaxf(mx, xx); }
        mx = fmaxf(mx, __shfl_xor(mx, 16)); mx = fmaxf(mx, __shfl_xor(mx, 32));
        const float msc = mx * SM_C; float lsum = 0.f;
#pragma unroll
        for (int tt = 0; tt < 9; ++tt)
#pragma unroll
            for (int j = 0; j < 4; ++j) { const float p = __builtin_amdgcn_exp2f(s[tt][j] * SM_C - msc); s[tt][j] = p; lsum += p; }
        lsum += __shfl_xor(lsum, 16); lsum += __shfl_xor(lsum, 32);
        f32x4 o[8];
#pragma unroll
        for (int dt = 0; dt < 8; ++dt) o[dt] = (f32x4){0.f, 0.f, 0.f, 0.f};
#pragma unroll
        for (int kk = 0; kk < 5; ++kk) {
            const int t0 = 2 * kk, t1 = 2 * kk + 1;
            u32x4 pw; pw.x = pg8::cvt_pk_bf16(s[t0][0], s[t0][1]); pw.y = pg8::cvt_pk_bf16(s[t0][2], s[t0][3]);
            if (t1 < 9) { pw.z = pg8::cvt_pk_bf16(s[t1 < 9 ? t1 : 8][0], s[t1 < 9 ? t1 : 8][1]); pw.w = pg8::cvt_pk_bf16(s[t1 < 9 ? t1 : 8][2], s[t1 < 9 ? t1 : 8][3]); } else { pw.z = 0u; pw.w = 0u; }
            const bf16x8 pf = __builtin_bit_cast(bf16x8, pw);
            int T1 = w + t1; T1 = T1 > 15 ? 15 : T1;
            const int row0 = 16 * (w + t0) * 256, row1 = 16 * T1 * 256;
#pragma unroll
            for (int dt = 0; dt < 8; ++dt) {
                const int choff = ((2 * dt + (p4 >> 1)) ^ (2 * q4)) * 16;
                const s16x4 lo = __builtin_amdgcn_ds_read_tr16_b64_v4i16((LAS s16x4*)(vt + tr_base + row0 + choff));
                const s16x4 hi = __builtin_amdgcn_ds_read_tr16_b64_v4i16((LAS s16x4*)(vt + tr_base + row1 + choff));
                const bf16x8 vf = __builtin_shufflevector(lo, hi, 0, 1, 2, 3, 4, 5, 6, 7);
                o[dt] = __builtin_amdgcn_mfma_f32_16x16x32_bf16(vf, pf, o[dt], 0, 0, 0); }
        }
        const float inv = 1.0f / lsum;
        bf16_t* op = OG + (size_t)grp * GS + qtok * 2048 + h * 128 + 4 * g4;
#pragma unroll
        for (int dt = 0; dt < 8; ++dt) { u32x2 wv; wv.x = pg8::cvt_pk_bf16(o[dt][0] * inv, o[dt][1] * inv); wv.y = pg8::cvt_pk_bf16(o[dt][2] * inv, o[dt][3] * inv); *(u32x2*)(op + 16 * dt) = wv; }
        if (g4 == 0) LSE[(size_t)grp * (MTOK * 16) + qtok * 16 + h] = mx * SM_SCALE + __logf(lsum);
    }
}

DI void merge_phase(const bf16_t* OG, const float* LSE, bf16_t* AO, int tid, int bid, int G) {
    const int lane = tid & 63, gw = bid * NWAVES + (tid >> 6), nw = G * NWAVES; const size_t GS = (size_t)MTOK * 2048;
    for (int tok = gw; tok < MTOK; tok += nw) {
#pragma unroll
        for (int it = 0; it < 4; ++it) { const int e = it * 512 + lane * 8, h = e >> 7;
            const float l0 = LSE[(size_t)tok * 16 + h], l1 = LSE[(size_t)(MTOK * 16) + (size_t)tok * 16 + h], l2 = LSE[(size_t)(2 * MTOK * 16) + (size_t)tok * 16 + h];
            const float mx = fmaxf(l0, fmaxf(l1, l2)); const float e0 = __expf(l0 - mx), e1 = __expf(l1 - mx), e2 = __expf(l2 - mx); const float inv = 1.0f / (e0 + e1 + e2);
            const float w0 = e0 * inv, w1 = e1 * inv, w2 = e2 * inv;
            const u32x4 a = *(const u32x4*)(OG + (size_t)tok * 2048 + e), b = *(const u32x4*)(OG + GS + (size_t)tok * 2048 + e), c = *(const u32x4*)(OG + 2 * GS + (size_t)tok * 2048 + e);
            u32x4 o;
#pragma unroll
            for (int k = 0; k < 4; ++k) { const float lo = w0 * __uint_as_float(a[k] << 16) + w1 * __uint_as_float(b[k] << 16) + w2 * __uint_as_float(c[k] << 16);
                const float hi = w0 * __uint_as_float(a[k] & 0xffff0000u) + w1 * __uint_as_float(b[k] & 0xffff0000u) + w2 * __uint_as_float(c[k] & 0xffff0000u);
                o[k] = pg8::cvt_pk_bf16(lo, hi); }
            *(u32x4*)(AO + (size_t)tok * 2048 + e) = o; }
    }
}

DI void kidx_phase(const float* KIR, const float* gain, const float* bias, const float* CS, const float* SN, unsigned short* KI16, int tid, int bid, int G) {
    const int lane = tid & 63, gw = bid * NWAVES + (tid >> 6), nw = G * NWAVES;
    const float g1 = gain[lane], g2 = gain[lane + 64], b1 = bias[lane], b2 = bias[lane + 64];
    const int j1 = sigma_inv(lane);
    for (int tok = gw; tok < MTOK; tok += nw) {
        const float x1 = KIR[(size_t)tok * 128 + lane], x2 = KIR[(size_t)tok * 128 + 64 + lane];
        const float mean = wave_sum(x1 + x2) * (1.0f / 128.0f); const float d1 = x1 - mean, d2 = x2 - mean;
        const float rstd = 1.0f / sqrtf(wave_sum(d1 * d1 + d2 * d2) * (1.0f / 128.0f) + LN_EPS);
        const float y1 = d1 * rstd * g1 + b1, y2 = d2 * rstd * g2 + b2;
        const float c = CS[(size_t)tok * 64 + lane], s = SN[(size_t)tok * 64 + lane];
        const _Float16 o1 = (_Float16)(y1 * c - y2 * s), o2 = (_Float16)(y2 * c + y1 * s);
        KI16[(size_t)tok * 128 + j1] = __builtin_bit_cast(unsigned short, o1); KI16[(size_t)tok * 128 + j1 + 4] = __builtin_bit_cast(unsigned short, o2);
    }
}

constexpr int KT_ROWB = 272, KT_BYTES = 64 * KT_ROWB;
DI size_t sc_row_off(int b, int s) { const int qb = s >> 7; return ((size_t)(b * 2080 + ((qb * (qb + 1)) >> 1))) * 16384 + (size_t)(s & 127) * ((qb + 1) * 128); }
DI float relu1(float x) { const int b = __builtin_bit_cast(int, x); return __builtin_bit_cast(float, b > 0 ? b : 0); }
DI void indexer_tile(const LAS unsigned char* buf, const f16x8 (&af)[2][8], const f32x4 (&wv)[2][4], float* sc0, float* sc1, int kt, int r32, int h2) {
    typedef float f32x2_t __attribute__((ext_vector_type(2)));
    f16x8 bfr[2][8];
#pragma unroll
    for (int sub = 0; sub < 2; ++sub)
#pragma unroll
        for (int ks = 0; ks < 8; ++ks) bfr[sub][ks] = *(const LAS f16x8*)(buf + (32 * sub + r32) * KT_ROWB + (16 * ks + 8 * h2) * 2);
    __builtin_amdgcn_sched_barrier(0);
#pragma unroll
    for (int sub = 0; sub < 2; ++sub) {
        f32x16 c0, c1;
#pragma unroll
        for (int i = 0; i < 16; ++i) { c0[i] = 0.f; c1[i] = 0.f; }
#pragma unroll
        for (int ks = 0; ks < 8; ++ks) { c0 = __builtin_amdgcn_mfma_f32_32x32x16_f16(af[0][ks], bfr[sub][ks], c0, 0, 0, 0); c1 = __builtin_amdgcn_mfma_f32_32x32x16_f16(af[1][ks], bfr[sub][ks], c1, 0, 0, 0); }
        f32x2_t a0 = {0.f, 0.f}, a1 = {0.f, 0.f};
#pragma unroll
        for (int q = 0; q < 4; ++q)
#pragma unroll
            for (int e = 0; e < 4; e += 2) {
                const f32x2_t r0 = {relu1(c0[4 * q + e]), relu1(c0[4 * q + e + 1])};
                const f32x2_t r1 = {relu1(c1[4 * q + e]), relu1(c1[4 * q + e + 1])};
                const f32x2_t w0 = {wv[0][q][e], wv[0][q][e + 1]}, w1 = {wv[1][q][e], wv[1][q][e + 1]};
                a0 = __builtin_elementwise_fma(r0, w0, a0); a1 = __builtin_elementwise_fma(r1, w1, a1); }
        float s0 = a0.x + a0.y, s1 = a1.x + a1.y;
        s0 += __shfl_xor(s0, 32); s1 += __shfl_xor(s1, 32);
        if (h2 == 0) { sc0[kt * 64 + 32 * sub + r32] = s0; sc1[kt * 64 + 32 * sub + r32] = s1; }
    }
}
DI void indexer_phase(const unsigned short* QI, const unsigned short* KI16, const float* WI, float* SC, LAS unsigned char* lds, int tid, int bid, int G) {
    const int lane = tid & 63, w = __builtin_amdgcn_readfirstlane(tid >> 6), r32 = lane & 31, h2 = lane >> 5;
    LAS unsigned char* buf0 = lds; LAS unsigned char* buf1 = lds + KT_BYTES;
    const int key0 = tid >> 4, ch = tid & 15;
    for (int v = bid; v < 256; v += G) {
        for (int it = 0; it < 4; ++it) {
            const int b = it >> 1, gi = (it & 1) ? (511 - v) : v; const int tb = 16 * gi;
            const int nt = ((tb + 15) >> 6) + 1;
            f16x8 af[2][8]; f32x4 wv[2][4];
#pragma unroll
            for (int tq = 0; tq < 2; ++tq) { const size_t tg = (size_t)b * SEQ + tb + 2 * w + tq;
#pragma unroll
                for (int ks = 0; ks < 8; ++ks) af[tq][ks] = *(const f16x8*)(QI + tg * 4096 + r32 * 128 + 16 * ks + 8 * h2);
#pragma unroll
                for (int q = 0; q < 4; ++q) wv[tq][q] = *(const f32x4*)(WI + tg * 32 + 8 * q + 4 * h2); }
            float* sc0 = SC + sc_row_off(b, tb + 2 * w); float* sc1 = SC + sc_row_off(b, tb + 2 * w + 1);
            const unsigned short* src = KI16 + (size_t)b * SEQ * 128 + (size_t)key0 * 128 + ch * 8;
            u32x4 a0, a1, b0 = {0u, 0u, 0u, 0u}, b1 = {0u, 0u, 0u, 0u};
            a0 = *(const u32x4*)src; a1 = *(const u32x4*)(src + 32 * 128);
            if (nt > 1) { b0 = *(const u32x4*)(src + 64 * 128); b1 = *(const u32x4*)(src + 96 * 128); }
            __syncthreads();
            *(LAS u32x4*)(buf0 + key0 * KT_ROWB + ch * 16) = a0; *(LAS u32x4*)(buf0 + (key0 + 32) * KT_ROWB + ch * 16) = a1;
            __syncthreads();
            for (int kt = 0; kt < nt; kt += 2) {
                if (kt + 2 < nt) { const unsigned short* p = src + (size_t)(kt + 2) * 64 * 128; a0 = *(const u32x4*)p; a1 = *(const u32x4*)(p + 32 * 128); }
                indexer_tile(buf0, af, wv, sc0, sc1, kt, r32, h2);
                if (kt + 1 < nt) { *(LAS u32x4*)(buf1 + key0 * KT_ROWB + ch * 16) = b0; *(LAS u32x4*)(buf1 + (key0 + 32) * KT_ROWB + ch * 16) = b1; }
                __syncthreads();
                if (kt + 1 >= nt) break;
                if (kt + 3 < nt) { const unsigned short* p = src + (size_t)(kt + 3) * 64 * 128; b0 = *(const u32x4*)p; b1 = *(const u32x4*)(p + 32 * 128); }
                indexer_tile(buf1, af, wv, sc0, sc1, kt + 1, r32, h2);
                if (kt + 2 < nt) { *(LAS u32x4*)(buf0 + key0 * KT_ROWB + ch * 16) = a0; *(LAS u32x4*)(buf0 + (key0 + 32) * KT_ROWB + ch * 16) = a1; }
                __syncthreads();
            }
        }
    }
}

DI unsigned mbcnt64(unsigned long long m) { return __builtin_amdgcn_mbcnt_hi((unsigned)(m >> 32), __builtin_amdgcn_mbcnt_lo((unsigned)m, 0u)); }
DI unsigned f2key(float f) { const unsigned u = __float_as_uint(f); return (u & 0x80000000u) ? ~u : (u | 0x80000000u); }
DI int wave_sum_i(int v) {
    v += __builtin_amdgcn_update_dpp(0, v, 0xB1, 0xF, 0xF, true);
    v += __builtin_amdgcn_update_dpp(0, v, 0x4E, 0xF, 0xF, true);
    v += __builtin_amdgcn_update_dpp(0, v, 0x141, 0xF, 0xF, true);
    v += __builtin_amdgcn_update_dpp(0, v, 0x140, 0xF, 0xF, true);
    return __builtin_amdgcn_readlane(v, 0) + __builtin_amdgcn_readlane(v, 16) + __builtin_amdgcn_readlane(v, 32) + __builtin_amdgcn_readlane(v, 48);
}
template <int NV>
DI void topk_row(const float* row, int s, LAS int* lst, int lane) {
    unsigned key[NV];
    { const unsigned long long ra = (unsigned long long)row; const unsigned rlo = __builtin_amdgcn_readfirstlane((unsigned)ra), rhi = __builtin_amdgcn_readfirstlane((unsigned)(ra >> 32));
      row = (const float*)(((unsigned long long)rhi << 32) | rlo); }
#pragma unroll
    for (int jo = 0; jo < NV / 16; ++jo) { const float* rb = row + jo * 1024;
#pragma unroll
        for (int ji = 0; ji < 16; ++ji) { const int j = jo * 16 + ji; const unsigned u = f2key(rb[ji * 64 + lane]); key[j] = (j * 64 + lane <= s) ? u : 0u; } }
    unsigned T = 0u;
#pragma unroll 1
    for (int bit = 31; bit >= 0; --bit) {
        const unsigned cand = T | (1u << bit); int c = 0;
#pragma unroll
        for (int j = 0; j < NV; ++j) asm volatile("v_cmp_le_u32 vcc, %2, %1\n\tv_addc_co_u32 %0, vcc, 0, %0, vcc" : "+v"(c) : "v"(key[j]), "s"(cand) : "vcc");
        if (wave_sum_i(c) >= 256) T = cand;
    }
    int bgt = 0;
#pragma unroll
    for (int j = 0; j < NV; ++j) { const bool sg = key[j] > T; const unsigned long long mg = __ballot(sg); if (sg) lst[bgt + (int)mbcnt64(mg)] = j * 64 + lane; bgt += __builtin_popcountll(mg); }
#pragma unroll
    for (int j = 0; j < NV; ++j) { const bool se = key[j] == T; const unsigned long long me = __ballot(se); const int pe = bgt + (int)mbcnt64(me); if (se && pe < 256) lst[pe] = j * 64 + lane; bgt += __builtin_popcountll(me); }
}
DI void topk_phase(const float* SC, unsigned short* IDX, LAS unsigned char* lds, int tid, int bid, int G) {
    const int lane = tid & 63, w = __builtin_amdgcn_readfirstlane(tid >> 6), gw = bid * NWAVES + w, nw = G * NWAVES;
    LAS int* lst = (LAS int*)(lds + w * 1024);
    for (int t = gw; t < MTOK; t += nw) {
        const int b = t >> 13, s = t & 8191; unsigned short* out = IDX + (size_t)t * 256;
        if (s < 256) {
#pragma unroll
            for (int i = 0; i < 4; ++i) { const int j = lane + 64 * i; out[j] = (unsigned short)((j <= s) ? j : 0); }
        } else {
            const float* row = SC + sc_row_off(b, s);
            if (s < 2048) topk_row<32>(row, s, lst, lane);
            else if (s < 4096) topk_row<64>(row, s, lst, lane);
            else if (s < 6144) topk_row<96>(row, s, lst, lane);
            else topk_row<128>(row, s, lst, lane);
#pragma unroll
            for (int i = 0; i < 4; ++i) out[lane + 64 * i] = (unsigned short)lst[lane + 64 * i];
        }
    }
}

typedef unsigned __attribute__((may_alias)) u32_alias_t;
constexpr int DSA_WB = 17408;
DI __amdgpu_buffer_rsrc_t kv_rsrc(const bf16_t* base) { return __builtin_amdgcn_make_buffer_rsrc((void*)base, 0, SEQ * 256, 0x00020000); }
DI __amdgpu_buffer_rsrc_t big_rsrc(const void* base, unsigned bytes) { return __builtin_amdgcn_make_buffer_rsrc((void*)base, 0, (int)bytes, 0x00020000); }
DI void dsa_attn_phase(const bf16_t* Q1, const bf16_t* K1, const bf16_t* V1, const unsigned short* IDX, bf16_t* AO, LAS unsigned char* lds, int tid, int bid, int G) {
    const int lane = tid & 63, w = __builtin_amdgcn_readfirstlane(tid >> 6), n = lane & 15, g4 = lane >> 4, q4 = n >> 2, p4 = n & 3;
    LAS unsigned char* vb = lds + w * DSA_WB; LAS unsigned short* il0 = (LAS unsigned short*)(vb + 16384); LAS unsigned short* il1 = il0 + 256;
    const bool xm = (G & 7) == 0;
    const int start = xm ? ((bid >> 3) * NWAVES + w) : (bid * NWAVES + w), step = xm ? ((G >> 3) * NWAVES) : (G * NWAVES), total = xm ? MTOK : MTOK * 8;
    const int tr_base = (4 * g4 + q4) * 256 + 8 * (p4 & 1);
    const int vvo = 16 * n;
    const __amdgpu_buffer_rsrc_t qr = big_rsrc(Q1, (unsigned)MTOK * 8192u), ir = big_rsrc(IDX, (unsigned)MTOK * 512u), orr = big_rsrc(AO, (unsigned)MTOK * 8192u);
    const int qlo = n * 256 + 16 * g4;
    const int olo = n * 256 + 8 * g4;
    LAS unsigned char* kwb[4]; LAS unsigned char* krb[4]; LAS unsigned char* trb[4];
#pragma unroll
    for (int j = 0; j < 4; ++j) { kwb[j] = vb + g4 * 256 + ((n ^ (4 * j + g4)) * 16);
                                  krb[j] = vb + n * 256 + (((4 * j + g4) ^ n) * 16);
                                  trb[j] = vb + tr_base + 32 * (j ^ q4) + 16 * (p4 >> 1); }
    LAS unsigned char* vwb = vb + g4 * 256 + ((n ^ (2 * g4)) * 16);
    int it = start;
    if (it >= total) return;
#define DSA_ITEM(itv, kvh_, t_) const int kvh_ = xm ? (bid & 7) : ((itv) & 7), t_ = xm ? (itv) : ((itv) >> 3)
    u32x4 vst[8], kst[16]; bf16x8 qf[4];
    {
        DSA_ITEM(it, kvh, t);
#pragma unroll
        for (int i = 0; i < 2; ++i) ((LAS u32_alias_t*)il0)[lane + 64 * i] = __builtin_amdgcn_raw_buffer_load_b32(ir, lane * 4 + 256 * i, t * 512, 0);
        const size_t slice = (size_t)((t >> 13) * 8 + kvh) * SEQ * 128;
        const __amdgpu_buffer_rsrc_t kr = kv_rsrc(K1 + slice), vr = kv_rsrc(V1 + slice);
#pragma unroll
        for (int ks = 0; ks < 4; ++ks) qf[ks] = (n < 4) ? __builtin_bit_cast(bf16x8, __builtin_amdgcn_raw_buffer_load_b128(qr, qlo + 64 * ks, t * 8192 + kvh * 1024, 0)) : (bf16x8){0, 0, 0, 0, 0, 0, 0, 0};
#pragma unroll
        for (int i = 0; i < 16; ++i) kst[i] = __builtin_amdgcn_raw_buffer_load_b128(kr, (int)il0[4 * i + g4] * 256 + vvo, 0, 0);
#pragma unroll
        for (int i = 0; i < 8; ++i) vst[i] = __builtin_amdgcn_raw_buffer_load_b128(vr, (int)il0[4 * i + g4] * 256 + vvo, 0, 0);
    }
    int par = 0;
    for (; it < total; it += step) {
        DSA_ITEM(it, kvh, t);
        LAS unsigned short* ilc = par ? il1 : il0; LAS unsigned short* iln = par ? il0 : il1;
        const bool has_next = (it + step) < total;
        DSA_ITEM(it + step, kvh2, t2);
        const int s = t & 8191; const int nvalid = s + 1 < 256 ? s + 1 : 256;
        const size_t slice = (size_t)((t >> 13) * 8 + kvh) * SEQ * 128;
        const __amdgpu_buffer_rsrc_t kr = kv_rsrc(K1 + slice), vr = kv_rsrc(V1 + slice);
        const size_t slice2 = (size_t)((t2 >> 13) * 8 + kvh2) * SEQ * 128;
        unsigned inext[2] = {0u, 0u};
        if (has_next) {
#pragma unroll
            for (int i = 0; i < 2; ++i) inext[i] = __builtin_amdgcn_raw_buffer_load_b32(ir, lane * 4 + 256 * i, t2 * 512, 0); }
        float mrun = -__builtin_inff(), lsum = 0.f;
        f32x4 o[8];
#pragma unroll
        for (int dt = 0; dt < 8; ++dt) o[dt] = (f32x4){0.f, 0.f, 0.f, 0.f};
#pragma unroll 1
        for (int c = 0; c < 4; ++c) {
#pragma unroll
            for (int i = 0; i < 16; ++i) *(LAS u32x4*)(kwb[i & 3] + i * 1024) = kst[i];
            if (c < 3) {
#pragma unroll
                for (int i = 0; i < 16; ++i) kst[i] = __builtin_amdgcn_raw_buffer_load_b128(kr, (int)ilc[(c + 1) * 64 + 4 * i + g4] * 256 + vvo, 0, 0);
            } else if (has_next) {
#pragma unroll
                for (int i = 0; i < 2; ++i) ((LAS u32_alias_t*)iln)[lane + 64 * i] = inext[i];
                const __amdgpu_buffer_rsrc_t kr2 = kv_rsrc(K1 + slice2);
#pragma unroll
                for (int i = 0; i < 16; ++i) kst[i] = __builtin_amdgcn_raw_buffer_load_b128(kr2, (int)iln[4 * i + g4] * 256 + vvo, 0, 0);
            }
            f32x4 sa[4];
#pragma unroll
            for (int tt = 0; tt < 4; ++tt) { f32x4 a = {0.f, 0.f, 0.f, 0.f};
#pragma unroll
                for (int ks = 0; ks < 4; ++ks) { const bf16x8 kf = *(const LAS bf16x8*)(krb[ks] + tt * 4096);
                    a = __builtin_amdgcn_mfma_f32_16x16x32_bf16(kf, qf[ks], a, 0, 0, 0); }
                sa[tt] = a; asm volatile("" ::: "memory"); }
            if (nvalid < 256) {
#pragma unroll
                for (int tt = 0; tt < 4; ++tt)
#pragma unroll
                    for (int j = 0; j < 4; ++j) { const int kk = 64 * c + 16 * tt + 4 * g4 + j; sa[tt][j] = (kk < nvalid) ? sa[tt][j] : -__builtin_inff(); }
            }
            float cm = fmaxf(fmaxf(fmaxf(sa[0][0], sa[0][1]), fmaxf(sa[0][2], sa[0][3])), fmaxf(fmaxf(sa[1][0], sa[1][1]), fmaxf(sa[1][2], sa[1][3])));
            cm = fmaxf(cm, fmaxf(fmaxf(fmaxf(sa[2][0], sa[2][1]), fmaxf(sa[2][2], sa[2][3])), fmaxf(fmaxf(sa[3][0], sa[3][1]), fmaxf(sa[3][2], sa[3][3]))));
            cm = fmaxf(cm, __shfl_xor(cm, 16)); cm = fmaxf(cm, __shfl_xor(cm, 32));
            const float mnew = fmaxf(mrun, cm); const float alpha = __builtin_amdgcn_exp2f((mrun - mnew) * SM_C); const float msc = mnew * SM_C; mrun = mnew;
            lsum *= alpha;
#pragma unroll
            for (int dt = 0; dt < 8; ++dt) o[dt] = o[dt] * alpha;
            unsigned pk[4][2];
#pragma unroll
            for (int tt = 0; tt < 4; ++tt) { float pp[4];
#pragma unroll
                for (int j = 0; j < 4; ++j) { pp[j] = __builtin_amdgcn_exp2f(sa[tt][j] * SM_C - msc); lsum += pp[j]; }
                pk[tt][0] = pg8::cvt_pk_bf16(pp[0], pp[1]); pk[tt][1] = pg8::cvt_pk_bf16(pp[2], pp[3]); }
            if (c == 3 && has_next) {
#pragma unroll
                for (int ks = 0; ks < 4; ++ks) qf[ks] = (n < 4) ? __builtin_bit_cast(bf16x8, __builtin_amdgcn_raw_buffer_load_b128(qr, qlo + 64 * ks, t2 * 8192 + kvh2 * 1024, 0)) : (bf16x8){0, 0, 0, 0, 0, 0, 0, 0};
            }
#pragma unroll
            for (int hf = 0; hf < 2; ++hf) {
#pragma unroll
                for (int i = 0; i < 8; ++i) *(LAS u32x4*)(vwb + i * 1024) = vst[i];
                if (hf == 0) {
#pragma unroll
                    for (int i = 0; i < 8; ++i) vst[i] = __builtin_amdgcn_raw_buffer_load_b128(vr, (int)ilc[c * 64 + 32 + 4 * i + g4] * 256 + vvo, 0, 0);
                } else if (c < 3) {
#pragma unroll
                    for (int i = 0; i < 8; ++i) vst[i] = __builtin_amdgcn_raw_buffer_load_b128(vr, (int)ilc[(c + 1) * 64 + 4 * i + g4] * 256 + vvo, 0, 0);
                } else if (has_next) {
                    const __amdgpu_buffer_rsrc_t vr2 = kv_rsrc(V1 + slice2);
#pragma unroll
                    for (int i = 0; i < 8; ++i) vst[i] = __builtin_amdgcn_raw_buffer_load_b128(vr2, (int)iln[4 * i + g4] * 256 + vvo, 0, 0);
                }
                u32x4 pw; pw.x = pk[2 * hf][0]; pw.y = pk[2 * hf][1]; pw.z = pk[2 * hf + 1][0]; pw.w = pk[2 * hf + 1][1];
                const bf16x8 pf = __builtin_bit_cast(bf16x8, pw);
#pragma unroll
                for (int dt = 0; dt < 8; ++dt) {
                    const s16x4 lo = __builtin_amdgcn_ds_read_tr16_b64_v4i16((LAS s16x4*)(trb[dt & 3] + 128 * (dt >> 2)));
                    const s16x4 hi = __builtin_amdgcn_ds_read_tr16_b64_v4i16((LAS s16x4*)(trb[dt & 3] + 128 * (dt >> 2) + 16 * 256));
                    const bf16x8 vf = __builtin_shufflevector(lo, hi, 0, 1, 2, 3, 4, 5, 6, 7);
                    o[dt] = __builtin_amdgcn_mfma_f32_16x16x32_bf16(vf, pf, o[dt], 0, 0, 0);
                    if (dt & 1) asm volatile("" ::: "memory");
                }
            }
        }
        lsum += __shfl_xor(lsum, 16); lsum += __shfl_xor(lsum, 32);
        if (n < 4) { const float li = 1.0f / lsum;
#pragma unroll
            for (int dt = 0; dt < 8; ++dt) { u32x2 wv; wv.x = pg8::cvt_pk_bf16(o[dt][0] * li, o[dt][1] * li); wv.y = pg8::cvt_pk_bf16(o[dt][2] * li, o[dt][3] * li);
                __builtin_amdgcn_raw_buffer_store_b64(wv, orr, olo + 32 * dt, t * 8192 + kvh * 1024, 0); } }
        par ^= 1;
    }
#undef DSA_ITEM
}

#ifndef MK_ONE_LAUNCH
#define MK_ONE_LAUNCH 1
#endif
constexpr int N_PHASES = 19;
#ifndef WGM_F
#define WGM_F 8
#endif
#ifndef WGM_Y
#define WGM_Y 2
#endif
struct Args { const float* in[22]; float* out; unsigned char* ws; int ph_lo, ph_hi; };

__global__ void __launch_bounds__(NTHR, 2) mk_fwd(Args args) {
    extern __shared__ __attribute__((aligned(16))) unsigned char lds_raw[];
    LAS unsigned char* lds = (LAS unsigned char*)lds_raw;
    const int tid = threadIdx.x, bid = blockIdx.x, G = gridDim.x;
    unsigned char* ws = args.ws;
    const __attribute__((address_space(4))) unsigned char* kargs = (const __attribute__((address_space(4))) unsigned char*)__builtin_amdgcn_kernarg_segment_ptr();
#define ARG_IN(i) (*(const float* const volatile __attribute__((address_space(4)))*)(kargs + 8 * (i)))
    volatile LAS unsigned* misc = (volatile LAS unsigned*)(lds + MISC_OFF);
    if (tid < 4) misc[tid] = 0u;
    __syncthreads();
    const int lo = args.ph_lo, hi = args.ph_hi;
    XcdBarrier bar; bar.bar = (unsigned*)(ws + WS_CTL); bar.x = 0; bar.st = nullptr;
    if (hi - lo > 1) bar = xcd_barrier_post((unsigned*)(ws + WS_CTL), misc);
#ifndef PH_MASK
#define PH_MASK 0x7ffff
#endif
#define IN(k) ((((PH_MASK) >> (k)) & 1) && lo <= (k) && (k) < hi)
#ifndef PROBE_PH
#define PROBE_PH -1
#endif
#ifndef PROBE_PH2
#define PROBE_PH2 -1
#endif
    unsigned long long pr_t0 = (PROBE_PH == 0) ? __builtin_amdgcn_s_memrealtime() : 0ull, pr_acc = 0ull;
#define SEAM(k) do { if (IN(k) && IN((k) + 1)) xcd_barrier(bar); \
        if (PROBE_PH >= 0 && bid == 0) { const unsigned long long now_ = __builtin_amdgcn_s_memrealtime(); if ((k) + 1 == PROBE_PH) pr_t0 = now_; if ((k) == (PROBE_PH2 >= 0 ? PROBE_PH2 : PROBE_PH)) pr_acc = now_ - pr_t0; } } while (0)
#ifndef DUP_MASK
#define DUP_MASK 0
#endif
#define REP(k) _Pragma("unroll 1") for (int rep_ = 0; rep_ < ((((DUP_MASK) >> (k)) & 1) ? 2 : 1); ++rep_)

    float* CS = (float*)(ws + WS_COS); float* SN = (float*)(ws + WS_SIN);
    bf16_t* XB = (bf16_t*)(ws + WS_XB); float* XA = (float*)(ws + WS_XA); float* Y = (float*)(ws + B_Y); bf16_t* Hh = (bf16_t*)(ws + B_H);
    float* OUT = args.out;
    const pg8::RopeTab rt{CS, SN};

    if (IN(0)) REP(0) {
        LAS float* scr = (LAS float*)lds;
        wt_matrix(ARG_IN(2), DM, N_A, (bf16_t*)(ws + W0IN), MapA{}, scr, tid, bid, G);
        wt_matrix(ARG_IN(3), 2048, DM, (bf16_t*)(ws + W0OUT), MapId{}, scr, tid, bid, G);
        wt_matrix(ARG_IN(10), DM, DFF, (bf16_t*)(ws + W0GU), MapGU{0}, scr, tid, bid, G);
        wt_matrix(ARG_IN(11), DM, DFF, (bf16_t*)(ws + W0GU), MapGU{1}, scr, tid, bid, G);
        wt_matrix(ARG_IN(12), DFF, DM, (bf16_t*)(ws + W0DN), MapId{}, scr, tid, bid, G);
        cvt_x_phase(ARG_IN(0), XB, tid, bid, G);
        rope_tab_phase((const int*)ARG_IN(1), CS, SN, tid, bid, G);
    }
    SEAM(0);
    if (IN(1)) REP(1) {
        pg8::Gemm g{XB, (const bf16_t*)(ws + W0IN), MTOK, N_A, DM}; pg8::StaticOrder S; S.init(MTOK, N_A, G, bid);
        pg8::EpiQKV0 E{(bf16_t*)(ws + B_QKV0), rt};
        pg8::gemm_phase<pg8::EpiQKV0, pg8::StaticOrder, true, true>(lds, g, S, E);
    }
    SEAM(1);
    if (IN(2)) REP(2) attn0_phase((const bf16_t*)(ws + B_QKV0), (bf16_t*)(ws + B_OG), (float*)(ws + B_LSE), lds, tid, bid, G);
    SEAM(2);
    if (IN(3)) REP(3) merge_phase((const bf16_t*)(ws + B_OG), (const float*)(ws + B_LSE), (bf16_t*)(ws + B_AO0), tid, bid, G);
    SEAM(3);
    if (IN(4)) REP(4) {
        pg8::Gemm g{(const bf16_t*)(ws + B_AO0), (const bf16_t*)(ws + W0OUT), MTOK, DM, 2048}; pg8::StaticOrder S; S.init(MTOK, DM, G, bid, WGM_Y);
        pg8::EpiY E{ARG_IN(0), Y, DM, ALPHA};
        pg8::gemm_phase<pg8::EpiY, pg8::StaticOrder, true, true>(lds, g, S, E);
    }
    SEAM(4);
    if (IN(5)) REP(5) ln_phase(Y, ARG_IN(8), ARG_IN(9), OUT, XB, tid, bid, G);
    SEAM(5);
    if (IN(6)) REP(6) {
        pg8::Gemm g{XB, (const bf16_t*)(ws + W0GU), MTOK, 2 * DFF, DM}; pg8::StaticOrder S; S.init(MTOK, 2 * DFF, G, bid, WGM_F);
        pg8::EpiSwiGLU E{Hh, DFF};
        pg8::gemm_phase<pg8::EpiSwiGLU, pg8::StaticOrder, true, true>(lds, g, S, E);
    }
    SEAM(6);
    if (IN(7)) REP(7) {
        pg8::Gemm g{Hh, (const bf16_t*)(ws + W0DN), MTOK, DM, DFF}; pg8::StaticOrder S; S.init(MTOK, DM, G, bid, WGM_Y);
        pg8::EpiY E{OUT, Y, DM, ALPHA};
        pg8::gemm_phase<pg8::EpiY, pg8::StaticOrder, true, true>(lds, g, S, E);
    }
    SEAM(7);
    if (IN(8)) REP(8) {
        ln_phase(Y, ARG_IN(13), ARG_IN(14), XA, XB, tid, bid, G);
        LAS float* scr = (LAS float*)lds;
        wt_matrix(ARG_IN(4), DM, N_B, (bf16_t*)(ws + W1IN), MapB{}, scr, tid, bid, G);
        { u32x4* z = (u32x4*)(ws + W1IN + (size_t)N_B * DM * 2); const int nz = (N_BP - N_B) * DM * 2 / 16; for (int i = bid * NTHR + tid; i < nz; i += G * NTHR) z[i] = (u32x4){0u, 0u, 0u, 0u}; }
        wt_matrix(ARG_IN(7), DM, DM, (bf16_t*)(ws + W1OUT), MapId{}, scr, tid, bid, G);
        wt_matrix(ARG_IN(17), DM, DFF, (bf16_t*)(ws + W1GU), MapGU{0}, scr, tid, bid, G);
        wt_matrix(ARG_IN(18), DM, DFF, (bf16_t*)(ws + W1GU), MapGU{1}, scr, tid, bid, G);
        wt_matrix(ARG_IN(19), DFF, DM, (bf16_t*)(ws + W1DN), MapId{}, scr, tid, bid, G);
    }
    SEAM(8);
    if (IN(9)) REP(9) {
        pg8::Gemm g{XB, (const bf16_t*)(ws + W1IN), MTOK, N_BP, DM}; pg8::StaticOrder S; S.init(MTOK, N_BP, G, bid);
        pg8::EpiQKV1 E{(bf16_t*)(ws + B_Q1), (bf16_t*)(ws + B_K1), (bf16_t*)(ws + B_V1), (unsigned short*)(ws + B_QI), (float*)(ws + B_KIR), (float*)(ws + B_WI), rt};
        pg8::gemm_phase<pg8::EpiQKV1, pg8::StaticOrder, true, true>(lds, g, S, E);
    }
    SEAM(9);
    if (IN(10)) REP(10) kidx_phase((const float*)(ws + B_KIR), ARG_IN(5), ARG_IN(6), CS, SN, (unsigned short*)(ws + B_KI16), tid, bid, G);
    SEAM(10);
    if (IN(11)) REP(11) indexer_phase((const unsigned short*)(ws + B_QI), (const unsigned short*)(ws + B_KI16), (const float*)(ws + B_WI), (float*)(ws + B_SC), lds, tid, bid, G);
    SEAM(11);
    if (IN(12)) REP(12) topk_phase((const float*)(ws + B_SC), (unsigned short*)(ws + B_IDX), lds, tid, bid, G);
    SEAM(12);
    if (IN(13)) REP(13) dsa_attn_phase((const bf16_t*)(ws + B_Q1), (const bf16_t*)(ws + B_K1), (const bf16_t*)(ws + B_V1), (const unsigned short*)(ws + B_IDX), (bf16_t*)(ws + B_AO1), lds, tid, bid, G);
    SEAM(13);
    if (IN(14)) REP(14) {
        pg8::Gemm g{(const bf16_t*)(ws + B_AO1), (const bf16_t*)(ws + W1OUT), MTOK, DM, DM}; pg8::StaticOrder S; S.init(MTOK, DM, G, bid, WGM_Y);
        pg8::EpiY E{XA, Y, DM, ALPHA};
        pg8::gemm_phase<pg8::EpiY, pg8::StaticOrder, true, true>(lds, g, S, E);
    }
    SEAM(14);
    if (IN(15)) REP(15) ln_phase(Y, ARG_IN(15), ARG_IN(16), OUT, XB, tid, bid, G);
    SEAM(15);
    if (IN(16)) REP(16) {
        pg8::Gemm g{XB, (const bf16_t*)(ws + W1GU), MTOK, 2 * DFF, DM}; pg8::StaticOrder S; S.init(MTOK, 2 * DFF, G, bid, WGM_F);
        pg8::EpiSwiGLU E{Hh, DFF};
        pg8::gemm_phase<pg8::EpiSwiGLU, pg8::StaticOrder, true, true>(lds, g, S, E);
    }
    SEAM(16);
    if (IN(17)) REP(17) {
        pg8::Gemm g{Hh, (const bf16_t*)(ws + W1DN), MTOK, DM, DFF}; pg8::StaticOrder S; S.init(MTOK, DM, G, bid, WGM_Y);
        pg8::EpiY E{OUT, Y, DM, ALPHA};
        pg8::gemm_phase<pg8::EpiY, pg8::StaticOrder, true, true>(lds, g, S, E);
    }
    SEAM(17);
    if (IN(18)) REP(18) ln_phase(Y, ARG_IN(20), ARG_IN(21), OUT, nullptr, tid, bid, G);
    if (PROBE_PH >= 0 && bid == 0) { const unsigned long long t1_ = __builtin_amdgcn_s_memrealtime(); while (__builtin_amdgcn_s_memrealtime() - t1_ < pr_acc) __builtin_amdgcn_s_sleep(8); }
#undef IN
#undef ARG_IN
#undef SEAM
#undef REP
}

extern "C" void kernel_launch(void* const* d_in, const int* in_sizes, int n_in, void* d_out, int out_size, void* d_ws, size_t ws_size, hipStream_t stream) {
    static int grid = 0;
    if (grid == 0) {
        if (n_in != 22 || out_size != MTOK * DM || ws_size < WS_END) { fprintf(stderr, "kernel_launch: unexpected problem (n_in %d, out %d, ws %zu < %zu); nothing launched\n", n_in, out_size, ws_size, (size_t)WS_END); grid = -1; return; }
        int dev = 0, cus = 0, per_cu = 0;
        if (hipGetDevice(&dev) != hipSuccess || hipDeviceGetAttribute(&cus, hipDeviceAttributeMultiprocessorCount, dev) != hipSuccess) { grid = -1; return; }
        if (hipFuncSetAttribute((const void*)mk_fwd, hipFuncAttributeMaxDynamicSharedMemorySize, LDS_BYTES) != hipSuccess) { fprintf(stderr, "kernel_launch: hipFuncSetAttribute failed\n"); grid = -1; return; }
        if (hipOccupancyMaxActiveBlocksPerMultiprocessor(&per_cu, (const void*)mk_fwd, NTHR, LDS_BYTES) != hipSuccess || per_cu < 1) { fprintf(stderr, "kernel_launch: occupancy query reports %d\n", per_cu); (void)hipGetLastError(); per_cu = 1; }
        grid = cus;
    }
    if (grid < 0) return;
    (void)in_sizes;
    if (hipMemsetAsync((char*)d_ws + WS_CTL, 0, CTL_ZERO_BYTES, stream) != hipSuccess) return;
    Args a{};
    for (int i = 0; i < 22; ++i) a.in[i] = (const float*)d_in[i];
    a.out = (float*)d_out; a.ws = (unsigned char*)d_ws;
#if MK_ONE_LAUNCH
    a.ph_lo = 0; a.ph_hi = N_PHASES;
    hipLaunchKernelGGL(mk_fwd, dim3(grid), dim3(NTHR), LDS_BYTES, stream, a);
#else
    for (int p = 0; p < N_PHASES; ++p) { a.ph_lo = p; a.ph_hi = p + 1; hipLaunchKernelGGL(mk_fwd, dim3(grid), dim3(NTHR), LDS_BYTES, stream, a); }
#endif
}
```

```cpp
#include <hip/hip_runtime.h>
#include <cstdio>
#include <cstdint>
namespace pg8 {
#define PG8_LAS __attribute__((address_space(3)))
typedef unsigned short bf16_t;
typedef short bf16x8 __attribute__((ext_vector_type(8)));
typedef float f32x4 __attribute__((ext_vector_type(4)));
typedef unsigned u32x4 __attribute__((ext_vector_type(4)));
constexpr int BM = 256, BK = 64, HALF = 128, HTB = HALF * BK * 2  , STAGE_BYTES = 8 * HTB, NXCD = 8, WGM = 8;

__host__ __device__ __forceinline__ int lds_byte(int r, int c) { const int st = (r >> 4) * 2 + (c >> 5), rr = r & 15, cc = c & 31, ob = rr * 64 + cc * 2; return st * 1024 + (ob ^ (((ob >> 9) & 1) << 5)); }
__host__ __device__ __forceinline__ void stage_rc(int b, int& R, int& C) { const int st = b / 1024, sb = b % 1024, swz = sb ^ (((sb >> 9) & 1) << 5); R = (st >> 1) * 16 + swz / 64; C = (st & 1) * 32 + (swz % 64) / 2; }
__host__ __device__ __forceinline__ int perm32(int rho) { const int n = rho >> 4, i = rho & 15; return 8 * (i >> 2) + 4 * n + (i & 3); }

struct Unit { int pm, pn; };
struct Gemm { const bf16_t* A; const bf16_t* Bt; int M, N, K; };

struct StaticOrder {
    int nM, nN, nwg, G, c, wgm;
    __host__ __device__ void init(int M, int N, int G_, int c_, int wgm_ = WGM) { nM = M / BM; nN = N / BM; nwg = nM * nN; G = G_; c = c_; wgm = wgm_; }
    __host__ __device__ bool next(int i, Unit& u) const {
        const long L = (long)i * G + c; if (L >= nwg) return false;
        int wgid = (int)L; { const int q = nwg / NXCD, r = nwg % NXCD, xcd = wgid % NXCD, off = wgid / NXCD; wgid = (xcd < r ? xcd * (q + 1) : r * (q + 1) + (xcd - r) * q) + off; }
        const int nig = wgm * nN, gid = wgid / nig, fm = gid * wgm, gsz = (nM - fm) < wgm ? (nM - fm) : wgm;
        u.pm = fm + ((wgid % nig) % gsz); u.pn = (wgid % nig) / gsz; return true;
    }
    __device__ __forceinline__ void a_ready(const Unit&) const {}
    __device__ __forceinline__ void done(const Unit&) const {}
};
__device__ __forceinline__ unsigned cvt_pk_bf16(float lo, float hi) { unsigned r; asm volatile("v_cvt_pk_bf16_f32 %0, %1, %2" : "=v"(r) : "v"(lo), "v"(hi)); return r; }
typedef _Float16 f16x2_t __attribute__((ext_vector_type(2)));
__device__ __forceinline__ unsigned cvt_pk_f16(float lo, float hi) { f16x2_t h; h.x = (_Float16)lo; h.y = (_Float16)hi; return __builtin_bit_cast(unsigned, h); }

struct RopeTab { const float* cs; const float* sn; };

__device__ __forceinline__ void rope_pair(f32x4& v0, f32x4& v1, const f32x4 c, const f32x4 s) {
    const f32x4 a = v0 * c - v1 * s, b = v1 * c + v0 * s; v0 = a; v1 = b;
}

struct EpiY {
    static constexpr bool PERM = false, AFTER_DRAIN = false;
    const float* X; float* Y; int ldc; float alpha;
    __device__ __forceinline__ void operator()(const f32x4 (&acc)[2][2][4][2], const Unit& u, int wr, int wc, int fr, int fq) const {
        const int row0 = u.pm * BM + wr * 64 + fr, col0 = u.pn * BM + wc * 32 + 4 * fq;
#pragma unroll
        for (int ai = 0; ai < 2; ++ai) {
            f32x4 xv[4][2][2];
#pragma unroll
            for (int m = 0; m < 4; ++m) { const size_t off = (size_t)(row0 + ai * HALF + m * 16) * ldc + col0;
#pragma unroll
                for (int bj = 0; bj < 2; ++bj)
#pragma unroll
                    for (int n = 0; n < 2; ++n) xv[m][bj][n] = *(const f32x4*)(X + off + bj * HALF + n * 16); }
#pragma unroll
            for (int m = 0; m < 4; ++m) { const size_t off = (size_t)(row0 + ai * HALF + m * 16) * ldc + col0;
#pragma unroll
                for (int bj = 0; bj < 2; ++bj)
#pragma unroll
                    for (int n = 0; n < 2; ++n) *(f32x4*)(Y + off + bj * HALF + n * 16) = xv[m][bj][n] * alpha + acc[ai][bj][m][n]; }
            asm volatile("" ::: "memory"); }
    }
};

struct EpiSwiGLU {
    static constexpr bool PERM = true, AFTER_DRAIN = false;
    bf16_t* Hh; int ldh;
    __device__ __forceinline__ void operator()(const f32x4 (&acc)[2][2][4][2], const Unit& u, int wr, int wc, int fr, int fq) const {
        const int row0 = u.pm * BM + wr * 64 + fr, col0 = u.pn * HALF + wc * 32 + 8 * fq;
#pragma unroll
        for (int ai = 0; ai < 2; ++ai)
#pragma unroll
            for (int m = 0; m < 4; ++m) { bf16_t* rowp = Hh + (size_t)(row0 + ai * HALF + m * 16) * ldh + col0;
                float h[8];
#pragma unroll
                for (int n = 0; n < 2; ++n)
#pragma unroll
                    for (int i = 0; i < 4; ++i) { const float g = acc[ai][0][m][n][i], up = acc[ai][1][m][n][i];
                        const float e = __builtin_amdgcn_exp2f(-g * 1.44269504089f); h[n * 4 + i] = g * __builtin_amdgcn_rcpf(1.0f + e) * up; }
                u32x4 w; w.x = cvt_pk_bf16(h[0], h[1]); w.y = cvt_pk_bf16(h[2], h[3]); w.z = cvt_pk_bf16(h[4], h[5]); w.w = cvt_pk_bf16(h[6], h[7]);
                *(u32x4*)rowp = w; }
    }
};

struct EpiQKV0 {
    static constexpr bool PERM = true, AFTER_DRAIN = false;
    bf16_t* O; RopeTab rt;
    __device__ __forceinline__ void operator()(const f32x4 (&acc)[2][2][4][2], const Unit& u, int wr, int wc, int fr, int fq) const {
        const int sg = u.pn >> 3, cw = wc * 32 + 8 * fq, hd0 = (u.pn & 7) * 2; const bool rope = sg < 6;
        const int dsh = 2 * (sg % 3);
        const int row0 = u.pm * BM + wr * 64 + fr, f0 = 16 * wc + 4 * fq;
#pragma unroll
        for (int ai = 0; ai < 2; ++ai)
#pragma unroll
            for (int m = 0; m < 4; ++m) { const int row = row0 + ai * HALF + m * 16; const int bb = row >> 13, si = row & 8191;
                const size_t rl = (size_t)(si & ((1 << dsh) - 1)) * (8192 >> dsh) + (si >> dsh);
                f32x4 c = {1.f, 1.f, 1.f, 1.f}, s = {0.f, 0.f, 0.f, 0.f};
                if (rope) { c = *(const f32x4*)(rt.cs + (size_t)row * 64 + f0); s = *(const f32x4*)(rt.sn + (size_t)row * 64 + f0); }
#pragma unroll
                for (int bj = 0; bj < 2; ++bj) { f32x4 v0 = acc[ai][bj][m][0], v1 = acc[ai][bj][m][1];
                    rope_pair(v0, v1, c, s);
                    u32x4 w; w.x = cvt_pk_bf16(v0[0], v0[1]); w.y = cvt_pk_bf16(v0[2], v0[3]); w.z = cvt_pk_bf16(v1[0], v1[1]); w.w = cvt_pk_bf16(v1[2], v1[3]);
                    bf16_t* dst = O + ((size_t)((sg * 2 + bb) * 16 + hd0 + bj) * 8192 + rl) * 128 + cw;
                    *(u32x4*)dst = w; } }
    }
};

struct EpiQKV1 {
    static constexpr bool PERM = true, AFTER_DRAIN = false;
    bf16_t* Q; bf16_t* Kc; bf16_t* Vc; unsigned short* QI; float* KIR; float* WI; RopeTab rt;
    __device__ __forceinline__ void operator()(const f32x4 (&acc)[2][2][4][2], const Unit& u, int wr, int wc, int fr, int fq) const {
        const int pn = u.pn; const int row0 = u.pm * BM + wr * 64 + fr, f0 = 16 * wc + 4 * fq, cw = wc * 32 + 8 * fq;
        const bool rope = (pn < 20) || (pn >= 24 && pn < 40);
#pragma unroll
        for (int ai = 0; ai < 2; ++ai)
#pragma unroll
            for (int m = 0; m < 4; ++m) { const int row = row0 + ai * HALF + m * 16;
                f32x4 c = {1.f, 1.f, 1.f, 1.f}, s = {0.f, 0.f, 0.f, 0.f};
                if (rope) { c = *(const f32x4*)(rt.cs + (size_t)row * 64 + f0); s = *(const f32x4*)(rt.sn + (size_t)row * 64 + f0); }
#pragma unroll
                for (int bj = 0; bj < 2; ++bj) { f32x4 v0 = acc[ai][bj][m][0], v1 = acc[ai][bj][m][1];
                    if (pn < 40) {
                        rope_pair(v0, v1, c, s);
                        u32x4 w;
                        if (pn >= 24) { w.x = cvt_pk_f16(v0[0], v0[1]); w.y = cvt_pk_f16(v0[2], v0[3]); w.z = cvt_pk_f16(v1[0], v1[1]); w.w = cvt_pk_f16(v1[2], v1[3]); }
                        else { w.x = cvt_pk_bf16(v0[0], v0[1]); w.y = cvt_pk_bf16(v0[2], v0[3]); w.z = cvt_pk_bf16(v1[0], v1[1]); w.w = cvt_pk_bf16(v1[2], v1[3]); }
                        if (pn < 16) *(u32x4*)(Q + (size_t)row * 4096 + pn * BM + bj * HALF + cw) = w;
                        else if (pn < 24) { const int kvh = ((pn - 16) & 3) * 2 + bj; bf16_t* dst = (pn < 20 ? Kc : Vc) + ((size_t)((row >> 13) * 8 + kvh) * 8192 + (row & 8191)) * 128 + cw; *(u32x4*)dst = w; }
                        else *(u32x4*)(QI + (size_t)row * 4096 + (pn - 24) * BM + bj * HALF + cw) = w;
                    } else {
                        if (bj == 0) { *(f32x4*)(KIR + (size_t)row * 128 + cw) = v0; *(f32x4*)(KIR + (size_t)row * 128 + cw + 4) = v1; }
                        else if (wc == 0) { *(f32x4*)(WI + (size_t)row * 32 + cw) = v0 * 0.015625f; *(f32x4*)(WI + (size_t)row * 32 + cw + 4) = v1 * 0.015625f; }
                    } } }
    }
};

template <class Epi, class Sched, bool ALIGN_EPI = false, bool SP2 = false>
__device__ __forceinline__ void gemm_phase(PG8_LAS unsigned char* lds, const Gemm g, const Sched& S, const Epi& E) {
    const int tid = threadIdx.x, wid = __builtin_amdgcn_readfirstlane(tid >> 6), lane = tid & 63, wr = wid >> 2, wc = wid & 3, fr = lane & 15, fq = lane >> 4;
    const int K = g.K, nt = K / BK;
    unsigned voffA[2], voffB[2];
#pragma unroll
    for (int i = 0; i < 2; ++i) { int R, C; stage_rc(tid * 16 + i * 8192, R, C); const int Rb = Epi::PERM ? ((R & ~31) + perm32(R & 31)) : R;
        voffA[i] = (unsigned)(R * K + C) * 2u; voffB[i] = (unsigned)(Rb * K + C) * 2u; }
    const size_t kstep = (size_t)(BK * 2);
    const size_t hstep = (size_t)HALF * K * 2;
    const size_t tstep = 2 * hstep;
    const unsigned ldsw = (unsigned)wid * 1024u;
    const int aoff = lds_byte(wr * 64 + fr, fq * 8), boff = lds_byte(wc * 32 + fr, fq * 8);
#define PG8_SA(b, h) (((b) * 2 + (h)) * HTB)
#define PG8_SB(b, h) ((4 + (b) * 2 + (h)) * HTB)
#define PG8_STAGE(bufoff, gbase, voff) do { _Pragma("unroll") for (int _i = 0; _i < 2; ++_i) \
        __builtin_amdgcn_global_load_lds((const unsigned*)((const char*)(gbase) + (voff)[_i]), (PG8_LAS unsigned*)(lds + (bufoff) + ldsw + _i * 8192), 16, 0, 0); } while (0)
#define PG8_LDA(dst, b, h) do { _Pragma("unroll") for (int m = 0; m < 4; ++m) _Pragma("unroll") for (int k = 0; k < 2; ++k) dst[m][k] = *(const PG8_LAS bf16x8*)(lds + PG8_SA(b, h) + aoff + m * 2048 + k * 1024); } while (0)
#define PG8_LDB(dst, b, h) do { _Pragma("unroll") for (int n = 0; n < 2; ++n) _Pragma("unroll") for (int k = 0; k < 2; ++k) dst[n][k] = *(const PG8_LAS bf16x8*)(lds + PG8_SB(b, h) + boff + n * 2048 + k * 1024); } while (0)
#define PG8_MMA(ai, bj, At, Bt) do { __builtin_amdgcn_s_setprio(1); _Pragma("unroll") for (int m = 0; m < 4; ++m) _Pragma("unroll") for (int n = 0; n < 2; ++n) _Pragma("unroll") for (int k = 0; k < 2; ++k) \
        acc[ai][bj][m][n] = __builtin_amdgcn_mfma_f32_16x16x32_bf16(Bt[n][k], At[m][k], acc[ai][bj][m][n], 0, 0, 0); __builtin_amdgcn_s_setprio(0); } while (0)
#define PG8_WAIT_V(n) asm volatile("s_waitcnt vmcnt(" #n ")" ::: "memory")
#define PG8_WAIT_L(n) asm volatile("s_waitcnt lgkmcnt(" #n ")" ::: "memory")
#define PG8_BAR __builtin_amdgcn_s_barrier()
#define PG8_SCHED __builtin_amdgcn_sched_barrier(0)
    Unit cur, nxt; int ui = 0;
    if (!S.next(0, cur)) return;
    f32x4 acc[2][2][4][2];
#pragma unroll
    for (int a = 0; a < 2; ++a)
#pragma unroll
        for (int b = 0; b < 2; ++b)
#pragma unroll
            for (int m = 0; m < 4; ++m)
#pragma unroll
                for (int n = 0; n < 2; ++n) acc[a][b][m][n] = (f32x4){0.f, 0.f, 0.f, 0.f};
    bf16x8 At[4][2], B0[2][2], B1[2][2];
    const char* cA = (const char*)g.A + (size_t)cur.pm * tstep; const char* cB = (const char*)g.Bt + (size_t)cur.pn * tstep;
    S.a_ready(cur);
    if constexpr (SP2) {
        PG8_STAGE(PG8_SB(0, 0), cB, voffB); PG8_STAGE(PG8_SB(0, 1), cB + hstep, voffB); PG8_STAGE(PG8_SA(0, 0), cA, voffA); PG8_STAGE(PG8_SA(0, 1), cA + hstep, voffA);
        if (wr == 1) PG8_BAR;
        PG8_WAIT_V(2); PG8_BAR;
        PG8_STAGE(PG8_SB(1, 0), cB + kstep, voffB); PG8_STAGE(PG8_SA(1, 0), cA + kstep, voffA); PG8_STAGE(PG8_SB(1, 1), cB + hstep + kstep, voffB);
        PG8_WAIT_V(6); PG8_BAR;
    } else {
        PG8_STAGE(PG8_SB(0, 0), cB, voffB); PG8_STAGE(PG8_SA(0, 0), cA, voffA); PG8_STAGE(PG8_SB(0, 1), cB + hstep, voffB); PG8_STAGE(PG8_SA(0, 1), cA + hstep, voffA);
        if (wr == 1) PG8_BAR;
        PG8_WAIT_V(4); PG8_BAR;
        PG8_STAGE(PG8_SB(1, 0), cB + kstep, voffB); PG8_STAGE(PG8_SA(1, 0), cA + kstep, voffA); PG8_STAGE(PG8_SB(1, 1), cB + hstep + kstep, voffB);
        PG8_WAIT_V(6); PG8_BAR;
    }
    for (;;) {
        const bool has_next = S.next(ui + 1, nxt);
        const char* nA = has_next ? (const char*)g.A + (size_t)nxt.pm * tstep : cA; const char* nB = has_next ? (const char*)g.Bt + (size_t)nxt.pn * tstep : cB;
        for (int t = 0; t < nt; t += 2) {
            const bool last = (t == nt - 2);
            const char* a1 = cA + (size_t)(t + 1) * kstep;
            const char* a2 = last ? nA : cA + (size_t)(t + 2) * kstep; const char* b2 = last ? nB : cB + (size_t)(t + 2) * kstep;
            const char* a3 = a2 + kstep; const char* b3 = b2 + kstep;
            if (last && has_next) S.a_ready(nxt);
            if constexpr (SP2) {
            PG8_LDB(B0, 0, 0); PG8_LDB(B1, 0, 1); PG8_SCHED; PG8_LDA(At, 0, 0); PG8_STAGE(PG8_SA(1, 1), a1 + hstep, voffA);
            PG8_WAIT_V(8); PG8_WAIT_L(0); PG8_BAR; PG8_MMA(0, 0, At, B0); PG8_MMA(0, 1, At, B1); PG8_BAR; PG8_SCHED;
            PG8_LDA(At, 0, 1); PG8_STAGE(PG8_SB(0, 0), b2, voffB); PG8_STAGE(PG8_SB(0, 1), b2 + hstep, voffB); PG8_STAGE(PG8_SA(0, 0), a2, voffA);
            PG8_WAIT_V(8); PG8_WAIT_L(0); PG8_BAR; PG8_MMA(1, 0, At, B0); PG8_MMA(1, 1, At, B1); PG8_BAR; PG8_SCHED;
            PG8_LDB(B0, 1, 0); PG8_LDB(B1, 1, 1); PG8_SCHED; PG8_LDA(At, 1, 0); PG8_STAGE(PG8_SA(0, 1), a2 + hstep, voffA);
            PG8_WAIT_V(8); PG8_WAIT_L(0); PG8_BAR; PG8_MMA(0, 0, At, B0); PG8_MMA(0, 1, At, B1); PG8_BAR; PG8_SCHED;
            PG8_LDA(At, 1, 1); PG8_STAGE(PG8_SB(1, 0), b3, voffB); PG8_STAGE(PG8_SB(1, 1), b3 + hstep, voffB); PG8_STAGE(PG8_SA(1, 0), a3, voffA);
            PG8_WAIT_V(8); PG8_WAIT_L(0); PG8_BAR; PG8_MMA(1, 0, At, B0); PG8_MMA(1, 1, At, B1); PG8_BAR; PG8_SCHED;
            } else {
            PG8_LDB(B0, 0, 0); PG8_SCHED; PG8_LDA(At, 0, 0); PG8_STAGE(PG8_SA(1, 1), a1 + hstep, voffA);
            PG8_WAIT_L(8); PG8_BAR; PG8_WAIT_L(0); PG8_MMA(0, 0, At, B0); PG8_BAR; PG8_SCHED;
            PG8_LDB(B1, 0, 1); PG8_STAGE(PG8_SB(0, 0), b2, voffB);
            PG8_BAR; PG8_WAIT_L(0); PG8_MMA(0, 1, At, B1); PG8_BAR;
            PG8_LDA(At, 0, 1); PG8_STAGE(PG8_SA(0, 0), a2, voffA);
            PG8_BAR; PG8_WAIT_L(0); PG8_MMA(1, 0, At, B0); PG8_BAR; PG8_SCHED;
            PG8_STAGE(PG8_SB(0, 1), b2 + hstep, voffB);
            PG8_WAIT_V(6); PG8_BAR; PG8_MMA(1, 1, At, B1); PG8_BAR;
            PG8_LDB(B0, 1, 0); PG8_SCHED; PG8_LDA(At, 1, 0); PG8_STAGE(PG8_SA(0, 1), a2 + hstep, voffA);
            PG8_WAIT_L(8); PG8_BAR; PG8_WAIT_L(0); PG8_MMA(0, 0, At, B0); PG8_BAR; PG8_SCHED;
            PG8_LDB(B1, 1, 1); PG8_STAGE(PG8_SB(1, 0), b3, voffB);
            PG8_BAR; PG8_WAIT_L(0); PG8_MMA(0, 1, At, B1); PG8_BAR;
            PG8_LDA(At, 1, 1); PG8_STAGE(PG8_SA(1, 0), a3, voffA);
            PG8_BAR; PG8_WAIT_L(0); PG8_MMA(1, 0, At, B0); PG8_BAR; PG8_SCHED;
            PG8_STAGE(PG8_SB(1, 1), b3 + hstep, voffB);
            PG8_WAIT_V(6); PG8_BAR; PG8_MMA(1, 1, At, B1); PG8_BAR;
            }
        }
        if constexpr (ALIGN_EPI) { if (wr == 0) PG8_BAR; }
        if constexpr (!Epi::AFTER_DRAIN) { E(acc, cur, wr, wc, fr, fq); S.done(cur); }
        if (!has_next) break;
#pragma unroll
        for (int a = 0; a < 2; ++a)
#pragma unroll
            for (int b = 0; b < 2; ++b)
#pragma unroll
                for (int m = 0; m < 4; ++m)
#pragma unroll
                    for (int n = 0; n < 2; ++n) acc[a][b][m][n] = (f32x4){0.f, 0.f, 0.f, 0.f};
        cur = nxt; cA = nA; cB = nB; ++ui;
        if constexpr (ALIGN_EPI) { if (wr == 1) PG8_BAR; }
    }
    PG8_WAIT_V(0);
    if constexpr (!ALIGN_EPI) { if (wr == 0) PG8_BAR; }
    PG8_BAR;
    if constexpr (Epi::AFTER_DRAIN) { E.fused(acc, cur, wr, wc, fr, fq, lds, wid, lane); S.done(cur); }
#undef PG8_SA
#undef PG8_SB
#undef PG8_STAGE
#undef PG8_LDA
#undef PG8_LDB
#undef PG8_MMA
#undef PG8_WAIT_V
#undef PG8_WAIT_L
#undef PG8_BAR
#undef PG8_SCHED
}
}
#define XB_TMO      128
#define XB_XCNT(j)  (256  + 64 * (j))
#define XB_XSUB(j)  (1280 + 64 * (j))
#define XB_XGEN(j)  (2304 + 64 * (j))
#define XB_TOP      3328
#define XB_TOPGEN   3392
#define XCD_BAR_WORDS 3456
#define XB_SPIN_CAP (1u << 18)
#define LAS __attribute__((address_space(3)))

__device__ __forceinline__ unsigned xb_ld(unsigned* p)              { return __hip_atomic_load(p, __ATOMIC_RELAXED, __HIP_MEMORY_SCOPE_AGENT); }
__device__ __forceinline__ unsigned xb_add(unsigned* p, unsigned v) { return __hip_atomic_fetch_add(p, v, __ATOMIC_RELAXED, __HIP_MEMORY_SCOPE_AGENT); }
__device__ __forceinline__ unsigned xb_xcc_id() { return (unsigned)__builtin_amdgcn_s_getreg((3 << 11) | 20) & 0xFu; }
#define XB_SPIN(cond, bar) do { unsigned _sp = 0; while (cond) { __builtin_amdgcn_s_sleep(1); \
    if ((++_sp & 255u) == 0u) { if (xb_ld(&(bar)[XB_TMO])) break; if (_sp > XB_SPIN_CAP) { atomicAdd(&(bar)[XB_TMO], 1u); break; } } } } while (0)

struct XcdBarrier {
    unsigned* bar; unsigned x;
    volatile LAS unsigned* st;
};

__device__ __forceinline__ XcdBarrier xcd_barrier_post(unsigned* bar, volatile LAS unsigned* st) {
    XcdBarrier b; b.bar = bar; b.x = xb_xcc_id(); b.st = st;
    if (threadIdx.x == 0) (void)xb_add(&bar[XB_XCNT(b.x)], 1u);
    return b;
}
__device__ __forceinline__ void xcd_barrier_complete(unsigned* bar, unsigned x, unsigned& nloc, unsigned& nx) {
    const unsigned G = gridDim.x * gridDim.y * gridDim.z;
    unsigned sum, cnt, mine, sp = 0u;
    for (;;) {
        sum = 0u; cnt = 0u; mine = 0u;
#pragma unroll
        for (unsigned j = 0; j < 16; ++j) { const unsigned c = xb_ld(&bar[XB_XCNT(j)]); sum += c; cnt += (c > 0u) ? 1u : 0u; mine = (j == x) ? c : mine; }
        if (sum == G) break;
        __builtin_amdgcn_s_sleep(1);
        if ((++sp & 255u) == 0u) { if (xb_ld(&bar[XB_TMO])) break; if (sp > XB_SPIN_CAP) { atomicAdd(&bar[XB_TMO], 1u); break; } }
    }
    nloc = mine > 0u ? mine : 1u; nx = cnt > 0u ? cnt : 1u;
}

__device__ __forceinline__ void xcd_barrier(const XcdBarrier& b) {
    asm volatile("s_waitcnt vmcnt(0)" ::: "memory");
    __syncthreads();
    if (threadIdx.x == 0) {
        unsigned* bar = b.bar;
        __builtin_amdgcn_s_waitcnt(0);
        unsigned nloc = b.st[0], nx = b.st[1];
        if (nloc == 0u) { xcd_barrier_complete(bar, b.x, nloc, nx); b.st[0] = nloc; b.st[1] = nx; }
        const unsigned old = xb_add(&bar[XB_XSUB(b.x)], 1u);
        const unsigned gen = old / nloc;
        if (old + 1u == (gen + 1u) * nloc) {
            __builtin_amdgcn_fence(__ATOMIC_RELEASE, "agent");
            asm volatile("s_waitcnt vmcnt(0)" ::: "memory");
            const unsigned og = xb_add(&bar[XB_TOP], 1u);
            const unsigned tg = og / nx;
            if (og + 1u == (tg + 1u) * nx) xb_add(&bar[XB_TOPGEN], 1u);
            else XB_SPIN(xb_ld(&bar[XB_TOPGEN]) == tg, bar);
            __builtin_amdgcn_fence(__ATOMIC_ACQUIRE, "agent");
            xb_add(&bar[XB_XGEN(b.x)], 1u);
            asm volatile("s_waitcnt vmcnt(0)" ::: "memory");
        } else {
            XB_SPIN(xb_ld(&bar[XB_XGEN(b.x)]) == gen, bar);
            __builtin_amdgcn_fence(__ATOMIC_ACQUIRE, "agent");
            asm volatile("s_waitcnt vmcnt(0)" ::: "memory");
        }
    }
    __syncthreads();
}


using pg8::bf16_t; using pg8::bf16x8; using pg8::f32x4; using pg8::u32x4;
typedef _Float16 f16x8 __attribute__((ext_vector_type(8)));
typedef float f32x16 __attribute__((ext_vector_type(16)));
typedef unsigned u32x2 __attribute__((ext_vector_type(2)));
#define DI __device__ __forceinline__

constexpr int NWAVES = 8, NTHR = 512;
constexpr int SEQ = 8192, MTOK = 16384, DM = 4096, DFF = 11008;
constexpr int N_A = 18432, N_B = 10400, N_BP = 10496;
constexpr float LN_EPS = 1e-5f;
constexpr float ALPHA = 1.41421356237309515f;
constexpr float SM_C = 0.08838834764831845f * 1.4426950408889634f;
constexpr float SM_SCALE = 0.08838834764831845f;

constexpr size_t MiB = (size_t)1 << 20;
constexpr size_t WS_CTL = 0, CTL_ZERO_BYTES = 16384;
constexpr size_t WS_COS = 1 * MiB, WS_SIN = 5 * MiB;
constexpr size_t WS_W = 9 * MiB;
constexpr size_t W0IN = WS_W, W0OUT = WS_W + 144 * MiB, W0GU = WS_W + 160 * MiB, W0DN = WS_W + 332 * MiB;
constexpr size_t W1IN = WS_W, W1OUT = WS_W + 82 * MiB, W1GU = WS_W + 114 * MiB, W1DN = WS_W + 286 * MiB;
constexpr size_t WS_XB = 427 * MiB, WS_XA = 555 * MiB, WS_BIG = 811 * MiB, WS_END = (811 + 835) * MiB;
constexpr size_t B_QKV0 = WS_BIG, B_OG = WS_BIG + 576 * MiB, B_LSE = WS_BIG + 768 * MiB, B_AO0 = WS_BIG + 771 * MiB;
constexpr size_t B_Y = WS_BIG + 360 * MiB, B_H = WS_BIG;
constexpr size_t B_Q1 = WS_BIG, B_K1 = WS_BIG + 128 * MiB, B_V1 = WS_BIG + 160 * MiB, B_QI = WS_BIG + 192 * MiB, B_KIR = WS_BIG + 320 * MiB, B_KI16 = WS_BIG + 328 * MiB,
                 B_WI = WS_BIG + 332 * MiB, B_SC = WS_BIG + 334 * MiB, B_IDX = WS_BIG + 594 * MiB, B_AO1 = WS_BIG + 640 * MiB;
constexpr int LDS_BYTES = 147456, MISC_OFF = 147456 - 64;

DI float wave_sum(float v) { v += __shfl_xor(v, 1); v += __shfl_xor(v, 2); v += __shfl_xor(v, 4); v += __shfl_xor(v, 8); v += __shfl_xor(v, 16); v += __shfl_xor(v, 32); return v; }
DI int sigma_inv(int d) { return 32 * ((d >> 4) & 3) + 8 * ((d >> 2) & 3) + 4 * (d >> 6) + (d & 3); }

struct MapId { DI long operator()(int c) const { return c; } };
struct MapA  { DI long operator()(int c) const { const int d = c & 127; return (c < 2 * 6144) ? (long)(c - d + sigma_inv(d)) : (long)c; } };
struct MapB  { DI long operator()(int c) const { const int d = c & 127; const bool rp = (c < 5120) || (c >= 6144 && c < 10240); return rp ? (long)(c - d + sigma_inv(d)) : (long)c; } };
struct MapGU { int up; DI long operator()(int c) const { return (long)((c >> 7) * 256 + up * 128 + (c & 127)); } };

DI void wt_load(const float* __restrict__ W, int N, int nct, int item, f32x4 (&v)[8], int tid) {
    const int kt = item / nct, ct = item - kt * nct; const int k0 = kt * 64, c0 = ct * 256; const int cq = tid & 63, kr0 = tid >> 6; const bool cok = (c0 + 4 * cq) < N;
#pragma unroll
    for (int i = 0; i < 8; ++i) v[i] = cok ? *(const f32x4*)(W + (size_t)(k0 + kr0 + 8 * i) * N + c0 + 4 * cq) : (f32x4){0.f, 0.f, 0.f, 0.f};
}
template <class Map>
DI void wt_store(int K, int N, int nct, bf16_t* __restrict__ WT, int item, const Map map, const f32x4 (&v)[8], LAS float* scr, int tid) {
    const int kt = item / nct, ct = item - kt * nct; const int k0 = kt * 64, c0 = ct * 256; const int cq = tid & 63, kr0 = tid >> 6;
    __syncthreads();
#pragma unroll
    for (int i = 0; i < 8; ++i) { const int k = kr0 + 8 * i; *(LAS f32x4*)(scr + k * 260 + 4 * (cq ^ ((k >> 3) & 7))) = v[i]; }
    __syncthreads();
#pragma unroll
    for (int i = 0; i < 4; ++i) { const int pc = tid + 512 * i; const int c = pc >> 3, j = pc & 7;
        if (c0 + c < N) { float f[8];
#pragma unroll
            for (int e = 0; e < 8; ++e) f[e] = scr[(8 * j + e) * 260 + 4 * ((c >> 2) ^ j) + (c & 3)];
            u32x4 o; o.x = pg8::cvt_pk_bf16(f[0], f[1]); o.y = pg8::cvt_pk_bf16(f[2], f[3]); o.z = pg8::cvt_pk_bf16(f[4], f[5]); o.w = pg8::cvt_pk_bf16(f[6], f[7]);
            *(u32x4*)(WT + (size_t)map(c0 + c) * K + k0 + 8 * j) = o; } }
}
template <class Map>
DI void wt_matrix(const float* W, int K, int N, bf16_t* WT, const Map map, LAS float* scr, int tid, int bid, int G) {
    const int nct = (N + 255) >> 8, nitems = (K >> 6) * nct;
    f32x4 va[8], vb[8];
    int it = bid;
    if (it < nitems) wt_load(W, N, nct, it, va, tid);
    for (; it < nitems; it += 2 * G) {
        if (it + G < nitems) wt_load(W, N, nct, it + G, vb, tid);
        wt_store(K, N, nct, WT, it, map, va, scr, tid);
        if (it + G >= nitems) break;
        if (it + 2 * G < nitems) wt_load(W, N, nct, it + 2 * G, va, tid);
        wt_store(K, N, nct, WT, it + G, map, vb, scr, tid);
    }
}

DI void rope_sincos(int pos, int f, float& cs, float& sn) {
    const double r1 = 0.8659643233600653; double inv = 1.0, rp = r1;
#pragma unroll
    for (int b = 0; b < 6; ++b) { if ((f >> b) & 1) inv *= rp; rp *= rp; }
    const double ang = (double)pos * inv;
    const double q = __builtin_rint(ang * 0.63661977236758134308);
    double r = __builtin_fma(-q, 1.57079632679489655800e+00, ang); r = __builtin_fma(-q, 6.12323399573676603587e-17, r);
    const double z = r * r;
    const double ps = r + r * z * (-1.66666666666666324348e-01 + z * (8.33333333332248946124e-03 + z * (-1.98412698298579493134e-04 + z * (2.75573137070700676789e-06 + z * (-2.50507602534068634195e-08 + z * 1.58969099521155010221e-10)))));
    const double pc = 1.0 - 0.5 * z + z * z * (4.16666666666666019037e-02 + z * (-1.38888888888741095749e-03 + z * (2.48015872894767294178e-05 + z * (-2.75573143513906633035e-07 + z * (2.08757232129817482790e-09 + z * -1.13596475577881948265e-11)))));
    const int qi = ((int)(long long)q) & 3;
    const double s = (qi == 0) ? ps : (qi == 1) ? pc : (qi == 2) ? -ps : -pc;
    const double c = (qi == 0) ? pc : (qi == 1) ? -ps : (qi == 2) ? -pc : ps;
    cs = (float)c; sn = (float)s;
}

DI void cvt_x_phase(const float* X, bf16_t* XB, int tid, int bid, int G) {
    const size_t n8 = (size_t)MTOK * DM / 8;
    for (size_t i = (size_t)bid * NTHR + tid; i < n8; i += (size_t)G * NTHR) {
        const f32x4 a = *(const f32x4*)(X + i * 8), b = *(const f32x4*)(X + i * 8 + 4);
        u32x4 o; o.x = pg8::cvt_pk_bf16(a[0], a[1]); o.y = pg8::cvt_pk_bf16(a[2], a[3]); o.z = pg8::cvt_pk_bf16(b[0], b[1]); o.w = pg8::cvt_pk_bf16(b[2], b[3]);
        *(u32x4*)(XB + i * 8) = o; }
}
DI void rope_tab_phase(const int* pos, float* CS, float* SN, int tid, int bid, int G) {
    for (int e = bid * NTHR + tid; e < MTOK * 64; e += G * NTHR) { float c, s; rope_sincos(pos[e >> 6], e & 63, c, s); CS[e] = c; SN[e] = s; }
}

DI void ln_phase(const float* Y, const float* gain, const float* bias, float* Xo, bf16_t* XBo, int tid, int bid, int G) {
    const int lane = tid & 63, gw = bid * NWAVES + (tid >> 6), nw = G * NWAVES;
    for (int row = gw; row < MTOK; row += nw) {
        const float* yr = Y + (size_t)row * DM; f32x4 v[16]; float s = 0.f;
#pragma unroll
        for (int j = 0; j < 16; ++j) { v[j] = *(const f32x4*)(yr + (j * 64 + lane) * 4); s += (v[j][0] + v[j][1]) + (v[j][2] + v[j][3]); }
        const float mean = wave_sum(s) * (1.0f / DM); float q = 0.f;
#pragma unroll
        for (int j = 0; j < 16; ++j) { v[j] = v[j] - mean; q += (v[j][0] * v[j][0] + v[j][1] * v[j][1]) + (v[j][2] * v[j][2] + v[j][3] * v[j][3]); }
        const float rstd = 1.0f / sqrtf(wave_sum(q) * (1.0f / DM) + LN_EPS);
#pragma unroll
        for (int j = 0; j < 16; ++j) { const int c = (j * 64 + lane) * 4; const f32x4 g = *(const f32x4*)(gain + c), b = *(const f32x4*)(bias + c); const f32x4 o = v[j] * rstd * g + b;
            *(f32x4*)(Xo + (size_t)row * DM + c) = o;
            if (XBo) { u32x2 w; w.x = pg8::cvt_pk_bf16(o[0], o[1]); w.y = pg8::cvt_pk_bf16(o[2], o[3]); *(u32x2*)(XBo + (size_t)row * DM + c) = w; } }
    }
}

DI bf16x8 ldg_bf16x8(const bf16_t* p) { return *(const bf16x8*)p; }
typedef short s16x4 __attribute__((ext_vector_type(4)));
struct A0Unit { int h, b, grp, d, r, nb; };
DI A0Unit a0_decode(int u) { A0Unit x; x.h = u & 15; const int blk = (u >> 4) & 63; x.b = (u >> 10) & 1; x.grp = u >> 11; const int dsh = 2 * x.grp; x.d = 1 << dsh; x.r = blk >> (6 - dsh); x.nb = blk & ((64 >> dsh) - 1); return x; }
DI size_t a0_sub(int sq, const A0Unit& x) { return ((size_t)(((sq * 3 + x.grp) * 2 + x.b) * 16 + x.h) * 8192 + (size_t)x.r * (8192 >> (2 * x.grp))) * 128; }
DI void a0_load_kv(const bf16_t* QKV, const A0Unit& x, u32x4 (&kpre)[8], u32x4 (&vpre)[8], int tid) {
    const bf16_t* Kg = QKV + a0_sub(1, x) + (tid & 15) * 8; const bf16_t* Vg = QKV + a0_sub(2, x) + (tid & 15) * 8;
#pragma unroll
    for (int i = 0; i < 8; ++i) { const int l = (x.nb - 1) * 128 + (tid >> 4) + 32 * i;
        kpre[i] = (l >= 0) ? *(const u32x4*)(Kg + (ptrdiff_t)l * 128) : (u32x4){0u, 0u, 0u, 0u};
        vpre[i] = (l >= 0) ? *(const u32x4*)(Vg + (ptrdiff_t)l * 128) : (u32x4){0u, 0u, 0u, 0u}; }
}
DI void a0_load_q(const bf16_t* QKV, const A0Unit& x, bf16x8 (&qf)[4], int w, int n, int g4) {
    const bf16_t* qp = QKV + a0_sub(0, x) + (size_t)(x.nb * 128 + 16 * w + n) * 128 + 8 * g4;
#pragma unroll
    for (int ks = 0; ks < 4; ++ks) qf[ks] = ldg_bf16x8(qp + 32 * ks);
}
DI void attn0_phase(const bf16_t* QKV, bf16_t* OG, float* LSE, LAS unsigned char* lds, int tid, int bid, int G) {
    const int lane = tid & 63, w = __builtin_amdgcn_readfirstlane(tid >> 6), n = lane & 15, g4 = lane >> 4, q4 = n >> 2, p4 = n & 3;
    LAS unsigned char* kimg = lds; LAS unsigned char* vt = lds + 65536;
    const size_t GS = (size_t)MTOK * 2048;
    const int tr_base = (4 * g4 + q4) * 256 + 8 * (p4 & 1);
    const int skey = tid >> 4, sch = tid & 15;
    LAS unsigned char* kwr = kimg + skey * 256 + ((sch ^ (skey & 15)) * 16); LAS unsigned char* vwr = vt + skey * 256 + ((sch ^ (2 * (skey & 3))) * 16);
    LAS unsigned char* krb[4];
#pragma unroll
    for (int j = 0; j < 4; ++j) krb[j] = kimg + (16 * w + n) * 256 + (((4 * j + g4) ^ n) * 16);
    u32x4 kpre[8], vpre[8]; bf16x8 qf[4];
    int u = bid;
    if (u < 6144) { const A0Unit x = a0_decode(u); a0_load_kv(QKV, x, kpre, vpre, tid); a0_load_q(QKV, x, qf, w, n, g4); }
    for (; u < 6144; u += G) {
        const A0Unit x = a0_decode(u);
        const int h = x.h, d = x.d, nb = x.nb, grp = x.grp;
        const size_t tok0 = (size_t)x.b * SEQ + x.r;
        const int iq = 16 * w + n, lq = nb * 128 + iq;
        const size_t qtok = tok0 + (size_t)lq * d;
        __syncthreads();
#pragma unroll
        for (int i = 0; i < 8; ++i) { *(LAS u32x4*)(kwr + i * 8192) = kpre[i]; *(LAS u32x4*)(vwr + i * 8192) = vpre[i]; }
        __syncthreads();
        if (u + G < 6144) { const A0Unit xn = a0_decode(u + G); a0_load_kv(QKV, xn, kpre, vpre, tid); }
        f32x4 s[9];
#pragma unroll
        for (int tt = 0; tt < 9; ++tt) { f32x4 a = {0.f, 0.f, 0.f, 0.f};
#pragma unroll
            for (int ks = 0; ks < 4; ++ks) a = __builtin_amdgcn_mfma_f32_16x16x32_bf16(*(const LAS bf16x8*)(krb[ks] + tt * 4096), qf[ks], a, 0, 0, 0);
            s[tt] = a; }
        if (u + G < 6144) { const A0Unit xn = a0_decode(u + G); a0_load_q(QKV, xn, qf, w, n, g4); }
        float mx = -__builtin_inff();
#pragma unroll
        for (int tt = 0; tt < 9; ++tt)
#pragma unroll
            for (int j = 0; j < 4; ++j) { const int kf = 16 * (w + tt) + 4 * g4 + j; const bool ok = (kf >= iq) && (kf <= iq + 128) && (nb > 0 || kf >= 128);
                const float xx = ok ? s[tt][j] : -__builtin_inff(); s[tt][j] = xx; mx = fmaxf(mx, xx); }
        mx = fmaxf(mx, __shfl_xor(mx, 16)); mx = fmaxf(mx, __shfl_xor(mx, 32));
        const float msc = mx * SM_C; float lsum = 0.f;
#pragma unroll
        for (int tt = 0; tt < 9; ++tt)
#pragma unroll
            for (int j = 0; j < 4; ++j) { const float p = __builtin_amdgcn_exp2f(s[tt][j] * SM_C - msc); s[tt][j] = p; lsum += p; }
        lsum += __shfl_xor(lsum, 16); lsum += __shfl_xor(lsum, 32);
        f32x4 o[8];
#pragma unroll
        for (int dt = 0; dt < 8; ++dt) o[dt] = (f32x4){0.f, 0.f, 0.f, 0.f};
#pragma unroll
        for (int kk = 0; kk < 5; ++kk) {
            const int t0 = 2 * kk, t1 = 2 * kk + 1;
            u32x4 pw; pw.x = pg8::cvt_pk_bf16(s[t0][0], s[t0][1]); pw.y = pg8::cvt_pk_bf16(s[t0][2], s[t0][3]);
            if (t1 < 9) { pw.z = pg8::cvt_pk_bf16(s[t1 < 9 ? t1 : 8][0], s[t1 < 9 ? t1 : 8][1]); pw.w = pg8::cvt_pk_bf16(s[t1 < 9 ? t1 : 8][2], s[t1 < 9 ? t1 : 8][3]); } else { pw.z = 0u; pw.w = 0u; }
            const bf16x8 pf = __builtin_bit_cast(bf16x8, pw);
            int T1 = w + t1; T1 = T1 > 15 ? 15 : T1;
            const int row0 = 16 * (w + t0) * 256, row1 = 16 * T1 * 256;
#pragma unroll
            for (int dt = 0; dt < 8; ++dt) {
                const int choff = ((2 * dt + (p4 >> 1)) ^ (2 * q4)) * 16;
                const s16x4 lo = __builtin_amdgcn_ds_read_tr16_b64_v4i16((LAS s16x4*)(vt + tr_base + row0 + choff));
                const s16x4 hi = __builtin_amdgcn_ds_read_tr16_b64_v4i16((LAS s16x4*)(vt + tr_base + row1 + choff));
                const bf16x8 vf = __builtin_shufflevector(lo, hi, 0, 1, 2, 3, 4, 5, 6, 7);
                o[dt] = __builtin_amdgcn_mfma_f32_16x16x32_bf16(vf, pf, o[dt], 0, 0, 0); }
        }
        const float inv = 1.0f / lsum;
        bf16_t* op = OG + (size_t)grp * GS + qtok * 2048 + h * 128 + 4 * g4;
#pragma unroll
        for (int dt = 0; dt < 8; ++dt) { u32x2 wv; wv.x = pg8::cvt_pk_bf16(o[dt][0] * inv, o[dt][1] * inv); wv.y = pg8::cvt_pk_bf16(o[dt][2] * inv, o[dt][3] * inv); *(u32x2*)(op + 16 * dt) = wv; }
        if (g4 == 0) LSE[(size_t)grp * (MTOK * 16) + qtok * 16 + h] = mx * SM_SCALE + __logf(lsum);
    }
}

DI void merge_phase(const bf16_t* OG, const float* LSE, bf16_t* AO, int tid, int bid, int G) {
    const int lane = tid & 63, gw = bid * NWAVES + (tid >> 6), nw = G * NWAVES; const size_t GS = (size_t)MTOK * 2048;
    for (int tok = gw; tok < MTOK; tok += nw) {
#pragma unroll
        for (int it = 0; it < 4; ++it) { const int e = it * 512 + lane * 8, h = e >> 7;
            const float l0 = LSE[(size_t)tok * 16 + h], l1 = LSE[(size_t)(MTOK * 16) + (size_t)tok * 16 + h], l2 = LSE[(size_t)(2 * MTOK * 16) + (size_t)tok * 16 + h];
            const float mx = fmaxf(l0, fmaxf(l1, l2)); const float e0 = __expf(l0 - mx), e1 = __expf(l1 - mx), e2 = __expf(l2 - mx); const float inv = 1.0f / (e0 + e1 + e2);
            const float w0 = e0 * inv, w1 = e1 * inv, w2 = e2 * inv;
            const u32x4 a = *(const u32x4*)(OG + (size_t)tok * 2048 + e), b = *(const u32x4*)(OG + GS + (size_t)tok * 2048 + e), c = *(const u32x4*)(OG + 2 * GS + (size_t)tok * 2048 + e);
            u32x4 o;
#pragma unroll
            for (int k = 0; k < 4; ++k) { const float lo = w0 * __uint_as_float(a[k] << 16) + w1 * __uint_as_float(b[k] << 16) + w2 * __uint_as_float(c[k] << 16);
                const float hi = w0 * __uint_as_float(a[k] & 0xffff0000u) + w1 * __uint_as_float(b[k] & 0xffff0000u) + w2 * __uint_as_float(c[k] & 0xffff0000u);
                o[k] = pg8::cvt_pk_bf16(lo, hi); }
            *(u32x4*)(AO + (size_t)tok * 2048 + e) = o; }
    }
}

DI void kidx_phase(const float* KIR, const float* gain, const float* bias, const float* CS, const float* SN, unsigned short* KI16, int tid, int bid, int G) {
    const int lane = tid & 63, gw = bid * NWAVES + (tid >> 6), nw = G * NWAVES;
    const float g1 = gain[lane], g2 = gain[lane + 64], b1 = bias[lane], b2 = bias[lane + 64];
    const int j1 = sigma_inv(lane);
    for (int tok = gw; tok < MTOK; tok += nw) {
        const float x1 = KIR[(size_t)tok * 128 + lane], x2 = KIR[(size_t)tok * 128 + 64 + lane];
        const float mean = wave_sum(x1 + x2) * (1.0f / 128.0f); const float d1 = x1 - mean, d2 = x2 - mean;
        const float rstd = 1.0f / sqrtf(wave_sum(d1 * d1 + d2 * d2) * (1.0f / 128.0f) + LN_EPS);
        const float y1 = d1 * rstd * g1 + b1, y2 = d2 * rstd * g2 + b2;
        const float c = CS[(size_t)tok * 64 + lane], s = SN[(size_t)tok * 64 + lane];
        const _Float16 o1 = (_Float16)(y1 * c - y2 * s), o2 = (_Float16)(y2 * c + y1 * s);
        KI16[(size_t)tok * 128 + j1] = __builtin_bit_cast(unsigned short, o1); KI16[(size_t)tok * 128 + j1 + 4] = __builtin_bit_cast(unsigned short, o2);
    }
}

constexpr int KT_ROWB = 272, KT_BYTES = 64 * KT_ROWB;
DI size_t sc_row_off(int b, int s) { const int qb = s >> 7; return ((size_t)(b * 2080 + ((qb * (qb + 1)) >> 1))) * 16384 + (size_t)(s & 127) * ((qb + 1) * 128); }
DI float relu1(float x) { const int b = __builtin_bit_cast(int, x); return __builtin_bit_cast(float, b > 0 ? b : 0); }
DI void indexer_tile(const LAS unsigned char* buf, const f16x8 (&af)[2][8], const f32x4 (&wv)[2][4], float* sc0, float* sc1, int kt, int r32, int h2) {
    typedef float f32x2_t __attribute__((ext_vector_type(2)));
    f16x8 bfr[2][8];
#pragma unroll
    for (int sub = 0; sub < 2; ++sub)
#pragma unroll
        for (int ks = 0; ks < 8; ++ks) bfr[sub][ks] = *(const LAS f16x8*)(buf + (32 * sub + r32) * KT_ROWB + (16 * ks + 8 * h2) * 2);
    __builtin_amdgcn_sched_barrier(0);
#pragma unroll
    for (int sub = 0; sub < 2; ++sub) {
        f32x16 c0, c1;
#pragma unroll
        for (int i = 0; i < 16; ++i) { c0[i] = 0.f; c1[i] = 0.f; }
#pragma unroll
        for (int ks = 0; ks < 8; ++ks) { c0 = __builtin_amdgcn_mfma_f32_32x32x16_f16(af[0][ks], bfr[sub][ks], c0, 0, 0, 0); c1 = __builtin_amdgcn_mfma_f32_32x32x16_f16(af[1][ks], bfr[sub][ks], c1, 0, 0, 0); }
        f32x2_t a0 = {0.f, 0.f}, a1 = {0.f, 0.f};
#pragma unroll
        for (int q = 0; q < 4; ++q)
#pragma unroll
            for (int e = 0; e < 4; e += 2) {
                const f32x2_t r0 = {relu1(c0[4 * q + e]), relu1(c0[4 * q + e + 1])};
                const f32x2_t r1 = {relu1(c1[4 * q + e]), relu1(c1[4 * q + e + 1])};
                const f32x2_t w0 = {wv[0][q][e], wv[0][q][e + 1]}, w1 = {wv[1][q][e], wv[1][q][e + 1]};
                a0 = __builtin_elementwise_fma(r0, w0, a0); a1 = __builtin_elementwise_fma(r1, w1, a1); }
        float s0 = a0.x + a0.y, s1 = a1.x + a1.y;
        s0 += __shfl_xor(s0, 32); s1 += __shfl_xor(s1, 32);
        if (h2 == 0) { sc0[kt * 64 + 32 * sub + r32] = s0; sc1[kt * 64 + 32 * sub + r32] = s1; }
    }
}
DI void indexer_phase(const unsigned short* QI, const unsigned short* KI16, const float* WI, float* SC, LAS unsigned char* lds, int tid, int bid, int G) {
    const int lane = tid & 63, w = __builtin_amdgcn_readfirstlane(tid >> 6), r32 = lane & 31, h2 = lane >> 5;
    LAS unsigned char* buf0 = lds; LAS unsigned char* buf1 = lds + KT_BYTES;
    const int key0 = tid >> 4, ch = tid & 15;
    for (int v = bid; v < 256; v += G) {
        for (int it = 0; it < 4; ++it) {
            const int b = it >> 1, gi = (it & 1) ? (511 - v) : v; const int tb = 16 * gi;
            const int nt = ((tb + 15) >> 6) + 1;
            f16x8 af[2][8]; f32x4 wv[2][4];
#pragma unroll
            for (int tq = 0; tq < 2; ++tq) { const size_t tg = (size_t)b * SEQ + tb + 2 * w + tq;
#pragma unroll
                for (int ks = 0; ks < 8; ++ks) af[tq][ks] = *(const f16x8*)(QI + tg * 4096 + r32 * 128 + 16 * ks + 8 * h2);
#pragma unroll
                for (int q = 0; q < 4; ++q) wv[tq][q] = *(const f32x4*)(WI + tg * 32 + 8 * q + 4 * h2); }
            float* sc0 = SC + sc_row_off(b, tb + 2 * w); float* sc1 = SC + sc_row_off(b, tb + 2 * w + 1);
            const unsigned short* src = KI16 + (size_t)b * SEQ * 128 + (size_t)key0 * 128 + ch * 8;
            u32x4 a0, a1, b0 = {0u, 0u, 0u, 0u}, b1 = {0u, 0u, 0u, 0u};
            a0 = *(const u32x4*)src; a1 = *(const u32x4*)(src + 32 * 128);
            if (nt > 1) { b0 = *(const u32x4*)(src + 64 * 128); b1 = *(const u32x4*)(src + 96 * 128); }
            __syncthreads();
            *(LAS u32x4*)(buf0 + key0 * KT_ROWB + ch * 16) = a0; *(LAS u32x4*)(buf0 + (key0 + 32) * KT_ROWB + ch * 16) = a1;
            __syncthreads();
            for (int kt = 0; kt < nt; kt += 2) {
                if (kt + 2 < nt) { const unsigned short* p = src + (size_t)(kt + 2) * 64 * 128; a0 = *(const u32x4*)p; a1 = *(const u32x4*)(p + 32 * 128); }
                indexer_tile(buf0, af, wv, sc0, sc1, kt, r32, h2);
                if (kt + 1 < nt) { *(LAS u32x4*)(buf1 + key0 * KT_ROWB + ch * 16) = b0; *(LAS u32x4*)(buf1 + (key0 + 32) * KT_ROWB + ch * 16) = b1; }
                __syncthreads();
                if (kt + 1 >= nt) break;
                if (kt + 3 < nt) { const unsigned short* p = src + (size_t)(kt + 3) * 64 * 128; b0 = *(const u32x4*)p; b1 = *(const u32x4*)(p + 32 * 128); }
                indexer_tile(buf1, af, wv, sc0, sc1, kt + 1, r32, h2);
                if (kt + 2 < nt) { *(LAS u32x4*)(buf0 + key0 * KT_ROWB + ch * 16) = a0; *(LAS u32x4*)(buf0 + (key0 + 32) * KT_ROWB + ch * 16) = a1; }
                __syncthreads();
            }
        }
    }
}

DI unsigned mbcnt64(unsigned long long m) { return __builtin_amdgcn_mbcnt_hi((unsigned)(m >> 32), __builtin_amdgcn_mbcnt_lo((unsigned)m, 0u)); }
DI unsigned f2key(float f) { const unsigned u = __float_as_uint(f); return (u & 0x80000000u) ? ~u : (u | 0x80000000u); }
DI int wave_sum_i(int v) {
    v += __builtin_amdgcn_update_dpp(0, v, 0xB1, 0xF, 0xF, true);
    v += __builtin_amdgcn_update_dpp(0, v, 0x4E, 0xF, 0xF, true);
    v += __builtin_amdgcn_update_dpp(0, v, 0x141, 0xF, 0xF, true);
    v += __builtin_amdgcn_update_dpp(0, v, 0x140, 0xF, 0xF, true);
    return __builtin_amdgcn_readlane(v, 0) + __builtin_amdgcn_readlane(v, 16) + __builtin_amdgcn_readlane(v, 32) + __builtin_amdgcn_readlane(v, 48);
}
template <int NV>
DI void topk_row(const float* row, int s, LAS int* lst, int lane) {
    unsigned key[NV];
    { const unsigned long long ra = (unsigned long long)row; const unsigned rlo = __builtin_amdgcn_readfirstlane((unsigned)ra), rhi = __builtin_amdgcn_readfirstlane((unsigned)(ra >> 32));
      row = (const float*)(((unsigned long long)rhi << 32) | rlo); }
#pragma unroll
    for (int jo = 0; jo < NV / 16; ++jo) { const float* rb = row + jo * 1024;
#pragma unroll
        for (int ji = 0; ji < 16; ++ji) { const int j = jo * 16 + ji; const unsigned u = f2key(rb[ji * 64 + lane]); key[j] = (j * 64 + lane <= s) ? u : 0u; } }
    unsigned T = 0u;
#pragma unroll 1
    for (int bit = 31; bit >= 0; --bit) {
        const unsigned cand = T | (1u << bit); int c = 0;
#pragma unroll
        for (int j = 0; j < NV; ++j) asm volatile("v_cmp_le_u32 vcc, %2, %1\n\tv_addc_co_u32 %0, vcc, 0, %0, vcc" : "+v"(c) : "v"(key[j]), "s"(cand) : "vcc");
        if (wave_sum_i(c) >= 256) T = cand;
    }
    int bgt = 0;
#pragma unroll
    for (int j = 0; j < NV; ++j) { const bool sg = key[j] > T; const unsigned long long mg = __ballot(sg); if (sg) lst[bgt + (int)mbcnt64(mg)] = j * 64 + lane; bgt += __builtin_popcountll(mg); }
#pragma unroll
    for (int j = 0; j < NV; ++j) { const bool se = key[j] == T; const unsigned long long me = __ballot(se); const int pe = bgt + (int)mbcnt64(me); if (se && pe < 256) lst[pe] = j * 64 + lane; bgt += __builtin_popcountll(me); }
}
DI void topk_phase(const float* SC, unsigned short* IDX, LAS unsigned char* lds, int tid, int bid, int G) {
    const int lane = tid & 63, w = __builtin_amdgcn_readfirstlane(tid >> 6), gw = bid * NWAVES + w, nw = G * NWAVES;
    LAS int* lst = (LAS int*)(lds + w * 1024);
    for (int t = gw; t < MTOK; t += nw) {
        const int b = t >> 13, s = t & 8191; unsigned short* out = IDX + (size_t)t * 256;
        if (s < 256) {
#pragma unroll
            for (int i = 0; i < 4; ++i) { const int j = lane + 64 * i; out[j] = (unsigned short)((j <= s) ? j : 0); }
        } else {
            const float* row = SC + sc_row_off(b, s);
            if (s < 2048) topk_row<32>(row, s, lst, lane);
            else if (s < 4096) topk_row<64>(row, s, lst, lane);
            else if (s < 6144) topk_row<96>(row, s, lst, lane);
            else topk_row<128>(row, s, lst, lane);
#pragma unroll
            for (int i = 0; i < 4; ++i) out[lane + 64 * i] = (unsigned short)lst[lane + 64 * i];
        }
    }
}

typedef unsigned __attribute__((may_alias)) u32_alias_t;
constexpr int DSA_WB = 17408;
DI __amdgpu_buffer_rsrc_t kv_rsrc(const bf16_t* base) { return __builtin_amdgcn_make_buffer_rsrc((void*)base, 0, SEQ * 256, 0x00020000); }
DI __amdgpu_buffer_rsrc_t big_rsrc(const void* base, unsigned bytes) { return __builtin_amdgcn_make_buffer_rsrc((void*)base, 0, (int)bytes, 0x00020000); }
DI void dsa_attn_phase(const bf16_t* Q1, const bf16_t* K1, const bf16_t* V1, const unsigned short* IDX, bf16_t* AO, LAS unsigned char* lds, int tid, int bid, int G) {
    const int lane = tid & 63, w = __builtin_amdgcn_readfirstlane(tid >> 6), n = lane & 15, g4 = lane >> 4, q4 = n >> 2, p4 = n & 3;
    LAS unsigned char* vb = lds + w * DSA_WB; LAS unsigned short* il0 = (LAS unsigned short*)(vb + 16384); LAS unsigned short* il1 = il0 + 256;
    const bool xm = (G & 7) == 0;
    const int start = xm ? ((bid >> 3) * NWAVES + w) : (bid * NWAVES + w), step = xm ? ((G >> 3) * NWAVES) : (G * NWAVES), total = xm ? MTOK : MTOK * 8;
    const int tr_base = (4 * g4 + q4) * 256 + 8 * (p4 & 1);
    const int vvo = 16 * n;
    const __amdgpu_buffer_rsrc_t qr = big_rsrc(Q1, (unsigned)MTOK * 8192u), ir = big_rsrc(IDX, (unsigned)MTOK * 512u), orr = big_rsrc(AO, (unsigned)MTOK * 8192u);
    const int qlo = n * 256 + 16 * g4;
    const int olo = n * 256 + 8 * g4;
    LAS unsigned char* kwb[4]; LAS unsigned char* krb[4]; LAS unsigned char* trb[4];
#pragma unroll
    for (int j = 0; j < 4; ++j) { kwb[j] = vb + g4 * 256 + ((n ^ (4 * j + g4)) * 16);
                                  krb[j] = vb + n * 256 + (((4 * j + g4) ^ n) * 16);
                                  trb[j] = vb + tr_base + 32 * (j ^ q4) + 16 * (p4 >> 1); }
    LAS unsigned char* vwb = vb + g4 * 256 + ((n ^ (2 * g4)) * 16);
    int it = start;
    if (it >= total) return;
#define DSA_ITEM(itv, kvh_, t_) const int kvh_ = xm ? (bid & 7) : ((itv) & 7), t_ = xm ? (itv) : ((itv) >> 3)
    u32x4 vst[8], kst[16]; bf16x8 qf[4];
    {
        DSA_ITEM(it, kvh, t);
#pragma unroll
        for (int i = 0; i < 2; ++i) ((LAS u32_alias_t*)il0)[lane + 64 * i] = __builtin_amdgcn_raw_buffer_load_b32(ir, lane * 4 + 256 * i, t * 512, 0);
        const size_t slice = (size_t)((t >> 13) * 8 + kvh) * SEQ * 128;
        const __amdgpu_buffer_rsrc_t kr = kv_rsrc(K1 + slice), vr = kv_rsrc(V1 + slice);
#pragma unroll
        for (int ks = 0; ks < 4; ++ks) qf[ks] = (n < 4) ? __builtin_bit_cast(bf16x8, __builtin_amdgcn_raw_buffer_load_b128(qr, qlo + 64 * ks, t * 8192 + kvh * 1024, 0)) : (bf16x8){0, 0, 0, 0, 0, 0, 0, 0};
#pragma unroll
        for (int i = 0; i < 16; ++i) kst[i] = __builtin_amdgcn_raw_buffer_load_b128(kr, (int)il0[4 * i + g4] * 256 + vvo, 0, 0);
#pragma unroll
        for (int i = 0; i < 8; ++i) vst[i] = __builtin_amdgcn_raw_buffer_load_b128(vr, (int)il0[4 * i + g4] * 256 + vvo, 0, 0);
    }
    int par = 0;
    for (; it < total; it += step) {
        DSA_ITEM(it, kvh, t);
        LAS unsigned short* ilc = par ? il1 : il0; LAS unsigned short* iln = par ? il0 : il1;
        const bool has_next = (it + step) < total;
        DSA_ITEM(it + step, kvh2, t2);
        const int s = t & 8191; const int nvalid = s + 1 < 256 ? s + 1 : 256;
        const size_t slice = (size_t)((t >> 13) * 8 + kvh) * SEQ * 128;
        const __amdgpu_buffer_rsrc_t kr = kv_rsrc(K1 + slice), vr = kv_rsrc(V1 + slice);
        const size_t slice2 = (size_t)((t2 >> 13) * 8 + kvh2) * SEQ * 128;
        unsigned inext[2] = {0u, 0u};
        if (has_next) {
#pragma unroll
            for (int i = 0; i < 2; ++i) inext[i] = __builtin_amdgcn_raw_buffer_load_b32(ir, lane * 4 + 256 * i, t2 * 512, 0); }
        float mrun = -__builtin_inff(), lsum = 0.f;
        f32x4 o[8];
#pragma unroll
        for (int dt = 0; dt < 8; ++dt) o[dt] = (f32x4){0.f, 0.f, 0.f, 0.f};
#pragma unroll 1
        for (int c = 0; c < 4; ++c) {
#pragma unroll
            for (int i = 0; i < 16; ++i) *(LAS u32x4*)(kwb[i & 3] + i * 1024) = kst[i];
            if (c < 3) {
#pragma unroll
                for (int i = 0; i < 16; ++i) kst[i] = __builtin_amdgcn_raw_buffer_load_b128(kr, (int)ilc[(c + 1) * 64 + 4 * i + g4] * 256 + vvo, 0, 0);
            } else if (has_next) {
#pragma unroll
                for (int i = 0; i < 2; ++i) ((LAS u32_alias_t*)iln)[lane + 64 * i] = inext[i];
                const __amdgpu_buffer_rsrc_t kr2 = kv_rsrc(K1 + slice2);
#pragma unroll
                for (int i = 0; i < 16; ++i) kst[i] = __builtin_amdgcn_raw_buffer_load_b128(kr2, (int)iln[4 * i + g4] * 256 + vvo, 0, 0);
            }
            f32x4 sa[4];
#pragma unroll
            for (int tt = 0; tt < 4; ++tt) { f32x4 a = {0.f, 0.f, 0.f, 0.f};
#pragma unroll
                for (int ks = 0; ks < 4; ++ks) { const bf16x8 kf = *(const LAS bf16x8*)(krb[ks] + tt * 4096);
                    a = __builtin_amdgcn_mfma_f32_16x16x32_bf16(kf, qf[ks], a, 0, 0, 0); }
                sa[tt] = a; asm volatile("" ::: "memory"); }
            if (nvalid < 256) {
#pragma unroll
                for (int tt = 0; tt < 4; ++tt)
#pragma unroll
                    for (int j = 0; j < 4; ++j) { const int kk = 64 * c + 16 * tt + 4 * g4 + j; sa[tt][j] = (kk < nvalid) ? sa[tt][j] : -__builtin_inff(); }
            }
            float cm = fmaxf(fmaxf(fmaxf(sa[0][0], sa[0][1]), fmaxf(sa[0][2], sa[0][3])), fmaxf(fmaxf(sa[1][0], sa[1][1]), fmaxf(sa[1][2], sa[1][3])));
            cm = fmaxf(cm, fmaxf(fmaxf(fmaxf(sa[2][0], sa[2][1]), fmaxf(sa[2][2], sa[2][3])), fmaxf(fmaxf(sa[3][0], sa[3][1]), fmaxf(sa[3][2], sa[3][3]))));
            cm = fmaxf(cm, __shfl_xor(cm, 16)); cm = fmaxf(cm, __shfl_xor(cm, 32));
            const float mnew = fmaxf(mrun, cm); const float alpha = __builtin_amdgcn_exp2f((mrun - mnew) * SM_C); const float msc = mnew * SM_C; mrun = mnew;
            lsum *= alpha;
#pragma unroll
            for (int dt = 0; dt < 8; ++dt) o[dt] = o[dt] * alpha;
            unsigned pk[4][2];
#pragma unroll
            for (int tt = 0; tt < 4; ++tt) { float pp[4];
#pragma unroll
                for (int j = 0; j < 4; ++j) { pp[j] = __builtin_amdgcn_exp2f(sa[tt][j] * SM_C - msc); lsum += pp[j]; }
                pk[tt][0] = pg8::cvt_pk_bf16(pp[0], pp[1]); pk[tt][1] = pg8::cvt_pk_bf16(pp[2], pp[3]); }
            if (c == 3 && has_next) {
#pragma unroll
                for (int ks = 0; ks < 4; ++ks) qf[ks] = (n < 4) ? __builtin_bit_cast(bf16x8, __builtin_amdgcn_raw_buffer_load_b128(qr, qlo + 64 * ks, t2 * 8192 + kvh2 * 1024, 0)) : (bf16x8){0, 0, 0, 0, 0, 0, 0, 0};
            }
#pragma unroll
            for (int hf = 0; hf < 2; ++hf) {
#pragma unroll
                for (int i = 0; i < 8; ++i) *(LAS u32x4*)(vwb + i * 1024) = vst[i];
                if (hf == 0) {
#pragma unroll
                    for (int i = 0; i < 8; ++i) vst[i] = __builtin_amdgcn_raw_buffer_load_b128(vr, (int)ilc[c * 64 + 32 + 4 * i + g4] * 256 + vvo, 0, 0);
                } else if (c < 3) {
#pragma unroll
                    for (int i = 0; i < 8; ++i) vst[i] = __builtin_amdgcn_raw_buffer_load_b128(vr, (int)ilc[(c + 1) * 64 + 4 * i + g4] * 256 + vvo, 0, 0);
                } else if (has_next) {
                    const __amdgpu_buffer_rsrc_t vr2 = kv_rsrc(V1 + slice2);
#pragma unroll
                    for (int i = 0; i < 8; ++i) vst[i] = __builtin_amdgcn_raw_buffer_load_b128(vr2, (int)iln[4 * i + g4] * 256 + vvo, 0, 0);
                }
                u32x4 pw; pw.x = pk[2 * hf][0]; pw.y = pk[2 * hf][1]; pw.z = pk[2 * hf + 1][0]; pw.w = pk[2 * hf + 1][1];
                const bf16x8 pf = __builtin_bit_cast(bf16x8, pw);
#pragma unroll
                for (int dt = 0; dt < 8; ++dt) {
                    const s16x4 lo = __builtin_amdgcn_ds_read_tr16_b64_v4i16((LAS s16x4*)(trb[dt & 3] + 128 * (dt >> 2)));
                    const s16x4 hi = __builtin_amdgcn_ds_read_tr16_b64_v4i16((LAS s16x4*)(trb[dt & 3] + 128 * (dt >> 2) + 16 * 256));
                    const bf16x8 vf = __builtin_shufflevector(lo, hi, 0, 1, 2, 3, 4, 5, 6, 7);
                    o[dt] = __builtin_amdgcn_mfma_f32_16x16x32_bf16(vf, pf, o[dt], 0, 0, 0);
                    if (dt & 1) asm volatile("" ::: "memory");
                }
            }
        }
        lsum += __shfl_xor(lsum, 16); lsum += __shfl_xor(lsum, 32);
        if (n < 4) { const float li = 1.0f / lsum;
#pragma unroll
            for (int dt = 0; dt < 8; ++dt) { u32x2 wv; wv.x = pg8::cvt_pk_bf16(o[dt][0] * li, o[dt][1] * li); wv.y = pg8::cvt_pk_bf16(o[dt][2] * li, o[dt][3] * li);
                __builtin_amdgcn_raw_buffer_store_b64(wv, orr, olo + 32 * dt, t * 8192 + kvh * 1024, 0); } }
        par ^= 1;
    }
#undef DSA_ITEM
}

#ifndef MK_ONE_LAUNCH
#define MK_ONE_LAUNCH 1
#endif
constexpr int N_PHASES = 19;
#ifndef WGM_F
#define WGM_F 8
#endif
#ifndef WGM_Y
#define WGM_Y 2
#endif
struct Args { const float* in[22]; float* out; unsigned char* ws; int ph_lo, ph_hi; };

__global__ void __launch_bounds__(NTHR, 2) mk_fwd(Args args) {
    extern __shared__ __attribute__((aligned(16))) unsigned char lds_raw[];
    LAS unsigned char* lds = (LAS unsigned char*)lds_raw;
    const int tid = threadIdx.x, bid = blockIdx.x, G = gridDim.x;
    unsigned char* ws = args.ws;
    const __attribute__((address_space(4))) unsigned char* kargs = (const __attribute__((address_space(4))) unsigned char*)__builtin_amdgcn_kernarg_segment_ptr();
#define ARG_IN(i) (*(const float* const volatile __attribute__((address_space(4)))*)(kargs + 8 * (i)))
    volatile LAS unsigned* misc = (volatile LAS unsigned*)(lds + MISC_OFF);
    if (tid < 4) misc[tid] = 0u;
    __syncthreads();
    const int lo = args.ph_lo, hi = args.ph_hi;
    XcdBarrier bar; bar.bar = (unsigned*)(ws + WS_CTL); bar.x = 0; bar.st = nullptr;
    if (hi - lo > 1) bar = xcd_barrier_post((unsigned*)(ws + WS_CTL), misc);
#ifndef PH_MASK
#define PH_MASK 0x7ffff
#endif
#define IN(k) ((((PH_MASK) >> (k)) & 1) && lo <= (k) && (k) < hi)
#ifndef PROBE_PH
#define PROBE_PH -1
#endif
#ifndef PROBE_PH2
#define PROBE_PH2 -1
#endif
    unsigned long long pr_t0 = (PROBE_PH == 0) ? __builtin_amdgcn_s_memrealtime() : 0ull, pr_acc = 0ull;
#define SEAM(k) do { if (IN(k) && IN((k) + 1)) xcd_barrier(bar); \
        if (PROBE_PH >= 0 && bid == 0) { const unsigned long long now_ = __builtin_amdgcn_s_memrealtime(); if ((k) + 1 == PROBE_PH) pr_t0 = now_; if ((k) == (PROBE_PH2 >= 0 ? PROBE_PH2 : PROBE_PH)) pr_acc = now_ - pr_t0; } } while (0)
#ifndef DUP_MASK
#define DUP_MASK 0
#endif
#define REP(k) _Pragma("unroll 1") for (int rep_ = 0; rep_ < ((((DUP_MASK) >> (k)) & 1) ? 2 : 1); ++rep_)

    float* CS = (float*)(ws + WS_COS); float* SN = (float*)(ws + WS_SIN);
    bf16_t* XB = (bf16_t*)(ws + WS_XB); float* XA = (float*)(ws + WS_XA); float* Y = (float*)(ws + B_Y); bf16_t* Hh = (bf16_t*)(ws + B_H);
    float* OUT = args.out;
    const pg8::RopeTab rt{CS, SN};

    if (IN(0)) REP(0) {
        LAS float* scr = (LAS float*)lds;
        wt_matrix(ARG_IN(2), DM, N_A, (bf16_t*)(ws + W0IN), MapA{}, scr, tid, bid, G);
        wt_matrix(ARG_IN(3), 2048, DM, (bf16_t*)(ws + W0OUT), MapId{}, scr, tid, bid, G);
        wt_matrix(ARG_IN(10), DM, DFF, (bf16_t*)(ws + W0GU), MapGU{0}, scr, tid, bid, G);
        wt_matrix(ARG_IN(11), DM, DFF, (bf16_t*)(ws + W0GU), MapGU{1}, scr, tid, bid, G);
        wt_matrix(ARG_IN(12), DFF, DM, (bf16_t*)(ws + W0DN), MapId{}, scr, tid, bid, G);
        cvt_x_phase(ARG_IN(0), XB, tid, bid, G);
        rope_tab_phase((const int*)ARG_IN(1), CS, SN, tid, bid, G);
    }
    SEAM(0);
    if (IN(1)) REP(1) {
        pg8::Gemm g{XB, (const bf16_t*)(ws + W0IN), MTOK, N_A, DM}; pg8::StaticOrder S; S.init(MTOK, N_A, G, bid);
        pg8::EpiQKV0 E{(bf16_t*)(ws + B_QKV0), rt};
        pg8::gemm_phase<pg8::EpiQKV0, pg8::StaticOrder, true, true>(lds, g, S, E);
    }
    SEAM(1);
    if (IN(2)) REP(2) attn0_phase((const bf16_t*)(ws + B_QKV0), (bf16_t*)(ws + B_OG), (float*)(ws + B_LSE), lds, tid, bid, G);
    SEAM(2);
    if (IN(3)) REP(3) merge_phase((const bf16_t*)(ws + B_OG), (const float*)(ws + B_LSE), (bf16_t*)(ws + B_AO0), tid, bid, G);
    SEAM(3);
    if (IN(4)) REP(4) {
        pg8::Gemm g{(const bf16_t*)(ws + B_AO0), (const bf16_t*)(ws + W0OUT), MTOK, DM, 2048}; pg8::StaticOrder S; S.init(MTOK, DM, G, bid, WGM_Y);
        pg8::EpiY E{ARG_IN(0), Y, DM, ALPHA};
        pg8::gemm_phase<pg8::EpiY, pg8::StaticOrder, true, true>(lds, g, S, E);
    }
    SEAM(4);
    if (IN(5)) REP(5) ln_phase(Y, ARG_IN(8), ARG_IN(9), OUT, XB, tid, bid, G);
    SEAM(5);
    if (IN(6)) REP(6) {
        pg8::Gemm g{XB, (const bf16_t*)(ws + W0GU), MTOK, 2 * DFF, DM}; pg8::StaticOrder S; S.init(MTOK, 2 * DFF, G, bid, WGM_F);
        pg8::EpiSwiGLU E{Hh, DFF};
        pg8::gemm_phase<pg8::EpiSwiGLU, pg8::StaticOrder, true, true>(lds, g, S, E);
    }
    SEAM(6);
    if (IN(7)) REP(7) {
        pg8::Gemm g{Hh, (const bf16_t*)(ws + W0DN), MTOK, DM, DFF}; pg8::StaticOrder S; S.init(MTOK, DM, G, bid, WGM_Y);
        pg8::EpiY E{OUT, Y, DM, ALPHA};
        pg8::gemm_phase<pg8::EpiY, pg8::StaticOrder, true, true>(lds, g, S, E);
    }
    SEAM(7);
    if (IN(8)) REP(8) {
        ln_phase(Y, ARG_IN(13), ARG_IN(14), XA, XB, tid, bid, G);
        LAS float* scr = (LAS float*)lds;
        wt_matrix(ARG_IN(4), DM, N_B, (bf16_t*)(ws + W1IN), MapB{}, scr, tid, bid, G);
        { u32x4* z = (u32x4*)(ws + W1IN + (size_t)N_B * DM * 2); const int nz = (N_BP - N_B) * DM * 2 / 16; for (int i = bid * NTHR + tid; i < nz; i += G * NTHR) z[i] = (u32x4){0u, 0u, 0u, 0u}; }
        wt_matrix(ARG_IN(7), DM, DM, (bf16_t*)(ws + W1OUT), MapId{}, scr, tid, bid, G);
        wt_matrix(ARG_IN(17), DM, DFF, (bf16_t*)(ws + W1GU), MapGU{0}, scr, tid, bid, G);
        wt_matrix(ARG_IN(18), DM, DFF, (bf16_t*)(ws + W1GU), MapGU{1}, scr, tid, bid, G);
        wt_matrix(ARG_IN(19), DFF, DM, (bf16_t*)(ws + W1DN), MapId{}, scr, tid, bid, G);
    }
    SEAM(8);
    if (IN(9)) REP(9) {
        pg8::Gemm g{XB, (const bf16_t*)(ws + W1IN), MTOK, N_BP, DM}; pg8::StaticOrder S; S.init(MTOK, N_BP, G, bid);
        pg8::EpiQKV1 E{(bf16_t*)(ws + B_Q1), (bf16_t*)(ws + B_K1), (bf16_t*)(ws + B_V1), (unsigned short*)(ws + B_QI), (float*)(ws + B_KIR), (float*)(ws + B_WI), rt};
        pg8::gemm_phase<pg8::EpiQKV1, pg8::StaticOrder, true, true>(lds, g, S, E);
    }
    SEAM(9);
    if (IN(10)) REP(10) kidx_phase((const float*)(ws + B_KIR), ARG_IN(5), ARG_IN(6), CS, SN, (unsigned short*)(ws + B_KI16), tid, bid, G);
    SEAM(10);
    if (IN(11)) REP(11) indexer_phase((const unsigned short*)(ws + B_QI), (const unsigned short*)(ws + B_KI16), (const float*)(ws + B_WI), (float*)(ws + B_SC), lds, tid, bid, G);
    SEAM(11);
    if (IN(12)) REP(12) topk_phase((const float*)(ws + B_SC), (unsigned short*)(ws + B_IDX), lds, tid, bid, G);
    SEAM(12);
    if (IN(13)) REP(13) dsa_attn_phase((const bf16_t*)(ws + B_Q1), (const bf16_t*)(ws + B_K1), (const bf16_t*)(ws + B_V1), (const unsigned short*)(ws + B_IDX), (bf16_t*)(ws + B_AO1), lds, tid, bid, G);
    SEAM(13);
    if (IN(14)) REP(14) {
        pg8::Gemm g{(const bf16_t*)(ws + B_AO1), (const bf16_t*)(ws + W1OUT), MTOK, DM, DM}; pg8::StaticOrder S; S.init(MTOK, DM, G, bid, WGM_Y);
        pg8::EpiY E{XA, Y, DM, ALPHA};
        pg8::gemm_phase<pg8::EpiY, pg8::StaticOrder, true, true>(lds, g, S, E);
    }
    SEAM(14);
    if (IN(15)) REP(15) ln_phase(Y, ARG_IN(15), ARG_IN(16), OUT, XB, tid, bid, G);
    SEAM(15);
    if (IN(16)) REP(16) {
        pg8::Gemm g{XB, (const bf16_t*)(ws + W1GU), MTOK, 2 * DFF, DM}; pg8::StaticOrder S; S.init(MTOK, 2 * DFF, G, bid, WGM_F);
        pg8::EpiSwiGLU E{Hh, DFF};
        pg8::gemm_phase<pg8::EpiSwiGLU, pg8::StaticOrder, true, true>(lds, g, S, E);
    }
    SEAM(16);
    if (IN(17)) REP(17) {
        pg8::Gemm g{Hh, (const bf16_t*)(ws + W1DN), MTOK, DM, DFF}; pg8::StaticOrder S; S.init(MTOK, DM, G, bid, WGM_Y);
        pg8::EpiY E{OUT, Y, DM, ALPHA};
        pg8::gemm_phase<pg8::EpiY, pg8::StaticOrder, true, true>(lds, g, S, E);
    }
    SEAM(17);
    if (IN(18)) REP(18) ln_phase(Y, ARG_IN(20), ARG_IN(21), OUT, nullptr, tid, bid, G);
    if (PROBE_PH >= 0 && bid == 0) { const unsigned long long t1_ = __builtin_amdgcn_s_memrealtime(); while (__builtin_amdgcn_s_memrealtime() - t1_ < pr_acc) __builtin_amdgcn_s_sleep(8); }
#undef IN
#undef ARG_IN
#undef SEAM
#undef REP
}

extern "C" void kernel_launch(void* const* d_in, const int* in_sizes, int n_in, void* d_out, int out_size, void* d_ws, size_t ws_size, hipStream_t stream) {
    static int grid = 0;
    if (grid == 0) {
        if (n_in != 22 || out_size != MTOK * DM || ws_size < WS_END) { fprintf(stderr, "kernel_launch: unexpected problem (n_in %d, out %d, ws %zu < %zu); nothing launched\n", n_in, out_size, ws_size, (size_t)WS_END); grid = -1; return; }
        int dev = 0, cus = 0, per_cu = 0;
        if (hipGetDevice(&dev) != hipSuccess || hipDeviceGetAttribute(&cus, hipDeviceAttributeMultiprocessorCount, dev) != hipSuccess) { grid = -1; return; }
        if (hipFuncSetAttribute((const void*)mk_fwd, hipFuncAttributeMaxDynamicSharedMemorySize, LDS_BYTES) != hipSuccess) { fprintf(stderr, "kernel_launch: hipFuncSetAttribute failed\n"); grid = -1; return; }
        if (hipOccupancyMaxActiveBlocksPerMultiprocessor(&per_cu, (const void*)mk_fwd, NTHR, LDS_BYTES) != hipSuccess || per_cu < 1) { fprintf(stderr, "kernel_launch: occupancy query reports %d\n", per_cu); (void)hipGetLastError(); per_cu = 1; }
        grid = cus;
    }
    if (grid < 0) return;
    (void)in_sizes;
    if (hipMemsetAsync((char*)d_ws + WS_CTL, 0, CTL_ZERO_BYTES, stream) != hipSuccess) return;
    Args a{};
    for (int i = 0; i < 22; ++i) a.in[i] = (const float*)d_in[i];
    a.out = (float*)d_out; a.ws = (unsigned char*)d_ws;
#if MK_ONE_LAUNCH
    a.ph_lo = 0; a.ph_hi = N_PHASES;
    hipLaunchKernelGGL(mk_fwd, dim3(grid), dim3(NTHR), LDS_BYTES, stream, a);
#else
    for (int p = 0; p < N_PHASES; ++p) { a.ph_lo = p; a.ph_hi = p + 1; hipLaunchKernelGGL(mk_fwd, dim3(grid), dim3(NTHR), LDS_BYTES, stream, a); }
#endif
}
```

```cpp
#include <hip/hip_runtime.h>
#include <cstdio>
#include <cstdint>
namespace pg8 {
#define PG8_LAS __attribute__((address_space(3)))
typedef unsigned short bf16_t;
typedef short bf16x8 __attribute__((ext_vector_type(8)));
typedef float f32x4 __attribute__((ext_vector_type(4)));
typedef unsigned u32x4 __attribute__((ext_vector_type(4)));
constexpr int BM = 256, BK = 64, HALF = 128, HTB = HALF * BK * 2  , STAGE_BYTES = 8 * HTB, NXCD = 8, WGM = 8;

__host__ __device__ __forceinline__ int lds_byte(int r, int c) { const int st = (r >> 4) * 2 + (c >> 5), rr = r & 15, cc = c & 31, ob = rr * 64 + cc * 2; return st * 1024 + (ob ^ (((ob >> 9) & 1) << 5)); }
__host__ __device__ __forceinline__ void stage_rc(int b, int& R, int& C) { const int st = b / 1024, sb = b % 1024, swz = sb ^ (((sb >> 9) & 1) << 5); R = (st >> 1) * 16 + swz / 64; C = (st & 1) * 32 + (swz % 64) / 2; }
__host__ __device__ __forceinline__ int perm32(int rho) { const int n = rho >> 4, i = rho & 15; return 8 * (i >> 2) + 4 * n + (i & 3); }

struct Unit { int pm, pn; };
struct Gemm { const bf16_t* A; const bf16_t* Bt; int M, N, K; };

struct StaticOrder {
    int nM, nN, nwg, G, c, wgm;
    __host__ __device__ void init(int M, int N, int G_, int c_, int wgm_ = WGM) { nM = M / BM; nN = N / BM; nwg = nM * nN; G = G_; c = c_; wgm = wgm_; }
    __host__ __device__ bool next(int i, Unit& u) const {
        const long L = (long)i * G + c; if (L >= nwg) return false;
        int wgid = (int)L; { const int q = nwg / NXCD, r = nwg % NXCD, xcd = wgid % NXCD, off = wgid / NXCD; wgid = (xcd < r ? xcd * (q + 1) : r * (q + 1) + (xcd - r) * q) + off; }
        const int nig = wgm * nN, gid = wgid / nig, fm = gid * wgm, gsz = (nM - fm) < wgm ? (nM - fm) : wgm;
        u.pm = fm + ((wgid % nig) % gsz); u.pn = (wgid % nig) / gsz; return true;
    }
    __device__ __forceinline__ void a_ready(const Unit&) const {}
    __device__ __forceinline__ void done(const Unit&) const {}
};
__device__ __forceinline__ unsigned cvt_pk_bf16(float lo, float hi) { unsigned r; asm volatile("v_cvt_pk_bf16_f32 %0, %1, %2" : "=v"(r) : "v"(lo), "v"(hi)); return r; }
typedef _Float16 f16x2_t __attribute__((ext_vector_type(2)));
__device__ __forceinline__ unsigned cvt_pk_f16(float lo, float hi) { f16x2_t h; h.x = (_Float16)lo; h.y = (_Float16)hi; return __builtin_bit_cast(unsigned, h); }

struct RopeTab { const float* cs; const float* sn; };

__device__ __forceinline__ void rope_pair(f32x4& v0, f32x4& v1, const f32x4 c, const f32x4 s) {
    const f32x4 a = v0 * c - v1 * s, b = v1 * c + v0 * s; v0 = a; v1 = b;
}

typedef float f32x2_t __attribute__((ext_vector_type(2)));
typedef unsigned u32x2e_t __attribute__((ext_vector_type(2)));
typedef _Float16 f16x4_t __attribute__((ext_vector_type(4)));
__device__ __forceinline__ f32x4 f16x4_to_f32(u32x2e_t w) { return __builtin_convertvector(__builtin_bit_cast(f16x4_t, w), f32x4); }
template <bool XH = true> struct EpiY {
    static constexpr bool PERM = false, AFTER_DRAIN = false;
    __amdgpu_buffer_rsrc_t X, Y; float alpha, scl;
    __device__ __forceinline__ void operator()(const f32x4 (&acc)[2][2][4][2], const Unit& u, int wr, int wc, int fr, int fq) const {
        const int row0 = u.pm * BM + wr * 64 + fr, col0 = u.pn * BM + wc * 32 + 4 * fq;
#pragma unroll
        for (int ai = 0; ai < 2; ++ai) {
            f32x4 xv[4][2][2];
#pragma unroll
            for (int m = 0; m < 4; ++m) { const int off = ((row0 + ai * HALF + m * 16) * 4096 + col0) * 2;
#pragma unroll
                for (int bj = 0; bj < 2; ++bj)
#pragma unroll
                    for (int n = 0; n < 2; ++n) {
                        if constexpr (XH) xv[m][bj][n] = f16x4_to_f32(__builtin_bit_cast(u32x2e_t, __builtin_amdgcn_raw_buffer_load_b64(X, off + (bj * HALF + n * 16) * 2, 0, 0)));
                        else xv[m][bj][n] = __builtin_bit_cast(f32x4, __builtin_amdgcn_raw_buffer_load_b128(X, 2 * off + (bj * HALF + n * 16) * 4, 0, 0)); } }
#pragma unroll
            for (int m = 0; m < 4; ++m) { const int off = ((row0 + ai * HALF + m * 16) * 4096 + col0) * 2;
#pragma unroll
                for (int bj = 0; bj < 2; ++bj)
#pragma unroll
                    for (int n = 0; n < 2; ++n) { const f32x4 r = xv[m][bj][n] * alpha + acc[ai][bj][m][n] * scl;
                        u32x2e_t w; w.x = cvt_pk_f16(r[0], r[1]); w.y = cvt_pk_f16(r[2], r[3]);
                        __builtin_amdgcn_raw_buffer_store_b64(w, Y, off + (bj * HALF + n * 16) * 2, 0, 0); } }
            asm volatile("" ::: "memory"); }
    }
};

template <bool OUT8 = false> struct EpiSwiGLU {
    static constexpr bool PERM = true, AFTER_DRAIN = false;
    bf16_t* Hh; int ldh;
    __device__ __forceinline__ void operator()(const f32x4 (&acc)[2][2][4][2], const Unit& u, int wr, int wc, int fr, int fq) const {
        const int row0 = u.pm * BM + wr * 64 + fr, col0 = u.pn * HALF + wc * 32 + 8 * fq;
#pragma unroll
        for (int ai = 0; ai < 2; ++ai)
#pragma unroll
            for (int m = 0; m < 4; ++m) { const size_t eoff = (size_t)(row0 + ai * HALF + m * 16) * ldh + col0;
                float h[8];
#pragma unroll
                for (int n = 0; n < 2; ++n)
#pragma unroll
                    for (int i = 0; i < 4; ++i) { const float g = acc[ai][0][m][n][i], up = acc[ai][1][m][n][i];
                        const float e = __builtin_amdgcn_exp2f(-g * 1.44269504089f); h[n * 4 + i] = g * __builtin_amdgcn_rcpf(1.0f + e) * up; }
                if constexpr (OUT8) { int w0 = __builtin_amdgcn_cvt_pk_fp8_f32(h[0] * 16.f, h[1] * 16.f, 0, false); w0 = __builtin_amdgcn_cvt_pk_fp8_f32(h[2] * 16.f, h[3] * 16.f, w0, true);
                    int w1 = __builtin_amdgcn_cvt_pk_fp8_f32(h[4] * 16.f, h[5] * 16.f, 0, false); w1 = __builtin_amdgcn_cvt_pk_fp8_f32(h[6] * 16.f, h[7] * 16.f, w1, true);
                    typedef int i32x2_t __attribute__((ext_vector_type(2))); *(i32x2_t*)((unsigned char*)Hh + eoff) = (i32x2_t){w0, w1}; }
                else { u32x4 w; w.x = cvt_pk_bf16(h[0], h[1]); w.y = cvt_pk_bf16(h[2], h[3]); w.z = cvt_pk_bf16(h[4], h[5]); w.w = cvt_pk_bf16(h[6], h[7]);
                    *(u32x4*)(Hh + eoff) = w; } }
    }
};

struct EpiQKV0 {
    static constexpr bool PERM = true, AFTER_DRAIN = false;
    __amdgpu_buffer_rsrc_t o, cs, sn; float scl;
    __device__ __forceinline__ void operator()(const f32x4 (&acc)[2][2][4][2], const Unit& u, int wr, int wc, int fr, int fq) const {
        const int sg = u.pn >> 3, cw = wc * 32 + 8 * fq, hd0 = (u.pn & 7) * 2; const bool rope = sg < 6;
        const int dsh = 2 * (sg % 3);
        const int row0 = u.pm * BM + wr * 64 + fr, f0 = 16 * wc + 4 * fq;
        const int bb = u.pm >> 5;
        const unsigned sbase = (unsigned)(((sg * 2 + bb) * 16 + hd0) * 8192) * 128u;
#pragma unroll
        for (int ai = 0; ai < 2; ++ai)
#pragma unroll
            for (int m = 0; m < 4; ++m) { const int row = row0 + ai * HALF + m * 16; const int si = row & 8191;
                const int rl = (si & ((1 << dsh) - 1)) * (8192 >> dsh) + (si >> dsh);
                f32x4 c = {1.f, 1.f, 1.f, 1.f}, s = {0.f, 0.f, 0.f, 0.f};
                if (rope) { c = __builtin_bit_cast(f32x4, __builtin_amdgcn_raw_buffer_load_b128(cs, (row * 64 + f0) * 4, 0, 0)); s = __builtin_bit_cast(f32x4, __builtin_amdgcn_raw_buffer_load_b128(sn, (row * 64 + f0) * 4, 0, 0)); }
#pragma unroll
                for (int bj = 0; bj < 2; ++bj) { f32x4 v0 = acc[ai][bj][m][0] * scl, v1 = acc[ai][bj][m][1] * scl;
                    rope_pair(v0, v1, c, s);
                    int w0 = __builtin_amdgcn_cvt_pk_fp8_f32(v0[0], v0[1], 0, false); w0 = __builtin_amdgcn_cvt_pk_fp8_f32(v0[2], v0[3], w0, true);
                    int w1 = __builtin_amdgcn_cvt_pk_fp8_f32(v1[0], v1[1], 0, false); w1 = __builtin_amdgcn_cvt_pk_fp8_f32(v1[2], v1[3], w1, true);
                    typedef unsigned u32x2_t __attribute__((ext_vector_type(2)));
                    __builtin_amdgcn_raw_buffer_store_b64((u32x2_t){(unsigned)w0, (unsigned)w1}, o, rl * 128 + cw, (int)(sbase + (unsigned)bj * (8192u * 128u)), 0); } }
    }
};

struct EpiQKV1a {
    static constexpr bool PERM = true, AFTER_DRAIN = false;
    __amdgpu_buffer_rsrc_t q, k, v, cs, sn; float scl;
    __device__ __forceinline__ void operator()(const f32x4 (&acc)[2][2][4][2], const Unit& u, int wr, int wc, int fr, int fq) const {
        const int pn = u.pn; const int row0 = u.pm * BM + wr * 64 + fr, f0 = 16 * wc + 4 * fq, cw = wc * 32 + 8 * fq;
        const bool rope = pn < 20;
#pragma unroll
        for (int ai = 0; ai < 2; ++ai)
#pragma unroll
            for (int m = 0; m < 4; ++m) { const int row = row0 + ai * HALF + m * 16;
                f32x4 c = {1.f, 1.f, 1.f, 1.f}, s = {0.f, 0.f, 0.f, 0.f};
                if (rope) { c = __builtin_bit_cast(f32x4, __builtin_amdgcn_raw_buffer_load_b128(cs, (row * 64 + f0) * 4, 0, 0)); s = __builtin_bit_cast(f32x4, __builtin_amdgcn_raw_buffer_load_b128(sn, (row * 64 + f0) * 4, 0, 0)); }
#pragma unroll
                for (int bj = 0; bj < 2; ++bj) { f32x4 v0 = acc[ai][bj][m][0] * scl, v1 = acc[ai][bj][m][1] * scl;
                    rope_pair(v0, v1, c, s);
                    u32x4 w; w.x = cvt_pk_bf16(v0[0], v0[1]); w.y = cvt_pk_bf16(v0[2], v0[3]); w.z = cvt_pk_bf16(v1[0], v1[1]); w.w = cvt_pk_bf16(v1[2], v1[3]);
                    if (pn < 16) __builtin_amdgcn_raw_buffer_store_b128(w, q, (row * 4096 + bj * HALF + cw) * 2, pn * 512, 0);
                    else { const int kvh = ((pn - 16) & 3) * 2 + bj; const int off = ((((row >> 13) * 8 + kvh) * 8192 + (row & 8191)) * 128 + cw) * 2;
                        if (pn < 20) __builtin_amdgcn_raw_buffer_store_b128(w, k, off, 0, 0); else __builtin_amdgcn_raw_buffer_store_b128(w, v, off, 0, 0); } } }
    }
};

struct EpiQKV1 {
    static constexpr bool PERM = true, AFTER_DRAIN = false;
    bf16_t* Q; bf16_t* Kc; bf16_t* Vc; unsigned short* QI; float* KIR; float* WI; RopeTab rt; int pn_off; float scl;
    __device__ __forceinline__ void operator()(const f32x4 (&acc)[2][2][4][2], const Unit& u, int wr, int wc, int fr, int fq) const {
        const int pn = u.pn + pn_off; const int row0 = u.pm * BM + wr * 64 + fr, f0 = 16 * wc + 4 * fq, cw = wc * 32 + 8 * fq;
        const bool rope = (pn < 20) || (pn >= 24 && pn < 40);
#pragma unroll
        for (int ai = 0; ai < 2; ++ai)
#pragma unroll
            for (int m = 0; m < 4; ++m) { const int row = row0 + ai * HALF + m * 16;
                f32x4 c = {1.f, 1.f, 1.f, 1.f}, s = {0.f, 0.f, 0.f, 0.f};
                if (rope) { c = *(const f32x4*)(rt.cs + (size_t)row * 64 + f0); s = *(const f32x4*)(rt.sn + (size_t)row * 64 + f0); }
#pragma unroll
                for (int bj = 0; bj < 2; ++bj) { f32x4 v0 = acc[ai][bj][m][0] * scl, v1 = acc[ai][bj][m][1] * scl;
                    if (pn < 40) {
                        rope_pair(v0, v1, c, s);
                        u32x4 w;
                        if (pn >= 24) { w.x = cvt_pk_f16(v0[0], v0[1]); w.y = cvt_pk_f16(v0[2], v0[3]); w.z = cvt_pk_f16(v1[0], v1[1]); w.w = cvt_pk_f16(v1[2], v1[3]); }
                        else { w.x = cvt_pk_bf16(v0[0], v0[1]); w.y = cvt_pk_bf16(v0[2], v0[3]); w.z = cvt_pk_bf16(v1[0], v1[1]); w.w = cvt_pk_bf16(v1[2], v1[3]); }
                        if (pn < 16) *(u32x4*)(Q + (size_t)row * 4096 + pn * BM + bj * HALF + cw) = w;
                        else if (pn < 24) { const int kvh = ((pn - 16) & 3) * 2 + bj; bf16_t* dst = (pn < 20 ? Kc : Vc) + ((size_t)((row >> 13) * 8 + kvh) * 8192 + (row & 8191)) * 128 + cw; *(u32x4*)dst = w; }
                        else *(u32x4*)(QI + (size_t)row * 4096 + (pn - 24) * BM + bj * HALF + cw) = w;
                    } else {
                        if (bj == 0) { *(f32x4*)(KIR + (size_t)row * 128 + cw) = v0; *(f32x4*)(KIR + (size_t)row * 128 + cw + 4) = v1; }
                        else if (wc == 0) { *(f32x4*)(WI + (size_t)row * 32 + cw) = v0 * 0.015625f; *(f32x4*)(WI + (size_t)row * 32 + cw + 4) = v1 * 0.015625f; }
                    } } }
    }
};

typedef int i32x4_t __attribute__((ext_vector_type(4)));
typedef int i32x8_t __attribute__((ext_vector_type(8)));
__device__ __forceinline__ i32x8_t cat8(bf16x8 a, bf16x8 b) { return __builtin_shufflevector(__builtin_bit_cast(i32x4_t, a), __builtin_bit_cast(i32x4_t, b), 0, 1, 2, 3, 4, 5, 6, 7); }
template <class Epi, class Sched, bool ALIGN_EPI = false, bool SP2 = false, bool FP8 = false, int WSH = 6>
__device__ __forceinline__ void gemm_phase(PG8_LAS unsigned char* lds, const Gemm g, const Sched& S, const Epi& E, const int tid) {
    const int wid = __builtin_amdgcn_readfirstlane(tid >> 6), lane = tid & 63, wr = wid >> 2, wc = wid & 3, fr = lane & 15, fq = lane >> 4;
    const int K = g.K, nt = K / BK;
    unsigned voffA[2], voffB[2];
#pragma unroll
    for (int i = 0; i < 2; ++i) { int R, C; stage_rc(tid * 16 + i * 8192, R, C); const int Rb = Epi::PERM ? ((R & ~31) + perm32(R & 31)) : R;
        voffA[i] = (unsigned)(R * K + C) * 2u; voffB[i] = (unsigned)(Rb * K + C) * 2u; }
    const size_t kstep = (size_t)(BK * 2);
    const size_t hstep = (size_t)HALF * K * 2;
    const size_t tstep = 2 * hstep;
    const unsigned ldsw = (unsigned)wid * 1024u;
    const int aoff = lds_byte(wr * 64 + fr, fq * 8), boff = lds_byte(wc * 32 + fr, fq * 8);
#define PG8_SA(b, h) (((b) * 2 + (h)) * HTB)
#define PG8_SB(b, h) ((4 + (b) * 2 + (h)) * HTB)
#define PG8_STAGE(bufoff, gbase, voff) do { const char* gb_ = (const char*)(gbase); \
        { const unsigned long long gq_ = (unsigned long long)gb_; gb_ = (const char*)(((unsigned long long)(unsigned)__builtin_amdgcn_readfirstlane((int)(gq_ >> 32)) << 32) | (unsigned)__builtin_amdgcn_readfirstlane((int)gq_)); }   \
        _Pragma("unroll") for (int _i = 0; _i < 2; ++_i) \
        __builtin_amdgcn_global_load_lds((const unsigned*)(gb_ + (voff)[_i]), (PG8_LAS unsigned*)(lds + (bufoff) + ldsw + _i * 8192), 16, 0, 0); } while (0)
#define PG8_LDA(dst, b, h) do { _Pragma("unroll") for (int m = 0; m < 4; ++m) { if constexpr (FP8) dst##8[m] = cat8(*(const PG8_LAS bf16x8*)(lds + PG8_SA(b, h) + aoff + m * 2048), *(const PG8_LAS bf16x8*)(lds + PG8_SA(b, h) + aoff + m * 2048 + 1024)); \
        else { _Pragma("unroll") for (int k = 0; k < 2; ++k) dst[m][k] = *(const PG8_LAS bf16x8*)(lds + PG8_SA(b, h) + aoff + m * 2048 + k * 1024); } } } while (0)
#define PG8_LDB(dst, b, h) do { _Pragma("unroll") for (int n = 0; n < 2; ++n) { if constexpr (FP8) dst##8[n] = cat8(*(const PG8_LAS bf16x8*)(lds + PG8_SB(b, h) + boff + n * 2048), *(const PG8_LAS bf16x8*)(lds + PG8_SB(b, h) + boff + n * 2048 + 1024)); \
        else { _Pragma("unroll") for (int k = 0; k < 2; ++k) dst[n][k] = *(const PG8_LAS bf16x8*)(lds + PG8_SB(b, h) + boff + n * 2048 + k * 1024); } } } while (0)
#define PG8_MMA(ai, bj, At, Bt) do { __builtin_amdgcn_s_setprio(1); _Pragma("unroll") for (int m = 0; m < 4; ++m) _Pragma("unroll") for (int n = 0; n < 2; ++n) { \
        if constexpr (FP8) acc[ai][bj][m][n] = __builtin_amdgcn_mfma_scale_f32_16x16x128_f8f6f4(Bt##8[n], At##8[m], acc[ai][bj][m][n], 0, 0, 0, 0x7f7f7f7f, 0, 0x7f7f7f7f); \
        else { _Pragma("unroll") for (int k = 0; k < 2; ++k) acc[ai][bj][m][n] = __builtin_amdgcn_mfma_f32_16x16x32_bf16(Bt[n][k], At[m][k], acc[ai][bj][m][n], 0, 0, 0); } } __builtin_amdgcn_s_setprio(0); } while (0)
#define PG8_WAIT_V(n) asm volatile("s_waitcnt vmcnt(" #n ")" ::: "memory")
#define PG8_WAIT_L(n) asm volatile("s_waitcnt lgkmcnt(" #n ")" ::: "memory")
#define PG8_BAR __builtin_amdgcn_s_barrier()
#define PG8_SCHED __builtin_amdgcn_sched_barrier(0)
    Unit cur, nxt; int ui = 0;
    if (!S.next(0, cur)) return;
    f32x4 acc[2][2][4][2];
#pragma unroll
    for (int a = 0; a < 2; ++a)
#pragma unroll
        for (int b = 0; b < 2; ++b)
#pragma unroll
            for (int m = 0; m < 4; ++m)
#pragma unroll
                for (int n = 0; n < 2; ++n) acc[a][b][m][n] = (f32x4){0.f, 0.f, 0.f, 0.f};
    bf16x8 At[4][2], B0[2][2], B1[2][2]; i32x8_t At8[4], B08[2], B18[2];
    const char* cA = (const char*)g.A + (size_t)cur.pm * tstep; const char* cB = (const char*)g.Bt + (size_t)cur.pn * tstep;
    S.a_ready(cur);
    if constexpr (SP2) {
        PG8_STAGE(PG8_SB(0, 0), cB, voffB); PG8_STAGE(PG8_SB(0, 1), cB + hstep, voffB); PG8_STAGE(PG8_SA(0, 0), cA, voffA); PG8_STAGE(PG8_SA(0, 1), cA + hstep, voffA);
        if (wr == 1) PG8_BAR;
        PG8_WAIT_V(2); PG8_BAR;
        PG8_STAGE(PG8_SB(1, 0), cB + kstep, voffB); PG8_STAGE(PG8_SA(1, 0), cA + kstep, voffA); PG8_STAGE(PG8_SB(1, 1), cB + hstep + kstep, voffB);
        PG8_WAIT_V(6); PG8_BAR;
    } else {
        PG8_STAGE(PG8_SB(0, 0), cB, voffB); PG8_STAGE(PG8_SA(0, 0), cA, voffA); PG8_STAGE(PG8_SB(0, 1), cB + hstep, voffB); PG8_STAGE(PG8_SA(0, 1), cA + hstep, voffA);
        if (wr == 1) PG8_BAR;
        PG8_WAIT_V(4); PG8_BAR;
        PG8_STAGE(PG8_SB(1, 0), cB + kstep, voffB); PG8_STAGE(PG8_SA(1, 0), cA + kstep, voffA); PG8_STAGE(PG8_SB(1, 1), cB + hstep + kstep, voffB);
        PG8_WAIT_V(6); PG8_BAR;
    }
    for (;;) {
        const bool has_next = S.next(ui + 1, nxt);
        const char* nA = has_next ? (const char*)g.A + (size_t)nxt.pm * tstep : cA; const char* nB = has_next ? (const char*)g.Bt + (size_t)nxt.pn * tstep : cB;
        for (int t = 0; t < nt; t += 2) {
            const bool last = (t == nt - 2);
            const char* a1 = cA + (size_t)(t + 1) * kstep;
            const char* a2 = last ? nA : cA + (size_t)(t + 2) * kstep; const char* b2 = last ? nB : cB + (size_t)(t + 2) * kstep;
            const char* a3 = a2 + kstep; const char* b3 = b2 + kstep;
            if (last && has_next) S.a_ready(nxt);
            if constexpr (SP2) {
            PG8_LDB(B0, 0, 0); PG8_LDB(B1, 0, 1); PG8_SCHED; PG8_LDA(At, 0, 0); PG8_STAGE(PG8_SA(1, 1), a1 + hstep, voffA);
            PG8_WAIT_V(8); PG8_WAIT_L(0); PG8_BAR; PG8_MMA(0, 0, At, B0); PG8_MMA(0, 1, At, B1); PG8_BAR; PG8_SCHED;
            PG8_LDA(At, 0, 1); PG8_STAGE(PG8_SB(0, 0), b2, voffB); PG8_STAGE(PG8_SB(0, 1), b2 + hstep, voffB); PG8_STAGE(PG8_SA(0, 0), a2, voffA);
            PG8_WAIT_V(8); PG8_WAIT_L(0); PG8_BAR; PG8_MMA(1, 0, At, B0); PG8_MMA(1, 1, At, B1); PG8_BAR; PG8_SCHED;
            PG8_LDB(B0, 1, 0); PG8_LDB(B1, 1, 1); PG8_SCHED; PG8_LDA(At, 1, 0); PG8_STAGE(PG8_SA(0, 1), a2 + hstep, voffA);
            PG8_WAIT_V(8); PG8_WAIT_L(0); PG8_BAR; PG8_MMA(0, 0, At, B0); PG8_MMA(0, 1, At, B1); PG8_BAR; PG8_SCHED;
            PG8_LDA(At, 1, 1); PG8_STAGE(PG8_SB(1, 0), b3, voffB); PG8_STAGE(PG8_SB(1, 1), b3 + hstep, voffB); PG8_STAGE(PG8_SA(1, 0), a3, voffA);
            PG8_WAIT_V(8); PG8_WAIT_L(0); PG8_BAR; PG8_MMA(1, 0, At, B0); PG8_MMA(1, 1, At, B1); PG8_BAR; PG8_SCHED;
            } else {
            PG8_LDB(B0, 0, 0); PG8_SCHED; PG8_LDA(At, 0, 0); PG8_STAGE(PG8_SA(1, 1), a1 + hstep, voffA);
            PG8_WAIT_L(8); PG8_BAR; PG8_WAIT_L(0); PG8_MMA(0, 0, At, B0); PG8_BAR; PG8_SCHED;
            PG8_LDB(B1, 0, 1); PG8_STAGE(PG8_SB(0, 0), b2, voffB);
            PG8_BAR; PG8_WAIT_L(0); PG8_MMA(0, 1, At, B1); PG8_BAR;
            PG8_LDA(At, 0, 1); PG8_STAGE(PG8_SA(0, 0), a2, voffA);
            PG8_BAR; PG8_WAIT_L(0); PG8_MMA(1, 0, At, B0); PG8_BAR; PG8_SCHED;
            PG8_STAGE(PG8_SB(0, 1), b2 + hstep, voffB);
            PG8_WAIT_V(6); PG8_BAR; PG8_MMA(1, 1, At, B1); PG8_BAR;
            PG8_LDB(B0, 1, 0); PG8_SCHED; PG8_LDA(At, 1, 0); PG8_STAGE(PG8_SA(0, 1), a2 + hstep, voffA);
            PG8_WAIT_L(8); PG8_BAR; PG8_WAIT_L(0); PG8_MMA(0, 0, At, B0); PG8_BAR; PG8_SCHED;
            PG8_LDB(B1, 1, 1); PG8_STAGE(PG8_SB(1, 0), b3, voffB);
            PG8_BAR; PG8_WAIT_L(0); PG8_MMA(0, 1, At, B1); PG8_BAR;
            PG8_LDA(At, 1, 1); PG8_STAGE(PG8_SA(1, 0), a3, voffA);
            PG8_BAR; PG8_WAIT_L(0); PG8_MMA(1, 0, At, B0); PG8_BAR; PG8_SCHED;
            PG8_STAGE(PG8_SB(1, 1), b3 + hstep, voffB);
            PG8_WAIT_V(6); PG8_BAR; PG8_MMA(1, 1, At, B1); PG8_BAR;
            }
        }
        if constexpr (ALIGN_EPI) { if (wr == 0) PG8_BAR; }
        if constexpr (!Epi::AFTER_DRAIN) { { unsigned z_ = 0u; asm volatile("" : "+v"(z_)); const int l2_ = (int)__builtin_amdgcn_mbcnt_hi(~0u, __builtin_amdgcn_mbcnt_lo(~0u, z_)); E(acc, cur, wr, wc, l2_ & 15, l2_ >> 4); } S.done(cur);     }
        if (!has_next) break;
#pragma unroll
        for (int a = 0; a < 2; ++a)
#pragma unroll
            for (int b = 0; b < 2; ++b)
#pragma unroll
                for (int m = 0; m < 4; ++m)
#pragma unroll
                    for (int n = 0; n < 2; ++n) acc[a][b][m][n] = (f32x4){0.f, 0.f, 0.f, 0.f};
        cur = nxt; cA = nA; cB = nB; ++ui;
        if constexpr (ALIGN_EPI) { if (wr == 1) PG8_BAR; }
    }
    PG8_WAIT_V(0);
    if constexpr (!ALIGN_EPI) { if (wr == 0) PG8_BAR; }
    PG8_BAR;
    if constexpr (Epi::AFTER_DRAIN) { E.fused(acc, cur, wr, wc, fr, fq, lds, wid, lane); S.done(cur); }
#undef PG8_SA
#undef PG8_SB
#undef PG8_STAGE
#undef PG8_LDA
#undef PG8_LDB
#undef PG8_MMA
#undef PG8_WAIT_V
#undef PG8_WAIT_L
#undef PG8_BAR
#undef PG8_SCHED
}
}
#define XB_TMO      128
#define XB_XCNT(j)  (256  + 64 * (j))
#define XB_XSUB(j)  (1280 + 64 * (j))
#define XB_XGEN(j)  (2304 + 64 * (j))
#define XB_TOP      3328
#define XB_TOPGEN   3392
#define XCD_BAR_WORDS 3456
#define XB_SPIN_CAP (1u << 18)
#define LAS __attribute__((address_space(3)))

__device__ __forceinline__ unsigned xb_ld(unsigned* p)              { return __hip_atomic_load(p, __ATOMIC_RELAXED, __HIP_MEMORY_SCOPE_AGENT); }
__device__ __forceinline__ unsigned xb_add(unsigned* p, unsigned v) { return __hip_atomic_fetch_add(p, v, __ATOMIC_RELAXED, __HIP_MEMORY_SCOPE_AGENT); }
__device__ __forceinline__ unsigned xb_xcc_id() { return (unsigned)__builtin_amdgcn_s_getreg((3 << 11) | 20) & 0xFu; }
#define XB_SPIN(cond, bar) do { unsigned _sp = 0; while (cond) { __builtin_amdgcn_s_sleep(1); \
    if ((++_sp & 255u) == 0u) { if (xb_ld(&(bar)[XB_TMO])) break; if (_sp > XB_SPIN_CAP) { atomicAdd(&(bar)[XB_TMO], 1u); break; } } } } while (0)

__device__ __forceinline__ bool xb_lane0() { unsigned z = 0u; asm volatile("" : "+v"(z)); return __builtin_amdgcn_mbcnt_hi(~0u, __builtin_amdgcn_mbcnt_lo(~0u, z)) == 0u; }
struct XcdBarrier {
    int wid;
    unsigned* bar; unsigned x;
    volatile LAS unsigned* st;
};

__device__ __forceinline__ XcdBarrier xcd_barrier_post(unsigned* bar, volatile LAS unsigned* st, int wid) {
    XcdBarrier b; b.bar = bar; b.x = xb_xcc_id(); b.st = st; b.wid = wid;
    if (wid == 0 && xb_lane0()) (void)xb_add(&bar[XB_XCNT(b.x)], 1u);
    return b;
}
__device__ __forceinline__ void xcd_barrier_complete(unsigned* bar, unsigned x, unsigned& nloc, unsigned& nx) {
    const unsigned G = gridDim.x * gridDim.y * gridDim.z;
    unsigned sum, cnt, mine, sp = 0u;
    for (;;) {
        sum = 0u; cnt = 0u; mine = 0u;
#pragma unroll
        for (unsigned j = 0; j < 16; ++j) { const unsigned c = xb_ld(&bar[XB_XCNT(j)]); sum += c; cnt += (c > 0u) ? 1u : 0u; mine = (j == x) ? c : mine; }
        if (sum == G) break;
        __builtin_amdgcn_s_sleep(1);
        if ((++sp & 255u) == 0u) { if (xb_ld(&bar[XB_TMO])) break; if (sp > XB_SPIN_CAP) { atomicAdd(&bar[XB_TMO], 1u); break; } }
    }
    nloc = mine > 0u ? mine : 1u; nx = cnt > 0u ? cnt : 1u;
}

__device__ __forceinline__ void xcd_barrier(const XcdBarrier& b) {
    asm volatile("s_waitcnt vmcnt(0)" ::: "memory");
    __syncthreads();
    if (b.wid == 0 && xb_lane0()) {
        unsigned* bar = b.bar;
        __builtin_amdgcn_s_waitcnt(0);
        unsigned nloc = b.st[0], nx = b.st[1];
        if (nloc == 0u) { xcd_barrier_complete(bar, b.x, nloc, nx); b.st[0] = nloc; b.st[1] = nx; }
        const unsigned old = xb_add(&bar[XB_XSUB(b.x)], 1u);
        const unsigned gen = old / nloc;
        if (old + 1u == (gen + 1u) * nloc) {
            __builtin_amdgcn_fence(__ATOMIC_RELEASE, "agent");
            asm volatile("s_waitcnt vmcnt(0)" ::: "memory");
            const unsigned og = xb_add(&bar[XB_TOP], 1u);
            const unsigned tg = og / nx;
            if (og + 1u == (tg + 1u) * nx) xb_add(&bar[XB_TOPGEN], 1u);
            else XB_SPIN(xb_ld(&bar[XB_TOPGEN]) == tg, bar);
            __builtin_amdgcn_fence(__ATOMIC_ACQUIRE, "agent");
            xb_add(&bar[XB_XGEN(b.x)], 1u);
            asm volatile("s_waitcnt vmcnt(0)" ::: "memory");
        } else {
            XB_SPIN(xb_ld(&bar[XB_XGEN(b.x)]) == gen, bar);
            __builtin_amdgcn_fence(__ATOMIC_ACQUIRE, "agent");
            asm volatile("s_waitcnt vmcnt(0)" ::: "memory");
        }
    }
    __syncthreads();
}


using pg8::bf16_t; using pg8::bf16x8; using pg8::f32x4; using pg8::u32x4;
typedef _Float16 f16x8 __attribute__((ext_vector_type(8)));
typedef float f32x16 __attribute__((ext_vector_type(16)));
typedef unsigned u32x2 __attribute__((ext_vector_type(2)));
#define DI __device__ __forceinline__

constexpr int NWAVES = 8, NTHR = 512;
constexpr int SEQ = 8192, MTOK = 16384, DM = 4096, DFF = 11008;
constexpr int N_A = 18432, N_B = 10400, N_BP = 10496;
constexpr float LN_EPS = 1e-5f;
constexpr float ALPHA = 1.41421356237309515f;
constexpr float SM_C = 0.08838834764831845f * 1.4426950408889634f;
constexpr float SM_SCALE = 0.08838834764831845f;

constexpr size_t MiB = (size_t)1 << 20;
constexpr size_t WS_CTL = 0, CTL_ZERO_BYTES = 16384;
constexpr size_t WS_COS = 1 * MiB, WS_SIN = 5 * MiB;
constexpr size_t WS_W = 9 * MiB;
constexpr size_t W0IN = WS_W, W0OUT = WS_W + 144 * MiB, W0GU = WS_W + 160 * MiB, W0DN = WS_W + 332 * MiB;
constexpr size_t W1IN = WS_W, W1INB = WS_W + 24 * MiB, W1OUT = WS_W + 82 * MiB, W1GU = WS_W + 114 * MiB, W1DN = WS_W + 286 * MiB;
constexpr size_t WS_XB = 427 * MiB, WS_XA = 555 * MiB, WS_BIG = 811 * MiB, WS_XB8 = (811 + 835) * MiB, WS_END = (811 + 835 + 64) * MiB;
constexpr size_t B_QKV0 = WS_BIG, B_OG = WS_BIG + 576 * MiB, B_LSE = WS_BIG + 768 * MiB, B_AO0 = WS_BIG + 771 * MiB;
constexpr size_t B_Y = WS_BIG + 360 * MiB, B_H = WS_BIG;
constexpr size_t B_Q1 = WS_BIG, B_K1 = WS_BIG + 128 * MiB, B_V1 = WS_BIG + 160 * MiB, B_QI = WS_BIG + 192 * MiB, B_KIR = WS_BIG + 320 * MiB, B_KI16 = WS_BIG + 328 * MiB,
                 B_WI = WS_BIG + 332 * MiB, B_SC = WS_BIG + 334 * MiB, B_IDX = WS_BIG + 594 * MiB, B_AO1 = WS_BIG + 640 * MiB;
constexpr int LDS_BYTES = 147456, MISC_OFF = 147456 - 64;

DI int fresh_tid(int wid) { unsigned z = 0u; asm volatile("" : "+v"(z)); return (wid << 6) | (int)__builtin_amdgcn_mbcnt_hi(~0u, __builtin_amdgcn_mbcnt_lo(~0u, z)); }
DI bf16x8 fp8x8_to_bf16(u32x2 w) {
    typedef float f32x2_t __attribute__((ext_vector_type(2)));
    const f32x2_t a = __builtin_amdgcn_cvt_pk_f32_fp8((int)w.x, false), b = __builtin_amdgcn_cvt_pk_f32_fp8((int)w.x, true), c = __builtin_amdgcn_cvt_pk_f32_fp8((int)w.y, false), d = __builtin_amdgcn_cvt_pk_f32_fp8((int)w.y, true);
    u32x4 o; o.x = pg8::cvt_pk_bf16(a.x, a.y); o.y = pg8::cvt_pk_bf16(b.x, b.y); o.z = pg8::cvt_pk_bf16(c.x, c.y); o.w = pg8::cvt_pk_bf16(d.x, d.y);
    return __builtin_bit_cast(bf16x8, o);
}
DI float wave_sum(float v) { v += __shfl_xor(v, 1); v += __shfl_xor(v, 2); v += __shfl_xor(v, 4); v += __shfl_xor(v, 8); v += __shfl_xor(v, 16); v += __shfl_xor(v, 32); return v; }
DI int sigma_inv(int d) { return 32 * ((d >> 4) & 3) + 8 * ((d >> 2) & 3) + 4 * (d >> 6) + (d & 3); }

struct MapId { DI long operator()(int c) const { return c; } };
struct MapA  { DI long operator()(int c) const { const int d = c & 127; return (c < 2 * 6144) ? (long)(c - d + sigma_inv(d)) : (long)c; } };
struct MapB  { DI long operator()(int c) const { const int d = c & 127; const bool rp = (c < 5120) || (c >= 6144 && c < 10240); return rp ? (long)(c - d + sigma_inv(d)) : (long)c; } };
struct MapB2 { DI long operator()(int c) const { return MapB{}(c + 6144) - 6144; } };
struct MapGU { int up; DI long operator()(int c) const { return (long)((c >> 7) * 256 + up * 128 + (c & 127)); } };

DI void wt_load(const float* __restrict__ W, int N, int nct, int item, f32x4 (&v)[8], int tid, int pitch) {
    const int kt = item / nct, ct = item - kt * nct; const int k0 = kt * 64, c0 = ct * 256; const int cq = tid & 63, kr0 = tid >> 6; const bool cok = (c0 + 4 * cq) < N;
#pragma unroll
    for (int i = 0; i < 8; ++i) v[i] = cok ? *(const f32x4*)(W + (size_t)(k0 + kr0 + 8 * i) * pitch + c0 + 4 * cq) : (f32x4){0.f, 0.f, 0.f, 0.f};
}
template <class Map>
DI void wt_store(int K, int N, int nct, bf16_t* __restrict__ WT, int item, const Map map, const f32x4 (&v)[8], LAS float* scr, int tid) {
    const int kt = item / nct, ct = item - kt * nct; const int k0 = kt * 64, c0 = ct * 256; const int cq = tid & 63, kr0 = tid >> 6;
    __syncthreads();
#pragma unroll
    for (int i = 0; i < 8; ++i) { const int k = kr0 + 8 * i; *(LAS f32x4*)(scr + k * 260 + 4 * (cq ^ ((k >> 3) & 7))) = v[i]; }
    __syncthreads();
#pragma unroll
    for (int i = 0; i < 4; ++i) { const int pc = tid + 512 * i; const int c = pc >> 3, j = pc & 7;
        if (c0 + c < N) { float f[8];
#pragma unroll
            for (int e = 0; e < 8; ++e) f[e] = scr[(8 * j + e) * 260 + 4 * ((c >> 2) ^ j) + (c & 3)];
            u32x4 o; o.x = pg8::cvt_pk_bf16(f[0], f[1]); o.y = pg8::cvt_pk_bf16(f[2], f[3]); o.z = pg8::cvt_pk_bf16(f[4], f[5]); o.w = pg8::cvt_pk_bf16(f[6], f[7]);
            *(u32x4*)(WT + (size_t)map(c0 + c) * K + k0 + 8 * j) = o; } }
}
template <class Map>
DI void wt_store8(int K, int N, int nct, unsigned char* __restrict__ WT8, int item, const Map map, const f32x4 (&v)[8], LAS float* scr, int tid, float wscale) {
    const int kt = item / nct, ct = item - kt * nct; const int k0 = kt * 64, c0 = ct * 256; const int cq = tid & 63, kr0 = tid >> 6;
    __syncthreads();
#pragma unroll
    for (int i = 0; i < 8; ++i) { const int k = kr0 + 8 * i; *(LAS f32x4*)(scr + k * 260 + 4 * (cq ^ ((k >> 3) & 7))) = v[i]; }
    __syncthreads();
#pragma unroll
    for (int i = 0; i < 4; ++i) { const int pc = tid + 512 * i; const int c = pc >> 3, j = pc & 7;
        if (c0 + c < N) { float f[8];
#pragma unroll
            for (int e = 0; e < 8; ++e) f[e] = scr[(8 * j + e) * 260 + 4 * ((c >> 2) ^ j) + (c & 3)] * wscale;
            int w0 = __builtin_amdgcn_cvt_pk_fp8_f32(f[0], f[1], 0, false); w0 = __builtin_amdgcn_cvt_pk_fp8_f32(f[2], f[3], w0, true);
            int w1 = __builtin_amdgcn_cvt_pk_fp8_f32(f[4], f[5], 0, false); w1 = __builtin_amdgcn_cvt_pk_fp8_f32(f[6], f[7], w1, true);
            typedef int i32x2_t __attribute__((ext_vector_type(2)));
            *(i32x2_t*)(WT8 + (size_t)map(c0 + c) * K + k0 + 8 * j) = (i32x2_t){w0, w1}; } }
}
template <class Map>
DI void wt_matrix8(const float* W, int K, int N, unsigned char* WT8, const Map map, LAS float* scr, int tid, int bid, int G, float wscale, int pitch0 = 0) {
    const int nct = (N + 255) >> 8, nitems = (K >> 6) * nct, pitch = pitch0 ? pitch0 : N;
    f32x4 va[8], vb[8], vc[8];
    int it = bid;
    if (it < nitems) wt_load(W, N, nct, it, va, tid, pitch);
    if (it + G < nitems) wt_load(W, N, nct, it + G, vb, tid, pitch);
    for (; it < nitems; it += 3 * G) {
        if (it + 2 * G < nitems) wt_load(W, N, nct, it + 2 * G, vc, tid, pitch);
        wt_store8(K, N, nct, WT8, it, map, va, scr, tid, wscale);
        if (it + G >= nitems) break;
        if (it + 3 * G < nitems) wt_load(W, N, nct, it + 3 * G, va, tid, pitch);
        wt_store8(K, N, nct, WT8, it + G, map, vb, scr, tid, wscale);
        if (it + 2 * G >= nitems) break;
        if (it + 4 * G < nitems) wt_load(W, N, nct, it + 4 * G, vb, tid, pitch);
        wt_store8(K, N, nct, WT8, it + 2 * G, map, vc, scr, tid, wscale);
    }
}
template <class Map>
DI void wt_matrix(const float* W, int K, int N, bf16_t* WT, const Map map, LAS float* scr, int tid, int bid, int G, int pitch0 = 0) {
    const int nct = (N + 255) >> 8, nitems = (K >> 6) * nct, pitch = pitch0 ? pitch0 : N;
    f32x4 va[8], vb[8], vc[8];
    int it = bid;
    if (it < nitems) wt_load(W, N, nct, it, va, tid, pitch);
    if (it + G < nitems) wt_load(W, N, nct, it + G, vb, tid, pitch);
    for (; it < nitems; it += 3 * G) {
        if (it + 2 * G < nitems) wt_load(W, N, nct, it + 2 * G, vc, tid, pitch);
        wt_store(K, N, nct, WT, it, map, va, scr, tid);
        if (it + G >= nitems) break;
        if (it + 3 * G < nitems) wt_load(W, N, nct, it + 3 * G, va, tid, pitch);
        wt_store(K, N, nct, WT, it + G, map, vb, scr, tid);
        if (it + 2 * G >= nitems) break;
        if (it + 4 * G < nitems) wt_load(W, N, nct, it + 4 * G, vb, tid, pitch);
        wt_store(K, N, nct, WT, it + 2 * G, map, vc, scr, tid);
    }
}

DI void rope_sincos(int pos, int f, float& cs, float& sn) {
    const double r1 = 0.8659643233600653; double inv = 1.0, rp = r1;
#pragma unroll
    for (int b = 0; b < 6; ++b) { if ((f >> b) & 1) inv *= rp; rp *= rp; }
    const double ang = (double)pos * inv;
    const double q = __builtin_rint(ang * 0.63661977236758134308);
    double r = __builtin_fma(-q, 1.57079632679489655800e+00, ang); r = __builtin_fma(-q, 6.12323399573676603587e-17, r);
    const double z = r * r;
    const double ps = r + r * z * (-1.66666666666666324348e-01 + z * (8.33333333332248946124e-03 + z * (-1.98412698298579493134e-04 + z * (2.75573137070700676789e-06 + z * (-2.50507602534068634195e-08 + z * 1.58969099521155010221e-10)))));
    const double pc = 1.0 - 0.5 * z + z * z * (4.16666666666666019037e-02 + z * (-1.38888888888741095749e-03 + z * (2.48015872894767294178e-05 + z * (-2.75573143513906633035e-07 + z * (2.08757232129817482790e-09 + z * -1.13596475577881948265e-11)))));
    const int qi = ((int)(long long)q) & 3;
    const double s = (qi == 0) ? ps : (qi == 1) ? pc : (qi == 2) ? -ps : -pc;
    const double c = (qi == 0) ? pc : (qi == 1) ? -ps : (qi == 2) ? -pc : ps;
    cs = (float)c; sn = (float)s;
}

DI void cvt_x_phase(const float* X, bf16_t* XB, int tid, int bid, int G) {
    const size_t n8 = (size_t)MTOK * DM / 8;
    for (size_t i = (size_t)bid * NTHR + tid; i < n8; i += (size_t)G * NTHR) {
        const f32x4 a = *(const f32x4*)(X + i * 8), b = *(const f32x4*)(X + i * 8 + 4);
        u32x4 o; o.x = pg8::cvt_pk_bf16(a[0], a[1]); o.y = pg8::cvt_pk_bf16(a[2], a[3]); o.z = pg8::cvt_pk_bf16(b[0], b[1]); o.w = pg8::cvt_pk_bf16(b[2], b[3]);
        *(u32x4*)(XB + i * 8) = o; }
}
DI void cvt_x8_phase(const float* X, unsigned char* XB8, int tid, int bid, int G) {
    const size_t n16 = (size_t)MTOK * DM / 16;
    for (size_t i = (size_t)bid * NTHR + tid; i < n16; i += (size_t)G * NTHR) { int w[4];
#pragma unroll
        for (int q = 0; q < 4; ++q) { const f32x4 a = *(const f32x4*)(X + i * 16 + 4 * q); int t = __builtin_amdgcn_cvt_pk_fp8_f32(a[0], a[1], 0, false); w[q] = __builtin_amdgcn_cvt_pk_fp8_f32(a[2], a[3], t, true); }
        *(u32x4*)(XB8 + i * 16) = (u32x4){(unsigned)w[0], (unsigned)w[1], (unsigned)w[2], (unsigned)w[3]}; }
}
DI void rope_tab_phase(const int* pos, float* CS, float* SN, int tid, int bid, int G) {
    for (int e = bid * NTHR + tid; e < MTOK * 64; e += G * NTHR) { float c, s; rope_sincos(pos[e >> 6], e & 63, c, s); CS[e] = c; SN[e] = s; }
}

typedef unsigned short half_t;
DI void ln_phase(const half_t* Y, const float* gain, const float* bias, float* Xo, half_t* XHo, bf16_t* XBo, int tid, int bid, int G, unsigned char* XB8o = nullptr) {
    const int lane = tid & 63, gw = bid * NWAVES + (tid >> 6), nw = G * NWAVES;
    for (int row = gw; row < MTOK; row += nw) {
        const half_t* yr = Y + (size_t)row * DM; f32x4 v[16]; float s = 0.f;
#pragma unroll
        for (int j = 0; j < 8; ++j) { const u32x4 raw = *(const u32x4*)(yr + (j * 64 + lane) * 8);
            v[2 * j] = pg8::f16x4_to_f32((pg8::u32x2e_t){raw.x, raw.y}); v[2 * j + 1] = pg8::f16x4_to_f32((pg8::u32x2e_t){raw.z, raw.w});
            s += ((v[2 * j][0] + v[2 * j][1]) + (v[2 * j][2] + v[2 * j][3])) + ((v[2 * j + 1][0] + v[2 * j + 1][1]) + (v[2 * j + 1][2] + v[2 * j + 1][3])); }
        const float mean = wave_sum(s) * (1.0f / DM); float q = 0.f;
#pragma unroll
        for (int j = 0; j < 16; ++j) { v[j] = v[j] - mean; q += (v[j][0] * v[j][0] + v[j][1] * v[j][1]) + (v[j][2] * v[j][2] + v[j][3] * v[j][3]); }
        const float rstd = 1.0f / sqrtf(wave_sum(q) * (1.0f / DM) + LN_EPS);
#pragma unroll
        for (int j = 0; j < 8; ++j) { const int c = (j * 64 + lane) * 8;
            const f32x4 o0 = v[2 * j] * rstd * *(const f32x4*)(gain + c) + *(const f32x4*)(bias + c), o1 = v[2 * j + 1] * rstd * *(const f32x4*)(gain + c + 4) + *(const f32x4*)(bias + c + 4);
            if (Xo) { *(f32x4*)(Xo + (size_t)row * DM + c) = o0; *(f32x4*)(Xo + (size_t)row * DM + c + 4) = o1; }
            if (XHo) { u32x4 w; w.x = pg8::cvt_pk_f16(o0[0], o0[1]); w.y = pg8::cvt_pk_f16(o0[2], o0[3]); w.z = pg8::cvt_pk_f16(o1[0], o1[1]); w.w = pg8::cvt_pk_f16(o1[2], o1[3]); *(u32x4*)(XHo + (size_t)row * DM + c) = w; }
            if (XBo) { u32x4 w; w.x = pg8::cvt_pk_bf16(o0[0], o0[1]); w.y = pg8::cvt_pk_bf16(o0[2], o0[3]); w.z = pg8::cvt_pk_bf16(o1[0], o1[1]); w.w = pg8::cvt_pk_bf16(o1[2], o1[3]); *(u32x4*)(XBo + (size_t)row * DM + c) = w; }
            if (XB8o) { int q0 = __builtin_amdgcn_cvt_pk_fp8_f32(o0[0], o0[1], 0, false); q0 = __builtin_amdgcn_cvt_pk_fp8_f32(o0[2], o0[3], q0, true);
                int q1 = __builtin_amdgcn_cvt_pk_fp8_f32(o1[0], o1[1], 0, false); q1 = __builtin_amdgcn_cvt_pk_fp8_f32(o1[2], o1[3], q1, true); *(u32x2*)(XB8o + (size_t)row * DM + c) = (u32x2){(unsigned)q0, (unsigned)q1}; } }
    }
}

DI bf16x8 ldg_bf16x8(const bf16_t* p) { return *(const bf16x8*)p; }
typedef short s16x4 __attribute__((ext_vector_type(4)));
struct A0Unit { int h, b, grp, d, r, nb; };
DI A0Unit a0_decode(int u) { A0Unit x; x.h = u & 15; const int blk = (u >> 4) & 63; x.b = (u >> 10) & 1; x.grp = u >> 11; const int dsh = 2 * x.grp; x.d = 1 << dsh; x.r = blk >> (6 - dsh); x.nb = blk & ((64 >> dsh) - 1); return x; }
DI size_t a0_sub(int sq, const A0Unit& x) { return ((size_t)(((sq * 3 + x.grp) * 2 + x.b) * 16 + x.h) * 8192 + (size_t)x.r * (8192 >> (2 * x.grp))) * 128; }
DI void a0_load_kv(const unsigned char* QKV, const A0Unit& x, u32x4 (&kpre)[4], u32x4 (&vpre)[4], int tid) {
    const unsigned char* Kg = QKV + a0_sub(1, x) + (tid & 7) * 16; const unsigned char* Vg = QKV + a0_sub(2, x) + (tid & 7) * 16;
#pragma unroll
    for (int i = 0; i < 4; ++i) { const int l = (x.nb - 1) * 128 + (tid >> 3) + 64 * i;
        kpre[i] = (l >= 0) ? *(const u32x4*)(Kg + (ptrdiff_t)l * 128) : (u32x4){0u, 0u, 0u, 0u};
        vpre[i] = (l >= 0) ? *(const u32x4*)(Vg + (ptrdiff_t)l * 128) : (u32x4){0u, 0u, 0u, 0u}; }
}
DI void a0_load_q(const unsigned char* QKV, const A0Unit& x, bf16x8 (&qf)[4], int w, int n, int g4) {
    const unsigned char* qp = QKV + a0_sub(0, x) + (size_t)(x.nb * 128 + 16 * w + n) * 128 + 8 * g4;
#pragma unroll
    for (int ks = 0; ks < 4; ++ks) qf[ks] = fp8x8_to_bf16(*(const u32x2*)(qp + 32 * ks));
}
DI void attn0_phase(const unsigned char* QKV, bf16_t* OG, float* LSE, LAS unsigned char* lds, int tid, int bid, int G) {
    const int lane = tid & 63, w = __builtin_amdgcn_readfirstlane(tid >> 6), n = lane & 15, g4 = lane >> 4, q4 = n >> 2, p4 = n & 3;
    LAS unsigned char* kimg = lds; LAS unsigned char* vt = lds + 65536;
    const size_t GS = (size_t)MTOK * 2048;
    const int tr_base = (4 * g4 + q4) * 256 + 8 * (p4 & 1);
    const int skey = tid >> 3, sj = tid & 7;
    LAS unsigned char* kwr0 = kimg + skey * 256 + (((2 * sj) ^ (skey & 15)) * 16); LAS unsigned char* kwr1 = kimg + skey * 256 + (((2 * sj + 1) ^ (skey & 15)) * 16);
    LAS unsigned char* vwr0 = vt + skey * 256 + (((2 * sj) ^ (2 * (skey & 3))) * 16); LAS unsigned char* vwr1 = vt + skey * 256 + (((2 * sj + 1) ^ (2 * (skey & 3))) * 16);
    LAS unsigned char* krb[4];
#pragma unroll
    for (int j = 0; j < 4; ++j) krb[j] = kimg + (16 * w + n) * 256 + (((4 * j + g4) ^ n) * 16);
    u32x4 kpre[4], vpre[4]; bf16x8 qf[4];
    int u = bid;
    if (u < 6144) { const A0Unit x = a0_decode(u); a0_load_kv(QKV, x, kpre, vpre, tid); a0_load_q(QKV, x, qf, w, n, g4); }
    for (; u < 6144; u += G) {
        const A0Unit x = a0_decode(u);
        const int h = x.h, d = x.d, nb = x.nb, grp = x.grp;
        const size_t tok0 = (size_t)x.b * SEQ + x.r;
        const int iq = 16 * w + n, lq = nb * 128 + iq;
        const size_t qtok = tok0 + (size_t)lq * d;
        __syncthreads();
#pragma unroll
        for (int i = 0; i < 4; ++i) {
            *(LAS bf16x8*)(kwr0 + i * 16384) = fp8x8_to_bf16((u32x2){kpre[i].x, kpre[i].y}); *(LAS bf16x8*)(kwr1 + i * 16384) = fp8x8_to_bf16((u32x2){kpre[i].z, kpre[i].w});
            *(LAS bf16x8*)(vwr0 + i * 16384) = fp8x8_to_bf16((u32x2){vpre[i].x, vpre[i].y}); *(LAS bf16x8*)(vwr1 + i * 16384) = fp8x8_to_bf16((u32x2){vpre[i].z, vpre[i].w}); }
        __syncthreads();
        if (u + G < 6144) { const A0Unit xn = a0_decode(u + G); a0_load_kv(QKV, xn, kpre, vpre, tid); }
        f32x4 s[9];
#pragma unroll
        for (int tt = 0; tt < 9; ++tt) { f32x4 a = {0.f, 0.f, 0.f, 0.f};
#pragma unroll
            for (int ks = 0; ks < 4; ++ks) a = __builtin_amdgcn_mfma_f32_16x16x32_bf16(*(const LAS bf16x8*)(krb[ks] + tt * 4096), qf[ks], a, 0, 0, 0);
            s[tt] = a; }
        if (u + G < 6144) { const A0Unit xn = a0_decode(u + G); a0_load_q(QKV, xn, qf, w, n, g4); }
        float mx = -__builtin_inff();
#pragma unroll
        for (int tt = 0; tt < 9; ++tt)
#pragma unroll
            for (int j = 0; j < 4; ++j) { const int kf = 16 * (w + tt) + 4 * g4 + j; const bool ok = (kf >= iq) && (kf <= iq + 128) && (nb > 0 || kf >= 128);
                const float xx = ok ? s[tt][j] : -__builtin_inff(); s[tt][j] = xx; mx = fmaxf(mx, xx); }
        mx = fmaxf(mx, __shfl_xor(mx, 16)); mx = fmaxf(mx, __shfl_xor(mx, 32));
        const float msc = mx * SM_C; float lsum = 0.f;
#pragma unroll
        for (int tt = 0; tt < 9; ++tt)
#pragma unroll
            for (int j = 0; j < 4; ++j) { const float p = __builtin_amdgcn_exp2f(s[tt][j] * SM_C - msc); s[tt][j] = p; lsum += p; }
        lsum += __shfl_xor(lsum, 16); lsum += __shfl_xor(lsum, 32);
        f32x4 o[8];
#pragma unroll
        for (int dt = 0; dt < 8; ++dt) o[dt] = (f32x4){0.f, 0.f, 0.f, 0.f};
#pragma unroll
        for (int kk = 0; kk < 5; ++kk) {
            const int t0 = 2 * kk, t1 = 2 * kk + 1;
            u32x4 pw; pw.x = pg8::cvt_pk_bf16(s[t0][0], s[t0][1]); pw.y = pg8::cvt_pk_bf16(s[t0][2], s[t0][3]);
            if (t1 < 9) { pw.z = pg8::cvt_pk_bf16(s[t1 < 9 ? t1 : 8][0], s[t1 < 9 ? t1 : 8][1]); pw.w = pg8::cvt_pk_bf16(s[t1 < 9 ? t1 : 8][2], s[t1 < 9 ? t1 : 8][3]); } else { pw.z = 0u; pw.w = 0u; }
            const bf16x8 pf = __builtin_bit_cast(bf16x8, pw);
            int T1 = w + t1; T1 = T1 > 15 ? 15 : T1;
            const int row0 = 16 * (w + t0) * 256, row1 = 16 * T1 * 256;
#pragma unroll
            for (int dt = 0; dt < 8; ++dt) {
                const int choff = ((2 * dt + (p4 >> 1)) ^ (2 * q4)) * 16;
                const s16x4 lo = __builtin_amdgcn_ds_read_tr16_b64_v4i16((LAS s16x4*)(vt + tr_base + row0 + choff));
                const s16x4 hi = __builtin_amdgcn_ds_read_tr16_b64_v4i16((LAS s16x4*)(vt + tr_base + row1 + choff));
                const bf16x8 vf = __builtin_shufflevector(lo, hi, 0, 1, 2, 3, 4, 5, 6, 7);
                o[dt] = __builtin_amdgcn_mfma_f32_16x16x32_bf16(vf, pf, o[dt], 0, 0, 0); }
        }
        const float inv = 1.0f / lsum;
        bf16_t* op = OG + (size_t)grp * GS + qtok * 2048 + h * 128 + 4 * g4;
#pragma unroll
        for (int dt = 0; dt < 8; ++dt) { u32x2 wv; wv.x = pg8::cvt_pk_bf16(o[dt][0] * inv, o[dt][1] * inv); wv.y = pg8::cvt_pk_bf16(o[dt][2] * inv, o[dt][3] * inv); *(u32x2*)(op + 16 * dt) = wv; }
        if (g4 == 0) LSE[(size_t)grp * (MTOK * 16) + qtok * 16 + h] = mx * SM_SCALE + __logf(lsum);
    }
}

DI void merge_phase(const bf16_t* OG, const float* LSE, unsigned char* AO8, int tid, int bid, int G) {
    const int lane = tid & 63, gw = bid * NWAVES + (tid >> 6), nw = G * NWAVES; const size_t GS = (size_t)MTOK * 2048;
    for (int tok = gw; tok < MTOK; tok += nw) {
#pragma unroll
        for (int it = 0; it < 4; ++it) { const int e = it * 512 + lane * 8, h = e >> 7;
            const float l0 = LSE[(size_t)tok * 16 + h], l1 = LSE[(size_t)(MTOK * 16) + (size_t)tok * 16 + h], l2 = LSE[(size_t)(2 * MTOK * 16) + (size_t)tok * 16 + h];
            const float mx = fmaxf(l0, fmaxf(l1, l2)); const float e0 = __expf(l0 - mx), e1 = __expf(l1 - mx), e2 = __expf(l2 - mx); const float inv = 1.0f / (e0 + e1 + e2);
            const float w0 = e0 * inv, w1 = e1 * inv, w2 = e2 * inv;
            const u32x4 a = *(const u32x4*)(OG + (size_t)tok * 2048 + e), b = *(const u32x4*)(OG + GS + (size_t)tok * 2048 + e), c = *(const u32x4*)(OG + 2 * GS + (size_t)tok * 2048 + e);
            float v[8];
#pragma unroll
            for (int k = 0; k < 4; ++k) { v[2 * k] = 16.0f * (w0 * __uint_as_float(a[k] << 16) + w1 * __uint_as_float(b[k] << 16) + w2 * __uint_as_float(c[k] << 16));
                v[2 * k + 1] = 16.0f * (w0 * __uint_as_float(a[k] & 0xffff0000u) + w1 * __uint_as_float(b[k] & 0xffff0000u) + w2 * __uint_as_float(c[k] & 0xffff0000u)); }
            int q0 = __builtin_amdgcn_cvt_pk_fp8_f32(v[0], v[1], 0, false); q0 = __builtin_amdgcn_cvt_pk_fp8_f32(v[2], v[3], q0, true);
            int q1 = __builtin_amdgcn_cvt_pk_fp8_f32(v[4], v[5], 0, false); q1 = __builtin_amdgcn_cvt_pk_fp8_f32(v[6], v[7], q1, true);
            *(u32x2*)(AO8 + (size_t)tok * 2048 + e) = (u32x2){(unsigned)q0, (unsigned)q1}; }
    }
}

DI void kidx_phase(const float* KIR, const float* gain, const float* bias, const float* CS, const float* SN, unsigned short* KI16, int tid, int bid, int G) {
    const int lane = tid & 63, gw = bid * NWAVES + (tid >> 6), nw = G * NWAVES;
    const float g1 = gain[lane], g2 = gain[lane + 64], b1 = bias[lane], b2 = bias[lane + 64];
    const int j1 = sigma_inv(lane);
    for (int tok = gw; tok < MTOK; tok += nw) {
        const float x1 = KIR[(size_t)tok * 128 + lane], x2 = KIR[(size_t)tok * 128 + 64 + lane];
        const float mean = wave_sum(x1 + x2) * (1.0f / 128.0f); const float d1 = x1 - mean, d2 = x2 - mean;
        const float rstd = 1.0f / sqrtf(wave_sum(d1 * d1 + d2 * d2) * (1.0f / 128.0f) + LN_EPS);
        const float y1 = d1 * rstd * g1 + b1, y2 = d2 * rstd * g2 + b2;
        const float c = CS[(size_t)tok * 64 + lane], s = SN[(size_t)tok * 64 + lane];
        const _Float16 o1 = (_Float16)(y1 * c - y2 * s), o2 = (_Float16)(y2 * c + y1 * s);
        KI16[(size_t)tok * 128 + j1] = __builtin_bit_cast(unsigned short, o1); KI16[(size_t)tok * 128 + j1 + 4] = __builtin_bit_cast(unsigned short, o2);
    }
}

constexpr int KT_ROWB = 272, KT_BYTES = 64 * KT_ROWB;
DI size_t sc_row_off(int b, int s) { const int qb = s >> 7; return ((size_t)(b * 2080 + ((qb * (qb + 1)) >> 1))) * 16384 + (size_t)(s & 127) * ((qb + 1) * 128); }
DI float relu1(float x) { const int b = __builtin_bit_cast(int, x); return __builtin_bit_cast(float, b > 0 ? b : 0); }
DI void indexer_tile(const LAS unsigned char* buf, const f16x8 (&af)[2][8], const f32x4 (&wv)[2][4], float* sc0, float* sc1, int kt, int r32, int h2) {
    typedef float f32x2_t __attribute__((ext_vector_type(2)));
    f16x8 bfr[2][8];
#pragma unroll
    for (int sub = 0; sub < 2; ++sub)
#pragma unroll
        for (int ks = 0; ks < 8; ++ks) bfr[sub][ks] = *(const LAS f16x8*)(buf + (32 * sub + r32) * KT_ROWB + (16 * ks + 8 * h2) * 2);
    __builtin_amdgcn_sched_barrier(0);
#pragma unroll
    for (int sub = 0; sub < 2; ++sub) {
        f32x16 c0, c1;
#pragma unroll
        for (int i = 0; i < 16; ++i) { c0[i] = 0.f; c1[i] = 0.f; }
#pragma unroll
        for (int ks = 0; ks < 8; ++ks) { c0 = __builtin_amdgcn_mfma_f32_32x32x16_f16(af[0][ks], bfr[sub][ks], c0, 0, 0, 0); c1 = __builtin_amdgcn_mfma_f32_32x32x16_f16(af[1][ks], bfr[sub][ks], c1, 0, 0, 0); }
        f32x2_t a0 = {0.f, 0.f}, a1 = {0.f, 0.f};
#pragma unroll
        for (int q = 0; q < 4; ++q)
#pragma unroll
            for (int e = 0; e < 4; e += 2) {
                const f32x2_t r0 = {relu1(c0[4 * q + e]), relu1(c0[4 * q + e + 1])};
                const f32x2_t r1 = {relu1(c1[4 * q + e]), relu1(c1[4 * q + e + 1])};
                const f32x2_t w0 = {wv[0][q][e], wv[0][q][e + 1]}, w1 = {wv[1][q][e], wv[1][q][e + 1]};
                a0 = __builtin_elementwise_fma(r0, w0, a0); a1 = __builtin_elementwise_fma(r1, w1, a1); }
        float s0 = a0.x + a0.y, s1 = a1.x + a1.y;
        s0 += __shfl_xor(s0, 32); s1 += __shfl_xor(s1, 32);
        if (h2 == 0) { sc0[kt * 64 + 32 * sub + r32] = s0; sc1[kt * 64 + 32 * sub + r32] = s1; }
    }
}
DI void indexer_phase(const unsigned short* QI, const unsigned short* KI16, const float* WI, float* SC, LAS unsigned char* lds, int tid, int bid, int G) {
    const int lane = tid & 63, w = __builtin_amdgcn_readfirstlane(tid >> 6), r32 = lane & 31, h2 = lane >> 5;
    LAS unsigned char* buf0 = lds; LAS unsigned char* buf1 = lds + KT_BYTES;
    const int key0 = tid >> 4, ch = tid & 15;
    for (int v = bid; v < 256; v += G) {
        for (int it = 0; it < 4; ++it) {
            const int b = it >> 1, gi = (it & 1) ? (511 - v) : v; const int tb = 16 * gi;
            const int nt = ((tb + 15) >> 6) + 1;
            f16x8 af[2][8]; f32x4 wv[2][4];
#pragma unroll
            for (int tq = 0; tq < 2; ++tq) { const size_t tg = (size_t)b * SEQ + tb + 2 * w + tq;
#pragma unroll
                for (int ks = 0; ks < 8; ++ks) af[tq][ks] = *(const f16x8*)(QI + tg * 4096 + r32 * 128 + 16 * ks + 8 * h2);
#pragma unroll
                for (int q = 0; q < 4; ++q) wv[tq][q] = *(const f32x4*)(WI + tg * 32 + 8 * q + 4 * h2); }
            float* sc0 = SC + sc_row_off(b, tb + 2 * w); float* sc1 = SC + sc_row_off(b, tb + 2 * w + 1);
            const unsigned short* src = KI16 + (size_t)b * SEQ * 128 + (size_t)key0 * 128 + ch * 8;
            u32x4 a0, a1, b0 = {0u, 0u, 0u, 0u}, b1 = {0u, 0u, 0u, 0u};
            a0 = *(const u32x4*)src; a1 = *(const u32x4*)(src + 32 * 128);
            if (nt > 1) { b0 = *(const u32x4*)(src + 64 * 128); b1 = *(const u32x4*)(src + 96 * 128); }
            __syncthreads();
            *(LAS u32x4*)(buf0 + key0 * KT_ROWB + ch * 16) = a0; *(LAS u32x4*)(buf0 + (key0 + 32) * KT_ROWB + ch * 16) = a1;
            __syncthreads();
            for (int kt = 0; kt < nt; kt += 2) {
                if (kt + 2 < nt) { const unsigned short* p = src + (size_t)(kt + 2) * 64 * 128; a0 = *(const u32x4*)p; a1 = *(const u32x4*)(p + 32 * 128); }
                indexer_tile(buf0, af, wv, sc0, sc1, kt, r32, h2);
                if (kt + 1 < nt) { *(LAS u32x4*)(buf1 + key0 * KT_ROWB + ch * 16) = b0; *(LAS u32x4*)(buf1 + (key0 + 32) * KT_ROWB + ch * 16) = b1; }
                __syncthreads();
                if (kt + 1 >= nt) break;
                if (kt + 3 < nt) { const unsigned short* p = src + (size_t)(kt + 3) * 64 * 128; b0 = *(const u32x4*)p; b1 = *(const u32x4*)(p + 32 * 128); }
                indexer_tile(buf1, af, wv, sc0, sc1, kt + 1, r32, h2);
                if (kt + 2 < nt) { *(LAS u32x4*)(buf0 + key0 * KT_ROWB + ch * 16) = a0; *(LAS u32x4*)(buf0 + (key0 + 32) * KT_ROWB + ch * 16) = a1; }
                __syncthreads();
            }
        }
    }
}

DI unsigned mbcnt64(unsigned long long m) { return __builtin_amdgcn_mbcnt_hi((unsigned)(m >> 32), __builtin_amdgcn_mbcnt_lo((unsigned)m, 0u)); }
DI unsigned f2key(float f) { const unsigned u = __float_as_uint(f); return (u & 0x80000000u) ? ~u : (u | 0x80000000u); }
DI int wave_sum_i(int v) {
    v += __builtin_amdgcn_update_dpp(0, v, 0xB1, 0xF, 0xF, true);
    v += __builtin_amdgcn_update_dpp(0, v, 0x4E, 0xF, 0xF, true);
    v += __builtin_amdgcn_update_dpp(0, v, 0x141, 0xF, 0xF, true);
    v += __builtin_amdgcn_update_dpp(0, v, 0x140, 0xF, 0xF, true);
    return __builtin_amdgcn_readlane(v, 0) + __builtin_amdgcn_readlane(v, 16) + __builtin_amdgcn_readlane(v, 32) + __builtin_amdgcn_readlane(v, 48);
}
template <int NV>
DI void topk_row(const float* row, int s, LAS int* lst, int lane) {
    unsigned key[NV];
    { const unsigned long long ra = (unsigned long long)row; const unsigned rlo = __builtin_amdgcn_readfirstlane((unsigned)ra), rhi = __builtin_amdgcn_readfirstlane((unsigned)(ra >> 32));
      row = (const float*)(((unsigned long long)rhi << 32) | rlo); }
#pragma unroll
    for (int jo = 0; jo < NV / 16; ++jo) { const float* rb = row + jo * 1024;
#pragma unroll
        for (int ji = 0; ji < 16; ++ji) { const int j = jo * 16 + ji; const unsigned u = f2key(rb[ji * 64 + lane]); key[j] = (j * 64 + lane <= s) ? u : 0u; } }
    unsigned T = 0u;
#pragma unroll 1
    for (int bit = 31; bit >= 0; --bit) {
        const unsigned cand = T | (1u << bit); int c = 0;
#pragma unroll
        for (int j = 0; j < NV; ++j) asm volatile("v_cmp_le_u32 vcc, %2, %1\n\tv_addc_co_u32 %0, vcc, 0, %0, vcc" : "+v"(c) : "v"(key[j]), "s"(cand) : "vcc");
        const int tot = wave_sum_i(c);
        if (tot >= 256) T = cand;
        if (tot == 256) break;
    }
    int bgt = 0;
#pragma unroll
    for (int j = 0; j < NV; ++j) { const bool sg = key[j] > T; const unsigned long long mg = __ballot(sg); if (sg) lst[bgt + (int)mbcnt64(mg)] = j * 64 + lane; bgt += __builtin_popcountll(mg); }
#pragma unroll
    for (int j = 0; j < NV; ++j) { const bool se = key[j] == T; const unsigned long long me = __ballot(se); const int pe = bgt + (int)mbcnt64(me); if (se && pe < 256) lst[pe] = j * 64 + lane; bgt += __builtin_popcountll(me); }
}
DI void topk_phase(const float* SC, unsigned short* IDX, LAS unsigned char* lds, int tid, int bid, int G) {
    const int lane = tid & 63, w = __builtin_amdgcn_readfirstlane(tid >> 6), gw = bid * NWAVES + w, nw = G * NWAVES;
    LAS int* lst = (LAS int*)(lds + w * 1024);
    for (int t = gw; t < MTOK; t += nw) {
        const int b = t >> 13, s = t & 8191; unsigned short* out = IDX + (size_t)t * 256;
        if (s < 256) {
#pragma unroll
            for (int i = 0; i < 4; ++i) { const int j = lane + 64 * i; out[j] = (unsigned short)((j <= s) ? j : 0); }
        } else {
            const float* row = SC + sc_row_off(b, s);
            if (s < 2048) topk_row<32>(row, s, lst, lane);
            else if (s < 4096) topk_row<64>(row, s, lst, lane);
            else if (s < 6144) topk_row<96>(row, s, lst, lane);
            else topk_row<128>(row, s, lst, lane);
#pragma unroll
            for (int i = 0; i < 4; ++i) out[lane + 64 * i] = (unsigned short)lst[lane + 64 * i];
        }
    }
}

typedef unsigned __attribute__((may_alias)) u32_alias_t;
constexpr int DSA_WB = 17408;
DI __amdgpu_buffer_rsrc_t kv_rsrc(const bf16_t* base) { return __builtin_amdgcn_make_buffer_rsrc((void*)base, 0, SEQ * 256, 0x00020000); }
DI __amdgpu_buffer_rsrc_t big_rsrc(const void* base, unsigned bytes) { return __builtin_amdgcn_make_buffer_rsrc((void*)base, 0, (int)bytes, 0x00020000); }
DI void dsa_attn_phase(const bf16_t* Q1, const bf16_t* K1, const bf16_t* V1, const unsigned short* IDX, unsigned char* AO, LAS unsigned char* lds, int tid, int bid, int G) {
    const int lane = tid & 63, w = __builtin_amdgcn_readfirstlane(tid >> 6), n = lane & 15, g4 = lane >> 4, q4 = n >> 2, p4 = n & 3;
    LAS unsigned char* vb = lds + w * DSA_WB; LAS unsigned short* il0 = (LAS unsigned short*)(vb + 16384); LAS unsigned short* il1 = il0 + 256;
    const bool xm = (G & 7) == 0;
    const int start = xm ? ((bid >> 3) * NWAVES + w) : (bid * NWAVES + w), step = xm ? ((G >> 3) * NWAVES) : (G * NWAVES), total = xm ? MTOK : MTOK * 8;
    const int tr_base = (4 * g4 + q4) * 256 + 8 * (p4 & 1);
    const int vvo = 16 * n;
    const __amdgpu_buffer_rsrc_t qr = big_rsrc(Q1, (unsigned)MTOK * 8192u), ir = big_rsrc(IDX, (unsigned)MTOK * 512u), orr = big_rsrc(AO, (unsigned)MTOK * 4096u);
    const int qlo = n * 256 + 16 * g4;
    const int olo = n * 128 + 4 * g4;
    LAS unsigned char* kwb[4]; LAS unsigned char* krb[4]; LAS unsigned char* trb[4];
#pragma unroll
    for (int j = 0; j < 4; ++j) { kwb[j] = vb + g4 * 256 + ((n ^ (4 * j + g4)) * 16);
                                  krb[j] = vb + n * 256 + (((4 * j + g4) ^ n) * 16);
                                  trb[j] = vb + tr_base + 32 * (j ^ q4) + 16 * (p4 >> 1); }
    LAS unsigned char* vwb = vb + g4 * 256 + ((n ^ (2 * g4)) * 16);
    int it = start;
    if (it >= total) return;
#define DSA_ITEM(itv, kvh_, t_) const int kvh_ = xm ? (bid & 7) : ((itv) & 7), t_ = xm ? (itv) : ((itv) >> 3)
    u32x4 vst[8], kst[16]; bf16x8 qf[4];
    {
        DSA_ITEM(it, kvh, t);
#pragma unroll
        for (int i = 0; i < 2; ++i) ((LAS u32_alias_t*)il0)[lane + 64 * i] = __builtin_amdgcn_raw_buffer_load_b32(ir, lane * 4 + 256 * i, t * 512, 0);
        const size_t slice = (size_t)((t >> 13) * 8 + kvh) * SEQ * 128;
        const __amdgpu_buffer_rsrc_t kr = kv_rsrc(K1 + slice), vr = kv_rsrc(V1 + slice);
#pragma unroll
        for (int ks = 0; ks < 4; ++ks) qf[ks] = (n < 4) ? __builtin_bit_cast(bf16x8, __builtin_amdgcn_raw_buffer_load_b128(qr, qlo + 64 * ks, t * 8192 + kvh * 1024, 0)) : (bf16x8){0, 0, 0, 0, 0, 0, 0, 0};
#pragma unroll
        for (int i = 0; i < 16; ++i) kst[i] = __builtin_amdgcn_raw_buffer_load_b128(kr, (int)il0[4 * i + g4] * 256 + vvo, 0, 0);
#pragma unroll
        for (int i = 0; i < 8; ++i) vst[i] = __builtin_amdgcn_raw_buffer_load_b128(vr, (int)il0[4 * i + g4] * 256 + vvo, 0, 0);
    }
    int par = 0;
    for (; it < total; it += step) {
        DSA_ITEM(it, kvh, t);
        LAS unsigned short* ilc = par ? il1 : il0; LAS unsigned short* iln = par ? il0 : il1;
        const bool has_next = (it + step) < total;
        DSA_ITEM(it + step, kvh2, t2);
        const int s = t & 8191; const int nvalid = s + 1 < 256 ? s + 1 : 256;
        const size_t slice = (size_t)((t >> 13) * 8 + kvh) * SEQ * 128;
        const __amdgpu_buffer_rsrc_t kr = kv_rsrc(K1 + slice), vr = kv_rsrc(V1 + slice);
        const size_t slice2 = (size_t)((t2 >> 13) * 8 + kvh2) * SEQ * 128;
        unsigned inext[2] = {0u, 0u};
        if (has_next) {
#pragma unroll
            for (int i = 0; i < 2; ++i) inext[i] = __builtin_amdgcn_raw_buffer_load_b32(ir, lane * 4 + 256 * i, t2 * 512, 0); }
        float mrun = -__builtin_inff(), lsum = 0.f;
        f32x4 o[8];
#pragma unroll
        for (int dt = 0; dt < 8; ++dt) o[dt] = (f32x4){0.f, 0.f, 0.f, 0.f};
#pragma unroll 1
        for (int c = 0; c < 4; ++c) {
#pragma unroll
            for (int i = 0; i < 16; ++i) *(LAS u32x4*)(kwb[i & 3] + i * 1024) = kst[i];
            if (c < 3) {
#pragma unroll
                for (int i = 0; i < 16; ++i) kst[i] = __builtin_amdgcn_raw_buffer_load_b128(kr, (int)ilc[(c + 1) * 64 + 4 * i + g4] * 256 + vvo, 0, 0);
            } else if (has_next) {
#pragma unroll
                for (int i = 0; i < 2; ++i) ((LAS u32_alias_t*)iln)[lane + 64 * i] = inext[i];
                const __amdgpu_buffer_rsrc_t kr2 = kv_rsrc(K1 + slice2);
#pragma unroll
                for (int i = 0; i < 16; ++i) kst[i] = __builtin_amdgcn_raw_buffer_load_b128(kr2, (int)iln[4 * i + g4] * 256 + vvo, 0, 0);
            }
            f32x4 sa[4];
#pragma unroll
            for (int tt = 0; tt < 4; ++tt) { f32x4 a = {0.f, 0.f, 0.f, 0.f};
#pragma unroll
                for (int ks = 0; ks < 4; ++ks) { const bf16x8 kf = *(const LAS bf16x8*)(krb[ks] + tt * 4096);
                    a = __builtin_amdgcn_mfma_f32_16x16x32_bf16(kf, qf[ks], a, 0, 0, 0); }
                sa[tt] = a; asm volatile("" ::: "memory"); }
            if (nvalid < 256) {
#pragma unroll
                for (int tt = 0; tt < 4; ++tt)
#pragma unroll
                    for (int j = 0; j < 4; ++j) { const int kk = 64 * c + 16 * tt + 4 * g4 + j; sa[tt][j] = (kk < nvalid) ? sa[tt][j] : -__builtin_inff(); }
            }
            float cm = fmaxf(fmaxf(fmaxf(sa[0][0], sa[0][1]), fmaxf(sa[0][2], sa[0][3])), fmaxf(fmaxf(sa[1][0], sa[1][1]), fmaxf(sa[1][2], sa[1][3])));
            cm = fmaxf(cm, fmaxf(fmaxf(fmaxf(sa[2][0], sa[2][1]), fmaxf(sa[2][2], sa[2][3])), fmaxf(fmaxf(sa[3][0], sa[3][1]), fmaxf(sa[3][2], sa[3][3]))));
            cm = fmaxf(cm, __shfl_xor(cm, 16)); cm = fmaxf(cm, __shfl_xor(cm, 32));
            const float mnew = fmaxf(mrun, cm); const float alpha = __builtin_amdgcn_exp2f((mrun - mnew) * SM_C); const float msc = mnew * SM_C; mrun = mnew;
            lsum *= alpha;
#pragma unroll
            for (int dt = 0; dt < 8; ++dt) o[dt] = o[dt] * alpha;
            unsigned pk[4][2];
#pragma unroll
            for (int tt = 0; tt < 4; ++tt) { float pp[4];
#pragma unroll
                for (int j = 0; j < 4; ++j) { pp[j] = __builtin_amdgcn_exp2f(sa[tt][j] * SM_C - msc); lsum += pp[j]; }
                pk[tt][0] = pg8::cvt_pk_bf16(pp[0], pp[1]); pk[tt][1] = pg8::cvt_pk_bf16(pp[2], pp[3]); }
            if (c == 3 && has_next) {
#pragma unroll
                for (int ks = 0; ks < 4; ++ks) qf[ks] = (n < 4) ? __builtin_bit_cast(bf16x8, __builtin_amdgcn_raw_buffer_load_b128(qr, qlo + 64 * ks, t2 * 8192 + kvh2 * 1024, 0)) : (bf16x8){0, 0, 0, 0, 0, 0, 0, 0};
            }
#pragma unroll
            for (int hf = 0; hf < 2; ++hf) {
#pragma unroll
                for (int i = 0; i < 8; ++i) *(LAS u32x4*)(vwb + i * 1024) = vst[i];
                if (hf == 0) {
#pragma unroll
                    for (int i = 0; i < 8; ++i) vst[i] = __builtin_amdgcn_raw_buffer_load_b128(vr, (int)ilc[c * 64 + 32 + 4 * i + g4] * 256 + vvo, 0, 0);
                } else if (c < 3) {
#pragma unroll
                    for (int i = 0; i < 8; ++i) vst[i] = __builtin_amdgcn_raw_buffer_load_b128(vr, (int)ilc[(c + 1) * 64 + 4 * i + g4] * 256 + vvo, 0, 0);
                } else if (has_next) {
                    const __amdgpu_buffer_rsrc_t vr2 = kv_rsrc(V1 + slice2);
#pragma unroll
                    for (int i = 0; i < 8; ++i) vst[i] = __builtin_amdgcn_raw_buffer_load_b128(vr2, (int)iln[4 * i + g4] * 256 + vvo, 0, 0);
                }
                u32x4 pw; pw.x = pk[2 * hf][0]; pw.y = pk[2 * hf][1]; pw.z = pk[2 * hf + 1][0]; pw.w = pk[2 * hf + 1][1];
                const bf16x8 pf = __builtin_bit_cast(bf16x8, pw);
#pragma unroll
                for (int dt = 0; dt < 8; ++dt) {
                    const s16x4 lo = __builtin_amdgcn_ds_read_tr16_b64_v4i16((LAS s16x4*)(trb[dt & 3] + 128 * (dt >> 2)));
                    const s16x4 hi = __builtin_amdgcn_ds_read_tr16_b64_v4i16((LAS s16x4*)(trb[dt & 3] + 128 * (dt >> 2) + 16 * 256));
                    const bf16x8 vf = __builtin_shufflevector(lo, hi, 0, 1, 2, 3, 4, 5, 6, 7);
                    o[dt] = __builtin_amdgcn_mfma_f32_16x16x32_bf16(vf, pf, o[dt], 0, 0, 0);
                    if (dt & 1) asm volatile("" ::: "memory");
                }
            }
        }
        lsum += __shfl_xor(lsum, 16); lsum += __shfl_xor(lsum, 32);
        if (n < 4) { const float li = 16.0f / lsum;
#pragma unroll
            for (int dt = 0; dt < 8; ++dt) { int wv = __builtin_amdgcn_cvt_pk_fp8_f32(o[dt][0] * li, o[dt][1] * li, 0, false); wv = __builtin_amdgcn_cvt_pk_fp8_f32(o[dt][2] * li, o[dt][3] * li, wv, true);
                __builtin_amdgcn_raw_buffer_store_b32((unsigned)wv, orr, olo + 16 * dt, t * 4096 + kvh * 512, 0); } }
        par ^= 1;
    }
#undef DSA_ITEM
}

#ifndef MK_ONE_LAUNCH
#define MK_ONE_LAUNCH 1
#endif
constexpr int N_PHASES = 19;
#ifndef FFN1_FP8
#define FFN1_FP8 1
#endif
#ifndef WGM_F
#define WGM_F 8
#endif
#ifndef WGM_Y
#define WGM_Y 2
#endif
struct Args { const float* in[22]; float* out; unsigned char* ws; int ph_lo, ph_hi; };

__global__ void __launch_bounds__(NTHR, 2) mk_fwd(Args args) {
    extern __shared__ __attribute__((aligned(16))) unsigned char lds_raw[];
    LAS unsigned char* lds = (LAS unsigned char*)lds_raw;
    const int bid = blockIdx.x, G = gridDim.x;
    const int wid_s = __builtin_amdgcn_readfirstlane((int)(threadIdx.x >> 6));
#define tid fresh_tid(wid_s)
    unsigned char* ws = args.ws;
    const __attribute__((address_space(4))) unsigned char* kargs = (const __attribute__((address_space(4))) unsigned char*)__builtin_amdgcn_kernarg_segment_ptr();
#define ARG_IN(i) (*(const float* const volatile __attribute__((address_space(4)))*)(kargs + 8 * (i)))
    volatile LAS unsigned* misc = (volatile LAS unsigned*)(lds + MISC_OFF);
    { const int t0_ = tid; if (t0_ < 4) misc[t0_] = 0u; }
    __syncthreads();
    const int lo = args.ph_lo, hi = args.ph_hi;
    XcdBarrier bar; bar.bar = (unsigned*)(ws + WS_CTL); bar.x = 0; bar.st = nullptr; bar.wid = wid_s;
    if (hi - lo > 1) bar = xcd_barrier_post((unsigned*)(ws + WS_CTL), misc, wid_s);
#ifndef PH_MASK
#define PH_MASK 0x7ffff
#endif
#define IN(k) ((((PH_MASK) >> (k)) & 1) && lo <= (k) && (k) < hi)
#ifndef PROBE_PH
#define PROBE_PH -1
#endif
#ifndef PROBE_PH2
#define PROBE_PH2 -1
#endif
    unsigned long long pr_t0 = (PROBE_PH == 0) ? __builtin_amdgcn_s_memrealtime() : 0ull, pr_acc = 0ull;
#define SEAM(k) do { if (IN(k) && IN((k) + 1)) xcd_barrier(bar); \
        if (PROBE_PH >= 0 && bid == 0) { const unsigned long long now_ = __builtin_amdgcn_s_memrealtime(); if ((k) + 1 == PROBE_PH) pr_t0 = now_; if ((k) == (PROBE_PH2 >= 0 ? PROBE_PH2 : PROBE_PH)) pr_acc = now_ - pr_t0; } } while (0)
#ifndef DUP_MASK
#define DUP_MASK 0
#endif
#define REP(k) _Pragma("unroll 1") for (int rep_ = 0; rep_ < ((((DUP_MASK) >> (k)) & 1) ? 2 : 1); ++rep_)

    float* CS = (float*)(ws + WS_COS); float* SN = (float*)(ws + WS_SIN);
    bf16_t* XB = (bf16_t*)(ws + WS_XB); half_t* XH = (half_t*)(ws + WS_XA); half_t* Y = (half_t*)(ws + B_Y); bf16_t* Hh = (bf16_t*)(ws + B_H);
    float* OUT = args.out;
    const pg8::RopeTab rt{CS, SN};
#define RSRC256M(p) __builtin_amdgcn_make_buffer_rsrc((void*)(p), 0, (int)(256u * 1048576u), 0x00020000)

    if (IN(0)) REP(0) {
        LAS float* scr = (LAS float*)lds;
        wt_matrix8(ARG_IN(2), DM, N_A, (unsigned char*)(ws + W0IN), MapA{}, scr, tid, bid, G, 64.0f);
        wt_matrix8(ARG_IN(3), 2048, DM, (unsigned char*)(ws + W0OUT), MapId{}, scr, tid, bid, G, 64.0f);
        wt_matrix(ARG_IN(10), DM, DFF, (bf16_t*)(ws + W0GU), MapGU{0}, scr, tid, bid, G);
        wt_matrix(ARG_IN(11), DM, DFF, (bf16_t*)(ws + W0GU), MapGU{1}, scr, tid, bid, G);
        cvt_x8_phase(ARG_IN(0), (unsigned char*)XB, tid, bid, G);
        rope_tab_phase((const int*)ARG_IN(1), CS, SN, tid, bid, G);
    }
    SEAM(0);
    if (IN(1)) REP(1) {
        pg8::Gemm g{XB, (const bf16_t*)(ws + W0IN), MTOK, N_A, DM / 2}; pg8::StaticOrder S; S.init(MTOK, N_A, G, bid);
        pg8::EpiQKV0 E{__builtin_amdgcn_make_buffer_rsrc((void*)(ws + B_QKV0), 0, (int)(576u * 1048576u), 0x00020000), __builtin_amdgcn_make_buffer_rsrc((void*)CS, 0, MTOK * 256, 0x00020000), __builtin_amdgcn_make_buffer_rsrc((void*)SN, 0, MTOK * 256, 0x00020000), 0.015625f};
        pg8::gemm_phase<pg8::EpiQKV0, pg8::StaticOrder, true, true, true, 6>(lds, g, S, E, tid);
    }
    SEAM(1);
    if (IN(2)) REP(2) attn0_phase((const unsigned char*)(ws + B_QKV0), (bf16_t*)(ws + B_OG), (float*)(ws + B_LSE), lds, tid, bid, G);
    SEAM(2);
    if (IN(3)) REP(3) merge_phase((const bf16_t*)(ws + B_OG), (const float*)(ws + B_LSE), (unsigned char*)(ws + B_AO0), tid, bid, G);
    SEAM(3);
    if (IN(4)) REP(4) {
        pg8::Gemm g{(const bf16_t*)(ws + B_AO0), (const bf16_t*)(ws + W0OUT), MTOK, DM, 1024}; pg8::StaticOrder S; S.init(MTOK, DM, G, bid, WGM_Y);
        pg8::EpiY<false> E{RSRC256M(ARG_IN(0)), RSRC256M(Y), ALPHA, 1.0f / 1024.0f};
        pg8::gemm_phase<pg8::EpiY<false>, pg8::StaticOrder, true, true, true>(lds, g, S, E, tid);
    }
    SEAM(4);
    if (IN(5)) REP(5) ln_phase(Y, ARG_IN(8), ARG_IN(9), nullptr, XH, XB, tid, bid, G);
    SEAM(5);
    if (IN(6)) REP(6) {
        pg8::Gemm g{XB, (const bf16_t*)(ws + W0GU), MTOK, 2 * DFF, DM}; pg8::StaticOrder S; S.init(MTOK, 2 * DFF, G, bid, WGM_F);
        pg8::EpiSwiGLU<false> E{Hh, DFF};
        pg8::gemm_phase<pg8::EpiSwiGLU<false>, pg8::StaticOrder, true, true>(lds, g, S, E, tid);
        {
            const int rem = ((MTOK / 256) * ((2 * DFF) / 256)) % G, cb = rem ? bid - rem : bid, cg = rem ? G - rem : G;
            if (cb >= 0) { __syncthreads(); wt_matrix(ARG_IN(12), DFF, DM, (bf16_t*)(ws + W0DN), MapId{}, (LAS float*)lds, tid, cb, cg); }
        }
    }
    SEAM(6);
    if (IN(7)) REP(7) {
        pg8::Gemm g{Hh, (const bf16_t*)(ws + W0DN), MTOK, DM, DFF}; pg8::StaticOrder S; S.init(MTOK, DM, G, bid, WGM_Y);
        pg8::EpiY<true> E{RSRC256M(XH), RSRC256M(Y), ALPHA, 1.0f};
        pg8::gemm_phase<pg8::EpiY<true>, pg8::StaticOrder, true, true>(lds, g, S, E, tid);
    }
    SEAM(7);
    if (IN(8)) REP(8) {
        ln_phase(Y, ARG_IN(13), ARG_IN(14), nullptr, XH, XB, tid, bid, G, ws + WS_XB8);
        LAS float* scr = (LAS float*)lds;
        wt_matrix8(ARG_IN(4), DM, 6144, (unsigned char*)(ws + W1IN), MapB{}, scr, tid, bid, G, 64.0f, N_B);
        wt_matrix(ARG_IN(4) + 6144, DM, N_B - 6144, (bf16_t*)(ws + W1INB), MapB2{}, scr, tid, bid, G, N_B);
        { u32x4* z = (u32x4*)(ws + W1INB + (size_t)(N_B - 6144) * DM * 2); const int nz = (N_BP - N_B) * DM * 2 / 16; for (int i = bid * NTHR + tid; i < nz; i += G * NTHR) z[i] = (u32x4){0u, 0u, 0u, 0u}; }
        wt_matrix8(ARG_IN(7), DM, DM, (unsigned char*)(ws + W1OUT), MapId{}, scr, tid, bid, G, 64.0f);
        wt_matrix(ARG_IN(17), DM, DFF, (bf16_t*)(ws + W1GU), MapGU{0}, scr, tid, bid, G);
        wt_matrix(ARG_IN(18), DM, DFF, (bf16_t*)(ws + W1GU), MapGU{1}, scr, tid, bid, G);
    }
    SEAM(8);
    if (IN(9)) REP(9) {
        {
            pg8::Gemm g{(const bf16_t*)(ws + WS_XB8), (const bf16_t*)(ws + W1IN), MTOK, 6144, DM / 2}; pg8::StaticOrder S; S.init(MTOK, 6144, G, bid);
            pg8::EpiQKV1a E{__builtin_amdgcn_make_buffer_rsrc((void*)(ws + B_Q1), 0, MTOK * 8192, 0x00020000), __builtin_amdgcn_make_buffer_rsrc((void*)(ws + B_K1), 0, MTOK * 2048, 0x00020000),
                            __builtin_amdgcn_make_buffer_rsrc((void*)(ws + B_V1), 0, MTOK * 2048, 0x00020000), __builtin_amdgcn_make_buffer_rsrc((void*)CS, 0, MTOK * 256, 0x00020000),
                            __builtin_amdgcn_make_buffer_rsrc((void*)SN, 0, MTOK * 256, 0x00020000), 0.015625f};
            pg8::gemm_phase<pg8::EpiQKV1a, pg8::StaticOrder, true, true, true>(lds, g, S, E, tid);
        }
        __syncthreads();
        {
            pg8::Gemm g{XB, (const bf16_t*)(ws + W1INB), MTOK, N_BP - 6144, DM}; pg8::StaticOrder S; S.init(MTOK, N_BP - 6144, G, bid);
            pg8::EpiQKV1 E{(bf16_t*)(ws + B_Q1), (bf16_t*)(ws + B_K1), (bf16_t*)(ws + B_V1), (unsigned short*)(ws + B_QI), (float*)(ws + B_KIR), (float*)(ws + B_WI), rt, 24, 1.0f};
            pg8::gemm_phase<pg8::EpiQKV1, pg8::StaticOrder, true, true>(lds, g, S, E, tid);
        }
        {
            const int rem = ((MTOK / 256) * ((N_BP - 6144) / 256)) % G, cb = rem ? bid - rem : bid, cg = rem ? G - rem : G;
            if (cb >= 0) { __syncthreads();
#if FFN1_FP8
                wt_matrix8(ARG_IN(19), DFF, DM, (unsigned char*)(ws + W1DN), MapId{}, (LAS float*)lds, tid, cb, cg, 128.0f);
#else
                wt_matrix(ARG_IN(19), DFF, DM, (bf16_t*)(ws + W1DN), MapId{}, (LAS float*)lds, tid, cb, cg);
#endif
            }
        }
    }
    SEAM(9);
    if (IN(10)) REP(10) kidx_phase((const float*)(ws + B_KIR), ARG_IN(5), ARG_IN(6), CS, SN, (unsigned short*)(ws + B_KI16), tid, bid, G);
    SEAM(10);
    if (IN(11)) REP(11) indexer_phase((const unsigned short*)(ws + B_QI), (const unsigned short*)(ws + B_KI16), (const float*)(ws + B_WI), (float*)(ws + B_SC), lds, tid, bid, G);
    SEAM(11);
    if (IN(12)) REP(12) topk_phase((const float*)(ws + B_SC), (unsigned short*)(ws + B_IDX), lds, tid, bid, G);
    SEAM(12);
    if (IN(13)) REP(13) dsa_attn_phase((const bf16_t*)(ws + B_Q1), (const bf16_t*)(ws + B_K1), (const bf16_t*)(ws + B_V1), (const unsigned short*)(ws + B_IDX), (unsigned char*)(ws + B_AO1), lds, tid, bid, G);
    SEAM(13);
    if (IN(14)) REP(14) {
        pg8::Gemm g{(const bf16_t*)(ws + B_AO1), (const bf16_t*)(ws + W1OUT), MTOK, DM, DM / 2}; pg8::StaticOrder S; S.init(MTOK, DM, G, bid, WGM_Y);
        pg8::EpiY<true> E{RSRC256M(XH), RSRC256M(Y), ALPHA, 1.0f / 1024.0f};
        pg8::gemm_phase<pg8::EpiY<true>, pg8::StaticOrder, true, true, true>(lds, g, S, E, tid);
    }
    SEAM(14);
    if (IN(15)) REP(15) ln_phase(Y, ARG_IN(15), ARG_IN(16), nullptr, XH, XB, tid, bid, G);
    SEAM(15);
    if (IN(16)) REP(16) {
        pg8::Gemm g{XB, (const bf16_t*)(ws + W1GU), MTOK, 2 * DFF, DM}; pg8::StaticOrder S; S.init(MTOK, 2 * DFF, G, bid, WGM_F);
        pg8::EpiSwiGLU<FFN1_FP8 != 0> E{Hh, DFF};
        pg8::gemm_phase<pg8::EpiSwiGLU<FFN1_FP8 != 0>, pg8::StaticOrder, true, true>(lds, g, S, E, tid);
    }
    SEAM(16);
    if (IN(17)) REP(17) {
#if FFN1_FP8
        pg8::Gemm g{Hh, (const bf16_t*)(ws + W1DN), MTOK, DM, DFF / 2}; pg8::StaticOrder S; S.init(MTOK, DM, G, bid, WGM_Y);
        pg8::EpiY<true> E{RSRC256M(XH), RSRC256M(Y), ALPHA, 1.0f / 2048.0f};
        pg8::gemm_phase<pg8::EpiY<true>, pg8::StaticOrder, true, true, true>(lds, g, S, E, tid);
#else
        pg8::Gemm g{Hh, (const bf16_t*)(ws + W1DN), MTOK, DM, DFF}; pg8::StaticOrder S; S.init(MTOK, DM, G, bid, WGM_Y);
        pg8::EpiY<true> E{RSRC256M(XH), RSRC256M(Y), ALPHA, 1.0f};
        pg8::gemm_phase<pg8::EpiY<true>, pg8::StaticOrder, true, true>(lds, g, S, E, tid);
#endif
    }
    SEAM(17);
    if (IN(18)) REP(18) ln_phase(Y, ARG_IN(20), ARG_IN(21), OUT, nullptr, nullptr, tid, bid, G);
    if (PROBE_PH >= 0 && bid == 0) { const unsigned long long t1_ = __builtin_amdgcn_s_memrealtime(); while (__builtin_amdgcn_s_memrealtime() - t1_ < pr_acc) __builtin_amdgcn_s_sleep(8); }
#undef IN
#undef ARG_IN
#undef tid
#undef SEAM
#undef REP
}

extern "C" void kernel_launch(void* const* d_in, const int* in_sizes, int n_in, void* d_out, int out_size, void* d_ws, size_t ws_size, hipStream_t stream) {
    static int grid = 0;
    if (grid == 0) {
        if (n_in != 22 || out_size != MTOK * DM || ws_size < WS_END) { fprintf(stderr, "kernel_launch: unexpected problem (n_in %d, out %d, ws %zu < %zu); nothing launched\n", n_in, out_size, ws_size, (size_t)WS_END); grid = -1; return; }
        int dev = 0, cus = 0, per_cu = 0;
        if (hipGetDevice(&dev) != hipSuccess || hipDeviceGetAttribute(&cus, hipDeviceAttributeMultiprocessorCount, dev) != hipSuccess) { grid = -1; return; }
        if (hipFuncSetAttribute((const void*)mk_fwd, hipFuncAttributeMaxDynamicSharedMemorySize, LDS_BYTES) != hipSuccess) { fprintf(stderr, "kernel_launch: hipFuncSetAttribute failed\n"); grid = -1; return; }
        if (hipOccupancyMaxActiveBlocksPerMultiprocessor(&per_cu, (const void*)mk_fwd, NTHR, LDS_BYTES) != hipSuccess || per_cu < 1) { fprintf(stderr, "kernel_launch: occupancy query reports %d\n", per_cu); (void)hipGetLastError(); per_cu = 1; }
        grid = cus;
    }
    if (grid < 0) return;
    (void)in_sizes;
    if (hipMemsetAsync((char*)d_ws + WS_CTL, 0, CTL_ZERO_BYTES, stream) != hipSuccess) return;
    Args a{};
    for (int i = 0; i < 22; ++i) a.in[i] = (const float*)d_in[i];
    a.out = (float*)d_out; a.ws = (unsigned char*)d_ws;
#if MK_ONE_LAUNCH
    a.ph_lo = 0; a.ph_hi = N_PHASES;
    hipLaunchKernelGGL(mk_fwd, dim3(grid), dim3(NTHR), LDS_BYTES, stream, a);
#else
    for (int p = 0; p < N_PHASES; ++p) { a.ph_lo = p; a.ph_hi = p + 1; hipLaunchKernelGGL(mk_fwd, dim3(grid), dim3(NTHR), LDS_BYTES, stream, a); }
#endif
}
```

```cpp
#include <hip/hip_runtime.h>
#include <cstdio>
#include <cstdint>
namespace pg8 {
#define PG8_LAS __attribute__((address_space(3)))
typedef unsigned short bf16_t;
typedef short bf16x8 __attribute__((ext_vector_type(8)));
typedef float f32x4 __attribute__((ext_vector_type(4)));
typedef unsigned u32x4 __attribute__((ext_vector_type(4)));
constexpr int BM = 256, BK = 64, HALF = 128, HTB = HALF * BK * 2  , STAGE_BYTES = 8 * HTB, NXCD = 8, WGM = 8;

__host__ __device__ __forceinline__ int lds_byte(int r, int c) { const int st = (r >> 4) * 2 + (c >> 5), rr = r & 15, cc = c & 31, ob = rr * 64 + cc * 2; return st * 1024 + (ob ^ (((ob >> 9) & 1) << 5)); }
__host__ __device__ __forceinline__ void stage_rc(int b, int& R, int& C) { const int st = b / 1024, sb = b % 1024, swz = sb ^ (((sb >> 9) & 1) << 5); R = (st >> 1) * 16 + swz / 64; C = (st & 1) * 32 + (swz % 64) / 2; }
__host__ __device__ __forceinline__ int perm32(int rho) { const int n = rho >> 4, i = rho & 15; return 8 * (i >> 2) + 4 * n + (i & 3); }

struct Unit { int pm, pn; };
struct Gemm { const bf16_t* A; const bf16_t* Bt; int M, N, K; };

struct StaticOrder {
    int nM, nN, nwg, G, c, wgm;
    __host__ __device__ void init(int M, int N, int G_, int c_, int wgm_ = WGM) { nM = M / BM; nN = N / BM; nwg = nM * nN; G = G_; c = c_; wgm = wgm_; }
    __host__ __device__ bool next(int i, Unit& u) const {
        const long L = (long)i * G + c; if (L >= nwg) return false;
        int wgid = (int)L; { const int q = nwg / NXCD, r = nwg % NXCD, xcd = wgid % NXCD, off = wgid / NXCD; wgid = (xcd < r ? xcd * (q + 1) : r * (q + 1) + (xcd - r) * q) + off; }
        const int nig = wgm * nN, gid = wgid / nig, fm = gid * wgm, gsz = (nM - fm) < wgm ? (nM - fm) : wgm;
        u.pm = fm + ((wgid % nig) % gsz); u.pn = (wgid % nig) / gsz; return true;
    }
    __device__ __forceinline__ void a_ready(const Unit&) const {}
    __device__ __forceinline__ void done(const Unit&) const {}
};
__device__ __forceinline__ unsigned cvt_pk_bf16(float lo, float hi) { unsigned r; asm volatile("v_cvt_pk_bf16_f32 %0, %1, %2" : "=v"(r) : "v"(lo), "v"(hi)); return r; }
typedef _Float16 f16x2_t __attribute__((ext_vector_type(2)));
__device__ __forceinline__ unsigned cvt_pk_f16(float lo, float hi) { f16x2_t h; h.x = (_Float16)lo; h.y = (_Float16)hi; return __builtin_bit_cast(unsigned, h); }

struct RopeTab { const float* cs; const float* sn; };

__device__ __forceinline__ void rope_pair(f32x4& v0, f32x4& v1, const f32x4 c, const f32x4 s) {
    const f32x4 a = v0 * c - v1 * s, b = v1 * c + v0 * s; v0 = a; v1 = b;
}

typedef float f32x2_t __attribute__((ext_vector_type(2)));
typedef unsigned u32x2e_t __attribute__((ext_vector_type(2)));
typedef _Float16 f16x4_t __attribute__((ext_vector_type(4)));
__device__ __forceinline__ f32x4 f16x4_to_f32(u32x2e_t w) { return __builtin_convertvector(__builtin_bit_cast(f16x4_t, w), f32x4); }
template <bool XH = true> struct EpiY {
    static constexpr bool PERM = false, AFTER_DRAIN = false;
    __amdgpu_buffer_rsrc_t X, Y; float alpha, scl;
    __device__ __forceinline__ void operator()(const f32x4 (&acc)[2][2][4][2], const Unit& u, int wr, int wc, int fr, int fq) const {
        const int row0 = u.pm * BM + wr * 64 + fr, col0 = u.pn * BM + wc * 32 + 4 * fq;
#pragma unroll
        for (int ai = 0; ai < 2; ++ai) {
            f32x4 xv[4][2][2];
#pragma unroll
            for (int m = 0; m < 4; ++m) { const int off = ((row0 + ai * HALF + m * 16) * 4096 + col0) * 2;
#pragma unroll
                for (int bj = 0; bj < 2; ++bj)
#pragma unroll
                    for (int n = 0; n < 2; ++n) {
                        if constexpr (XH) xv[m][bj][n] = f16x4_to_f32(__builtin_bit_cast(u32x2e_t, __builtin_amdgcn_raw_buffer_load_b64(X, off + (bj * HALF + n * 16) * 2, 0, 0)));
                        else xv[m][bj][n] = __builtin_bit_cast(f32x4, __builtin_amdgcn_raw_buffer_load_b128(X, 2 * off + (bj * HALF + n * 16) * 4, 0, 0)); } }
#pragma unroll
            for (int m = 0; m < 4; ++m) { const int off = ((row0 + ai * HALF + m * 16) * 4096 + col0) * 2;
#pragma unroll
                for (int bj = 0; bj < 2; ++bj)
#pragma unroll
                    for (int n = 0; n < 2; ++n) { const f32x4 r = xv[m][bj][n] * alpha + acc[ai][bj][m][n] * scl;
                        u32x2e_t w; w.x = cvt_pk_f16(r[0], r[1]); w.y = cvt_pk_f16(r[2], r[3]);
                        __builtin_amdgcn_raw_buffer_store_b64(w, Y, off + (bj * HALF + n * 16) * 2, 0, 0); } }
            asm volatile("" ::: "memory"); }
    }
};

template <bool OUT8 = false> struct EpiSwiGLU {
    static constexpr bool PERM = true, AFTER_DRAIN = false;
    bf16_t* Hh; int ldh;
    __device__ __forceinline__ void operator()(const f32x4 (&acc)[2][2][4][2], const Unit& u, int wr, int wc, int fr, int fq) const {
        const int row0 = u.pm * BM + wr * 64 + fr, col0 = u.pn * HALF + wc * 32 + 8 * fq;
#pragma unroll
        for (int ai = 0; ai < 2; ++ai)
#pragma unroll
            for (int m = 0; m < 4; ++m) { const size_t eoff = (size_t)(row0 + ai * HALF + m * 16) * ldh + col0;
                float h[8];
#pragma unroll
                for (int n = 0; n < 2; ++n)
#pragma unroll
                    for (int i = 0; i < 4; ++i) { const float g = acc[ai][0][m][n][i], up = acc[ai][1][m][n][i];
                        const float e = __builtin_amdgcn_exp2f(-g * 1.44269504089f); h[n * 4 + i] = g * __builtin_amdgcn_rcpf(1.0f + e) * up; }
                if constexpr (OUT8) { int w0 = __builtin_amdgcn_cvt_pk_fp8_f32(h[0] * 16.f, h[1] * 16.f, 0, false); w0 = __builtin_amdgcn_cvt_pk_fp8_f32(h[2] * 16.f, h[3] * 16.f, w0, true);
                    int w1 = __builtin_amdgcn_cvt_pk_fp8_f32(h[4] * 16.f, h[5] * 16.f, 0, false); w1 = __builtin_amdgcn_cvt_pk_fp8_f32(h[6] * 16.f, h[7] * 16.f, w1, true);
                    typedef int i32x2_t __attribute__((ext_vector_type(2))); *(i32x2_t*)((unsigned char*)Hh + eoff) = (i32x2_t){w0, w1}; }
                else { u32x4 w; w.x = cvt_pk_bf16(h[0], h[1]); w.y = cvt_pk_bf16(h[2], h[3]); w.z = cvt_pk_bf16(h[4], h[5]); w.w = cvt_pk_bf16(h[6], h[7]);
                    *(u32x4*)(Hh + eoff) = w; } }
    }
};

struct EpiQKV0 {
    static constexpr bool PERM = true, AFTER_DRAIN = false;
    __amdgpu_buffer_rsrc_t o, cs, sn; float scl;
    __device__ __forceinline__ void operator()(const f32x4 (&acc)[2][2][4][2], const Unit& u, int wr, int wc, int fr, int fq) const {
        const int sg = u.pn >> 3, cw = wc * 32 + 8 * fq, hd0 = (u.pn & 7) * 2; const bool rope = sg < 6;
        const int dsh = 2 * (sg % 3);
        const int row0 = u.pm * BM + wr * 64 + fr, f0 = 16 * wc + 4 * fq;
        const int bb = u.pm >> 5;
        const unsigned sbase = (unsigned)(((sg * 2 + bb) * 16 + hd0) * 8192) * 128u;
#pragma unroll
        for (int ai = 0; ai < 2; ++ai)
#pragma unroll
            for (int m = 0; m < 4; ++m) { const int row = row0 + ai * HALF + m * 16; const int si = row & 8191;
                const int rl = (si & ((1 << dsh) - 1)) * (8192 >> dsh) + (si >> dsh);
                f32x4 c = {1.f, 1.f, 1.f, 1.f}, s = {0.f, 0.f, 0.f, 0.f};
                if (rope) { c = __builtin_bit_cast(f32x4, __builtin_amdgcn_raw_buffer_load_b128(cs, (row * 64 + f0) * 4, 0, 0)); s = __builtin_bit_cast(f32x4, __builtin_amdgcn_raw_buffer_load_b128(sn, (row * 64 + f0) * 4, 0, 0)); }
#pragma unroll
                for (int bj = 0; bj < 2; ++bj) { f32x4 v0 = acc[ai][bj][m][0] * scl, v1 = acc[ai][bj][m][1] * scl;
                    rope_pair(v0, v1, c, s);
                    int w0 = __builtin_amdgcn_cvt_pk_fp8_f32(v0[0], v0[1], 0, false); w0 = __builtin_amdgcn_cvt_pk_fp8_f32(v0[2], v0[3], w0, true);
                    int w1 = __builtin_amdgcn_cvt_pk_fp8_f32(v1[0], v1[1], 0, false); w1 = __builtin_amdgcn_cvt_pk_fp8_f32(v1[2], v1[3], w1, true);
                    typedef unsigned u32x2_t __attribute__((ext_vector_type(2)));
                    __builtin_amdgcn_raw_buffer_store_b64((u32x2_t){(unsigned)w0, (unsigned)w1}, o, rl * 128 + cw, (int)(sbase + (unsigned)bj * (8192u * 128u)), 0); } }
    }
};

struct EpiQKV1a {
    static constexpr bool PERM = true, AFTER_DRAIN = false;
    __amdgpu_buffer_rsrc_t q, k, v, cs, sn; float scl;
    __device__ __forceinline__ void operator()(const f32x4 (&acc)[2][2][4][2], const Unit& u, int wr, int wc, int fr, int fq) const {
        const int pn = u.pn; const int row0 = u.pm * BM + wr * 64 + fr, f0 = 16 * wc + 4 * fq, cw = wc * 32 + 8 * fq;
        const bool rope = pn < 20;
#pragma unroll
        for (int ai = 0; ai < 2; ++ai)
#pragma unroll
            for (int m = 0; m < 4; ++m) { const int row = row0 + ai * HALF + m * 16;
                f32x4 c = {1.f, 1.f, 1.f, 1.f}, s = {0.f, 0.f, 0.f, 0.f};
                if (rope) { c = __builtin_bit_cast(f32x4, __builtin_amdgcn_raw_buffer_load_b128(cs, (row * 64 + f0) * 4, 0, 0)); s = __builtin_bit_cast(f32x4, __builtin_amdgcn_raw_buffer_load_b128(sn, (row * 64 + f0) * 4, 0, 0)); }
#pragma unroll
                for (int bj = 0; bj < 2; ++bj) { f32x4 v0 = acc[ai][bj][m][0] * scl, v1 = acc[ai][bj][m][1] * scl;
                    rope_pair(v0, v1, c, s);
                    u32x4 w; w.x = cvt_pk_bf16(v0[0], v0[1]); w.y = cvt_pk_bf16(v0[2], v0[3]); w.z = cvt_pk_bf16(v1[0], v1[1]); w.w = cvt_pk_bf16(v1[2], v1[3]);
                    if (pn < 16) __builtin_amdgcn_raw_buffer_store_b128(w, q, (row * 4096 + bj * HALF + cw) * 2, pn * 512, 0);
                    else { const int kvh = ((pn - 16) & 3) * 2 + bj; const int off = ((((row >> 13) * 8 + kvh) * 8192 + (row & 8191)) * 128 + cw) * 2;
                        if (pn < 20) __builtin_amdgcn_raw_buffer_store_b128(w, k, off, 0, 0); else __builtin_amdgcn_raw_buffer_store_b128(w, v, off, 0, 0); } } }
    }
};

struct EpiQKV1 {
    static constexpr bool PERM = true, AFTER_DRAIN = false;
    bf16_t* Q; bf16_t* Kc; bf16_t* Vc; unsigned short* QI; float* KIR; float* WI; RopeTab rt; int pn_off; float scl;
    __device__ __forceinline__ void operator()(const f32x4 (&acc)[2][2][4][2], const Unit& u, int wr, int wc, int fr, int fq) const {
        const int pn = u.pn + pn_off; const int row0 = u.pm * BM + wr * 64 + fr, f0 = 16 * wc + 4 * fq, cw = wc * 32 + 8 * fq;
        const bool rope = (pn < 20) || (pn >= 24 && pn < 40);
#pragma unroll
        for (int ai = 0; ai < 2; ++ai)
#pragma unroll
            for (int m = 0; m < 4; ++m) { const int row = row0 + ai * HALF + m * 16;
                f32x4 c = {1.f, 1.f, 1.f, 1.f}, s = {0.f, 0.f, 0.f, 0.f};
                if (rope) { c = *(const f32x4*)(rt.cs + (size_t)row * 64 + f0); s = *(const f32x4*)(rt.sn + (size_t)row * 64 + f0); }
#pragma unroll
                for (int bj = 0; bj < 2; ++bj) { f32x4 v0 = acc[ai][bj][m][0] * scl, v1 = acc[ai][bj][m][1] * scl;
                    if (pn < 40) {
                        rope_pair(v0, v1, c, s);
                        u32x4 w;
                        if (pn >= 24) { w.x = cvt_pk_f16(v0[0], v0[1]); w.y = cvt_pk_f16(v0[2], v0[3]); w.z = cvt_pk_f16(v1[0], v1[1]); w.w = cvt_pk_f16(v1[2], v1[3]); }
                        else { w.x = cvt_pk_bf16(v0[0], v0[1]); w.y = cvt_pk_bf16(v0[2], v0[3]); w.z = cvt_pk_bf16(v1[0], v1[1]); w.w = cvt_pk_bf16(v1[2], v1[3]); }
                        if (pn < 16) *(u32x4*)(Q + (size_t)row * 4096 + pn * BM + bj * HALF + cw) = w;
                        else if (pn < 24) { const int kvh = ((pn - 16) & 3) * 2 + bj; bf16_t* dst = (pn < 20 ? Kc : Vc) + ((size_t)((row >> 13) * 8 + kvh) * 8192 + (row & 8191)) * 128 + cw; *(u32x4*)dst = w; }
                        else *(u32x4*)(QI + (size_t)row * 4096 + (pn - 24) * BM + bj * HALF + cw) = w;
                    } else {
                        if (bj == 0) { *(f32x4*)(KIR + (size_t)row * 128 + cw) = v0; *(f32x4*)(KIR + (size_t)row * 128 + cw + 4) = v1; }
                        else if (wc == 0) { *(f32x4*)(WI + (size_t)row * 32 + cw) = v0 * 0.015625f; *(f32x4*)(WI + (size_t)row * 32 + cw + 4) = v1 * 0.015625f; }
                    } } }
    }
};

typedef int i32x4_t __attribute__((ext_vector_type(4)));
typedef int i32x8_t __attribute__((ext_vector_type(8)));
__device__ __forceinline__ i32x8_t cat8(bf16x8 a, bf16x8 b) { return __builtin_shufflevector(__builtin_bit_cast(i32x4_t, a), __builtin_bit_cast(i32x4_t, b), 0, 1, 2, 3, 4, 5, 6, 7); }
template <class Epi, class Sched, bool ALIGN_EPI = false, bool SP2 = false, bool FP8 = false, int WSH = 6>
__device__ __forceinline__ void gemm_phase(PG8_LAS unsigned char* lds, const Gemm g, const Sched& S, const Epi& E, const int tid) {
    const int wid = __builtin_amdgcn_readfirstlane(tid >> 6), lane = tid & 63, wr = wid >> 2, wc = wid & 3, fr = lane & 15, fq = lane >> 4;
    const int K = g.K, nt = K / BK;
    unsigned voffA[2], voffB[2];
#pragma unroll
    for (int i = 0; i < 2; ++i) { int R, C; stage_rc(tid * 16 + i * 8192, R, C); const int Rb = Epi::PERM ? ((R & ~31) + perm32(R & 31)) : R;
        voffA[i] = (unsigned)(R * K + C) * 2u; voffB[i] = (unsigned)(Rb * K + C) * 2u; }
    const size_t kstep = (size_t)(BK * 2);
    const size_t hstep = (size_t)HALF * K * 2;
    const size_t tstep = 2 * hstep;
    const unsigned ldsw = (unsigned)wid * 1024u;
    const int aoff = lds_byte(wr * 64 + fr, fq * 8), boff = lds_byte(wc * 32 + fr, fq * 8);
#define PG8_SA(b, h) (((b) * 2 + (h)) * HTB)
#define PG8_SB(b, h) ((4 + (b) * 2 + (h)) * HTB)
#define PG8_STAGE(bufoff, gbase, voff) do { const char* gb_ = (const char*)(gbase); \
        { const unsigned long long gq_ = (unsigned long long)gb_; gb_ = (const char*)(((unsigned long long)(unsigned)__builtin_amdgcn_readfirstlane((int)(gq_ >> 32)) << 32) | (unsigned)__builtin_amdgcn_readfirstlane((int)gq_)); }   \
        _Pragma("unroll") for (int _i = 0; _i < 2; ++_i) \
        __builtin_amdgcn_global_load_lds((const unsigned*)(gb_ + (voff)[_i]), (PG8_LAS unsigned*)(lds + (bufoff) + ldsw + _i * 8192), 16, 0, 0); } while (0)
#define PG8_LDA(dst, b, h) do { _Pragma("unroll") for (int m = 0; m < 4; ++m) { if constexpr (FP8) dst##8[m] = cat8(*(const PG8_LAS bf16x8*)(lds + PG8_SA(b, h) + aoff + m * 2048), *(const PG8_LAS bf16x8*)(lds + PG8_SA(b, h) + aoff + m * 2048 + 1024)); \
        else { _Pragma("unroll") for (int k = 0; k < 2; ++k) dst[m][k] = *(const PG8_LAS bf16x8*)(lds + PG8_SA(b, h) + aoff + m * 2048 + k * 1024); } } } while (0)
#define PG8_LDB(dst, b, h) do { _Pragma("unroll") for (int n = 0; n < 2; ++n) { if constexpr (FP8) dst##8[n] = cat8(*(const PG8_LAS bf16x8*)(lds + PG8_SB(b, h) + boff + n * 2048), *(const PG8_LAS bf16x8*)(lds + PG8_SB(b, h) + boff + n * 2048 + 1024)); \
        else { _Pragma("unroll") for (int k = 0; k < 2; ++k) dst[n][k] = *(const PG8_LAS bf16x8*)(lds + PG8_SB(b, h) + boff + n * 2048 + k * 1024); } } } while (0)
#define PG8_MMA(ai, bj, At, Bt) do { __builtin_amdgcn_s_setprio(1); _Pragma("unroll") for (int m = 0; m < 4; ++m) _Pragma("unroll") for (int n = 0; n < 2; ++n) { \
        if constexpr (FP8) acc[ai][bj][m][n] = __builtin_amdgcn_mfma_scale_f32_16x16x128_f8f6f4(Bt##8[n], At##8[m], acc[ai][bj][m][n], 0, 0, 0, 0x7f7f7f7f, 0, 0x7f7f7f7f); \
        else { _Pragma("unroll") for (int k = 0; k < 2; ++k) acc[ai][bj][m][n] = __builtin_amdgcn_mfma_f32_16x16x32_bf16(Bt[n][k], At[m][k], acc[ai][bj][m][n], 0, 0, 0); } } __builtin_amdgcn_s_setprio(0); } while (0)
#define PG8_WAIT_V(n) asm volatile("s_waitcnt vmcnt(" #n ")" ::: "memory")
#define PG8_WAIT_L(n) asm volatile("s_waitcnt lgkmcnt(" #n ")" ::: "memory")
#define PG8_BAR __builtin_amdgcn_s_barrier()
#define PG8_SCHED __builtin_amdgcn_sched_barrier(0)
    Unit cur, nxt; int ui = 0;
    if (!S.next(0, cur)) return;
    f32x4 acc[2][2][4][2];
#pragma unroll
    for (int a = 0; a < 2; ++a)
#pragma unroll
        for (int b = 0; b < 2; ++b)
#pragma unroll
            for (int m = 0; m < 4; ++m)
#pragma unroll
                for (int n = 0; n < 2; ++n) acc[a][b][m][n] = (f32x4){0.f, 0.f, 0.f, 0.f};
    bf16x8 At[4][2], B0[2][2], B1[2][2]; i32x8_t At8[4], B08[2], B18[2];
    const char* cA = (const char*)g.A + (size_t)cur.pm * tstep; const char* cB = (const char*)g.Bt + (size_t)cur.pn * tstep;
    S.a_ready(cur);
    if constexpr (SP2) {
        PG8_STAGE(PG8_SB(0, 0), cB, voffB); PG8_STAGE(PG8_SB(0, 1), cB + hstep, voffB); PG8_STAGE(PG8_SA(0, 0), cA, voffA); PG8_STAGE(PG8_SA(0, 1), cA + hstep, voffA);
        if (wr == 1) PG8_BAR;
        PG8_WAIT_V(2); PG8_BAR;
        PG8_STAGE(PG8_SB(1, 0), cB + kstep, voffB); PG8_STAGE(PG8_SA(1, 0), cA + kstep, voffA); PG8_STAGE(PG8_SB(1, 1), cB + hstep + kstep, voffB);
        PG8_WAIT_V(6); PG8_BAR;
    } else {
        PG8_STAGE(PG8_SB(0, 0), cB, voffB); PG8_STAGE(PG8_SA(0, 0), cA, voffA); PG8_STAGE(PG8_SB(0, 1), cB + hstep, voffB); PG8_STAGE(PG8_SA(0, 1), cA + hstep, voffA);
        if (wr == 1) PG8_BAR;
        PG8_WAIT_V(4); PG8_BAR;
        PG8_STAGE(PG8_SB(1, 0), cB + kstep, voffB); PG8_STAGE(PG8_SA(1, 0), cA + kstep, voffA); PG8_STAGE(PG8_SB(1, 1), cB + hstep + kstep, voffB);
        PG8_WAIT_V(6); PG8_BAR;
    }
    for (;;) {
        const bool has_next = S.next(ui + 1, nxt);
        const char* nA = has_next ? (const char*)g.A + (size_t)nxt.pm * tstep : cA; const char* nB = has_next ? (const char*)g.Bt + (size_t)nxt.pn * tstep : cB;
        for (int t = 0; t < nt; t += 2) {
            const bool last = (t == nt - 2);
            const char* a1 = cA + (size_t)(t + 1) * kstep;
            const char* a2 = last ? nA : cA + (size_t)(t + 2) * kstep; const char* b2 = last ? nB : cB + (size_t)(t + 2) * kstep;
            const char* a3 = a2 + kstep; const char* b3 = b2 + kstep;
            if (last && has_next) S.a_ready(nxt);
            if constexpr (SP2) {
            PG8_LDB(B0, 0, 0); PG8_LDB(B1, 0, 1); PG8_SCHED; PG8_LDA(At, 0, 0); PG8_STAGE(PG8_SA(1, 1), a1 + hstep, voffA);
            PG8_WAIT_V(8); PG8_WAIT_L(0); PG8_BAR; PG8_MMA(0, 0, At, B0); PG8_MMA(0, 1, At, B1); PG8_BAR; PG8_SCHED;
            PG8_LDA(At, 0, 1); PG8_STAGE(PG8_SB(0, 0), b2, voffB); PG8_STAGE(PG8_SB(0, 1), b2 + hstep, voffB); PG8_STAGE(PG8_SA(0, 0), a2, voffA);
            PG8_WAIT_V(8); PG8_WAIT_L(0); PG8_BAR; PG8_MMA(1, 0, At, B0); PG8_MMA(1, 1, At, B1); PG8_BAR; PG8_SCHED;
            PG8_LDB(B0, 1, 0); PG8_LDB(B1, 1, 1); PG8_SCHED; PG8_LDA(At, 1, 0); PG8_STAGE(PG8_SA(0, 1), a2 + hstep, voffA);
            PG8_WAIT_V(8); PG8_WAIT_L(0); PG8_BAR; PG8_MMA(0, 0, At, B0); PG8_MMA(0, 1, At, B1); PG8_BAR; PG8_SCHED;
            PG8_LDA(At, 1, 1); PG8_STAGE(PG8_SB(1, 0), b3, voffB); PG8_STAGE(PG8_SB(1, 1), b3 + hstep, voffB); PG8_STAGE(PG8_SA(1, 0), a3, voffA);
            PG8_WAIT_V(8); PG8_WAIT_L(0); PG8_BAR; PG8_MMA(1, 0, At, B0); PG8_MMA(1, 1, At, B1); PG8_BAR; PG8_SCHED;
            } else {
            PG8_LDB(B0, 0, 0); PG8_SCHED; PG8_LDA(At, 0, 0); PG8_STAGE(PG8_SA(1, 1), a1 + hstep, voffA);
            PG8_WAIT_L(8); PG8_BAR; PG8_WAIT_L(0); PG8_MMA(0, 0, At, B0); PG8_BAR; PG8_SCHED;
            PG8_LDB(B1, 0, 1); PG8_STAGE(PG8_SB(0, 0), b2, voffB);
            PG8_BAR; PG8_WAIT_L(0); PG8_MMA(0, 1, At, B1); PG8_BAR;
            PG8_LDA(At, 0, 1); PG8_STAGE(PG8_SA(0, 0), a2, voffA);
            PG8_BAR; PG8_WAIT_L(0); PG8_MMA(1, 0, At, B0); PG8_BAR; PG8_SCHED;
            PG8_STAGE(PG8_SB(0, 1), b2 + hstep, voffB);
            PG8_WAIT_V(6); PG8_BAR; PG8_MMA(1, 1, At, B1); PG8_BAR;
            PG8_LDB(B0, 1, 0); PG8_SCHED; PG8_LDA(At, 1, 0); PG8_STAGE(PG8_SA(0, 1), a2 + hstep, voffA);
            PG8_WAIT_L(8); PG8_BAR; PG8_WAIT_L(0); PG8_MMA(0, 0, At, B0); PG8_BAR; PG8_SCHED;
            PG8_LDB(B1, 1, 1); PG8_STAGE(PG8_SB(1, 0), b3, voffB);
            PG8_BAR; PG8_WAIT_L(0); PG8_MMA(0, 1, At, B1); PG8_BAR;
            PG8_LDA(At, 1, 1); PG8_STAGE(PG8_SA(1, 0), a3, voffA);
            PG8_BAR; PG8_WAIT_L(0); PG8_MMA(1, 0, At, B0); PG8_BAR; PG8_SCHED;
            PG8_STAGE(PG8_SB(1, 1), b3 + hstep, voffB);
            PG8_WAIT_V(6); PG8_BAR; PG8_MMA(1, 1, At, B1); PG8_BAR;
            }
        }
        if constexpr (ALIGN_EPI) { if (wr == 0) PG8_BAR; }
        if constexpr (!Epi::AFTER_DRAIN) { { unsigned z_ = 0u; asm volatile("" : "+v"(z_)); const int l2_ = (int)__builtin_amdgcn_mbcnt_hi(~0u, __builtin_amdgcn_mbcnt_lo(~0u, z_)); E(acc, cur, wr, wc, l2_ & 15, l2_ >> 4); } S.done(cur);     }
        if (!has_next) break;
#pragma unroll
        for (int a = 0; a < 2; ++a)
#pragma unroll
            for (int b = 0; b < 2; ++b)
#pragma unroll
                for (int m = 0; m < 4; ++m)
#pragma unroll
                    for (int n = 0; n < 2; ++n) acc[a][b][m][n] = (f32x4){0.f, 0.f, 0.f, 0.f};
        cur = nxt; cA = nA; cB = nB; ++ui;
        if constexpr (ALIGN_EPI) { if (wr == 1) PG8_BAR; }
    }
    PG8_WAIT_V(0);
    if constexpr (!ALIGN_EPI) { if (wr == 0) PG8_BAR; }
    PG8_BAR;
    if constexpr (Epi::AFTER_DRAIN) { E.fused(acc, cur, wr, wc, fr, fq, lds, wid, lane); S.done(cur); }
#undef PG8_SA
#undef PG8_SB
#undef PG8_STAGE
#undef PG8_LDA
#undef PG8_LDB
#undef PG8_MMA
#undef PG8_WAIT_V
#undef PG8_WAIT_L
#undef PG8_BAR
#undef PG8_SCHED
}
}
#define XB_TMO      128
#define XB_XCNT(j)  (256  + 64 * (j))
#define XB_XSUB(j)  (1280 + 64 * (j))
#define XB_XGEN(j)  (2304 + 64 * (j))
#define XB_TOP      3328
#define XB_TOPGEN   3392
#define XCD_BAR_WORDS 3456
#define XB_SPIN_CAP (1u << 18)
#define LAS __attribute__((address_space(3)))

__device__ __forceinline__ unsigned xb_ld(unsigned* p)              { return __hip_atomic_load(p, __ATOMIC_RELAXED, __HIP_MEMORY_SCOPE_AGENT); }
__device__ __forceinline__ unsigned xb_add(unsigned* p, unsigned v) { return __hip_atomic_fetch_add(p, v, __ATOMIC_RELAXED, __HIP_MEMORY_SCOPE_AGENT); }
__device__ __forceinline__ unsigned xb_xcc_id() { return (unsigned)__builtin_amdgcn_s_getreg((3 << 11) | 20) & 0xFu; }
#define XB_SPIN(cond, bar) do { unsigned _sp = 0; while (cond) { __builtin_amdgcn_s_sleep(1); \
    if ((++_sp & 255u) == 0u) { if (xb_ld(&(bar)[XB_TMO])) break; if (_sp > XB_SPIN_CAP) { atomicAdd(&(bar)[XB_TMO], 1u); break; } } } } while (0)

__device__ __forceinline__ bool xb_lane0() { unsigned z = 0u; asm volatile("" : "+v"(z)); return __builtin_amdgcn_mbcnt_hi(~0u, __builtin_amdgcn_mbcnt_lo(~0u, z)) == 0u; }
struct XcdBarrier {
    int wid;
    unsigned* bar; unsigned x;
    volatile LAS unsigned* st;
};

__device__ __forceinline__ XcdBarrier xcd_barrier_post(unsigned* bar, volatile LAS unsigned* st, int wid) {
    XcdBarrier b; b.bar = bar; b.x = xb_xcc_id(); b.st = st; b.wid = wid;
    if (wid == 0 && xb_lane0()) (void)xb_add(&bar[XB_XCNT(b.x)], 1u);
    return b;
}
__device__ __forceinline__ void xcd_barrier_complete(unsigned* bar, unsigned x, unsigned& nloc, unsigned& nx) {
    const unsigned G = gridDim.x * gridDim.y * gridDim.z;
    unsigned sum, cnt, mine, sp = 0u;
    for (;;) {
        sum = 0u; cnt = 0u; mine = 0u;
#pragma unroll
        for (unsigned j = 0; j < 16; ++j) { const unsigned c = xb_ld(&bar[XB_XCNT(j)]); sum += c; cnt += (c > 0u) ? 1u : 0u; mine = (j == x) ? c : mine; }
        if (sum == G) break;
        __builtin_amdgcn_s_sleep(1);
        if ((++sp & 255u) == 0u) { if (xb_ld(&bar[XB_TMO])) break; if (sp > XB_SPIN_CAP) { atomicAdd(&bar[XB_TMO], 1u); break; } }
    }
    nloc = mine > 0u ? mine : 1u; nx = cnt > 0u ? cnt : 1u;
}

__device__ __forceinline__ void xcd_barrier(const XcdBarrier& b) {
    asm volatile("s_waitcnt vmcnt(0)" ::: "memory");
    __syncthreads();
    if (b.wid == 0 && xb_lane0()) {
        unsigned* bar = b.bar;
        __builtin_amdgcn_s_waitcnt(0);
        unsigned nloc = b.st[0], nx = b.st[1];
        if (nloc == 0u) { xcd_barrier_complete(bar, b.x, nloc, nx); b.st[0] = nloc; b.st[1] = nx; }
        const unsigned old = xb_add(&bar[XB_XSUB(b.x)], 1u);
        const unsigned gen = old / nloc;
        if (old + 1u == (gen + 1u) * nloc) {
            __builtin_amdgcn_fence(__ATOMIC_RELEASE, "agent");
            asm volatile("s_waitcnt vmcnt(0)" ::: "memory");
            const unsigned og = xb_add(&bar[XB_TOP], 1u);
            const unsigned tg = og / nx;
            if (og + 1u == (tg + 1u) * nx) xb_add(&bar[XB_TOPGEN], 1u);
            else XB_SPIN(xb_ld(&bar[XB_TOPGEN]) == tg, bar);
            __builtin_amdgcn_fence(__ATOMIC_ACQUIRE, "agent");
            xb_add(&bar[XB_XGEN(b.x)], 1u);
            asm volatile("s_waitcnt vmcnt(0)" ::: "memory");
        } else {
            XB_SPIN(xb_ld(&bar[XB_XGEN(b.x)]) == gen, bar);
            __builtin_amdgcn_fence(__ATOMIC_ACQUIRE, "agent");
            asm volatile("s_waitcnt vmcnt(0)" ::: "memory");
        }
    }
    __syncthreads();
}


using pg8::bf16_t; using pg8::bf16x8; using pg8::f32x4; using pg8::u32x4;
typedef _Float16 f16x8 __attribute__((ext_vector_type(8)));
typedef float f32x16 __attribute__((ext_vector_type(16)));
typedef unsigned u32x2 __attribute__((ext_vector_type(2)));
#define DI __device__ __forceinline__

constexpr int NWAVES = 8, NTHR = 512;
constexpr int SEQ = 8192, MTOK = 16384, DM = 4096, DFF = 11008;
constexpr int N_A = 18432, N_B = 10400, N_BP = 10496;
constexpr float LN_EPS = 1e-5f;
constexpr float ALPHA = 1.41421356237309515f;
constexpr float SM_C = 0.08838834764831845f * 1.4426950408889634f;
constexpr float SM_SCALE = 0.08838834764831845f;

constexpr size_t MiB = (size_t)1 << 20;
constexpr size_t WS_CTL = 0, CTL_ZERO_BYTES = 16384;
constexpr size_t WS_COS = 1 * MiB, WS_SIN = 5 * MiB;
constexpr size_t WS_W = 9 * MiB;
constexpr size_t W0IN = WS_W, W0OUT = WS_W + 144 * MiB, W0GU = WS_W + 160 * MiB, W0DN = WS_W + 332 * MiB;
constexpr size_t W1IN = WS_W, W1INB = WS_W + 24 * MiB, W1OUT = WS_W + 82 * MiB, W1GU = WS_W + 114 * MiB, W1DN = WS_W + 286 * MiB;
constexpr size_t WS_XB = 427 * MiB, WS_XA = 555 * MiB, WS_BIG = 811 * MiB, WS_XB8 = (811 + 835) * MiB, WS_END = (811 + 835 + 64) * MiB;
constexpr size_t B_QKV0 = WS_BIG, B_OG = WS_BIG + 576 * MiB, B_LSE = WS_BIG + 768 * MiB, B_AO0 = WS_BIG + 771 * MiB;
constexpr size_t B_Y = WS_BIG + 360 * MiB, B_H = WS_BIG;
constexpr size_t B_Q1 = WS_BIG, B_K1 = WS_BIG + 128 * MiB, B_V1 = WS_BIG + 160 * MiB, B_QI = WS_BIG + 192 * MiB, B_KIR = WS_BIG + 320 * MiB, B_KI16 = WS_BIG + 328 * MiB,
                 B_WI = WS_BIG + 332 * MiB, B_SC = WS_BIG + 334 * MiB, B_IDX = WS_BIG + 594 * MiB, B_AO1 = WS_BIG + 640 * MiB;
constexpr int LDS_BYTES = 147456, MISC_OFF = 147456 - 64;

DI int fresh_tid(int wid) { unsigned z = 0u; asm volatile("" : "+v"(z)); return (wid << 6) | (int)__builtin_amdgcn_mbcnt_hi(~0u, __builtin_amdgcn_mbcnt_lo(~0u, z)); }
DI bf16x8 fp8x8_to_bf16(u32x2 w) {
    typedef float f32x2_t __attribute__((ext_vector_type(2)));
    const f32x2_t a = __builtin_amdgcn_cvt_pk_f32_fp8((int)w.x, false), b = __builtin_amdgcn_cvt_pk_f32_fp8((int)w.x, true), c = __builtin_amdgcn_cvt_pk_f32_fp8((int)w.y, false), d = __builtin_amdgcn_cvt_pk_f32_fp8((int)w.y, true);
    u32x4 o; o.x = pg8::cvt_pk_bf16(a.x, a.y); o.y = pg8::cvt_pk_bf16(b.x, b.y); o.z = pg8::cvt_pk_bf16(c.x, c.y); o.w = pg8::cvt_pk_bf16(d.x, d.y);
    return __builtin_bit_cast(bf16x8, o);
}
DI float wave_sum(float v) { v += __shfl_xor(v, 1); v += __shfl_xor(v, 2); v += __shfl_xor(v, 4); v += __shfl_xor(v, 8); v += __shfl_xor(v, 16); v += __shfl_xor(v, 32); return v; }
DI int sigma_inv(int d) { return 32 * ((d >> 4) & 3) + 8 * ((d >> 2) & 3) + 4 * (d >> 6) + (d & 3); }

struct MapId { DI long operator()(int c) const { return c; } };
struct MapA  { DI long operator()(int c) const { const int d = c & 127; return (c < 2 * 6144) ? (long)(c - d + sigma_inv(d)) : (long)c; } };
struct MapB  { DI long operator()(int c) const { const int d = c & 127; const bool rp = (c < 5120) || (c >= 6144 && c < 10240); return rp ? (long)(c - d + sigma_inv(d)) : (long)c; } };
struct MapB2 { DI long operator()(int c) const { return MapB{}(c + 6144) - 6144; } };
struct MapGU { int up; DI long operator()(int c) const { return (long)((c >> 7) * 256 + up * 128 + (c & 127)); } };

DI void wt_load(const float* __restrict__ W, int N, int nct, int item, f32x4 (&v)[8], int tid, int pitch) {
    const int kt = item / nct, ct = item - kt * nct; const int k0 = kt * 64, c0 = ct * 256; const int cq = tid & 63, kr0 = tid >> 6; const bool cok = (c0 + 4 * cq) < N;
#pragma unroll
    for (int i = 0; i < 8; ++i) v[i] = cok ? *(const f32x4*)(W + (size_t)(k0 + kr0 + 8 * i) * pitch + c0 + 4 * cq) : (f32x4){0.f, 0.f, 0.f, 0.f};
}
template <class Map>
DI void wt_store(int K, int N, int nct, bf16_t* __restrict__ WT, int item, const Map map, const f32x4 (&v)[8], LAS float* scr, int tid) {
    const int kt = item / nct, ct = item - kt * nct; const int k0 = kt * 64, c0 = ct * 256; const int cq = tid & 63, kr0 = tid >> 6;
    __syncthreads();
#pragma unroll
    for (int i = 0; i < 8; ++i) { const int k = kr0 + 8 * i; *(LAS f32x4*)(scr + k * 260 + 4 * (cq ^ ((k >> 3) & 7))) = v[i]; }
    __syncthreads();
#pragma unroll
    for (int i = 0; i < 4; ++i) { const int pc = tid + 512 * i; const int c = pc >> 3, j = pc & 7;
        if (c0 + c < N) { float f[8];
#pragma unroll
            for (int e = 0; e < 8; ++e) f[e] = scr[(8 * j + e) * 260 + 4 * ((c >> 2) ^ j) + (c & 3)];
            u32x4 o; o.x = pg8::cvt_pk_bf16(f[0], f[1]); o.y = pg8::cvt_pk_bf16(f[2], f[3]); o.z = pg8::cvt_pk_bf16(f[4], f[5]); o.w = pg8::cvt_pk_bf16(f[6], f[7]);
            *(u32x4*)(WT + (size_t)map(c0 + c) * K + k0 + 8 * j) = o; } }
}
template <class Map>
DI void wt_store8(int K, int N, int nct, unsigned char* __restrict__ WT8, int item, const Map map, const f32x4 (&v)[8], LAS float* scr, int tid, float wscale) {
    const int kt = item / nct, ct = item - kt * nct; const int k0 = kt * 64, c0 = ct * 256; const int cq = tid & 63, kr0 = tid >> 6;
    __syncthreads();
#pragma unroll
    for (int i = 0; i < 8; ++i) { const int k = kr0 + 8 * i; *(LAS f32x4*)(scr + k * 260 + 4 * (cq ^ ((k >> 3) & 7))) = v[i]; }
    __syncthreads();
#pragma unroll
    for (int i = 0; i < 4; ++i) { const int pc = tid + 512 * i; const int c = pc >> 3, j = pc & 7;
        if (c0 + c < N) { float f[8];
#pragma unroll
            for (int e = 0; e < 8; ++e) f[e] = scr[(8 * j + e) * 260 + 4 * ((c >> 2) ^ j) + (c & 3)] * wscale;
            int w0 = __builtin_amdgcn_cvt_pk_fp8_f32(f[0], f[1], 0, false); w0 = __builtin_amdgcn_cvt_pk_fp8_f32(f[2], f[3], w0, true);
            int w1 = __builtin_amdgcn_cvt_pk_fp8_f32(f[4], f[5], 0, false); w1 = __builtin_amdgcn_cvt_pk_fp8_f32(f[6], f[7], w1, true);
            typedef int i32x2_t __attribute__((ext_vector_type(2)));
            *(i32x2_t*)(WT8 + (size_t)map(c0 + c) * K + k0 + 8 * j) = (i32x2_t){w0, w1}; } }
}
template <class Map>
DI void wt_matrix8(const float* W, int K, int N, unsigned char* WT8, const Map map, LAS float* scr, int tid, int bid, int G, float wscale, int pitch0 = 0) {
    const int nct = (N + 255) >> 8, nitems = (K >> 6) * nct, pitch = pitch0 ? pitch0 : N;
    f32x4 va[8], vb[8];
    int it = bid;
    if (it < nitems) wt_load(W, N, nct, it, va, tid, pitch);
    for (; it < nitems; it += 2 * G) {
        if (it + G < nitems) wt_load(W, N, nct, it + G, vb, tid, pitch);
        wt_store8(K, N, nct, WT8, it, map, va, scr, tid, wscale);
        if (it + G >= nitems) break;
        if (it + 2 * G < nitems) wt_load(W, N, nct, it + 2 * G, va, tid, pitch);
        wt_store8(K, N, nct, WT8, it + G, map, vb, scr, tid, wscale);
    }
}
template <class Map>
DI void wt_matrix(const float* W, int K, int N, bf16_t* WT, const Map map, LAS float* scr, int tid, int bid, int G, int pitch0 = 0) {
    const int nct = (N + 255) >> 8, nitems = (K >> 6) * nct, pitch = pitch0 ? pitch0 : N;
    f32x4 va[8], vb[8];
    int it = bid;
    if (it < nitems) wt_load(W, N, nct, it, va, tid, pitch);
    for (; it < nitems; it += 2 * G) {
        if (it + G < nitems) wt_load(W, N, nct, it + G, vb, tid, pitch);
        wt_store(K, N, nct, WT, it, map, va, scr, tid);
        if (it + G >= nitems) break;
        if (it + 2 * G < nitems) wt_load(W, N, nct, it + 2 * G, va, tid, pitch);
        wt_store(K, N, nct, WT, it + G, map, vb, scr, tid);
    }
}

DI void rope_sincos(int pos, int f, float& cs, float& sn) {
    const double r1 = 0.8659643233600653; double inv = 1.0, rp = r1;
#pragma unroll
    for (int b = 0; b < 6; ++b) { if ((f >> b) & 1) inv *= rp; rp *= rp; }
    const double ang = (double)pos * inv;
    const double q = __builtin_rint(ang * 0.63661977236758134308);
    double r = __builtin_fma(-q, 1.57079632679489655800e+00, ang); r = __builtin_fma(-q, 6.12323399573676603587e-17, r);
    const double z = r * r;
    const double ps = r + r * z * (-1.66666666666666324348e-01 + z * (8.33333333332248946124e-03 + z * (-1.98412698298579493134e-04 + z * (2.75573137070700676789e-06 + z * (-2.50507602534068634195e-08 + z * 1.58969099521155010221e-10)))));
    const double pc = 1.0 - 0.5 * z + z * z * (4.16666666666666019037e-02 + z * (-1.38888888888741095749e-03 + z * (2.48015872894767294178e-05 + z * (-2.75573143513906633035e-07 + z * (2.08757232129817482790e-09 + z * -1.13596475577881948265e-11)))));
    const int qi = ((int)(long long)q) & 3;
    const double s = (qi == 0) ? ps : (qi == 1) ? pc : (qi == 2) ? -ps : -pc;
    const double c = (qi == 0) ? pc : (qi == 1) ? -ps : (qi == 2) ? -pc : ps;
    cs = (float)c; sn = (float)s;
}

DI void cvt_x_phase(const float* X, bf16_t* XB, int tid, int bid, int G) {
    const size_t n8 = (size_t)MTOK * DM / 8;
    for (size_t i = (size_t)bid * NTHR + tid; i < n8; i += (size_t)G * NTHR) {
        const f32x4 a = *(const f32x4*)(X + i * 8), b = *(const f32x4*)(X + i * 8 + 4);
        u32x4 o; o.x = pg8::cvt_pk_bf16(a[0], a[1]); o.y = pg8::cvt_pk_bf16(a[2], a[3]); o.z = pg8::cvt_pk_bf16(b[0], b[1]); o.w = pg8::cvt_pk_bf16(b[2], b[3]);
        *(u32x4*)(XB + i * 8) = o; }
}
DI void cvt_x8_phase(const float* X, unsigned char* XB8, int tid, int bid, int G) {
    const size_t n16 = (size_t)MTOK * DM / 16;
    for (size_t i = (size_t)bid * NTHR + tid; i < n16; i += (size_t)G * NTHR) { int w[4];
#pragma unroll
        for (int q = 0; q < 4; ++q) { const f32x4 a = *(const f32x4*)(X + i * 16 + 4 * q); int t = __builtin_amdgcn_cvt_pk_fp8_f32(a[0], a[1], 0, false); w[q] = __builtin_amdgcn_cvt_pk_fp8_f32(a[2], a[3], t, true); }
        *(u32x4*)(XB8 + i * 16) = (u32x4){(unsigned)w[0], (unsigned)w[1], (unsigned)w[2], (unsigned)w[3]}; }
}
DI void rope_tab_phase(const int* pos, float* CS, float* SN, int tid, int bid, int G) {
    for (int e = bid * NTHR + tid; e < MTOK * 64; e += G * NTHR) { float c, s; rope_sincos(pos[e >> 6], e & 63, c, s); CS[e] = c; SN[e] = s; }
}

typedef unsigned short half_t;
DI void ln_phase(const half_t* Y, const float* gain, const float* bias, float* Xo, half_t* XHo, bf16_t* XBo, int tid, int bid, int G, unsigned char* XB8o = nullptr) {
    const int lane = tid & 63, gw = bid * NWAVES + (tid >> 6), nw = G * NWAVES;
    u32x4 raw[8];
    if (gw < MTOK) {
#pragma unroll
        for (int j = 0; j < 8; ++j) raw[j] = *(const u32x4*)(Y + (size_t)gw * DM + (j * 64 + lane) * 8); }
#pragma unroll 1
    for (int row = gw; row < MTOK; row += nw) {
        f32x4 v[16]; float s = 0.f;
#pragma unroll
        for (int j = 0; j < 8; ++j) {
            v[2 * j] = pg8::f16x4_to_f32((pg8::u32x2e_t){raw[j].x, raw[j].y}); v[2 * j + 1] = pg8::f16x4_to_f32((pg8::u32x2e_t){raw[j].z, raw[j].w});
            s += ((v[2 * j][0] + v[2 * j][1]) + (v[2 * j][2] + v[2 * j][3])) + ((v[2 * j + 1][0] + v[2 * j + 1][1]) + (v[2 * j + 1][2] + v[2 * j + 1][3])); }
        if (row + nw < MTOK) {
#pragma unroll
            for (int j = 0; j < 8; ++j) raw[j] = *(const u32x4*)(Y + (size_t)(row + nw) * DM + (j * 64 + lane) * 8); }
        const float mean = wave_sum(s) * (1.0f / DM); float q = 0.f;
#pragma unroll
        for (int j = 0; j < 16; ++j) { v[j] = v[j] - mean; q += (v[j][0] * v[j][0] + v[j][1] * v[j][1]) + (v[j][2] * v[j][2] + v[j][3] * v[j][3]); }
        const float rstd = 1.0f / sqrtf(wave_sum(q) * (1.0f / DM) + LN_EPS);
#pragma unroll
        for (int j = 0; j < 8; ++j) { const int c = (j * 64 + lane) * 8;
            const f32x4 o0 = v[2 * j] * rstd * *(const f32x4*)(gain + c) + *(const f32x4*)(bias + c), o1 = v[2 * j + 1] * rstd * *(const f32x4*)(gain + c + 4) + *(const f32x4*)(bias + c + 4);
            if (Xo) { *(f32x4*)(Xo + (size_t)row * DM + c) = o0; *(f32x4*)(Xo + (size_t)row * DM + c + 4) = o1; }
            if (XHo) { u32x4 w; w.x = pg8::cvt_pk_f16(o0[0], o0[1]); w.y = pg8::cvt_pk_f16(o0[2], o0[3]); w.z = pg8::cvt_pk_f16(o1[0], o1[1]); w.w = pg8::cvt_pk_f16(o1[2], o1[3]); *(u32x4*)(XHo + (size_t)row * DM + c) = w; }
            if (XBo) { u32x4 w; w.x = pg8::cvt_pk_bf16(o0[0], o0[1]); w.y = pg8::cvt_pk_bf16(o0[2], o0[3]); w.z = pg8::cvt_pk_bf16(o1[0], o1[1]); w.w = pg8::cvt_pk_bf16(o1[2], o1[3]); *(u32x4*)(XBo + (size_t)row * DM + c) = w; }
            if (XB8o) { int q0 = __builtin_amdgcn_cvt_pk_fp8_f32(o0[0], o0[1], 0, false); q0 = __builtin_amdgcn_cvt_pk_fp8_f32(o0[2], o0[3], q0, true);
                int q1 = __builtin_amdgcn_cvt_pk_fp8_f32(o1[0], o1[1], 0, false); q1 = __builtin_amdgcn_cvt_pk_fp8_f32(o1[2], o1[3], q1, true); *(u32x2*)(XB8o + (size_t)row * DM + c) = (u32x2){(unsigned)q0, (unsigned)q1}; } }
    }
}

DI bf16x8 ldg_bf16x8(const bf16_t* p) { return *(const bf16x8*)p; }
typedef short s16x4 __attribute__((ext_vector_type(4)));
struct A0Unit { int h, b, grp, d, r, nb; };
DI A0Unit a0_decode(int u) { A0Unit x; x.h = u & 15; const int blk = (u >> 4) & 63; x.b = (u >> 10) & 1; x.grp = u >> 11; const int dsh = 2 * x.grp; x.d = 1 << dsh; x.r = blk >> (6 - dsh); x.nb = blk & ((64 >> dsh) - 1); return x; }
DI size_t a0_sub(int sq, const A0Unit& x) { return ((size_t)(((sq * 3 + x.grp) * 2 + x.b) * 16 + x.h) * 8192 + (size_t)x.r * (8192 >> (2 * x.grp))) * 128; }
DI void a0_load_kv(const unsigned char* QKV, const A0Unit& x, u32x4 (&kpre)[4], u32x4 (&vpre)[4], int tid) {
    const unsigned char* Kg = QKV + a0_sub(1, x) + (tid & 7) * 16; const unsigned char* Vg = QKV + a0_sub(2, x) + (tid & 7) * 16;
#pragma unroll
    for (int i = 0; i < 4; ++i) { const int l = (x.nb - 1) * 128 + (tid >> 3) + 64 * i;
        kpre[i] = (l >= 0) ? *(const u32x4*)(Kg + (ptrdiff_t)l * 128) : (u32x4){0u, 0u, 0u, 0u};
        vpre[i] = (l >= 0) ? *(const u32x4*)(Vg + (ptrdiff_t)l * 128) : (u32x4){0u, 0u, 0u, 0u}; }
}
DI void a0_load_q(const unsigned char* QKV, const A0Unit& x, bf16x8 (&qf)[4], int w, int n, int g4) {
    const unsigned char* qp = QKV + a0_sub(0, x) + (size_t)(x.nb * 128 + 16 * w + n) * 128 + 8 * g4;
#pragma unroll
    for (int ks = 0; ks < 4; ++ks) qf[ks] = fp8x8_to_bf16(*(const u32x2*)(qp + 32 * ks));
}
DI void attn0_phase(const unsigned char* QKV, bf16_t* OG, float* LSE, LAS unsigned char* lds, int tid, int bid, int G) {
    const int lane = tid & 63, w = __builtin_amdgcn_readfirstlane(tid >> 6), n = lane & 15, g4 = lane >> 4, q4 = n >> 2, p4 = n & 3;
    LAS unsigned char* kimg = lds; LAS unsigned char* vt = lds + 65536;
    const size_t GS = (size_t)MTOK * 2048;
    const int tr_base = (4 * g4 + q4) * 256 + 8 * (p4 & 1);
    const int skey = tid >> 3, sj = tid & 7;
    LAS unsigned char* kwr0 = kimg + skey * 256 + (((2 * sj) ^ (skey & 15)) * 16); LAS unsigned char* kwr1 = kimg + skey * 256 + (((2 * sj + 1) ^ (skey & 15)) * 16);
    LAS unsigned char* vwr0 = vt + skey * 256 + (((2 * sj) ^ (2 * (skey & 3))) * 16); LAS unsigned char* vwr1 = vt + skey * 256 + (((2 * sj + 1) ^ (2 * (skey & 3))) * 16);
    LAS unsigned char* krb[4];
#pragma unroll
    for (int j = 0; j < 4; ++j) krb[j] = kimg + (16 * w + n) * 256 + (((4 * j + g4) ^ n) * 16);
    u32x4 kpre[4], vpre[4]; bf16x8 qf[4];
    int u = bid;
    if (u < 6144) { const A0Unit x = a0_decode(u); a0_load_kv(QKV, x, kpre, vpre, tid); a0_load_q(QKV, x, qf, w, n, g4); }
    for (; u < 6144; u += G) {
        const A0Unit x = a0_decode(u);
        const int h = x.h, d = x.d, nb = x.nb, grp = x.grp;
        const size_t tok0 = (size_t)x.b * SEQ + x.r;
        const int iq = 16 * w + n, lq = nb * 128 + iq;
        const size_t qtok = tok0 + (size_t)lq * d;
        __syncthreads();
#pragma unroll
        for (int i = 0; i < 4; ++i) {
            *(LAS bf16x8*)(kwr0 + i * 16384) = fp8x8_to_bf16((u32x2){kpre[i].x, kpre[i].y}); *(LAS bf16x8*)(kwr1 + i * 16384) = fp8x8_to_bf16((u32x2){kpre[i].z, kpre[i].w});
            *(LAS bf16x8*)(vwr0 + i * 16384) = fp8x8_to_bf16((u32x2){vpre[i].x, vpre[i].y}); *(LAS bf16x8*)(vwr1 + i * 16384) = fp8x8_to_bf16((u32x2){vpre[i].z, vpre[i].w}); }
        __syncthreads();
        if (u + G < 6144) { const A0Unit xn = a0_decode(u + G); a0_load_kv(QKV, xn, kpre, vpre, tid); }
        f32x4 s[9];
#pragma unroll
        for (int tt = 0; tt < 9; ++tt) { f32x4 a = {0.f, 0.f, 0.f, 0.f};
#pragma unroll
            for (int ks = 0; ks < 4; ++ks) a = __builtin_amdgcn_mfma_f32_16x16x32_bf16(*(const LAS bf16x8*)(krb[ks] + tt * 4096), qf[ks], a, 0, 0, 0);
            s[tt] = a; }
        if (u + G < 6144) { const A0Unit xn = a0_decode(u + G); a0_load_q(QKV, xn, qf, w, n, g4); }
        float mx = -__builtin_inff();
#pragma unroll
        for (int tt = 0; tt < 9; ++tt)
#pragma unroll
            for (int j = 0; j < 4; ++j) { const int kf = 16 * (w + tt) + 4 * g4 + j; const bool ok = (kf >= iq) && (kf <= iq + 128) && (nb > 0 || kf >= 128);
                const float xx = ok ? s[tt][j] : -__builtin_inff(); s[tt][j] = xx; mx = fmaxf(mx, xx); }
        mx = fmaxf(mx, __shfl_xor(mx, 16)); mx = fmaxf(mx, __shfl_xor(mx, 32));
        const float msc = mx * SM_C; float lsum = 0.f;
#pragma unroll
        for (int tt = 0; tt < 9; ++tt)
#pragma unroll
            for (int j = 0; j < 4; ++j) { const float p = __builtin_amdgcn_exp2f(s[tt][j] * SM_C - msc); s[tt][j] = p; lsum += p; }
        lsum += __shfl_xor(lsum, 16); lsum += __shfl_xor(lsum, 32);
        f32x4 o[8];
#pragma unroll
        for (int dt = 0; dt < 8; ++dt) o[dt] = (f32x4){0.f, 0.f, 0.f, 0.f};
#pragma unroll
        for (int kk = 0; kk < 5; ++kk) {
            const int t0 = 2 * kk, t1 = 2 * kk + 1;
            u32x4 pw; pw.x = pg8::cvt_pk_bf16(s[t0][0], s[t0][1]); pw.y = pg8::cvt_pk_bf16(s[t0][2], s[t0][3]);
            if (t1 < 9) { pw.z = pg8::cvt_pk_bf16(s[t1 < 9 ? t1 : 8][0], s[t1 < 9 ? t1 : 8][1]); pw.w = pg8::cvt_pk_bf16(s[t1 < 9 ? t1 : 8][2], s[t1 < 9 ? t1 : 8][3]); } else { pw.z = 0u; pw.w = 0u; }
            const bf16x8 pf = __builtin_bit_cast(bf16x8, pw);
            int T1 = w + t1; T1 = T1 > 15 ? 15 : T1;
            const int row0 = 16 * (w + t0) * 256, row1 = 16 * T1 * 256;
#pragma unroll
            for (int dt = 0; dt < 8; ++dt) {
                const int choff = ((2 * dt + (p4 >> 1)) ^ (2 * q4)) * 16;
                const s16x4 lo = __builtin_amdgcn_ds_read_tr16_b64_v4i16((LAS s16x4*)(vt + tr_base + row0 + choff));
                const s16x4 hi = __builtin_amdgcn_ds_read_tr16_b64_v4i16((LAS s16x4*)(vt + tr_base + row1 + choff));
                const bf16x8 vf = __builtin_shufflevector(lo, hi, 0, 1, 2, 3, 4, 5, 6, 7);
                o[dt] = __builtin_amdgcn_mfma_f32_16x16x32_bf16(vf, pf, o[dt], 0, 0, 0); }
        }
        const float inv = 1.0f / lsum;
        bf16_t* op = OG + (size_t)grp * GS + qtok * 2048 + h * 128 + 4 * g4;
#pragma unroll
        for (int dt = 0; dt < 8; ++dt) { u32x2 wv; wv.x = pg8::cvt_pk_bf16(o[dt][0] * inv, o[dt][1] * inv); wv.y = pg8::cvt_pk_bf16(o[dt][2] * inv, o[dt][3] * inv); *(u32x2*)(op + 16 * dt) = wv; }
        if (g4 == 0) LSE[(size_t)grp * (MTOK * 16) + qtok * 16 + h] = mx * SM_SCALE + __logf(lsum);
    }
}

DI void merge_phase(const bf16_t* OG, const float* LSE, unsigned char* AO8, int tid, int bid, int G) {
    const int lane = tid & 63, gw = bid * NWAVES + (tid >> 6), nw = G * NWAVES; const size_t GS = (size_t)MTOK * 2048;
    for (int tok = gw; tok < MTOK; tok += nw) {
#pragma unroll
        for (int it = 0; it < 4; ++it) { const int e = it * 512 + lane * 8, h = e >> 7;
            const float l0 = LSE[(size_t)tok * 16 + h], l1 = LSE[(size_t)(MTOK * 16) + (size_t)tok * 16 + h], l2 = LSE[(size_t)(2 * MTOK * 16) + (size_t)tok * 16 + h];
            const float mx = fmaxf(l0, fmaxf(l1, l2)); const float e0 = __expf(l0 - mx), e1 = __expf(l1 - mx), e2 = __expf(l2 - mx); const float inv = 1.0f / (e0 + e1 + e2);
            const float w0 = e0 * inv, w1 = e1 * inv, w2 = e2 * inv;
            const u32x4 a = *(const u32x4*)(OG + (size_t)tok * 2048 + e), b = *(const u32x4*)(OG + GS + (size_t)tok * 2048 + e), c = *(const u32x4*)(OG + 2 * GS + (size_t)tok * 2048 + e);
            float v[8];
#pragma unroll
            for (int k = 0; k < 4; ++k) { v[2 * k] = 16.0f * (w0 * __uint_as_float(a[k] << 16) + w1 * __uint_as_float(b[k] << 16) + w2 * __uint_as_float(c[k] << 16));
                v[2 * k + 1] = 16.0f * (w0 * __uint_as_float(a[k] & 0xffff0000u) + w1 * __uint_as_float(b[k] & 0xffff0000u) + w2 * __uint_as_float(c[k] & 0xffff0000u)); }
            int q0 = __builtin_amdgcn_cvt_pk_fp8_f32(v[0], v[1], 0, false); q0 = __builtin_amdgcn_cvt_pk_fp8_f32(v[2], v[3], q0, true);
            int q1 = __builtin_amdgcn_cvt_pk_fp8_f32(v[4], v[5], 0, false); q1 = __builtin_amdgcn_cvt_pk_fp8_f32(v[6], v[7], q1, true);
            *(u32x2*)(AO8 + (size_t)tok * 2048 + e) = (u32x2){(unsigned)q0, (unsigned)q1}; }
    }
}

DI void kidx_phase(const float* KIR, const float* gain, const float* bias, const float* CS, const float* SN, unsigned short* KI16, int tid, int bid, int G) {
    const int lane = tid & 63, gw = bid * NWAVES + (tid >> 6), nw = G * NWAVES;
    const float g1 = gain[lane], g2 = gain[lane + 64], b1 = bias[lane], b2 = bias[lane + 64];
    const int j1 = sigma_inv(lane);
    for (int tok = gw; tok < MTOK; tok += nw) {
        const float x1 = KIR[(size_t)tok * 128 + lane], x2 = KIR[(size_t)tok * 128 + 64 + lane];
        const float mean = wave_sum(x1 + x2) * (1.0f / 128.0f); const float d1 = x1 - mean, d2 = x2 - mean;
        const float rstd = 1.0f / sqrtf(wave_sum(d1 * d1 + d2 * d2) * (1.0f / 128.0f) + LN_EPS);
        const float y1 = d1 * rstd * g1 + b1, y2 = d2 * rstd * g2 + b2;
        const float c = CS[(size_t)tok * 64 + lane], s = SN[(size_t)tok * 64 + lane];
        const _Float16 o1 = (_Float16)(y1 * c - y2 * s), o2 = (_Float16)(y2 * c + y1 * s);
        KI16[(size_t)tok * 128 + j1] = __builtin_bit_cast(unsigned short, o1); KI16[(size_t)tok * 128 + j1 + 4] = __builtin_bit_cast(unsigned short, o2);
    }
}

constexpr int KT_ROWB = 272, KT_BYTES = 64 * KT_ROWB;
DI size_t sc_row_off(int b, int s) { const int qb = s >> 7; return ((size_t)(b * 2080 + ((qb * (qb + 1)) >> 1))) * 16384 + (size_t)(s & 127) * ((qb + 1) * 128); }
DI float relu1(float x) { const int b = __builtin_bit_cast(int, x); return __builtin_bit_cast(float, b > 0 ? b : 0); }
DI void indexer_tile(const LAS unsigned char* buf, const f16x8 (&af)[2][8], const f32x4 (&wv)[2][4], float* sc0, float* sc1, int kt, int r32, int h2) {
    typedef float f32x2_t __attribute__((ext_vector_type(2)));
    f16x8 bfr[2][8];
#pragma unroll
    for (int sub = 0; sub < 2; ++sub)
#pragma unroll
        for (int ks = 0; ks < 8; ++ks) bfr[sub][ks] = *(const LAS f16x8*)(buf + (32 * sub + r32) * KT_ROWB + (16 * ks + 8 * h2) * 2);
    __builtin_amdgcn_sched_barrier(0);
#pragma unroll
    for (int sub = 0; sub < 2; ++sub) {
        f32x16 c0, c1;
#pragma unroll
        for (int i = 0; i < 16; ++i) { c0[i] = 0.f; c1[i] = 0.f; }
#pragma unroll
        for (int ks = 0; ks < 8; ++ks) { c0 = __builtin_amdgcn_mfma_f32_32x32x16_f16(af[0][ks], bfr[sub][ks], c0, 0, 0, 0); c1 = __builtin_amdgcn_mfma_f32_32x32x16_f16(af[1][ks], bfr[sub][ks], c1, 0, 0, 0); }
        f32x2_t a0 = {0.f, 0.f}, a1 = {0.f, 0.f};
#pragma unroll
        for (int q = 0; q < 4; ++q)
#pragma unroll
            for (int e = 0; e < 4; e += 2) {
                const f32x2_t r0 = {relu1(c0[4 * q + e]), relu1(c0[4 * q + e + 1])};
                const f32x2_t r1 = {relu1(c1[4 * q + e]), relu1(c1[4 * q + e + 1])};
                const f32x2_t w0 = {wv[0][q][e], wv[0][q][e + 1]}, w1 = {wv[1][q][e], wv[1][q][e + 1]};
                a0 = __builtin_elementwise_fma(r0, w0, a0); a1 = __builtin_elementwise_fma(r1, w1, a1); }
        float s0 = a0.x + a0.y, s1 = a1.x + a1.y;
        s0 += __shfl_xor(s0, 32); s1 += __shfl_xor(s1, 32);
        if (h2 == 0) { sc0[kt * 64 + 32 * sub + r32] = s0; sc1[kt * 64 + 32 * sub + r32] = s1; }
    }
}
DI void indexer_phase(const unsigned short* QI, const unsigned short* KI16, const float* WI, float* SC, LAS unsigned char* lds, int tid, int bid, int G) {
    const int lane = tid & 63, w = __builtin_amdgcn_readfirstlane(tid >> 6), r32 = lane & 31, h2 = lane >> 5;
    LAS unsigned char* buf0 = lds; LAS unsigned char* buf1 = lds + KT_BYTES;
    const int key0 = tid >> 4, ch = tid & 15;
    for (int v = bid; v < 256; v += G) {
        for (int it = 0; it < 4; ++it) {
            const int b = it >> 1, gi = (it & 1) ? (511 - v) : v; const int tb = 16 * gi;
            const int nt = ((tb + 15) >> 6) + 1;
            f16x8 af[2][8]; f32x4 wv[2][4];
#pragma unroll
            for (int tq = 0; tq < 2; ++tq) { const size_t tg = (size_t)b * SEQ + tb + 2 * w + tq;
#pragma unroll
                for (int ks = 0; ks < 8; ++ks) af[tq][ks] = *(const f16x8*)(QI + tg * 4096 + r32 * 128 + 16 * ks + 8 * h2);
#pragma unroll
                for (int q = 0; q < 4; ++q) wv[tq][q] = *(const f32x4*)(WI + tg * 32 + 8 * q + 4 * h2); }
            float* sc0 = SC + sc_row_off(b, tb + 2 * w); float* sc1 = SC + sc_row_off(b, tb + 2 * w + 1);
            const unsigned short* src = KI16 + (size_t)b * SEQ * 128 + (size_t)key0 * 128 + ch * 8;
            u32x4 a0, a1, b0 = {0u, 0u, 0u, 0u}, b1 = {0u, 0u, 0u, 0u};
            a0 = *(const u32x4*)src; a1 = *(const u32x4*)(src + 32 * 128);
            if (nt > 1) { b0 = *(const u32x4*)(src + 64 * 128); b1 = *(const u32x4*)(src + 96 * 128); }
            __syncthreads();
            *(LAS u32x4*)(buf0 + key0 * KT_ROWB + ch * 16) = a0; *(LAS u32x4*)(buf0 + (key0 + 32) * KT_ROWB + ch * 16) = a1;
            __syncthreads();
            for (int kt = 0; kt < nt; kt += 2) {
                if (kt + 2 < nt) { const unsigned short* p = src + (size_t)(kt + 2) * 64 * 128; a0 = *(const u32x4*)p; a1 = *(const u32x4*)(p + 32 * 128); }
                indexer_tile(buf0, af, wv, sc0, sc1, kt, r32, h2);
                if (kt + 1 < nt) { *(LAS u32x4*)(buf1 + key0 * KT_ROWB + ch * 16) = b0; *(LAS u32x4*)(buf1 + (key0 + 32) * KT_ROWB + ch * 16) = b1; }
                __syncthreads();
                if (kt + 1 >= nt) break;
                if (kt + 3 < nt) { const unsigned short* p = src + (size_t)(kt + 3) * 64 * 128; b0 = *(const u32x4*)p; b1 = *(const u32x4*)(p + 32 * 128); }
                indexer_tile(buf1, af, wv, sc0, sc1, kt + 1, r32, h2);
                if (kt + 2 < nt) { *(LAS u32x4*)(buf0 + key0 * KT_ROWB + ch * 16) = a0; *(LAS u32x4*)(buf0 + (key0 + 32) * KT_ROWB + ch * 16) = a1; }
                __syncthreads();
            }
        }
    }
}

DI unsigned mbcnt64(unsigned long long m) { return __builtin_amdgcn_mbcnt_hi((unsigned)(m >> 32), __builtin_amdgcn_mbcnt_lo((unsigned)m, 0u)); }
DI unsigned f2key(float f) { const unsigned u = __float_as_uint(f); return (u & 0x80000000u) ? ~u : (u | 0x80000000u); }
DI int wave_sum_i(int v) {
    v += __builtin_amdgcn_update_dpp(0, v, 0xB1, 0xF, 0xF, true);
    v += __builtin_amdgcn_update_dpp(0, v, 0x4E, 0xF, 0xF, true);
    v += __builtin_amdgcn_update_dpp(0, v, 0x141, 0xF, 0xF, true);
    v += __builtin_amdgcn_update_dpp(0, v, 0x140, 0xF, 0xF, true);
    return __builtin_amdgcn_readlane(v, 0) + __builtin_amdgcn_readlane(v, 16) + __builtin_amdgcn_readlane(v, 32) + __builtin_amdgcn_readlane(v, 48);
}
template <int NV>
DI void topk_row(const float* row, int s, LAS int* lst, int lane) {
    unsigned key[NV];
    { const unsigned long long ra = (unsigned long long)row; const unsigned rlo = __builtin_amdgcn_readfirstlane((unsigned)ra), rhi = __builtin_amdgcn_readfirstlane((unsigned)(ra >> 32));
      row = (const float*)(((unsigned long long)rhi << 32) | rlo); }
#pragma unroll
    for (int jo = 0; jo < NV / 16; ++jo) { const float* rb = row + jo * 1024;
#pragma unroll
        for (int ji = 0; ji < 16; ++ji) { const int j = jo * 16 + ji; const unsigned u = f2key(rb[ji * 64 + lane]); key[j] = (j * 64 + lane <= s) ? u : 0u; } }
    unsigned T = 0u;
#pragma unroll 1
    for (int bit = 31; bit >= 0; --bit) {
        const unsigned cand = T | (1u << bit); int c = 0;
#pragma unroll
        for (int j = 0; j < NV; ++j) asm volatile("v_cmp_le_u32 vcc, %2, %1\n\tv_addc_co_u32 %0, vcc, 0, %0, vcc" : "+v"(c) : "v"(key[j]), "s"(cand) : "vcc");
        const int tot = wave_sum_i(c);
        if (tot >= 256) T = cand;
        if (tot == 256) break;
    }
    int bgt = 0;
#pragma unroll
    for (int j = 0; j < NV; ++j) { const bool sg = key[j] > T; const unsigned long long mg = __ballot(sg); if (sg) lst[bgt + (int)mbcnt64(mg)] = j * 64 + lane; bgt += __builtin_popcountll(mg); }
#pragma unroll
    for (int j = 0; j < NV; ++j) { const bool se = key[j] == T; const unsigned long long me = __ballot(se); const int pe = bgt + (int)mbcnt64(me); if (se && pe < 256) lst[pe] = j * 64 + lane; bgt += __builtin_popcountll(me); }
}
DI void topk_phase(const float* SC, unsigned short* IDX, LAS unsigned char* lds, int tid, int bid, int G) {
    const int lane = tid & 63, w = __builtin_amdgcn_readfirstlane(tid >> 6), gw = bid * NWAVES + w, nw = G * NWAVES;
    LAS int* lst = (LAS int*)(lds + w * 1024);
    for (int t = gw; t < MTOK; t += nw) {
        const int b = t >> 13, s = t & 8191; unsigned short* out = IDX + (size_t)t * 256;
        if (s < 256) {
#pragma unroll
            for (int i = 0; i < 4; ++i) { const int j = lane + 64 * i; out[j] = (unsigned short)((j <= s) ? j : 0); }
        } else {
            const float* row = SC + sc_row_off(b, s);
            if (s < 2048) topk_row<32>(row, s, lst, lane);
            else if (s < 4096) topk_row<64>(row, s, lst, lane);
            else if (s < 6144) topk_row<96>(row, s, lst, lane);
            else topk_row<128>(row, s, lst, lane);
#pragma unroll
            for (int i = 0; i < 4; ++i) out[lane + 64 * i] = (unsigned short)lst[lane + 64 * i];
        }
    }
}

typedef unsigned __attribute__((may_alias)) u32_alias_t;
constexpr int DSA_WB = 17408;
DI __amdgpu_buffer_rsrc_t kv_rsrc(const bf16_t* base) { return __builtin_amdgcn_make_buffer_rsrc((void*)base, 0, SEQ * 256, 0x00020000); }
DI __amdgpu_buffer_rsrc_t big_rsrc(const void* base, unsigned bytes) { return __builtin_amdgcn_make_buffer_rsrc((void*)base, 0, (int)bytes, 0x00020000); }
DI void dsa_attn_phase(const bf16_t* Q1, const bf16_t* K1, const bf16_t* V1, const unsigned short* IDX, unsigned char* AO, LAS unsigned char* lds, int tid, int bid, int G) {
    const int lane = tid & 63, w = __builtin_amdgcn_readfirstlane(tid >> 6), n = lane & 15, g4 = lane >> 4, q4 = n >> 2, p4 = n & 3;
    LAS unsigned char* vb = lds + w * DSA_WB; LAS unsigned short* il0 = (LAS unsigned short*)(vb + 16384); LAS unsigned short* il1 = il0 + 256;
    const bool xm = (G & 7) == 0;
    const int start = xm ? ((bid >> 3) * NWAVES + w) : (bid * NWAVES + w), step = xm ? ((G >> 3) * NWAVES) : (G * NWAVES), total = xm ? MTOK : MTOK * 8;
    const int tr_base = (4 * g4 + q4) * 256 + 8 * (p4 & 1);
    const int vvo = 16 * n;
    const __amdgpu_buffer_rsrc_t qr = big_rsrc(Q1, (unsigned)MTOK * 8192u), ir = big_rsrc(IDX, (unsigned)MTOK * 512u), orr = big_rsrc(AO, (unsigned)MTOK * 4096u);
    const int qlo = n * 256 + 16 * g4;
    const int olo = n * 128 + 4 * g4;
    LAS unsigned char* kwb[4]; LAS unsigned char* krb[4]; LAS unsigned char* trb[4];
#pragma unroll
    for (int j = 0; j < 4; ++j) { kwb[j] = vb + g4 * 256 + ((n ^ (4 * j + g4)) * 16);
                                  krb[j] = vb + n * 256 + (((4 * j + g4) ^ n) * 16);
                                  trb[j] = vb + tr_base + 32 * (j ^ q4) + 16 * (p4 >> 1); }
    LAS unsigned char* vwb = vb + g4 * 256 + ((n ^ (2 * g4)) * 16);
    int it = start;
    if (it >= total) return;
#define DSA_ITEM(itv, kvh_, t_) const int kvh_ = xm ? (bid & 7) : ((itv) & 7), t_ = xm ? (itv) : ((itv) >> 3)
    u32x4 vst[8], kst[16]; bf16x8 qf[4];
    {
        DSA_ITEM(it, kvh, t);
#pragma unroll
        for (int i = 0; i < 2; ++i) ((LAS u32_alias_t*)il0)[lane + 64 * i] = __builtin_amdgcn_raw_buffer_load_b32(ir, lane * 4 + 256 * i, t * 512, 0);
        const size_t slice = (size_t)((t >> 13) * 8 + kvh) * SEQ * 128;
        const __amdgpu_buffer_rsrc_t kr = kv_rsrc(K1 + slice), vr = kv_rsrc(V1 + slice);
#pragma unroll
        for (int ks = 0; ks < 4; ++ks) qf[ks] = (n < 4) ? __builtin_bit_cast(bf16x8, __builtin_amdgcn_raw_buffer_load_b128(qr, qlo + 64 * ks, t * 8192 + kvh * 1024, 0)) : (bf16x8){0, 0, 0, 0, 0, 0, 0, 0};
#pragma unroll
        for (int i = 0; i < 16; ++i) kst[i] = __builtin_amdgcn_raw_buffer_load_b128(kr, (int)il0[4 * i + g4] * 256 + vvo, 0, 0);
#pragma unroll
        for (int i = 0; i < 8; ++i) vst[i] = __builtin_amdgcn_raw_buffer_load_b128(vr, (int)il0[4 * i + g4] * 256 + vvo, 0, 0);
    }
    int par = 0;
    for (; it < total; it += step) {
        DSA_ITEM(it, kvh, t);
        LAS unsigned short* ilc = par ? il1 : il0; LAS unsigned short* iln = par ? il0 : il1;
        const bool has_next = (it + step) < total;
        DSA_ITEM(it + step, kvh2, t2);
        const int s = t & 8191; const int nvalid = s + 1 < 256 ? s + 1 : 256;
        const size_t slice = (size_t)((t >> 13) * 8 + kvh) * SEQ * 128;
        const __amdgpu_buffer_rsrc_t kr = kv_rsrc(K1 + slice), vr = kv_rsrc(V1 + slice);
        const size_t slice2 = (size_t)((t2 >> 13) * 8 + kvh2) * SEQ * 128;
        unsigned inext[2] = {0u, 0u};
        if (has_next) {
#pragma unroll
            for (int i = 0; i < 2; ++i) inext[i] = __builtin_amdgcn_raw_buffer_load_b32(ir, lane * 4 + 256 * i, t2 * 512, 0); }
        float mrun = -__builtin_inff(), lsum = 0.f;
        f32x4 o[8];
#pragma unroll
        for (int dt = 0; dt < 8; ++dt) o[dt] = (f32x4){0.f, 0.f, 0.f, 0.f};
#pragma unroll 1
        for (int c = 0; c < 4; ++c) {
#pragma unroll
            for (int i = 0; i < 16; ++i) *(LAS u32x4*)(kwb[i & 3] + i * 1024) = kst[i];
            if (c < 3) {
#pragma unroll
                for (int i = 0; i < 16; ++i) kst[i] = __builtin_amdgcn_raw_buffer_load_b128(kr, (int)ilc[(c + 1) * 64 + 4 * i + g4] * 256 + vvo, 0, 0);
            } else if (has_next) {
#pragma unroll
                for (int i = 0; i < 2; ++i) ((LAS u32_alias_t*)iln)[lane + 64 * i] = inext[i];
                const __amdgpu_buffer_rsrc_t kr2 = kv_rsrc(K1 + slice2);
#pragma unroll
                for (int i = 0; i < 16; ++i) kst[i] = __builtin_amdgcn_raw_buffer_load_b128(kr2, (int)iln[4 * i + g4] * 256 + vvo, 0, 0);
            }
            f32x4 sa[4];
#pragma unroll
            for (int tt = 0; tt < 4; ++tt) { f32x4 a = {0.f, 0.f, 0.f, 0.f};
#pragma unroll
                for (int ks = 0; ks < 4; ++ks) { const bf16x8 kf = *(const LAS bf16x8*)(krb[ks] + tt * 4096);
                    a = __builtin_amdgcn_mfma_f32_16x16x32_bf16(kf, qf[ks], a, 0, 0, 0); }
                sa[tt] = a; asm volatile("" ::: "memory"); }
            if (nvalid < 256) {
#pragma unroll
                for (int tt = 0; tt < 4; ++tt)
#pragma unroll
                    for (int j = 0; j < 4; ++j) { const int kk = 64 * c + 16 * tt + 4 * g4 + j; sa[tt][j] = (kk < nvalid) ? sa[tt][j] : -__builtin_inff(); }
            }
            float cm = fmaxf(fmaxf(fmaxf(sa[0][0], sa[0][1]), fmaxf(sa[0][2], sa[0][3])), fmaxf(fmaxf(sa[1][0], sa[1][1]), fmaxf(sa[1][2], sa[1][3])));
            cm = fmaxf(cm, fmaxf(fmaxf(fmaxf(sa[2][0], sa[2][1]), fmaxf(sa[2][2], sa[2][3])), fmaxf(fmaxf(sa[3][0], sa[3][1]), fmaxf(sa[3][2], sa[3][3]))));
            cm = fmaxf(cm, __shfl_xor(cm, 16)); cm = fmaxf(cm, __shfl_xor(cm, 32));
            const float mnew = fmaxf(mrun, cm); const float alpha = __builtin_amdgcn_exp2f((mrun - mnew) * SM_C); const float msc = mnew * SM_C; mrun = mnew;
            lsum *= alpha;
#pragma unroll
            for (int dt = 0; dt < 8; ++dt) o[dt] = o[dt] * alpha;
            unsigned pk[4][2];
#pragma unroll
            for (int tt = 0; tt < 4; ++tt) { float pp[4];
#pragma unroll
                for (int j = 0; j < 4; ++j) { pp[j] = __builtin_amdgcn_exp2f(sa[tt][j] * SM_C - msc); lsum += pp[j]; }
                pk[tt][0] = pg8::cvt_pk_bf16(pp[0], pp[1]); pk[tt][1] = pg8::cvt_pk_bf16(pp[2], pp[3]); }
            if (c == 3 && has_next) {
#pragma unroll
                for (int ks = 0; ks < 4; ++ks) qf[ks] = (n < 4) ? __builtin_bit_cast(bf16x8, __builtin_amdgcn_raw_buffer_load_b128(qr, qlo + 64 * ks, t2 * 8192 + kvh2 * 1024, 0)) : (bf16x8){0, 0, 0, 0, 0, 0, 0, 0};
            }
#pragma unroll
            for (int hf = 0; hf < 2; ++hf) {
#pragma unroll
                for (int i = 0; i < 8; ++i) *(LAS u32x4*)(vwb + i * 1024) = vst[i];
                if (hf == 0) {
#pragma unroll
                    for (int i = 0; i < 8; ++i) vst[i] = __builtin_amdgcn_raw_buffer_load_b128(vr, (int)ilc[c * 64 + 32 + 4 * i + g4] * 256 + vvo, 0, 0);
                } else if (c < 3) {
#pragma unroll
                    for (int i = 0; i < 8; ++i) vst[i] = __builtin_amdgcn_raw_buffer_load_b128(vr, (int)ilc[(c + 1) * 64 + 4 * i + g4] * 256 + vvo, 0, 0);
                } else if (has_next) {
                    const __amdgpu_buffer_rsrc_t vr2 = kv_rsrc(V1 + slice2);
#pragma unroll
                    for (int i = 0; i < 8; ++i) vst[i] = __builtin_amdgcn_raw_buffer_load_b128(vr2, (int)iln[4 * i + g4] * 256 + vvo, 0, 0);
                }
                u32x4 pw; pw.x = pk[2 * hf][0]; pw.y = pk[2 * hf][1]; pw.z = pk[2 * hf + 1][0]; pw.w = pk[2 * hf + 1][1];
                const bf16x8 pf = __builtin_bit_cast(bf16x8, pw);
#pragma unroll
                for (int dt = 0; dt < 8; ++dt) {
                    const s16x4 lo = __builtin_amdgcn_ds_read_tr16_b64_v4i16((LAS s16x4*)(trb[dt & 3] + 128 * (dt >> 2)));
                    const s16x4 hi = __builtin_amdgcn_ds_read_tr16_b64_v4i16((LAS s16x4*)(trb[dt & 3] + 128 * (dt >> 2) + 16 * 256));
                    const bf16x8 vf = __builtin_shufflevector(lo, hi, 0, 1, 2, 3, 4, 5, 6, 7);
                    o[dt] = __builtin_amdgcn_mfma_f32_16x16x32_bf16(vf, pf, o[dt], 0, 0, 0);
                    if (dt & 1) asm volatile("" ::: "memory");
                }
            }
        }
        lsum += __shfl_xor(lsum, 16); lsum += __shfl_xor(lsum, 32);
        if (n < 4) { const float li = 16.0f / lsum;
#pragma unroll
            for (int dt = 0; dt < 8; ++dt) { int wv = __builtin_amdgcn_cvt_pk_fp8_f32(o[dt][0] * li, o[dt][1] * li, 0, false); wv = __builtin_amdgcn_cvt_pk_fp8_f32(o[dt][2] * li, o[dt][3] * li, wv, true);
                __builtin_amdgcn_raw_buffer_store_b32((unsigned)wv, orr, olo + 16 * dt, t * 4096 + kvh * 512, 0); } }
        par ^= 1;
    }
#undef DSA_ITEM
}

#ifndef MK_ONE_LAUNCH
#define MK_ONE_LAUNCH 1
#endif
constexpr int N_PHASES = 19;
#ifndef FFN1_FP8
#define FFN1_FP8 1
#endif
#ifndef WGM_F
#define WGM_F 8
#endif
#ifndef WGM_Y
#define WGM_Y 2
#endif
struct Args { const float* in[22]; float* out; unsigned char* ws; int ph_lo, ph_hi; };

__global__ void __launch_bounds__(NTHR, 2) mk_fwd(Args args) {
    extern __shared__ __attribute__((aligned(16))) unsigned char lds_raw[];
    LAS unsigned char* lds = (LAS unsigned char*)lds_raw;
    const int bid = blockIdx.x, G = gridDim.x;
    const int wid_s = __builtin_amdgcn_readfirstlane((int)(threadIdx.x >> 6));
#define tid fresh_tid(wid_s)
    unsigned char* ws = args.ws;
    const __attribute__((address_space(4))) unsigned char* kargs = (const __attribute__((address_space(4))) unsigned char*)__builtin_amdgcn_kernarg_segment_ptr();
#define ARG_IN(i) (*(const float* const volatile __attribute__((address_space(4)))*)(kargs + 8 * (i)))
    volatile LAS unsigned* misc = (volatile LAS unsigned*)(lds + MISC_OFF);
    { const int t0_ = tid; if (t0_ < 4) misc[t0_] = 0u; }
    __syncthreads();
    const int lo = args.ph_lo, hi = args.ph_hi;
    XcdBarrier bar; bar.bar = (unsigned*)(ws + WS_CTL); bar.x = 0; bar.st = nullptr; bar.wid = wid_s;
    if (hi - lo > 1) bar = xcd_barrier_post((unsigned*)(ws + WS_CTL), misc, wid_s);
#ifndef PH_MASK
#define PH_MASK 0x7ffff
#endif
#define IN(k) ((((PH_MASK) >> (k)) & 1) && lo <= (k) && (k) < hi)
#ifndef PROBE_PH
#define PROBE_PH -1
#endif
#ifndef PROBE_PH2
#define PROBE_PH2 -1
#endif
    unsigned long long pr_t0 = (PROBE_PH == 0) ? __builtin_amdgcn_s_memrealtime() : 0ull, pr_acc = 0ull;
#define SEAM(k) do { if (IN(k) && IN((k) + 1)) xcd_barrier(bar); \
        if (PROBE_PH >= 0 && bid == 0) { const unsigned long long now_ = __builtin_amdgcn_s_memrealtime(); if ((k) + 1 == PROBE_PH) pr_t0 = now_; if ((k) == (PROBE_PH2 >= 0 ? PROBE_PH2 : PROBE_PH)) pr_acc = now_ - pr_t0; } } while (0)
#ifndef DUP_MASK
#define DUP_MASK 0
#endif
#define REP(k) _Pragma("unroll 1") for (int rep_ = 0; rep_ < ((((DUP_MASK) >> (k)) & 1) ? 2 : 1); ++rep_)

    float* CS = (float*)(ws + WS_COS); float* SN = (float*)(ws + WS_SIN);
    bf16_t* XB = (bf16_t*)(ws + WS_XB); half_t* XH = (half_t*)(ws + WS_XA); half_t* Y = (half_t*)(ws + B_Y); bf16_t* Hh = (bf16_t*)(ws + B_H);
    float* OUT = args.out;
    const pg8::RopeTab rt{CS, SN};
#define RSRC256M(p) __builtin_amdgcn_make_buffer_rsrc((void*)(p), 0, (int)(256u * 1048576u), 0x00020000)

    if (IN(0)) REP(0) {
        LAS float* scr = (LAS float*)lds;
        wt_matrix8(ARG_IN(2), DM, N_A, (unsigned char*)(ws + W0IN), MapA{}, scr, tid, bid, G, 64.0f);
        wt_matrix8(ARG_IN(3), 2048, DM, (unsigned char*)(ws + W0OUT), MapId{}, scr, tid, bid, G, 64.0f);
        wt_matrix(ARG_IN(10), DM, DFF, (bf16_t*)(ws + W0GU), MapGU{0}, scr, tid, bid, G);
        wt_matrix(ARG_IN(11), DM, DFF, (bf16_t*)(ws + W0GU), MapGU{1}, scr, tid, bid, G);
        cvt_x8_phase(ARG_IN(0), (unsigned char*)XB, tid, bid, G);
        rope_tab_phase((const int*)ARG_IN(1), CS, SN, tid, bid, G);
    }
    SEAM(0);
    if (IN(1)) REP(1) {
        pg8::Gemm g{XB, (const bf16_t*)(ws + W0IN), MTOK, N_A, DM / 2}; pg8::StaticOrder S; S.init(MTOK, N_A, G, bid);
        pg8::EpiQKV0 E{__builtin_amdgcn_make_buffer_rsrc((void*)(ws + B_QKV0), 0, (int)(576u * 1048576u), 0x00020000), __builtin_amdgcn_make_buffer_rsrc((void*)CS, 0, MTOK * 256, 0x00020000), __builtin_amdgcn_make_buffer_rsrc((void*)SN, 0, MTOK * 256, 0x00020000), 0.015625f};
        pg8::gemm_phase<pg8::EpiQKV0, pg8::StaticOrder, true, true, true, 6>(lds, g, S, E, tid);
    }
    SEAM(1);
    if (IN(2)) REP(2) attn0_phase((const unsigned char*)(ws + B_QKV0), (bf16_t*)(ws + B_OG), (float*)(ws + B_LSE), lds, tid, bid, G);
    SEAM(2);
    if (IN(3)) REP(3) merge_phase((const bf16_t*)(ws + B_OG), (const float*)(ws + B_LSE), (unsigned char*)(ws + B_AO0), tid, bid, G);
    SEAM(3);
    if (IN(4)) REP(4) {
        pg8::Gemm g{(const bf16_t*)(ws + B_AO0), (const bf16_t*)(ws + W0OUT), MTOK, DM, 1024}; pg8::StaticOrder S; S.init(MTOK, DM, G, bid, WGM_Y);
        pg8::EpiY<false> E{RSRC256M(ARG_IN(0)), RSRC256M(Y), ALPHA, 1.0f / 1024.0f};
        pg8::gemm_phase<pg8::EpiY<false>, pg8::StaticOrder, true, true, true>(lds, g, S, E, tid);
    }
    SEAM(4);
    if (IN(5)) REP(5) ln_phase(Y, ARG_IN(8), ARG_IN(9), nullptr, XH, XB, tid, bid, G);
    SEAM(5);
    if (IN(6)) REP(6) {
        pg8::Gemm g{XB, (const bf16_t*)(ws + W0GU), MTOK, 2 * DFF, DM}; pg8::StaticOrder S; S.init(MTOK, 2 * DFF, G, bid, WGM_F);
        pg8::EpiSwiGLU<false> E{Hh, DFF};
        pg8::gemm_phase<pg8::EpiSwiGLU<false>, pg8::StaticOrder, true, true>(lds, g, S, E, tid);
        {
            const int rem = ((MTOK / 256) * ((2 * DFF) / 256)) % G, cb = rem ? bid - rem : bid, cg = rem ? G - rem : G;
            if (cb >= 0) { __syncthreads(); wt_matrix(ARG_IN(12), DFF, DM, (bf16_t*)(ws + W0DN), MapId{}, (LAS float*)lds, tid, cb, cg); }
        }
    }
    SEAM(6);
    if (IN(7)) REP(7) {
        pg8::Gemm g{Hh, (const bf16_t*)(ws + W0DN), MTOK, DM, DFF}; pg8::StaticOrder S; S.init(MTOK, DM, G, bid, WGM_Y);
        pg8::EpiY<true> E{RSRC256M(XH), RSRC256M(Y), ALPHA, 1.0f};
        pg8::gemm_phase<pg8::EpiY<true>, pg8::StaticOrder, true, true>(lds, g, S, E, tid);
    }
    SEAM(7);
    if (IN(8)) REP(8) {
        ln_phase(Y, ARG_IN(13), ARG_IN(14), nullptr, XH, XB, tid, bid, G, ws + WS_XB8);
        LAS float* scr = (LAS float*)lds;
        wt_matrix8(ARG_IN(4), DM, 6144, (unsigned char*)(ws + W1IN), MapB{}, scr, tid, bid, G, 64.0f, N_B);
        wt_matrix(ARG_IN(4) + 6144, DM, N_B - 6144, (bf16_t*)(ws + W1INB), MapB2{}, scr, tid, bid, G, N_B);
        { u32x4* z = (u32x4*)(ws + W1INB + (size_t)(N_B - 6144) * DM * 2); const int nz = (N_BP - N_B) * DM * 2 / 16; for (int i = bid * NTHR + tid; i < nz; i += G * NTHR) z[i] = (u32x4){0u, 0u, 0u, 0u}; }
        wt_matrix8(ARG_IN(7), DM, DM, (unsigned char*)(ws + W1OUT), MapId{}, scr, tid, bid, G, 64.0f);
        wt_matrix(ARG_IN(17), DM, DFF, (bf16_t*)(ws + W1GU), MapGU{0}, scr, tid, bid, G);
        wt_matrix(ARG_IN(18), DM, DFF, (bf16_t*)(ws + W1GU), MapGU{1}, scr, tid, bid, G);
    }
    SEAM(8);
    if (IN(9)) REP(9) {
        {
            pg8::Gemm g{(const bf16_t*)(ws + WS_XB8), (const bf16_t*)(ws + W1IN), MTOK, 6144, DM / 2}; pg8::StaticOrder S; S.init(MTOK, 6144, G, bid);
            pg8::EpiQKV1a E{__builtin_amdgcn_make_buffer_rsrc((void*)(ws + B_Q1), 0, MTOK * 8192, 0x00020000), __builtin_amdgcn_make_buffer_rsrc((void*)(ws + B_K1), 0, MTOK * 2048, 0x00020000),
                            __builtin_amdgcn_make_buffer_rsrc((void*)(ws + B_V1), 0, MTOK * 2048, 0x00020000), __builtin_amdgcn_make_buffer_rsrc((void*)CS, 0, MTOK * 256, 0x00020000),
                            __builtin_amdgcn_make_buffer_rsrc((void*)SN, 0, MTOK * 256, 0x00020000), 0.015625f};
            pg8::gemm_phase<pg8::EpiQKV1a, pg8::StaticOrder, true, true, true>(lds, g, S, E, tid);
        }
        __syncthreads();
        {
            pg8::Gemm g{XB, (const bf16_t*)(ws + W1INB), MTOK, N_BP - 6144, DM}; pg8::StaticOrder S; S.init(MTOK, N_BP - 6144, G, bid);
            pg8::EpiQKV1 E{(bf16_t*)(ws + B_Q1), (bf16_t*)(ws + B_K1), (bf16_t*)(ws + B_V1), (unsigned short*)(ws + B_QI), (float*)(ws + B_KIR), (float*)(ws + B_WI), rt, 24, 1.0f};
            pg8::gemm_phase<pg8::EpiQKV1, pg8::StaticOrder, true, true>(lds, g, S, E, tid);
        }
        {
            const int rem = ((MTOK / 256) * ((N_BP - 6144) / 256)) % G, cb = rem ? bid - rem : bid, cg = rem ? G - rem : G;
            if (cb >= 0) { __syncthreads();
#if FFN1_FP8
                wt_matrix8(ARG_IN(19), DFF, DM, (unsigned char*)(ws + W1DN), MapId{}, (LAS float*)lds, tid, cb, cg, 128.0f);
#else
                wt_matrix(ARG_IN(19), DFF, DM, (bf16_t*)(ws + W1DN), MapId{}, (LAS float*)lds, tid, cb, cg);
#endif
            }
        }
    }
    SEAM(9);
    if (IN(10)) REP(10) kidx_phase((const float*)(ws + B_KIR), ARG_IN(5), ARG_IN(6), CS, SN, (unsigned short*)(ws + B_KI16), tid, bid, G);
    SEAM(10);
    if (IN(11)) REP(11) indexer_phase((const unsigned short*)(ws + B_QI), (const unsigned short*)(ws + B_KI16), (const float*)(ws + B_WI), (float*)(ws + B_SC), lds, tid, bid, G);
    SEAM(11);
    if (IN(12)) REP(12) topk_phase((const float*)(ws + B_SC), (unsigned short*)(ws + B_IDX), lds, tid, bid, G);
    SEAM(12);
    if (IN(13)) REP(13) dsa_attn_phase((const bf16_t*)(ws + B_Q1), (const bf16_t*)(ws + B_K1), (const bf16_t*)(ws + B_V1), (const unsigned short*)(ws + B_IDX), (unsigned char*)(ws + B_AO1), lds, tid, bid, G);
    SEAM(13);
    if (IN(14)) REP(14) {
        pg8::Gemm g{(const bf16_t*)(ws + B_AO1), (const bf16_t*)(ws + W1OUT), MTOK, DM, DM / 2}; pg8::StaticOrder S; S.init(MTOK, DM, G, bid, WGM_Y);
        pg8::EpiY<true> E{RSRC256M(XH), RSRC256M(Y), ALPHA, 1.0f / 1024.0f};
        pg8::gemm_phase<pg8::EpiY<true>, pg8::StaticOrder, true, true, true>(lds, g, S, E, tid);
    }
    SEAM(14);
    if (IN(15)) REP(15) ln_phase(Y, ARG_IN(15), ARG_IN(16), nullptr, XH, XB, tid, bid, G);
    SEAM(15);
    if (IN(16)) REP(16) {
        pg8::Gemm g{XB, (const bf16_t*)(ws + W1GU), MTOK, 2 * DFF, DM}; pg8::StaticOrder S; S.init(MTOK, 2 * DFF, G, bid, WGM_F);
        pg8::EpiSwiGLU<FFN1_FP8 != 0> E{Hh, DFF};
        pg8::gemm_phase<pg8::EpiSwiGLU<FFN1_FP8 != 0>, pg8::StaticOrder, true, true>(lds, g, S, E, tid);
    }
    SEAM(16);
    if (IN(17)) REP(17) {
#if FFN1_FP8
        pg8::Gemm g{Hh, (const bf16_t*)(ws + W1DN), MTOK, DM, DFF / 2}; pg8::StaticOrder S; S.init(MTOK, DM, G, bid, WGM_Y);
        pg8::EpiY<true> E{RSRC256M(XH), RSRC256M(Y), ALPHA, 1.0f / 2048.0f};
        pg8::gemm_phase<pg8::EpiY<true>, pg8::StaticOrder, true, true, true>(lds, g, S, E, tid);
#else
        pg8::Gemm g{Hh, (const bf16_t*)(ws + W1DN), MTOK, DM, DFF}; pg8::StaticOrder S; S.init(MTOK, DM, G, bid, WGM_Y);
        pg8::EpiY<true> E{RSRC256M(XH), RSRC256M(Y), ALPHA, 1.0f};
        pg8::gemm_phase<pg8::EpiY<true>, pg8::StaticOrder, true, true>(lds, g, S, E, tid);
#endif
    }
    SEAM(17);
    if (IN(18)) REP(18) ln_phase(Y, ARG_IN(20), ARG_IN(21), OUT, nullptr, nullptr, tid, bid, G);
    if (PROBE_PH >= 0 && bid == 0) { const unsigned long long t1_ = __builtin_amdgcn_s_memrealtime(); while (__builtin_amdgcn_s_memrealtime() - t1_ < pr_acc) __builtin_amdgcn_s_sleep(8); }
#undef IN
#undef ARG_IN
#undef tid
#undef SEAM
#undef REP
}

extern "C" void kernel_launch(void* const* d_in, const int* in_sizes, int n_in, void* d_out, int out_size, void* d_ws, size_t ws_size, hipStream_t stream) {
    static int grid = 0;
    if (grid == 0) {
        if (n_in != 22 || out_size != MTOK * DM || ws_size < WS_END) { fprintf(stderr, "kernel_launch: unexpected problem (n_in %d, out %d, ws %zu < %zu); nothing launched\n", n_in, out_size, ws_size, (size_t)WS_END); grid = -1; return; }
        int dev = 0, cus = 0, per_cu = 0;
        if (hipGetDevice(&dev) != hipSuccess || hipDeviceGetAttribute(&cus, hipDeviceAttributeMultiprocessorCount, dev) != hipSuccess) { grid = -1; return; }
        if (hipFuncSetAttribute((const void*)mk_fwd, hipFuncAttributeMaxDynamicSharedMemorySize, LDS_BYTES) != hipSuccess) { fprintf(stderr, "kernel_launch: hipFuncSetAttribute failed\n"); grid = -1; return; }
        if (hipOccupancyMaxActiveBlocksPerMultiprocessor(&per_cu, (const void*)mk_fwd, NTHR, LDS_BYTES) != hipSuccess || per_cu < 1) { fprintf(stderr, "kernel_launch: occupancy query reports %d\n", per_cu); (void)hipGetLastError(); per_cu = 1; }
        grid = cus;
    }
    if (grid < 0) return;
    (void)in_sizes;
    if (hipMemsetAsync((char*)d_ws + WS_CTL, 0, CTL_ZERO_BYTES, stream) != hipSuccess) return;
    Args a{};
    for (int i = 0; i < 22; ++i) a.in[i] = (const float*)d_in[i];
    a.out = (float*)d_out; a.ws = (unsigned char*)d_ws;
#if MK_ONE_LAUNCH
    a.ph_lo = 0; a.ph_hi = N_PHASES;
    hipLaunchKernelGGL(mk_fwd, dim3(grid), dim3(NTHR), LDS_BYTES, stream, a);
#else
    for (int p = 0; p < N_PHASES; ++p) { a.ph_lo = p; a.ph_hi = p + 1; hipLaunchKernelGGL(mk_fwd, dim3(grid), dim3(NTHR), LDS_BYTES, stream, a); }
#endif
}
```

```cpp
#include <hip/hip_runtime.h>
#include <cstdio>
#include <cstdint>
namespace pg8 {
#define PG8_LAS __attribute__((address_space(3)))
typedef unsigned short bf16_t;
typedef short bf16x8 __attribute__((ext_vector_type(8)));
typedef float f32x4 __attribute__((ext_vector_type(4)));
typedef unsigned u32x4 __attribute__((ext_vector_type(4)));
constexpr int BM = 256, BK = 64, HALF = 128, HTB = HALF * BK * 2  , STAGE_BYTES = 8 * HTB, NXCD = 8, WGM = 8;

__host__ __device__ __forceinline__ int lds_byte(int r, int c) { const int st = (r >> 4) * 2 + (c >> 5), rr = r & 15, cc = c & 31, ob = rr * 64 + cc * 2; return st * 1024 + (ob ^ (((ob >> 9) & 1) << 5)); }
__host__ __device__ __forceinline__ void stage_rc(int b, int& R, int& C) { const int st = b / 1024, sb = b % 1024, swz = sb ^ (((sb >> 9) & 1) << 5); R = (st >> 1) * 16 + swz / 64; C = (st & 1) * 32 + (swz % 64) / 2; }
__host__ __device__ __forceinline__ int perm32(int rho) { const int n = rho >> 4, i = rho & 15; return 8 * (i >> 2) + 4 * n + (i & 3); }

struct Unit { int pm, pn; };
struct Gemm { const bf16_t* A; const bf16_t* Bt; int M, N, K; };

struct StaticOrder {
    int nM, nN, nwg, G, c, wgm;
    __host__ __device__ void init(int M, int N, int G_, int c_, int wgm_ = WGM) { nM = M / BM; nN = N / BM; nwg = nM * nN; G = G_; c = c_; wgm = wgm_; }
    __host__ __device__ bool next(int i, Unit& u) const {
        const long L = (long)i * G + c; if (L >= nwg) return false;
        int wgid = (int)L; { const int q = nwg / NXCD, r = nwg % NXCD, xcd = wgid % NXCD, off = wgid / NXCD; wgid = (xcd < r ? xcd * (q + 1) : r * (q + 1) + (xcd - r) * q) + off; }
        const int nig = wgm * nN, gid = wgid / nig, fm = gid * wgm, gsz = (nM - fm) < wgm ? (nM - fm) : wgm;
        u.pm = fm + ((wgid % nig) % gsz); u.pn = (wgid % nig) / gsz; return true;
    }
    __device__ __forceinline__ void a_ready(const Unit&) const {}
    __device__ __forceinline__ void done(const Unit&) const {}
};
__device__ __forceinline__ unsigned cvt_pk_bf16(float lo, float hi) { unsigned r; asm volatile("v_cvt_pk_bf16_f32 %0, %1, %2" : "=v"(r) : "v"(lo), "v"(hi)); return r; }
typedef _Float16 f16x2_t __attribute__((ext_vector_type(2)));
__device__ __forceinline__ unsigned cvt_pk_f16(float lo, float hi) { f16x2_t h; h.x = (_Float16)lo; h.y = (_Float16)hi; return __builtin_bit_cast(unsigned, h); }

struct RopeTab { const float* cs; const float* sn; };

__device__ __forceinline__ void rope_pair(f32x4& v0, f32x4& v1, const f32x4 c, const f32x4 s) {
    const f32x4 a = v0 * c - v1 * s, b = v1 * c + v0 * s; v0 = a; v1 = b;
}

typedef float f32x2_t __attribute__((ext_vector_type(2)));
typedef unsigned u32x2e_t __attribute__((ext_vector_type(2)));
typedef _Float16 f16x4_t __attribute__((ext_vector_type(4)));
__device__ __forceinline__ f32x4 f16x4_to_f32(u32x2e_t w) { return __builtin_convertvector(__builtin_bit_cast(f16x4_t, w), f32x4); }
template <bool XH = true> struct EpiY {
    static constexpr bool PERM = false, AFTER_DRAIN = false;
    __amdgpu_buffer_rsrc_t X, Y; float alpha, scl;
    __device__ __forceinline__ void operator()(const f32x4 (&acc)[2][2][4][2], const Unit& u, int wr, int wc, int fr, int fq) const {
        const int row0 = u.pm * BM + wr * 64 + fr, col0 = u.pn * BM + wc * 32 + 4 * fq;
#pragma unroll
        for (int ai = 0; ai < 2; ++ai) {
            f32x4 xv[4][2][2];
#pragma unroll
            for (int m = 0; m < 4; ++m) { const int off = ((row0 + ai * HALF + m * 16) * 4096 + col0) * 2;
#pragma unroll
                for (int bj = 0; bj < 2; ++bj)
#pragma unroll
                    for (int n = 0; n < 2; ++n) {
                        if constexpr (XH) xv[m][bj][n] = f16x4_to_f32(__builtin_bit_cast(u32x2e_t, __builtin_amdgcn_raw_buffer_load_b64(X, off + (bj * HALF + n * 16) * 2, 0, 0)));
                        else xv[m][bj][n] = __builtin_bit_cast(f32x4, __builtin_amdgcn_raw_buffer_load_b128(X, 2 * off + (bj * HALF + n * 16) * 4, 0, 0)); } }
#pragma unroll
            for (int m = 0; m < 4; ++m) { const int off = ((row0 + ai * HALF + m * 16) * 4096 + col0) * 2;
#pragma unroll
                for (int bj = 0; bj < 2; ++bj)
#pragma unroll
                    for (int n = 0; n < 2; ++n) { const f32x4 r = xv[m][bj][n] * alpha + acc[ai][bj][m][n] * scl;
                        u32x2e_t w; w.x = cvt_pk_f16(r[0], r[1]); w.y = cvt_pk_f16(r[2], r[3]);
                        __builtin_amdgcn_raw_buffer_store_b64(w, Y, off + (bj * HALF + n * 16) * 2, 0, 0); } }
            asm volatile("" ::: "memory"); }
    }
};

template <bool OUT8 = false> struct EpiSwiGLU {
    static constexpr bool PERM = true, AFTER_DRAIN = false;
    bf16_t* Hh; int ldh;
    __device__ __forceinline__ void operator()(const f32x4 (&acc)[2][2][4][2], const Unit& u, int wr, int wc, int fr, int fq) const {
        const int row0 = u.pm * BM + wr * 64 + fr, col0 = u.pn * HALF + wc * 32 + 8 * fq;
#pragma unroll
        for (int ai = 0; ai < 2; ++ai)
#pragma unroll
            for (int m = 0; m < 4; ++m) { const size_t eoff = (size_t)(row0 + ai * HALF + m * 16) * ldh + col0;
                float h[8];
#pragma unroll
                for (int n = 0; n < 2; ++n)
#pragma unroll
                    for (int i = 0; i < 4; ++i) { const float g = acc[ai][0][m][n][i], up = acc[ai][1][m][n][i];
                        const float e = __builtin_amdgcn_exp2f(-g * 1.44269504089f); h[n * 4 + i] = g * __builtin_amdgcn_rcpf(1.0f + e) * up; }
                if constexpr (OUT8) { int w0 = __builtin_amdgcn_cvt_pk_fp8_f32(h[0] * 16.f, h[1] * 16.f, 0, false); w0 = __builtin_amdgcn_cvt_pk_fp8_f32(h[2] * 16.f, h[3] * 16.f, w0, true);
                    int w1 = __builtin_amdgcn_cvt_pk_fp8_f32(h[4] * 16.f, h[5] * 16.f, 0, false); w1 = __builtin_amdgcn_cvt_pk_fp8_f32(h[6] * 16.f, h[7] * 16.f, w1, true);
                    typedef int i32x2_t __attribute__((ext_vector_type(2))); *(i32x2_t*)((unsigned char*)Hh + eoff) = (i32x2_t){w0, w1}; }
                else { u32x4 w; w.x = cvt_pk_bf16(h[0], h[1]); w.y = cvt_pk_bf16(h[2], h[3]); w.z = cvt_pk_bf16(h[4], h[5]); w.w = cvt_pk_bf16(h[6], h[7]);
                    *(u32x4*)(Hh + eoff) = w; } }
    }
};

struct EpiQKV0 {
    static constexpr bool PERM = true, AFTER_DRAIN = false;
    __amdgpu_buffer_rsrc_t o, cs, sn; float scl;
    __device__ __forceinline__ void operator()(const f32x4 (&acc)[2][2][4][2], const Unit& u, int wr, int wc, int fr, int fq) const {
        const int sg = u.pn >> 3, cw = wc * 32 + 8 * fq, hd0 = (u.pn & 7) * 2; const bool rope = sg < 6;
        const int dsh = 2 * (sg % 3);
        const int row0 = u.pm * BM + wr * 64 + fr, f0 = 16 * wc + 4 * fq;
        const int bb = u.pm >> 5;
        const unsigned sbase = (unsigned)(((sg * 2 + bb) * 16 + hd0) * 8192) * 128u;
#pragma unroll
        for (int ai = 0; ai < 2; ++ai)
#pragma unroll
            for (int m = 0; m < 4; ++m) { const int row = row0 + ai * HALF + m * 16; const int si = row & 8191;
                const int rl = (si & ((1 << dsh) - 1)) * (8192 >> dsh) + (si >> dsh);
                f32x4 c = {1.f, 1.f, 1.f, 1.f}, s = {0.f, 0.f, 0.f, 0.f};
                if (rope) { c = __builtin_bit_cast(f32x4, __builtin_amdgcn_raw_buffer_load_b128(cs, (row * 64 + f0) * 4, 0, 0)); s = __builtin_bit_cast(f32x4, __builtin_amdgcn_raw_buffer_load_b128(sn, (row * 64 + f0) * 4, 0, 0)); }
#pragma unroll
                for (int bj = 0; bj < 2; ++bj) { f32x4 v0 = acc[ai][bj][m][0] * scl, v1 = acc[ai][bj][m][1] * scl;
                    rope_pair(v0, v1, c, s);
                    int w0 = __builtin_amdgcn_cvt_pk_fp8_f32(v0[0], v0[1], 0, false); w0 = __builtin_amdgcn_cvt_pk_fp8_f32(v0[2], v0[3], w0, true);
                    int w1 = __builtin_amdgcn_cvt_pk_fp8_f32(v1[0], v1[1], 0, false); w1 = __builtin_amdgcn_cvt_pk_fp8_f32(v1[2], v1[3], w1, true);
                    typedef unsigned u32x2_t __attribute__((ext_vector_type(2)));
                    __builtin_amdgcn_raw_buffer_store_b64((u32x2_t){(unsigned)w0, (unsigned)w1}, o, rl * 128 + cw, (int)(sbase + (unsigned)bj * (8192u * 128u)), 0); } }
    }
};

struct EpiQKV1a {
    static constexpr bool PERM = true, AFTER_DRAIN = false;
    __amdgpu_buffer_rsrc_t q, k, v, cs, sn; float scl;
    __device__ __forceinline__ void operator()(const f32x4 (&acc)[2][2][4][2], const Unit& u, int wr, int wc, int fr, int fq) const {
        const int pn = u.pn; const int row0 = u.pm * BM + wr * 64 + fr, f0 = 16 * wc + 4 * fq, cw = wc * 32 + 8 * fq;
        const bool rope = pn < 20;
#pragma unroll
        for (int ai = 0; ai < 2; ++ai)
#pragma unroll
            for (int m = 0; m < 4; ++m) { const int row = row0 + ai * HALF + m * 16;
                f32x4 c = {1.f, 1.f, 1.f, 1.f}, s = {0.f, 0.f, 0.f, 0.f};
                if (rope) { c = __builtin_bit_cast(f32x4, __builtin_amdgcn_raw_buffer_load_b128(cs, (row * 64 + f0) * 4, 0, 0)); s = __builtin_bit_cast(f32x4, __builtin_amdgcn_raw_buffer_load_b128(sn, (row * 64 + f0) * 4, 0, 0)); }
#pragma unroll
                for (int bj = 0; bj < 2; ++bj) { f32x4 v0 = acc[ai][bj][m][0] * scl, v1 = acc[ai][bj][m][1] * scl;
                    rope_pair(v0, v1, c, s);
                    u32x4 w; w.x = cvt_pk_bf16(v0[0], v0[1]); w.y = cvt_pk_bf16(v0[2], v0[3]); w.z = cvt_pk_bf16(v1[0], v1[1]); w.w = cvt_pk_bf16(v1[2], v1[3]);
                    if (pn < 16) __builtin_amdgcn_raw_buffer_store_b128(w, q, (row * 4096 + bj * HALF + cw) * 2, pn * 512, 0);
                    else { const int kvh = ((pn - 16) & 3) * 2 + bj; const int off = ((((row >> 13) * 8 + kvh) * 8192 + (row & 8191)) * 128 + cw) * 2;
                        if (pn < 20) __builtin_amdgcn_raw_buffer_store_b128(w, k, off, 0, 0); else __builtin_amdgcn_raw_buffer_store_b128(w, v, off, 0, 0); } } }
    }
};

struct EpiQKV1 {
    static constexpr bool PERM = true, AFTER_DRAIN = false;
    bf16_t* Q; bf16_t* Kc; bf16_t* Vc; unsigned short* QI; float* KIR; float* WI; RopeTab rt; int pn_off; float scl;
    __device__ __forceinline__ void operator()(const f32x4 (&acc)[2][2][4][2], const Unit& u, int wr, int wc, int fr, int fq) const {
        const int pn = u.pn + pn_off; const int row0 = u.pm * BM + wr * 64 + fr, f0 = 16 * wc + 4 * fq, cw = wc * 32 + 8 * fq;
        const bool rope = (pn < 20) || (pn >= 24 && pn < 40);
#pragma unroll
        for (int ai = 0; ai < 2; ++ai)
#pragma unroll
            for (int m = 0; m < 4; ++m) { const int row = row0 + ai * HALF + m * 16;
                f32x4 c = {1.f, 1.f, 1.f, 1.f}, s = {0.f, 0.f, 0.f, 0.f};
                if (rope) { c = *(const f32x4*)(rt.cs + (size_t)row * 64 + f0); s = *(const f32x4*)(rt.sn + (size_t)row * 64 + f0); }
#pragma unroll
                for (int bj = 0; bj < 2; ++bj) { f32x4 v0 = acc[ai][bj][m][0] * scl, v1 = acc[ai][bj][m][1] * scl;
                    if (pn < 40) {
                        rope_pair(v0, v1, c, s);
                        u32x4 w;
                        if (pn >= 24) { w.x = cvt_pk_f16(v0[0], v0[1]); w.y = cvt_pk_f16(v0[2], v0[3]); w.z = cvt_pk_f16(v1[0], v1[1]); w.w = cvt_pk_f16(v1[2], v1[3]); }
                        else { w.x = cvt_pk_bf16(v0[0], v0[1]); w.y = cvt_pk_bf16(v0[2], v0[3]); w.z = cvt_pk_bf16(v1[0], v1[1]); w.w = cvt_pk_bf16(v1[2], v1[3]); }
                        if (pn < 16) *(u32x4*)(Q + (size_t)row * 4096 + pn * BM + bj * HALF + cw) = w;
                        else if (pn < 24) { const int kvh = ((pn - 16) & 3) * 2 + bj; bf16_t* dst = (pn < 20 ? Kc : Vc) + ((size_t)((row >> 13) * 8 + kvh) * 8192 + (row & 8191)) * 128 + cw; *(u32x4*)dst = w; }
                        else *(u32x4*)(QI + (size_t)row * 4096 + (pn - 24) * BM + bj * HALF + cw) = w;
                    } else {
                        if (bj == 0) { *(f32x4*)(KIR + (size_t)row * 128 + cw) = v0; *(f32x4*)(KIR + (size_t)row * 128 + cw + 4) = v1; }
                        else if (wc == 0) { *(f32x4*)(WI + (size_t)row * 32 + cw) = v0 * 0.015625f; *(f32x4*)(WI + (size_t)row * 32 + cw + 4) = v1 * 0.015625f; }
                    } } }
    }
};

typedef int i32x4_t __attribute__((ext_vector_type(4)));
typedef int i32x8_t __attribute__((ext_vector_type(8)));
__device__ __forceinline__ i32x8_t cat8(bf16x8 a, bf16x8 b) { return __builtin_shufflevector(__builtin_bit_cast(i32x4_t, a), __builtin_bit_cast(i32x4_t, b), 0, 1, 2, 3, 4, 5, 6, 7); }
template <class Epi, class Sched, bool ALIGN_EPI = false, bool SP2 = false, bool FP8 = false, int WSH = 6>
__device__ __forceinline__ void gemm_phase(PG8_LAS unsigned char* lds, const Gemm g, const Sched& S, const Epi& E, const int tid) {
    const int wid = __builtin_amdgcn_readfirstlane(tid >> 6), lane = tid & 63, wr = wid >> 2, wc = wid & 3, fr = lane & 15, fq = lane >> 4;
    const int K = g.K, nt = K / BK;
    unsigned voffA[2], voffB[2];
#pragma unroll
    for (int i = 0; i < 2; ++i) { int R, C; stage_rc(tid * 16 + i * 8192, R, C); const int Rb = Epi::PERM ? ((R & ~31) + perm32(R & 31)) : R;
        voffA[i] = (unsigned)(R * K + C) * 2u; voffB[i] = (unsigned)(Rb * K + C) * 2u; }
    const size_t kstep = (size_t)(BK * 2);
    const size_t hstep = (size_t)HALF * K * 2;
    const size_t tstep = 2 * hstep;
    const unsigned ldsw = (unsigned)wid * 1024u;
    const int aoff = lds_byte(wr * 64 + fr, fq * 8), boff = lds_byte(wc * 32 + fr, fq * 8);
#define PG8_SA(b, h) (((b) * 2 + (h)) * HTB)
#define PG8_SB(b, h) ((4 + (b) * 2 + (h)) * HTB)
#define PG8_STAGE(bufoff, gbase, voff) do { const char* gb_ = (const char*)(gbase); \
        { const unsigned long long gq_ = (unsigned long long)gb_; gb_ = (const char*)(((unsigned long long)(unsigned)__builtin_amdgcn_readfirstlane((int)(gq_ >> 32)) << 32) | (unsigned)__builtin_amdgcn_readfirstlane((int)gq_)); }   \
        _Pragma("unroll") for (int _i = 0; _i < 2; ++_i) \
        __builtin_amdgcn_global_load_lds((const unsigned*)(gb_ + (voff)[_i]), (PG8_LAS unsigned*)(lds + (bufoff) + ldsw + _i * 8192), 16, 0, 0); } while (0)
#define PG8_LDA(dst, b, h) do { _Pragma("unroll") for (int m = 0; m < 4; ++m) { if constexpr (FP8) dst##8[m] = cat8(*(const PG8_LAS bf16x8*)(lds + PG8_SA(b, h) + aoff + m * 2048), *(const PG8_LAS bf16x8*)(lds + PG8_SA(b, h) + aoff + m * 2048 + 1024)); \
        else { _Pragma("unroll") for (int k = 0; k < 2; ++k) dst[m][k] = *(const PG8_LAS bf16x8*)(lds + PG8_SA(b, h) + aoff + m * 2048 + k * 1024); } } } while (0)
#define PG8_LDB(dst, b, h) do { _Pragma("unroll") for (int n = 0; n < 2; ++n) { if constexpr (FP8) dst##8[n] = cat8(*(const PG8_LAS bf16x8*)(lds + PG8_SB(b, h) + boff + n * 2048), *(const PG8_LAS bf16x8*)(lds + PG8_SB(b, h) + boff + n * 2048 + 1024)); \
        else { _Pragma("unroll") for (int k = 0; k < 2; ++k) dst[n][k] = *(const PG8_LAS bf16x8*)(lds + PG8_SB(b, h) + boff + n * 2048 + k * 1024); } } } while (0)
#define PG8_MMA(ai, bj, At, Bt) do { __builtin_amdgcn_s_setprio(1); _Pragma("unroll") for (int m = 0; m < 4; ++m) _Pragma("unroll") for (int n = 0; n < 2; ++n) { \
        if constexpr (FP8) acc[ai][bj][m][n] = __builtin_amdgcn_mfma_scale_f32_16x16x128_f8f6f4(Bt##8[n], At##8[m], acc[ai][bj][m][n], 0, 0, 0, 0x7f7f7f7f, 0, 0x7f7f7f7f); \
        else { _Pragma("unroll") for (int k = 0; k < 2; ++k) acc[ai][bj][m][n] = __builtin_amdgcn_mfma_f32_16x16x32_bf16(Bt[n][k], At[m][k], acc[ai][bj][m][n], 0, 0, 0); } } __builtin_amdgcn_s_setprio(0); } while (0)
#define PG8_WAIT_V(n) asm volatile("s_waitcnt vmcnt(" #n ")" ::: "memory")
#define PG8_WAIT_L(n) asm volatile("s_waitcnt lgkmcnt(" #n ")" ::: "memory")
#define PG8_BAR __builtin_amdgcn_s_barrier()
#define PG8_SCHED __builtin_amdgcn_sched_barrier(0)
    Unit cur, nxt; int ui = 0;
    if (!S.next(0, cur)) return;
    f32x4 acc[2][2][4][2];
#pragma unroll
    for (int a = 0; a < 2; ++a)
#pragma unroll
        for (int b = 0; b < 2; ++b)
#pragma unroll
            for (int m = 0; m < 4; ++m)
#pragma unroll
                for (int n = 0; n < 2; ++n) acc[a][b][m][n] = (f32x4){0.f, 0.f, 0.f, 0.f};
    bf16x8 At[4][2], B0[2][2], B1[2][2]; i32x8_t At8[4], B08[2], B18[2];
    const char* cA = (const char*)g.A + (size_t)cur.pm * tstep; const char* cB = (const char*)g.Bt + (size_t)cur.pn * tstep;
    S.a_ready(cur);
    if constexpr (SP2) {
        PG8_STAGE(PG8_SB(0, 0), cB, voffB); PG8_STAGE(PG8_SB(0, 1), cB + hstep, voffB); PG8_STAGE(PG8_SA(0, 0), cA, voffA); PG8_STAGE(PG8_SA(0, 1), cA + hstep, voffA);
        if (wr == 1) PG8_BAR;
        PG8_WAIT_V(2); PG8_BAR;
        PG8_STAGE(PG8_SB(1, 0), cB + kstep, voffB); PG8_STAGE(PG8_SA(1, 0), cA + kstep, voffA); PG8_STAGE(PG8_SB(1, 1), cB + hstep + kstep, voffB);
        PG8_WAIT_V(6); PG8_BAR;
    } else {
        PG8_STAGE(PG8_SB(0, 0), cB, voffB); PG8_STAGE(PG8_SA(0, 0), cA, voffA); PG8_STAGE(PG8_SB(0, 1), cB + hstep, voffB); PG8_STAGE(PG8_SA(0, 1), cA + hstep, voffA);
        if (wr == 1) PG8_BAR;
        PG8_WAIT_V(4); PG8_BAR;
        PG8_STAGE(PG8_SB(1, 0), cB + kstep, voffB); PG8_STAGE(PG8_SA(1, 0), cA + kstep, voffA); PG8_STAGE(PG8_SB(1, 1), cB + hstep + kstep, voffB);
        PG8_WAIT_V(6); PG8_BAR;
    }
    for (;;) {
        const bool has_next = S.next(ui + 1, nxt);
        const char* nA = has_next ? (const char*)g.A + (size_t)nxt.pm * tstep : cA; const char* nB = has_next ? (const char*)g.Bt + (size_t)nxt.pn * tstep : cB;
        for (int t = 0; t < nt; t += 2) {
            const bool last = (t == nt - 2);
            const char* a1 = cA + (size_t)(t + 1) * kstep;
            const char* a2 = last ? nA : cA + (size_t)(t + 2) * kstep; const char* b2 = last ? nB : cB + (size_t)(t + 2) * kstep;
            const char* a3 = a2 + kstep; const char* b3 = b2 + kstep;
            if (last && has_next) S.a_ready(nxt);
            if constexpr (SP2) {
            PG8_LDB(B0, 0, 0); PG8_LDB(B1, 0, 1); PG8_SCHED; PG8_LDA(At, 0, 0); PG8_STAGE(PG8_SA(1, 1), a1 + hstep, voffA);
            PG8_WAIT_V(8); PG8_WAIT_L(0); PG8_BAR; PG8_MMA(0, 0, At, B0); PG8_MMA(0, 1, At, B1); PG8_BAR; PG8_SCHED;
            PG8_LDA(At, 0, 1); PG8_STAGE(PG8_SB(0, 0), b2, voffB); PG8_STAGE(PG8_SB(0, 1), b2 + hstep, voffB); PG8_STAGE(PG8_SA(0, 0), a2, voffA);
            PG8_WAIT_V(8); PG8_WAIT_L(0); PG8_BAR; PG8_MMA(1, 0, At, B0); PG8_MMA(1, 1, At, B1); PG8_BAR; PG8_SCHED;
            PG8_LDB(B0, 1, 0); PG8_LDB(B1, 1, 1); PG8_SCHED; PG8_LDA(At, 1, 0); PG8_STAGE(PG8_SA(0, 1), a2 + hstep, voffA);
            PG8_WAIT_V(8); PG8_WAIT_L(0); PG8_BAR; PG8_MMA(0, 0, At, B0); PG8_MMA(0, 1, At, B1); PG8_BAR; PG8_SCHED;
            PG8_LDA(At, 1, 1); PG8_STAGE(PG8_SB(1, 0), b3, voffB); PG8_STAGE(PG8_SB(1, 1), b3 + hstep, voffB); PG8_STAGE(PG8_SA(1, 0), a3, voffA);
            PG8_WAIT_V(8); PG8_WAIT_L(0); PG8_BAR; PG8_MMA(1, 0, At, B0); PG8_MMA(1, 1, At, B1); PG8_BAR; PG8_SCHED;
            } else {
            PG8_LDB(B0, 0, 0); PG8_SCHED; PG8_LDA(At, 0, 0); PG8_STAGE(PG8_SA(1, 1), a1 + hstep, voffA);
            PG8_WAIT_L(8); PG8_BAR; PG8_WAIT_L(0); PG8_MMA(0, 0, At, B0); PG8_BAR; PG8_SCHED;
            PG8_LDB(B1, 0, 1); PG8_STAGE(PG8_SB(0, 0), b2, voffB);
            PG8_BAR; PG8_WAIT_L(0); PG8_MMA(0, 1, At, B1); PG8_BAR;
            PG8_LDA(At, 0, 1); PG8_STAGE(PG8_SA(0, 0), a2, voffA);
            PG8_BAR; PG8_WAIT_L(0); PG8_MMA(1, 0, At, B0); PG8_BAR; PG8_SCHED;
            PG8_STAGE(PG8_SB(0, 1), b2 + hstep, voffB);
            PG8_WAIT_V(6); PG8_BAR; PG8_MMA(1, 1, At, B1); PG8_BAR;
            PG8_LDB(B0, 1, 0); PG8_SCHED; PG8_LDA(At, 1, 0); PG8_STAGE(PG8_SA(0, 1), a2 + hstep, voffA);
            PG8_WAIT_L(8); PG8_BAR; PG8_WAIT_L(0); PG8_MMA(0, 0, At, B0); PG8_BAR; PG8_SCHED;
            PG8_LDB(B1, 1, 1); PG8_STAGE(PG8_SB(1, 0), b3, voffB);
            PG8_BAR; PG8_WAIT_L(0); PG8_MMA(0, 1, At, B1); PG8_BAR;
            PG8_LDA(At, 1, 1); PG8_STAGE(PG8_SA(1, 0), a3, voffA);
            PG8_BAR; PG8_WAIT_L(0); PG8_MMA(1, 0, At, B0); PG8_BAR; PG8_SCHED;
            PG8_STAGE(PG8_SB(1, 1), b3 + hstep, voffB);
            PG8_WAIT_V(6); PG8_BAR; PG8_MMA(1, 1, At, B1); PG8_BAR;
            }
        }
        if constexpr (ALIGN_EPI) { if (wr == 0) PG8_BAR; }
        if constexpr (!Epi::AFTER_DRAIN) { { unsigned z_ = 0u; asm volatile("" : "+v"(z_)); const int l2_ = (int)__builtin_amdgcn_mbcnt_hi(~0u, __builtin_amdgcn_mbcnt_lo(~0u, z_)); E(acc, cur, wr, wc, l2_ & 15, l2_ >> 4); } S.done(cur);     }
        if (!has_next) break;
#pragma unroll
        for (int a = 0; a < 2; ++a)
#pragma unroll
            for (int b = 0; b < 2; ++b)
#pragma unroll
                for (int m = 0; m < 4; ++m)
#pragma unroll
                    for (int n = 0; n < 2; ++n) acc[a][b][m][n] = (f32x4){0.f, 0.f, 0.f, 0.f};
        cur = nxt; cA = nA; cB = nB; ++ui;
        if constexpr (ALIGN_EPI) { if (wr == 1) PG8_BAR; }
    }
    PG8_WAIT_V(0);
    if constexpr (!ALIGN_EPI) { if (wr == 0) PG8_BAR; }
    PG8_BAR;
    if constexpr (Epi::AFTER_DRAIN) { E.fused(acc, cur, wr, wc, fr, fq, lds, wid, lane); S.done(cur); }
#undef PG8_SA
#undef PG8_SB
#undef PG8_STAGE
#undef PG8_LDA
#undef PG8_LDB
#undef PG8_MMA
#undef PG8_WAIT_V
#undef PG8_WAIT_L
#undef PG8_BAR
#undef PG8_SCHED
}
}
#define XB_TMO      128
#define XB_XCNT(j)  (256  + 64 * (j))
#define XB_XSUB(j)  (1280 + 64 * (j))
#define XB_XGEN(j)  (2304 + 64 * (j))
#define XB_TOP      3328
#define XB_TOPGEN   3392
#define XCD_BAR_WORDS 3456
#define XB_SPIN_CAP (1u << 18)
#define LAS __attribute__((address_space(3)))

__device__ __forceinline__ unsigned xb_ld(unsigned* p)              { return __hip_atomic_load(p, __ATOMIC_RELAXED, __HIP_MEMORY_SCOPE_AGENT); }
__device__ __forceinline__ unsigned xb_add(unsigned* p, unsigned v) { return __hip_atomic_fetch_add(p, v, __ATOMIC_RELAXED, __HIP_MEMORY_SCOPE_AGENT); }
__device__ __forceinline__ unsigned xb_xcc_id() { return (unsigned)__builtin_amdgcn_s_getreg((3 << 11) | 20) & 0xFu; }
#define XB_SPIN(cond, bar) do { unsigned _sp = 0; while (cond) { __builtin_amdgcn_s_sleep(1); \
    if ((++_sp & 255u) == 0u) { if (xb_ld(&(bar)[XB_TMO])) break; if (_sp > XB_SPIN_CAP) { atomicAdd(&(bar)[XB_TMO], 1u); break; } } } } while (0)

__device__ __forceinline__ bool xb_lane0() { unsigned z = 0u; asm volatile("" : "+v"(z)); return __builtin_amdgcn_mbcnt_hi(~0u, __builtin_amdgcn_mbcnt_lo(~0u, z)) == 0u; }
struct XcdBarrier {
    int wid;
    unsigned* bar; unsigned x;
    volatile LAS unsigned* st;
};

__device__ __forceinline__ XcdBarrier xcd_barrier_post(unsigned* bar, volatile LAS unsigned* st, int wid) {
    XcdBarrier b; b.bar = bar; b.x = xb_xcc_id(); b.st = st; b.wid = wid;
    if (wid == 0 && xb_lane0()) (void)xb_add(&bar[XB_XCNT(b.x)], 1u);
    return b;
}
__device__ __forceinline__ void xcd_barrier_complete(unsigned* bar, unsigned x, unsigned& nloc, unsigned& nx) {
    const unsigned G = gridDim.x * gridDim.y * gridDim.z;
    unsigned sum, cnt, mine, sp = 0u;
    for (;;) {
        sum = 0u; cnt = 0u; mine = 0u;
#pragma unroll
        for (unsigned j = 0; j < 16; ++j) { const unsigned c = xb_ld(&bar[XB_XCNT(j)]); sum += c; cnt += (c > 0u) ? 1u : 0u; mine = (j == x) ? c : mine; }
        if (sum == G) break;
        __builtin_amdgcn_s_sleep(1);
        if ((++sp & 255u) == 0u) { if (xb_ld(&bar[XB_TMO])) break; if (sp > XB_SPIN_CAP) { atomicAdd(&bar[XB_TMO], 1u); break; } }
    }
    nloc = mine > 0u ? mine : 1u; nx = cnt > 0u ? cnt : 1u;
}

__device__ __forceinline__ void xcd_barrier(const XcdBarrier& b) {
    asm volatile("s_waitcnt vmcnt(0)" ::: "memory");
    __syncthreads();
    if (b.wid == 0 && xb_lane0()) {
        unsigned* bar = b.bar;
        __builtin_amdgcn_s_waitcnt(0);
        unsigned nloc = b.st[0], nx = b.st[1];
        if (nloc == 0u) { xcd_barrier_complete(bar, b.x, nloc, nx); b.st[0] = nloc; b.st[1] = nx; }
        const unsigned old = xb_add(&bar[XB_XSUB(b.x)], 1u);
        const unsigned gen = old / nloc;
        if (old + 1u == (gen + 1u) * nloc) {
            __builtin_amdgcn_fence(__ATOMIC_RELEASE, "agent");
            asm volatile("s_waitcnt vmcnt(0)" ::: "memory");
            const unsigned og = xb_add(&bar[XB_TOP], 1u);
            const unsigned tg = og / nx;
            if (og + 1u == (tg + 1u) * nx) xb_add(&bar[XB_TOPGEN], 1u);
            else XB_SPIN(xb_ld(&bar[XB_TOPGEN]) == tg, bar);
            __builtin_amdgcn_fence(__ATOMIC_ACQUIRE, "agent");
            xb_add(&bar[XB_XGEN(b.x)], 1u);
            asm volatile("s_waitcnt vmcnt(0)" ::: "memory");
        } else {
            XB_SPIN(xb_ld(&bar[XB_XGEN(b.x)]) == gen, bar);
            __builtin_amdgcn_fence(__ATOMIC_ACQUIRE, "agent");
            asm volatile("s_waitcnt vmcnt(0)" ::: "memory");
        }
    }
    __syncthreads();
}


using pg8::bf16_t; using pg8::bf16x8; using pg8::f32x4; using pg8::u32x4;
typedef _Float16 f16x8 __attribute__((ext_vector_type(8)));
typedef float f32x16 __attribute__((ext_vector_type(16)));
typedef unsigned u32x2 __attribute__((ext_vector_type(2)));
#define DI __device__ __forceinline__

constexpr int NWAVES = 8, NTHR = 512;
constexpr int SEQ = 8192, MTOK = 16384, DM = 4096, DFF = 11008;
constexpr int N_A = 18432, N_B = 10400, N_BP = 10496;
constexpr float LN_EPS = 1e-5f;
constexpr float ALPHA = 1.41421356237309515f;
constexpr float SM_C = 0.08838834764831845f * 1.4426950408889634f;
constexpr float SM_SCALE = 0.08838834764831845f;

constexpr size_t MiB = (size_t)1 << 20;
constexpr size_t WS_CTL = 0, CTL_ZERO_BYTES = 16384;
constexpr size_t WS_COS = 1 * MiB, WS_SIN = 5 * MiB;
constexpr size_t WS_W = 9 * MiB;
constexpr size_t W0IN = WS_W, W0OUT = WS_W + 144 * MiB, W0GU = WS_W + 160 * MiB, W0DN = WS_W + 332 * MiB;
constexpr size_t W1IN = WS_W, W1INB = WS_W + 24 * MiB, W1OUT = WS_W + 82 * MiB, W1GU = WS_W + 114 * MiB, W1DN = WS_W + 286 * MiB;
constexpr size_t WS_XB = 427 * MiB, WS_XA = 555 * MiB, WS_BIG = 811 * MiB, WS_XB8 = (811 + 835) * MiB, WS_END = (811 + 835 + 64) * MiB;
constexpr size_t B_QKV0 = WS_BIG, B_OG = WS_BIG + 576 * MiB, B_LSE = WS_BIG + 768 * MiB, B_AO0 = WS_BIG + 771 * MiB;
constexpr size_t B_Y = WS_BIG + 360 * MiB, B_H = WS_BIG;
constexpr size_t B_Q1 = WS_BIG, B_K1 = WS_BIG + 128 * MiB, B_V1 = WS_BIG + 160 * MiB, B_QI = WS_BIG + 192 * MiB, B_KIR = WS_BIG + 320 * MiB, B_KI16 = WS_BIG + 328 * MiB,
                 B_WI = WS_BIG + 332 * MiB, B_SC = WS_BIG + 334 * MiB, B_IDX = WS_BIG + 594 * MiB, B_AO1 = WS_BIG + 640 * MiB;
constexpr int LDS_BYTES = 147456, MISC_OFF = 147456 - 64;

DI int fresh_tid(int wid) { unsigned z = 0u; asm volatile("" : "+v"(z)); return (wid << 6) | (int)__builtin_amdgcn_mbcnt_hi(~0u, __builtin_amdgcn_mbcnt_lo(~0u, z)); }
DI bf16x8 fp8x8_to_bf16(u32x2 w) {
    typedef float f32x2_t __attribute__((ext_vector_type(2)));
    const f32x2_t a = __builtin_amdgcn_cvt_pk_f32_fp8((int)w.x, false), b = __builtin_amdgcn_cvt_pk_f32_fp8((int)w.x, true), c = __builtin_amdgcn_cvt_pk_f32_fp8((int)w.y, false), d = __builtin_amdgcn_cvt_pk_f32_fp8((int)w.y, true);
    u32x4 o; o.x = pg8::cvt_pk_bf16(a.x, a.y); o.y = pg8::cvt_pk_bf16(b.x, b.y); o.z = pg8::cvt_pk_bf16(c.x, c.y); o.w = pg8::cvt_pk_bf16(d.x, d.y);
    return __builtin_bit_cast(bf16x8, o);
}
DI float wave_sum(float v) { v += __shfl_xor(v, 1); v += __shfl_xor(v, 2); v += __shfl_xor(v, 4); v += __shfl_xor(v, 8); v += __shfl_xor(v, 16); v += __shfl_xor(v, 32); return v; }
DI int sigma_inv(int d) { return 32 * ((d >> 4) & 3) + 8 * ((d >> 2) & 3) + 4 * (d >> 6) + (d & 3); }

struct MapId { DI long operator()(int c) const { return c; } };
struct MapA  { DI long operator()(int c) const { const int d = c & 127; return (c < 2 * 6144) ? (long)(c - d + sigma_inv(d)) : (long)c; } };
struct MapB  { DI long operator()(int c) const { const int d = c & 127; const bool rp = (c < 5120) || (c >= 6144 && c < 10240); return rp ? (long)(c - d + sigma_inv(d)) : (long)c; } };
struct MapB2 { DI long operator()(int c) const { return MapB{}(c + 6144) - 6144; } };
struct MapGU { int up; DI long operator()(int c) const { return (long)((c >> 7) * 256 + up * 128 + (c & 127)); } };

DI void wt_load(const float* __restrict__ W, int N, int nct, int item, f32x4 (&v)[8], int tid, int pitch) {
    const int kt = item / nct, ct = item - kt * nct; const int k0 = kt * 64, c0 = ct * 256; const int cq = tid & 63, kr0 = tid >> 6; const bool cok = (c0 + 4 * cq) < N;
#pragma unroll
    for (int i = 0; i < 8; ++i) v[i] = cok ? *(const f32x4*)(W + (size_t)(k0 + kr0 + 8 * i) * pitch + c0 + 4 * cq) : (f32x4){0.f, 0.f, 0.f, 0.f};
}
template <class Map>
DI void wt_store(int K, int N, int nct, bf16_t* __restrict__ WT, int item, const Map map, const f32x4 (&v)[8], LAS float* scr, int tid) {
    const int kt = item / nct, ct = item - kt * nct; const int k0 = kt * 64, c0 = ct * 256; const int cq = tid & 63, kr0 = tid >> 6;
    __syncthreads();
#pragma unroll
    for (int i = 0; i < 8; ++i) { const int k = kr0 + 8 * i; *(LAS f32x4*)(scr + k * 260 + 4 * (cq ^ ((k >> 3) & 7))) = v[i]; }
    __syncthreads();
#pragma unroll
    for (int i = 0; i < 4; ++i) { const int pc = tid + 512 * i; const int c = pc >> 3, j = pc & 7;
        if (c0 + c < N) { float f[8];
#pragma unroll
            for (int e = 0; e < 8; ++e) f[e] = scr[(8 * j + e) * 260 + 4 * ((c >> 2) ^ j) + (c & 3)];
            u32x4 o; o.x = pg8::cvt_pk_bf16(f[0], f[1]); o.y = pg8::cvt_pk_bf16(f[2], f[3]); o.z = pg8::cvt_pk_bf16(f[4], f[5]); o.w = pg8::cvt_pk_bf16(f[6], f[7]);
            *(u32x4*)(WT + (size_t)map(c0 + c) * K + k0 + 8 * j) = o; } }
}
template <class Map>
DI void wt_store8(int K, int N, int nct, unsigned char* __restrict__ WT8, int item, const Map map, const f32x4 (&v)[8], LAS float* scr, int tid, float wscale) {
    const int kt = item / nct, ct = item - kt * nct; const int k0 = kt * 64, c0 = ct * 256; const int cq = tid & 63, kr0 = tid >> 6;
    __syncthreads();
#pragma unroll
    for (int i = 0; i < 8; ++i) { const int k = kr0 + 8 * i; *(LAS f32x4*)(scr + k * 260 + 4 * (cq ^ ((k >> 3) & 7))) = v[i]; }
    __syncthreads();
#pragma unroll
    for (int i = 0; i < 4; ++i) { const int pc = tid + 512 * i; const int c = pc >> 3, j = pc & 7;
        if (c0 + c < N) { float f[8];
#pragma unroll
            for (int e = 0; e < 8; ++e) f[e] = scr[(8 * j + e) * 260 + 4 * ((c >> 2) ^ j) + (c & 3)] * wscale;
            int w0 = __builtin_amdgcn_cvt_pk_fp8_f32(f[0], f[1], 0, false); w0 = __builtin_amdgcn_cvt_pk_fp8_f32(f[2], f[3], w0, true);
            int w1 = __builtin_amdgcn_cvt_pk_fp8_f32(f[4], f[5], 0, false); w1 = __builtin_amdgcn_cvt_pk_fp8_f32(f[6], f[7], w1, true);
            typedef int i32x2_t __attribute__((ext_vector_type(2)));
            *(i32x2_t*)(WT8 + (size_t)map(c0 + c) * K + k0 + 8 * j) = (i32x2_t){w0, w1}; } }
}
template <class Map>
DI void wt_matrix8(const float* W, int K, int N, unsigned char* WT8, const Map map, LAS float* scr, int tid, int bid, int G, float wscale, int pitch0 = 0) {
    const int nct = (N + 255) >> 8, nitems = (K >> 6) * nct, pitch = pitch0 ? pitch0 : N;
    f32x4 va[8], vb[8];
    int it = bid;
    if (it < nitems) wt_load(W, N, nct, it, va, tid, pitch);
    for (; it < nitems; it += 2 * G) {
        if (it + G < nitems) wt_load(W, N, nct, it + G, vb, tid, pitch);
        wt_store8(K, N, nct, WT8, it, map, va, scr, tid, wscale);
        if (it + G >= nitems) break;
        if (it + 2 * G < nitems) wt_load(W, N, nct, it + 2 * G, va, tid, pitch);
        wt_store8(K, N, nct, WT8, it + G, map, vb, scr, tid, wscale);
    }
}
template <class Map>
DI void wt_matrix(const float* W, int K, int N, bf16_t* WT, const Map map, LAS float* scr, int tid, int bid, int G, int pitch0 = 0) {
    const int nct = (N + 255) >> 8, nitems = (K >> 6) * nct, pitch = pitch0 ? pitch0 : N;
    f32x4 va[8], vb[8];
    int it = bid;
    if (it < nitems) wt_load(W, N, nct, it, va, tid, pitch);
    for (; it < nitems; it += 2 * G) {
        if (it + G < nitems) wt_load(W, N, nct, it + G, vb, tid, pitch);
        wt_store(K, N, nct, WT, it, map, va, scr, tid);
        if (it + G >= nitems) break;
        if (it + 2 * G < nitems) wt_load(W, N, nct, it + 2 * G, va, tid, pitch);
        wt_store(K, N, nct, WT, it + G, map, vb, scr, tid);
    }
}

DI void rope_sincos(int pos, int f, float& cs, float& sn) {
    const double r1 = 0.8659643233600653; double inv = 1.0, rp = r1;
#pragma unroll
    for (int b = 0; b < 6; ++b) { if ((f >> b) & 1) inv *= rp; rp *= rp; }
    const double ang = (double)pos * inv;
    const double q = __builtin_rint(ang * 0.63661977236758134308);
    double r = __builtin_fma(-q, 1.57079632679489655800e+00, ang); r = __builtin_fma(-q, 6.12323399573676603587e-17, r);
    const double z = r * r;
    const double ps = r + r * z * (-1.66666666666666324348e-01 + z * (8.33333333332248946124e-03 + z * (-1.98412698298579493134e-04 + z * (2.75573137070700676789e-06 + z * (-2.50507602534068634195e-08 + z * 1.58969099521155010221e-10)))));
    const double pc = 1.0 - 0.5 * z + z * z * (4.16666666666666019037e-02 + z * (-1.38888888888741095749e-03 + z * (2.48015872894767294178e-05 + z * (-2.75573143513906633035e-07 + z * (2.08757232129817482790e-09 + z * -1.13596475577881948265e-11)))));
    const int qi = ((int)(long long)q) & 3;
    const double s = (qi == 0) ? ps : (qi == 1) ? pc : (qi == 2) ? -ps : -pc;
    const double c = (qi == 0) ? pc : (qi == 1) ? -ps : (qi == 2) ? -pc : ps;
    cs = (float)c; sn = (float)s;
}

DI void cvt_x_phase(const float* X, bf16_t* XB, int tid, int bid, int G) {
    const size_t n8 = (size_t)MTOK * DM / 8;
    for (size_t i = (size_t)bid * NTHR + tid; i < n8; i += (size_t)G * NTHR) {
        const f32x4 a = *(const f32x4*)(X + i * 8), b = *(const f32x4*)(X + i * 8 + 4);
        u32x4 o; o.x = pg8::cvt_pk_bf16(a[0], a[1]); o.y = pg8::cvt_pk_bf16(a[2], a[3]); o.z = pg8::cvt_pk_bf16(b[0], b[1]); o.w = pg8::cvt_pk_bf16(b[2], b[3]);
        *(u32x4*)(XB + i * 8) = o; }
}
DI void cvt_x8_phase(const float* X, unsigned char* XB8, int tid, int bid, int G) {
    const size_t n4 = (size_t)MTOK * DM / 4, S = (size_t)G * NTHR;
    for (size_t i = (size_t)bid * NTHR + tid; i < n4; i += 4 * S) { f32x4 a[4];
#pragma unroll
        for (int q = 0; q < 4; ++q) if (i + q * S < n4) a[q] = *(const f32x4*)(X + (i + q * S) * 4);
#pragma unroll
        for (int q = 0; q < 4; ++q) if (i + q * S < n4) { int t = __builtin_amdgcn_cvt_pk_fp8_f32(a[q][0], a[q][1], 0, false); t = __builtin_amdgcn_cvt_pk_fp8_f32(a[q][2], a[q][3], t, true); *(int*)(XB8 + (i + q * S) * 4) = t; } }
}
DI void rope_tab_phase(const int* pos, float* CS, float* SN, int tid, int bid, int G) {
    for (int e = bid * NTHR + tid; e < MTOK * 64; e += G * NTHR) { float c, s; rope_sincos(pos[e >> 6], e & 63, c, s); CS[e] = c; SN[e] = s; }
}

typedef unsigned short half_t;
DI void ln_phase(const half_t* Y, const float* gain, const float* bias, float* Xo, half_t* XHo, bf16_t* XBo, int tid, int bid, int G, unsigned char* XB8o = nullptr) {
    const int lane = tid & 63, gw = bid * NWAVES + (tid >> 6), nw = G * NWAVES;
    u32x4 raw[8];
    if (gw < MTOK) {
#pragma unroll
        for (int j = 0; j < 8; ++j) raw[j] = *(const u32x4*)(Y + (size_t)gw * DM + (j * 64 + lane) * 8); }
#pragma unroll 1
    for (int row = gw; row < MTOK; row += nw) {
        f32x4 v[16]; float s = 0.f;
#pragma unroll
        for (int j = 0; j < 8; ++j) {
            v[2 * j] = pg8::f16x4_to_f32((pg8::u32x2e_t){raw[j].x, raw[j].y}); v[2 * j + 1] = pg8::f16x4_to_f32((pg8::u32x2e_t){raw[j].z, raw[j].w});
            s += ((v[2 * j][0] + v[2 * j][1]) + (v[2 * j][2] + v[2 * j][3])) + ((v[2 * j + 1][0] + v[2 * j + 1][1]) + (v[2 * j + 1][2] + v[2 * j + 1][3])); }
        if (row + nw < MTOK) {
#pragma unroll
            for (int j = 0; j < 8; ++j) raw[j] = *(const u32x4*)(Y + (size_t)(row + nw) * DM + (j * 64 + lane) * 8); }
        const float mean = wave_sum(s) * (1.0f / DM); float q = 0.f;
#pragma unroll
        for (int j = 0; j < 16; ++j) { v[j] = v[j] - mean; q += (v[j][0] * v[j][0] + v[j][1] * v[j][1]) + (v[j][2] * v[j][2] + v[j][3] * v[j][3]); }
        const float rstd = 1.0f / sqrtf(wave_sum(q) * (1.0f / DM) + LN_EPS);
#pragma unroll
        for (int j = 0; j < 8; ++j) { const int c = (j * 64 + lane) * 8;
            const f32x4 o0 = v[2 * j] * rstd * *(const f32x4*)(gain + c) + *(const f32x4*)(bias + c), o1 = v[2 * j + 1] * rstd * *(const f32x4*)(gain + c + 4) + *(const f32x4*)(bias + c + 4);
            if (Xo) { *(f32x4*)(Xo + (size_t)row * DM + c) = o0; *(f32x4*)(Xo + (size_t)row * DM + c + 4) = o1; }
            if (XHo) { u32x4 w; w.x = pg8::cvt_pk_f16(o0[0], o0[1]); w.y = pg8::cvt_pk_f16(o0[2], o0[3]); w.z = pg8::cvt_pk_f16(o1[0], o1[1]); w.w = pg8::cvt_pk_f16(o1[2], o1[3]); *(u32x4*)(XHo + (size_t)row * DM + c) = w; }
            if (XBo) { u32x4 w; w.x = pg8::cvt_pk_bf16(o0[0], o0[1]); w.y = pg8::cvt_pk_bf16(o0[2], o0[3]); w.z = pg8::cvt_pk_bf16(o1[0], o1[1]); w.w = pg8::cvt_pk_bf16(o1[2], o1[3]); *(u32x4*)(XBo + (size_t)row * DM + c) = w; }
            if (XB8o) { int q0 = __builtin_amdgcn_cvt_pk_fp8_f32(o0[0], o0[1], 0, false); q0 = __builtin_amdgcn_cvt_pk_fp8_f32(o0[2], o0[3], q0, true);
                int q1 = __builtin_amdgcn_cvt_pk_fp8_f32(o1[0], o1[1], 0, false); q1 = __builtin_amdgcn_cvt_pk_fp8_f32(o1[2], o1[3], q1, true); *(u32x2*)(XB8o + (size_t)row * DM + c) = (u32x2){(unsigned)q0, (unsigned)q1}; } }
    }
}

DI bf16x8 ldg_bf16x8(const bf16_t* p) { return *(const bf16x8*)p; }
typedef short s16x4 __attribute__((ext_vector_type(4)));
struct A0Unit { int h, b, grp, d, r, nb; };
DI A0Unit a0_decode(int u) { A0Unit x; x.h = u & 15; const int blk = (u >> 4) & 63; x.b = (u >> 10) & 1; x.grp = u >> 11; const int dsh = 2 * x.grp; x.d = 1 << dsh; x.r = blk >> (6 - dsh); x.nb = blk & ((64 >> dsh) - 1); return x; }
DI size_t a0_sub(int sq, const A0Unit& x) { return ((size_t)(((sq * 3 + x.grp) * 2 + x.b) * 16 + x.h) * 8192 + (size_t)x.r * (8192 >> (2 * x.grp))) * 128; }
DI void a0_load_kv(const unsigned char* QKV, const A0Unit& x, u32x4 (&kpre)[4], u32x4 (&vpre)[4], int tid) {
    const unsigned char* Kg = QKV + a0_sub(1, x) + (tid & 7) * 16; const unsigned char* Vg = QKV + a0_sub(2, x) + (tid & 7) * 16;
#pragma unroll
    for (int i = 0; i < 4; ++i) { const int l = (x.nb - 1) * 128 + (tid >> 3) + 64 * i;
        kpre[i] = (l >= 0) ? *(const u32x4*)(Kg + (ptrdiff_t)l * 128) : (u32x4){0u, 0u, 0u, 0u};
        vpre[i] = (l >= 0) ? *(const u32x4*)(Vg + (ptrdiff_t)l * 128) : (u32x4){0u, 0u, 0u, 0u}; }
}
DI void a0_load_q(const unsigned char* QKV, const A0Unit& x, bf16x8 (&qf)[4], int w, int n, int g4) {
    const unsigned char* qp = QKV + a0_sub(0, x) + (size_t)(x.nb * 128 + 16 * w + n) * 128 + 8 * g4;
#pragma unroll
    for (int ks = 0; ks < 4; ++ks) qf[ks] = fp8x8_to_bf16(*(const u32x2*)(qp + 32 * ks));
}
DI void attn0_phase(const unsigned char* QKV, bf16_t* OG, float* LSE, LAS unsigned char* lds, int tid, int bid, int G) {
    const int lane = tid & 63, w = __builtin_amdgcn_readfirstlane(tid >> 6), n = lane & 15, g4 = lane >> 4, q4 = n >> 2, p4 = n & 3;
    LAS unsigned char* kimg = lds; LAS unsigned char* vt = lds + 65536;
    const size_t GS = (size_t)MTOK * 2048;
    const int tr_base = (4 * g4 + q4) * 256 + 8 * (p4 & 1);
    const int skey = tid >> 3, sj = tid & 7;
    LAS unsigned char* kwr0 = kimg + skey * 256 + (((2 * sj) ^ (skey & 15)) * 16); LAS unsigned char* kwr1 = kimg + skey * 256 + (((2 * sj + 1) ^ (skey & 15)) * 16);
    LAS unsigned char* vwr0 = vt + skey * 256 + (((2 * sj) ^ (2 * (skey & 3))) * 16); LAS unsigned char* vwr1 = vt + skey * 256 + (((2 * sj + 1) ^ (2 * (skey & 3))) * 16);
    LAS unsigned char* krb[4];
#pragma unroll
    for (int j = 0; j < 4; ++j) krb[j] = kimg + (16 * w + n) * 256 + (((4 * j + g4) ^ n) * 16);
    u32x4 kpre[4], vpre[4]; bf16x8 qf[4];
    int u = bid;
    if (u < 6144) { const A0Unit x = a0_decode(u); a0_load_kv(QKV, x, kpre, vpre, tid); a0_load_q(QKV, x, qf, w, n, g4); }
    for (; u < 6144; u += G) {
        const A0Unit x = a0_decode(u);
        const int h = x.h, d = x.d, nb = x.nb, grp = x.grp;
        const size_t tok0 = (size_t)x.b * SEQ + x.r;
        const int iq = 16 * w + n, lq = nb * 128 + iq;
        const size_t qtok = tok0 + (size_t)lq * d;
        __syncthreads();
#pragma unroll
        for (int i = 0; i < 4; ++i) {
            *(LAS bf16x8*)(kwr0 + i * 16384) = fp8x8_to_bf16((u32x2){kpre[i].x, kpre[i].y}); *(LAS bf16x8*)(kwr1 + i * 16384) = fp8x8_to_bf16((u32x2){kpre[i].z, kpre[i].w});
            *(LAS bf16x8*)(vwr0 + i * 16384) = fp8x8_to_bf16((u32x2){vpre[i].x, vpre[i].y}); *(LAS bf16x8*)(vwr1 + i * 16384) = fp8x8_to_bf16((u32x2){vpre[i].z, vpre[i].w}); }
        __syncthreads();
        if (u + G < 6144) { const A0Unit xn = a0_decode(u + G); a0_load_kv(QKV, xn, kpre, vpre, tid); }
        f32x4 s[9];
#pragma unroll
        for (int tt = 0; tt < 9; ++tt) { f32x4 a = {0.f, 0.f, 0.f, 0.f};
#pragma unroll
            for (int ks = 0; ks < 4; ++ks) a = __builtin_amdgcn_mfma_f32_16x16x32_bf16(*(const LAS bf16x8*)(krb[ks] + tt * 4096), qf[ks], a, 0, 0, 0);
            s[tt] = a; }
        if (u + G < 6144) { const A0Unit xn = a0_decode(u + G); a0_load_q(QKV, xn, qf, w, n, g4); }
        float mx = -__builtin_inff();
#pragma unroll
        for (int tt = 0; tt < 9; ++tt)
#pragma unroll
            for (int j = 0; j < 4; ++j) { const int kf = 16 * (w + tt) + 4 * g4 + j; const bool ok = (kf >= iq) && (kf <= iq + 128) && (nb > 0 || kf >= 128);
                const float xx = ok ? s[tt][j] : -__builtin_inff(); s[tt][j] = xx; mx = fmaxf(mx, xx); }
        mx = fmaxf(mx, __shfl_xor(mx, 16)); mx = fmaxf(mx, __shfl_xor(mx, 32));
        const float msc = mx * SM_C; float lsum = 0.f;
#pragma unroll
        for (int tt = 0; tt < 9; ++tt)
#pragma unroll
            for (int j = 0; j < 4; ++j) { const float p = __builtin_amdgcn_exp2f(s[tt][j] * SM_C - msc); s[tt][j] = p; lsum += p; }
        lsum += __shfl_xor(lsum, 16); lsum += __shfl_xor(lsum, 32);
        f32x4 o[8];
#pragma unroll
        for (int dt = 0; dt < 8; ++dt) o[dt] = (f32x4){0.f, 0.f, 0.f, 0.f};
#pragma unroll
        for (int kk = 0; kk < 5; ++kk) {
            const int t0 = 2 * kk, t1 = 2 * kk + 1;
            u32x4 pw; pw.x = pg8::cvt_pk_bf16(s[t0][0], s[t0][1]); pw.y = pg8::cvt_pk_bf16(s[t0][2], s[t0][3]);
            if (t1 < 9) { pw.z = pg8::cvt_pk_bf16(s[t1 < 9 ? t1 : 8][0], s[t1 < 9 ? t1 : 8][1]); pw.w = pg8::cvt_pk_bf16(s[t1 < 9 ? t1 : 8][2], s[t1 < 9 ? t1 : 8][3]); } else { pw.z = 0u; pw.w = 0u; }
            const bf16x8 pf = __builtin_bit_cast(bf16x8, pw);
            int T1 = w + t1; T1 = T1 > 15 ? 15 : T1;
            const int row0 = 16 * (w + t0) * 256, row1 = 16 * T1 * 256;
#pragma unroll
            for (int dt = 0; dt < 8; ++dt) {
                const int choff = ((2 * dt + (p4 >> 1)) ^ (2 * q4)) * 16;
                const s16x4 lo = __builtin_amdgcn_ds_read_tr16_b64_v4i16((LAS s16x4*)(vt + tr_base + row0 + choff));
                const s16x4 hi = __builtin_amdgcn_ds_read_tr16_b64_v4i16((LAS s16x4*)(vt + tr_base + row1 + choff));
                const bf16x8 vf = __builtin_shufflevector(lo, hi, 0, 1, 2, 3, 4, 5, 6, 7);
                o[dt] = __builtin_amdgcn_mfma_f32_16x16x32_bf16(vf, pf, o[dt], 0, 0, 0); }
        }
        const float inv = 1.0f / lsum;
        bf16_t* op = OG + (size_t)grp * GS + qtok * 2048 + h * 128 + 4 * g4;
#pragma unroll
        for (int dt = 0; dt < 8; ++dt) { u32x2 wv; wv.x = pg8::cvt_pk_bf16(o[dt][0] * inv, o[dt][1] * inv); wv.y = pg8::cvt_pk_bf16(o[dt][2] * inv, o[dt][3] * inv); *(u32x2*)(op + 16 * dt) = wv; }
        if (g4 == 0) LSE[(size_t)grp * (MTOK * 16) + qtok * 16 + h] = mx * SM_SCALE + __logf(lsum);
    }
}

DI void merge_phase(const bf16_t* OG, const float* LSE, unsigned char* AO8, int tid, int bid, int G) {
    const int lane = tid & 63, gw = bid * NWAVES + (tid >> 6), nw = G * NWAVES; const size_t GS = (size_t)MTOK * 2048;
    for (int tok = gw; tok < MTOK; tok += nw) {
#pragma unroll
        for (int it = 0; it < 4; ++it) { const int e = it * 512 + lane * 8, h = e >> 7;
            const float l0 = LSE[(size_t)tok * 16 + h], l1 = LSE[(size_t)(MTOK * 16) + (size_t)tok * 16 + h], l2 = LSE[(size_t)(2 * MTOK * 16) + (size_t)tok * 16 + h];
            const float mx = fmaxf(l0, fmaxf(l1, l2)); const float e0 = __expf(l0 - mx), e1 = __expf(l1 - mx), e2 = __expf(l2 - mx); const float inv = 1.0f / (e0 + e1 + e2);
            const float w0 = e0 * inv, w1 = e1 * inv, w2 = e2 * inv;
            const u32x4 a = *(const u32x4*)(OG + (size_t)tok * 2048 + e), b = *(const u32x4*)(OG + GS + (size_t)tok * 2048 + e), c = *(const u32x4*)(OG + 2 * GS + (size_t)tok * 2048 + e);
            float v[8];
#pragma unroll
            for (int k = 0; k < 4; ++k) { v[2 * k] = 16.0f * (w0 * __uint_as_float(a[k] << 16) + w1 * __uint_as_float(b[k] << 16) + w2 * __uint_as_float(c[k] << 16));
                v[2 * k + 1] = 16.0f * (w0 * __uint_as_float(a[k] & 0xffff0000u) + w1 * __uint_as_float(b[k] & 0xffff0000u) + w2 * __uint_as_float(c[k] & 0xffff0000u)); }
            int q0 = __builtin_amdgcn_cvt_pk_fp8_f32(v[0], v[1], 0, false); q0 = __builtin_amdgcn_cvt_pk_fp8_f32(v[2], v[3], q0, true);
            int q1 = __builtin_amdgcn_cvt_pk_fp8_f32(v[4], v[5], 0, false); q1 = __builtin_amdgcn_cvt_pk_fp8_f32(v[6], v[7], q1, true);
            *(u32x2*)(AO8 + (size_t)tok * 2048 + e) = (u32x2){(unsigned)q0, (unsigned)q1}; }
    }
}

DI void kidx_phase(const float* KIR, const float* gain, const float* bias, const float* CS, const float* SN, unsigned short* KI16, int tid, int bid, int G) {
    const int lane = tid & 63, gw = bid * NWAVES + (tid >> 6), nw = G * NWAVES;
    const float g1 = gain[lane], g2 = gain[lane + 64], b1 = bias[lane], b2 = bias[lane + 64];
    const int j1 = sigma_inv(lane);
    for (int tok = gw; tok < MTOK; tok += nw) {
        const float x1 = KIR[(size_t)tok * 128 + lane], x2 = KIR[(size_t)tok * 128 + 64 + lane];
        const float mean = wave_sum(x1 + x2) * (1.0f / 128.0f); const float d1 = x1 - mean, d2 = x2 - mean;
        const float rstd = 1.0f / sqrtf(wave_sum(d1 * d1 + d2 * d2) * (1.0f / 128.0f) + LN_EPS);
        const float y1 = d1 * rstd * g1 + b1, y2 = d2 * rstd * g2 + b2;
        const float c = CS[(size_t)tok * 64 + lane], s = SN[(size_t)tok * 64 + lane];
        const _Float16 o1 = (_Float16)(y1 * c - y2 * s), o2 = (_Float16)(y2 * c + y1 * s);
        KI16[(size_t)tok * 128 + j1] = __builtin_bit_cast(unsigned short, o1); KI16[(size_t)tok * 128 + j1 + 4] = __builtin_bit_cast(unsigned short, o2);
    }
}

constexpr int KT_ROWB = 272, KT_BYTES = 64 * KT_ROWB;
DI size_t sc_row_off(int b, int s) { const int qb = s >> 7; return ((size_t)(b * 2080 + ((qb * (qb + 1)) >> 1))) * 16384 + (size_t)(s & 127) * ((qb + 1) * 128); }
DI float relu1(float x) { const int b = __builtin_bit_cast(int, x); return __builtin_bit_cast(float, b > 0 ? b : 0); }
DI void indexer_tile(const LAS unsigned char* buf, const f16x8 (&af)[2][8], const f32x4 (&wv)[2][4], float* sc0, float* sc1, int kt, int r32, int h2) {
    typedef float f32x2_t __attribute__((ext_vector_type(2)));
    f16x8 bfr[2][8];
#pragma unroll
    for (int sub = 0; sub < 2; ++sub)
#pragma unroll
        for (int ks = 0; ks < 8; ++ks) bfr[sub][ks] = *(const LAS f16x8*)(buf + (32 * sub + r32) * KT_ROWB + (16 * ks + 8 * h2) * 2);
    __builtin_amdgcn_sched_barrier(0);
#pragma unroll
    for (int sub = 0; sub < 2; ++sub) {
        f32x16 c0, c1;
#pragma unroll
        for (int i = 0; i < 16; ++i) { c0[i] = 0.f; c1[i] = 0.f; }
#pragma unroll
        for (int ks = 0; ks < 8; ++ks) { c0 = __builtin_amdgcn_mfma_f32_32x32x16_f16(af[0][ks], bfr[sub][ks], c0, 0, 0, 0); c1 = __builtin_amdgcn_mfma_f32_32x32x16_f16(af[1][ks], bfr[sub][ks], c1, 0, 0, 0); }
        f32x2_t a0 = {0.f, 0.f}, a1 = {0.f, 0.f};
#pragma unroll
        for (int q = 0; q < 4; ++q)
#pragma unroll
            for (int e = 0; e < 4; e += 2) {
                const f32x2_t r0 = {relu1(c0[4 * q + e]), relu1(c0[4 * q + e + 1])};
                const f32x2_t r1 = {relu1(c1[4 * q + e]), relu1(c1[4 * q + e + 1])};
                const f32x2_t w0 = {wv[0][q][e], wv[0][q][e + 1]}, w1 = {wv[1][q][e], wv[1][q][e + 1]};
                a0 = __builtin_elementwise_fma(r0, w0, a0); a1 = __builtin_elementwise_fma(r1, w1, a1); }
        float s0 = a0.x + a0.y, s1 = a1.x + a1.y;
        s0 += __shfl_xor(s0, 32); s1 += __shfl_xor(s1, 32);
        if (h2 == 0) { sc0[kt * 64 + 32 * sub + r32] = s0; sc1[kt * 64 + 32 * sub + r32] = s1; }
    }
}
DI void indexer_phase(const unsigned short* QI, const unsigned short* KI16, const float* WI, float* SC, LAS unsigned char* lds, int tid, int bid, int G) {
    const int lane = tid & 63, w = __builtin_amdgcn_readfirstlane(tid >> 6), r32 = lane & 31, h2 = lane >> 5;
    LAS unsigned char* buf0 = lds; LAS unsigned char* buf1 = lds + KT_BYTES;
    const int key0 = tid >> 4, ch = tid & 15;
    for (int v = bid; v < 256; v += G) {
        for (int it = 0; it < 4; ++it) {
            const int b = it >> 1, gi = (it & 1) ? (511 - v) : v; const int tb = 16 * gi;
            const int nt = ((tb + 15) >> 6) + 1;
            f16x8 af[2][8]; f32x4 wv[2][4];
#pragma unroll
            for (int tq = 0; tq < 2; ++tq) { const size_t tg = (size_t)b * SEQ + tb + 2 * w + tq;
#pragma unroll
                for (int ks = 0; ks < 8; ++ks) af[tq][ks] = *(const f16x8*)(QI + tg * 4096 + r32 * 128 + 16 * ks + 8 * h2);
#pragma unroll
                for (int q = 0; q < 4; ++q) wv[tq][q] = *(const f32x4*)(WI + tg * 32 + 8 * q + 4 * h2); }
            float* sc0 = SC + sc_row_off(b, tb + 2 * w); float* sc1 = SC + sc_row_off(b, tb + 2 * w + 1);
            const unsigned short* src = KI16 + (size_t)b * SEQ * 128 + (size_t)key0 * 128 + ch * 8;
            u32x4 a0, a1, b0 = {0u, 0u, 0u, 0u}, b1 = {0u, 0u, 0u, 0u};
            a0 = *(const u32x4*)src; a1 = *(const u32x4*)(src + 32 * 128);
            if (nt > 1) { b0 = *(const u32x4*)(src + 64 * 128); b1 = *(const u32x4*)(src + 96 * 128); }
            __syncthreads();
            *(LAS u32x4*)(buf0 + key0 * KT_ROWB + ch * 16) = a0; *(LAS u32x4*)(buf0 + (key0 + 32) * KT_ROWB + ch * 16) = a1;
            __syncthreads();
            for (int kt = 0; kt < nt; kt += 2) {
                if (kt + 2 < nt) { const unsigned short* p = src + (size_t)(kt + 2) * 64 * 128; a0 = *(const u32x4*)p; a1 = *(const u32x4*)(p + 32 * 128); }
                indexer_tile(buf0, af, wv, sc0, sc1, kt, r32, h2);
                if (kt + 1 < nt) { *(LAS u32x4*)(buf1 + key0 * KT_ROWB + ch * 16) = b0; *(LAS u32x4*)(buf1 + (key0 + 32) * KT_ROWB + ch * 16) = b1; }
                __syncthreads();
                if (kt + 1 >= nt) break;
                if (kt + 3 < nt) { const unsigned short* p = src + (size_t)(kt + 3) * 64 * 128; b0 = *(const u32x4*)p; b1 = *(const u32x4*)(p + 32 * 128); }
                indexer_tile(buf1, af, wv, sc0, sc1, kt + 1, r32, h2);
                if (kt + 2 < nt) { *(LAS u32x4*)(buf0 + key0 * KT_ROWB + ch * 16) = a0; *(LAS u32x4*)(buf0 + (key0 + 32) * KT_ROWB + ch * 16) = a1; }
                __syncthreads();
            }
        }
    }
}

DI unsigned mbcnt64(unsigned long long m) { return __builtin_amdgcn_mbcnt_hi((unsigned)(m >> 32), __builtin_amdgcn_mbcnt_lo((unsigned)m, 0u)); }
DI unsigned f2key(float f) { const unsigned u = __float_as_uint(f); return (u & 0x80000000u) ? ~u : (u | 0x80000000u); }
DI int wave_sum_i(int v) {
    v += __builtin_amdgcn_update_dpp(0, v, 0xB1, 0xF, 0xF, true);
    v += __builtin_amdgcn_update_dpp(0, v, 0x4E, 0xF, 0xF, true);
    v += __builtin_amdgcn_update_dpp(0, v, 0x141, 0xF, 0xF, true);
    v += __builtin_amdgcn_update_dpp(0, v, 0x140, 0xF, 0xF, true);
    return __builtin_amdgcn_readlane(v, 0) + __builtin_amdgcn_readlane(v, 16) + __builtin_amdgcn_readlane(v, 32) + __builtin_amdgcn_readlane(v, 48);
}
template <int NV>
DI void topk_row(const float* row, int s, LAS int* lst, int lane) {
    unsigned key[NV];
    { const unsigned long long ra = (unsigned long long)row; const unsigned rlo = __builtin_amdgcn_readfirstlane((unsigned)ra), rhi = __builtin_amdgcn_readfirstlane((unsigned)(ra >> 32));
      row = (const float*)(((unsigned long long)rhi << 32) | rlo); }
#pragma unroll
    for (int jo = 0; jo < NV / 16; ++jo) { const float* rb = row + jo * 1024;
#pragma unroll
        for (int ji = 0; ji < 16; ++ji) { const int j = jo * 16 + ji; const unsigned u = f2key(rb[ji * 64 + lane]); key[j] = (j * 64 + lane <= s) ? u : 0u; } }
    unsigned T = 0u;
#pragma unroll 1
    for (int bit = 31; bit >= 0; --bit) {
        const unsigned cand = T | (1u << bit); int c = 0;
#pragma unroll
        for (int j = 0; j < NV; ++j) asm volatile("v_cmp_le_u32 vcc, %2, %1\n\tv_addc_co_u32 %0, vcc, 0, %0, vcc" : "+v"(c) : "v"(key[j]), "s"(cand) : "vcc");
        const int tot = wave_sum_i(c);
        if (tot >= 256) T = cand;
        if (tot == 256) break;
    }
    int bgt = 0;
#pragma unroll
    for (int j = 0; j < NV; ++j) { const bool sg = key[j] > T; const unsigned long long mg = __ballot(sg); if (sg) lst[bgt + (int)mbcnt64(mg)] = j * 64 + lane; bgt += __builtin_popcountll(mg); }
#pragma unroll
    for (int j = 0; j < NV; ++j) { const bool se = key[j] == T; const unsigned long long me = __ballot(se); const int pe = bgt + (int)mbcnt64(me); if (se && pe < 256) lst[pe] = j * 64 + lane; bgt += __builtin_popcountll(me); }
}
DI void topk_phase(const float* SC, unsigned short* IDX, LAS unsigned char* lds, int tid, int bid, int G) {
    const int lane = tid & 63, w = __builtin_amdgcn_readfirstlane(tid >> 6), gw = bid * NWAVES + w, nw = G * NWAVES;
    LAS int* lst = (LAS int*)(lds + w * 1024);
    for (int t = gw; t < MTOK; t += nw) {
        const int b = t >> 13, s = t & 8191; unsigned short* out = IDX + (size_t)t * 256;
        if (s < 256) {
#pragma unroll
            for (int i = 0; i < 4; ++i) { const int j = lane + 64 * i; out[j] = (unsigned short)((j <= s) ? j : 0); }
        } else {
            const float* row = SC + sc_row_off(b, s);
            if (s < 2048) topk_row<32>(row, s, lst, lane);
            else if (s < 4096) topk_row<64>(row, s, lst, lane);
            else if (s < 6144) topk_row<96>(row, s, lst, lane);
            else topk_row<128>(row, s, lst, lane);
#pragma unroll
            for (int i = 0; i < 4; ++i) out[lane + 64 * i] = (unsigned short)lst[lane + 64 * i];
        }
    }
}

typedef unsigned __attribute__((may_alias)) u32_alias_t;
constexpr int DSA_WB = 17408;
DI __amdgpu_buffer_rsrc_t kv_rsrc(const bf16_t* base) { return __builtin_amdgcn_make_buffer_rsrc((void*)base, 0, SEQ * 256, 0x00020000); }
DI __amdgpu_buffer_rsrc_t big_rsrc(const void* base, unsigned bytes) { return __builtin_amdgcn_make_buffer_rsrc((void*)base, 0, (int)bytes, 0x00020000); }
DI void dsa_attn_phase(const bf16_t* Q1, const bf16_t* K1, const bf16_t* V1, const unsigned short* IDX, unsigned char* AO, LAS unsigned char* lds, int tid, int bid, int G) {
    const int lane = tid & 63, w = __builtin_amdgcn_readfirstlane(tid >> 6), n = lane & 15, g4 = lane >> 4, q4 = n >> 2, p4 = n & 3;
    LAS unsigned char* vb = lds + w * DSA_WB; LAS unsigned short* il0 = (LAS unsigned short*)(vb + 16384); LAS unsigned short* il1 = il0 + 256;
    const bool xm = (G & 7) == 0;
    const int start = xm ? ((bid >> 3) * NWAVES + w) : (bid * NWAVES + w), step = xm ? ((G >> 3) * NWAVES) : (G * NWAVES), total = xm ? MTOK : MTOK * 8;
    const int tr_base = (4 * g4 + q4) * 256 + 8 * (p4 & 1);
    const int vvo = 16 * n;
    const __amdgpu_buffer_rsrc_t qr = big_rsrc(Q1, (unsigned)MTOK * 8192u), ir = big_rsrc(IDX, (unsigned)MTOK * 512u), orr = big_rsrc(AO, (unsigned)MTOK * 4096u);
    const int qlo = n * 256 + 16 * g4;
    const int olo = n * 128 + 4 * g4;
    LAS unsigned char* kwb[4]; LAS unsigned char* krb[4]; LAS unsigned char* trb[4];
#pragma unroll
    for (int j = 0; j < 4; ++j) { kwb[j] = vb + g4 * 256 + ((n ^ (4 * j + g4)) * 16);
                                  krb[j] = vb + n * 256 + (((4 * j + g4) ^ n) * 16);
                                  trb[j] = vb + tr_base + 32 * (j ^ q4) + 16 * (p4 >> 1); }
    LAS unsigned char* vwb = vb + g4 * 256 + ((n ^ (2 * g4)) * 16);
    int it = start;
    if (it >= total) return;
#define DSA_ITEM(itv, kvh_, t_) const int kvh_ = xm ? (bid & 7) : ((itv) & 7), t_ = xm ? (itv) : ((itv) >> 3)
    u32x4 vst[8], kst[16]; bf16x8 qf[4];
    {
        DSA_ITEM(it, kvh, t);
#pragma unroll
        for (int i = 0; i < 2; ++i) ((LAS u32_alias_t*)il0)[lane + 64 * i] = __builtin_amdgcn_raw_buffer_load_b32(ir, lane * 4 + 256 * i, t * 512, 0);
        const size_t slice = (size_t)((t >> 13) * 8 + kvh) * SEQ * 128;
        const __amdgpu_buffer_rsrc_t kr = kv_rsrc(K1 + slice), vr = kv_rsrc(V1 + slice);
#pragma unroll
        for (int ks = 0; ks < 4; ++ks) qf[ks] = (n < 4) ? __builtin_bit_cast(bf16x8, __builtin_amdgcn_raw_buffer_load_b128(qr, qlo + 64 * ks, t * 8192 + kvh * 1024, 0)) : (bf16x8){0, 0, 0, 0, 0, 0, 0, 0};
#pragma unroll
        for (int i = 0; i < 16; ++i) kst[i] = __builtin_amdgcn_raw_buffer_load_b128(kr, (int)il0[4 * i + g4] * 256 + vvo, 0, 0);
#pragma unroll
        for (int i = 0; i < 8; ++i) vst[i] = __builtin_amdgcn_raw_buffer_load_b128(vr, (int)il0[4 * i + g4] * 256 + vvo, 0, 0);
    }
    int par = 0;
    for (; it < total; it += step) {
        DSA_ITEM(it, kvh, t);
        LAS unsigned short* ilc = par ? il1 : il0; LAS unsigned short* iln = par ? il0 : il1;
        const bool has_next = (it + step) < total;
        DSA_ITEM(it + step, kvh2, t2);
        const int s = t & 8191; const int nvalid = s + 1 < 256 ? s + 1 : 256;
        const size_t slice = (size_t)((t >> 13) * 8 + kvh) * SEQ * 128;
        const __amdgpu_buffer_rsrc_t kr = kv_rsrc(K1 + slice), vr = kv_rsrc(V1 + slice);
        const size_t slice2 = (size_t)((t2 >> 13) * 8 + kvh2) * SEQ * 128;
        unsigned inext[2] = {0u, 0u};
        if (has_next) {
#pragma unroll
            for (int i = 0; i < 2; ++i) inext[i] = __builtin_amdgcn_raw_buffer_load_b32(ir, lane * 4 + 256 * i, t2 * 512, 0); }
        float mrun = -__builtin_inff(), lsum = 0.f;
        f32x4 o[8];
#pragma unroll
        for (int dt = 0; dt < 8; ++dt) o[dt] = (f32x4){0.f, 0.f, 0.f, 0.f};
#pragma unroll 1
        for (int c = 0; c < 4; ++c) {
#pragma unroll
            for (int i = 0; i < 16; ++i) *(LAS u32x4*)(kwb[i & 3] + i * 1024) = kst[i];
            if (c < 3) {
#pragma unroll
                for (int i = 0; i < 16; ++i) kst[i] = __builtin_amdgcn_raw_buffer_load_b128(kr, (int)ilc[(c + 1) * 64 + 4 * i + g4] * 256 + vvo, 0, 0);
            } else if (has_next) {
#pragma unroll
                for (int i = 0; i < 2; ++i) ((LAS u32_alias_t*)iln)[lane + 64 * i] = inext[i];
                const __amdgpu_buffer_rsrc_t kr2 = kv_rsrc(K1 + slice2);
#pragma unroll
                for (int i = 0; i < 16; ++i) kst[i] = __builtin_amdgcn_raw_buffer_load_b128(kr2, (int)iln[4 * i + g4] * 256 + vvo, 0, 0);
            }
            f32x4 sa[4];
#pragma unroll
            for (int tt = 0; tt < 4; ++tt) { f32x4 a = {0.f, 0.f, 0.f, 0.f};
#pragma unroll
                for (int ks = 0; ks < 4; ++ks) { const bf16x8 kf = *(const LAS bf16x8*)(krb[ks] + tt * 4096);
                    a = __builtin_amdgcn_mfma_f32_16x16x32_bf16(kf, qf[ks], a, 0, 0, 0); }
                sa[tt] = a; asm volatile("" ::: "memory"); }
            if (nvalid < 256) {
#pragma unroll
                for (int tt = 0; tt < 4; ++tt)
#pragma unroll
                    for (int j = 0; j < 4; ++j) { const int kk = 64 * c + 16 * tt + 4 * g4 + j; sa[tt][j] = (kk < nvalid) ? sa[tt][j] : -__builtin_inff(); }
            }
            float cm = fmaxf(fmaxf(fmaxf(sa[0][0], sa[0][1]), fmaxf(sa[0][2], sa[0][3])), fmaxf(fmaxf(sa[1][0], sa[1][1]), fmaxf(sa[1][2], sa[1][3])));
            cm = fmaxf(cm, fmaxf(fmaxf(fmaxf(sa[2][0], sa[2][1]), fmaxf(sa[2][2], sa[2][3])), fmaxf(fmaxf(sa[3][0], sa[3][1]), fmaxf(sa[3][2], sa[3][3]))));
            cm = fmaxf(cm, __shfl_xor(cm, 16)); cm = fmaxf(cm, __shfl_xor(cm, 32));
            const float mnew = fmaxf(mrun, cm); const float alpha = __builtin_amdgcn_exp2f((mrun - mnew) * SM_C); const float msc = mnew * SM_C; mrun = mnew;
            lsum *= alpha;
#pragma unroll
            for (int dt = 0; dt < 8; ++dt) o[dt] = o[dt] * alpha;
            unsigned pk[4][2];
#pragma unroll
            for (int tt = 0; tt < 4; ++tt) { float pp[4];
#pragma unroll
                for (int j = 0; j < 4; ++j) { pp[j] = __builtin_amdgcn_exp2f(sa[tt][j] * SM_C - msc); lsum += pp[j]; }
                pk[tt][0] = pg8::cvt_pk_bf16(pp[0], pp[1]); pk[tt][1] = pg8::cvt_pk_bf16(pp[2], pp[3]); }
            if (c == 3 && has_next) {
#pragma unroll
                for (int ks = 0; ks < 4; ++ks) qf[ks] = (n < 4) ? __builtin_bit_cast(bf16x8, __builtin_amdgcn_raw_buffer_load_b128(qr, qlo + 64 * ks, t2 * 8192 + kvh2 * 1024, 0)) : (bf16x8){0, 0, 0, 0, 0, 0, 0, 0};
            }
#pragma unroll
            for (int hf = 0; hf < 2; ++hf) {
#pragma unroll
                for (int i = 0; i < 8; ++i) *(LAS u32x4*)(vwb + i * 1024) = vst[i];
                if (hf == 0) {
#pragma unroll
                    for (int i = 0; i < 8; ++i) vst[i] = __builtin_amdgcn_raw_buffer_load_b128(vr, (int)ilc[c * 64 + 32 + 4 * i + g4] * 256 + vvo, 0, 0);
                } else if (c < 3) {
#pragma unroll
                    for (int i = 0; i < 8; ++i) vst[i] = __builtin_amdgcn_raw_buffer_load_b128(vr, (int)ilc[(c + 1) * 64 + 4 * i + g4] * 256 + vvo, 0, 0);
                } else if (has_next) {
                    const __amdgpu_buffer_rsrc_t vr2 = kv_rsrc(V1 + slice2);
#pragma unroll
                    for (int i = 0; i < 8; ++i) vst[i] = __builtin_amdgcn_raw_buffer_load_b128(vr2, (int)iln[4 * i + g4] * 256 + vvo, 0, 0);
                }
                u32x4 pw; pw.x = pk[2 * hf][0]; pw.y = pk[2 * hf][1]; pw.z = pk[2 * hf + 1][0]; pw.w = pk[2 * hf + 1][1];
                const bf16x8 pf = __builtin_bit_cast(bf16x8, pw);
#pragma unroll
                for (int dt = 0; dt < 8; ++dt) {
                    const s16x4 lo = __builtin_amdgcn_ds_read_tr16_b64_v4i16((LAS s16x4*)(trb[dt & 3] + 128 * (dt >> 2)));
                    const s16x4 hi = __builtin_amdgcn_ds_read_tr16_b64_v4i16((LAS s16x4*)(trb[dt & 3] + 128 * (dt >> 2) + 16 * 256));
                    const bf16x8 vf = __builtin_shufflevector(lo, hi, 0, 1, 2, 3, 4, 5, 6, 7);
                    o[dt] = __builtin_amdgcn_mfma_f32_16x16x32_bf16(vf, pf, o[dt], 0, 0, 0);
                    if (dt & 1) asm volatile("" ::: "memory");
                }
            }
        }
        lsum += __shfl_xor(lsum, 16); lsum += __shfl_xor(lsum, 32);
        if (n < 4) { const float li = 16.0f / lsum;
#pragma unroll
            for (int dt = 0; dt < 8; ++dt) { int wv = __builtin_amdgcn_cvt_pk_fp8_f32(o[dt][0] * li, o[dt][1] * li, 0, false); wv = __builtin_amdgcn_cvt_pk_fp8_f32(o[dt][2] * li, o[dt][3] * li, wv, true);
                __builtin_amdgcn_raw_buffer_store_b32((unsigned)wv, orr, olo + 16 * dt, t * 4096 + kvh * 512, 0); } }
        par ^= 1;
    }
#undef DSA_ITEM
}

#ifndef MK_ONE_LAUNCH
#define MK_ONE_LAUNCH 1
#endif
constexpr int N_PHASES = 19;
#ifndef FFN1_FP8
#define FFN1_FP8 1
#endif
#ifndef WGM_F
#define WGM_F 8
#endif
#ifndef WGM_Y
#define WGM_Y 2
#endif
struct Args { const float* in[22]; float* out; unsigned char* ws; int ph_lo, ph_hi; };

__global__ void __launch_bounds__(NTHR, 2) mk_fwd(Args args) {
    extern __shared__ __attribute__((aligned(16))) unsigned char lds_raw[];
    LAS unsigned char* lds = (LAS unsigned char*)lds_raw;
    const int bid = blockIdx.x, G = gridDim.x;
    const int wid_s = __builtin_amdgcn_readfirstlane((int)(threadIdx.x >> 6));
#define tid fresh_tid(wid_s)
    unsigned char* ws = args.ws;
    const __attribute__((address_space(4))) unsigned char* kargs = (const __attribute__((address_space(4))) unsigned char*)__builtin_amdgcn_kernarg_segment_ptr();
#define ARG_IN(i) (*(const float* const volatile __attribute__((address_space(4)))*)(kargs + 8 * (i)))
    volatile LAS unsigned* misc = (volatile LAS unsigned*)(lds + MISC_OFF);
    { const int t0_ = tid; if (t0_ < 4) misc[t0_] = 0u; }
    __syncthreads();
    const int lo = args.ph_lo, hi = args.ph_hi;
    XcdBarrier bar; bar.bar = (unsigned*)(ws + WS_CTL); bar.x = 0; bar.st = nullptr; bar.wid = wid_s;
    if (hi - lo > 1) bar = xcd_barrier_post((unsigned*)(ws + WS_CTL), misc, wid_s);
#ifndef PH_MASK
#define PH_MASK 0x7ffff
#endif
#define IN(k) ((((PH_MASK) >> (k)) & 1) && lo <= (k) && (k) < hi)
#ifndef PROBE_PH
#define PROBE_PH -1
#endif
#ifndef PROBE_PH2
#define PROBE_PH2 -1
#endif
    unsigned long long pr_t0 = (PROBE_PH == 0) ? __builtin_amdgcn_s_memrealtime() : 0ull, pr_acc = 0ull;
#define SEAM(k) do { if (IN(k) && IN((k) + 1)) xcd_barrier(bar); \
        if (PROBE_PH >= 0 && bid == 0) { const unsigned long long now_ = __builtin_amdgcn_s_memrealtime(); if ((k) + 1 == PROBE_PH) pr_t0 = now_; if ((k) == (PROBE_PH2 >= 0 ? PROBE_PH2 : PROBE_PH)) pr_acc = now_ - pr_t0; } } while (0)
#ifndef DUP_MASK
#define DUP_MASK 0
#endif
#define REP(k) _Pragma("unroll 1") for (int rep_ = 0; rep_ < ((((DUP_MASK) >> (k)) & 1) ? 2 : 1); ++rep_)

    float* CS = (float*)(ws + WS_COS); float* SN = (float*)(ws + WS_SIN);
    bf16_t* XB = (bf16_t*)(ws + WS_XB); half_t* XH = (half_t*)(ws + WS_XA); half_t* Y = (half_t*)(ws + B_Y); bf16_t* Hh = (bf16_t*)(ws + B_H);
    float* OUT = args.out;
    const pg8::RopeTab rt{CS, SN};
#define RSRC256M(p) __builtin_amdgcn_make_buffer_rsrc((void*)(p), 0, (int)(256u * 1048576u), 0x00020000)

    if (IN(0)) REP(0) {
        LAS float* scr = (LAS float*)lds;
        wt_matrix8(ARG_IN(2), DM, N_A, (unsigned char*)(ws + W0IN), MapA{}, scr, tid, bid, G, 64.0f);
        wt_matrix8(ARG_IN(3), 2048, DM, (unsigned char*)(ws + W0OUT), MapId{}, scr, tid, bid, G, 64.0f);
        wt_matrix(ARG_IN(10), DM, DFF, (bf16_t*)(ws + W0GU), MapGU{0}, scr, tid, bid, G);
        wt_matrix(ARG_IN(11), DM, DFF, (bf16_t*)(ws + W0GU), MapGU{1}, scr, tid, bid, G);
        cvt_x8_phase(ARG_IN(0), (unsigned char*)XB, tid, bid, G);
        rope_tab_phase((const int*)ARG_IN(1), CS, SN, tid, bid, G);
    }
    SEAM(0);
    if (IN(1)) REP(1) {
        pg8::Gemm g{XB, (const bf16_t*)(ws + W0IN), MTOK, N_A, DM / 2}; pg8::StaticOrder S; S.init(MTOK, N_A, G, bid);
        pg8::EpiQKV0 E{__builtin_amdgcn_make_buffer_rsrc((void*)(ws + B_QKV0), 0, (int)(576u * 1048576u), 0x00020000), __builtin_amdgcn_make_buffer_rsrc((void*)CS, 0, MTOK * 256, 0x00020000), __builtin_amdgcn_make_buffer_rsrc((void*)SN, 0, MTOK * 256, 0x00020000), 0.015625f};
        pg8::gemm_phase<pg8::EpiQKV0, pg8::StaticOrder, true, true, true, 6>(lds, g, S, E, tid);
    }
    SEAM(1);
    if (IN(2)) REP(2) attn0_phase((const unsigned char*)(ws + B_QKV0), (bf16_t*)(ws + B_OG), (float*)(ws + B_LSE), lds, tid, bid, G);
    SEAM(2);
    if (IN(3)) REP(3) merge_phase((const bf16_t*)(ws + B_OG), (const float*)(ws + B_LSE), (unsigned char*)(ws + B_AO0), tid, bid, G);
    SEAM(3);
    if (IN(4)) REP(4) {
        pg8::Gemm g{(const bf16_t*)(ws + B_AO0), (const bf16_t*)(ws + W0OUT), MTOK, DM, 1024}; pg8::StaticOrder S; S.init(MTOK, DM, G, bid, WGM_Y);
        pg8::EpiY<false> E{RSRC256M(ARG_IN(0)), RSRC256M(Y), ALPHA, 1.0f / 1024.0f};
        pg8::gemm_phase<pg8::EpiY<false>, pg8::StaticOrder, true, true, true>(lds, g, S, E, tid);
    }
    SEAM(4);
    if (IN(5)) REP(5) ln_phase(Y, ARG_IN(8), ARG_IN(9), nullptr, XH, XB, tid, bid, G);
    SEAM(5);
    if (IN(6)) REP(6) {
        pg8::Gemm g{XB, (const bf16_t*)(ws + W0GU), MTOK, 2 * DFF, DM}; pg8::StaticOrder S; S.init(MTOK, 2 * DFF, G, bid, WGM_F);
        pg8::EpiSwiGLU<false> E{Hh, DFF};
        pg8::gemm_phase<pg8::EpiSwiGLU<false>, pg8::StaticOrder, true, true>(lds, g, S, E, tid);
        {
            const int rem = ((MTOK / 256) * ((2 * DFF) / 256)) % G, cb = rem ? bid - rem : bid, cg = rem ? G - rem : G;
            if (cb >= 0) { __syncthreads(); wt_matrix(ARG_IN(12), DFF, DM, (bf16_t*)(ws + W0DN), MapId{}, (LAS float*)lds, tid, cb, cg); }
        }
    }
    SEAM(6);
    if (IN(7)) REP(7) {
        pg8::Gemm g{Hh, (const bf16_t*)(ws + W0DN), MTOK, DM, DFF}; pg8::StaticOrder S; S.init(MTOK, DM, G, bid, WGM_Y);
        pg8::EpiY<true> E{RSRC256M(XH), RSRC256M(Y), ALPHA, 1.0f};
        pg8::gemm_phase<pg8::EpiY<true>, pg8::StaticOrder, true, true>(lds, g, S, E, tid);
    }
    SEAM(7);
    if (IN(8)) REP(8) {
        ln_phase(Y, ARG_IN(13), ARG_IN(14), nullptr, XH, XB, tid, bid, G, ws + WS_XB8);
        LAS float* scr = (LAS float*)lds;
        wt_matrix8(ARG_IN(4), DM, 6144, (unsigned char*)(ws + W1IN), MapB{}, scr, tid, bid, G, 64.0f, N_B);
        wt_matrix(ARG_IN(4) + 6144, DM, N_B - 6144, (bf16_t*)(ws + W1INB), MapB2{}, scr, tid, bid, G, N_B);
        { u32x4* z = (u32x4*)(ws + W1INB + (size_t)(N_B - 6144) * DM * 2); const int nz = (N_BP - N_B) * DM * 2 / 16; for (int i = bid * NTHR + tid; i < nz; i += G * NTHR) z[i] = (u32x4){0u, 0u, 0u, 0u}; }
        wt_matrix8(ARG_IN(7), DM, DM, (unsigned char*)(ws + W1OUT), MapId{}, scr, tid, bid, G, 64.0f);
        wt_matrix(ARG_IN(17), DM, DFF, (bf16_t*)(ws + W1GU), MapGU{0}, scr, tid, bid, G);
        wt_matrix(ARG_IN(18), DM, DFF, (bf16_t*)(ws + W1GU), MapGU{1}, scr, tid, bid, G);
    }
    SEAM(8);
    if (IN(9)) REP(9) {
        {
            pg8::Gemm g{(const bf16_t*)(ws + WS_XB8), (const bf16_t*)(ws + W1IN), MTOK, 6144, DM / 2}; pg8::StaticOrder S; S.init(MTOK, 6144, G, bid);
            pg8::EpiQKV1a E{__builtin_amdgcn_make_buffer_rsrc((void*)(ws + B_Q1), 0, MTOK * 8192, 0x00020000), __builtin_amdgcn_make_buffer_rsrc((void*)(ws + B_K1), 0, MTOK * 2048, 0x00020000),
                            __builtin_amdgcn_make_buffer_rsrc((void*)(ws + B_V1), 0, MTOK * 2048, 0x00020000), __builtin_amdgcn_make_buffer_rsrc((void*)CS, 0, MTOK * 256, 0x00020000),
                            __builtin_amdgcn_make_buffer_rsrc((void*)SN, 0, MTOK * 256, 0x00020000), 0.015625f};
            pg8::gemm_phase<pg8::EpiQKV1a, pg8::StaticOrder, true, true, true>(lds, g, S, E, tid);
        }
        __syncthreads();
        {
            pg8::Gemm g{XB, (const bf16_t*)(ws + W1INB), MTOK, N_BP - 6144, DM}; pg8::StaticOrder S; S.init(MTOK, N_BP - 6144, G, bid);
            pg8::EpiQKV1 E{(bf16_t*)(ws + B_Q1), (bf16_t*)(ws + B_K1), (bf16_t*)(ws + B_V1), (unsigned short*)(ws + B_QI), (float*)(ws + B_KIR), (float*)(ws + B_WI), rt, 24, 1.0f};
            pg8::gemm_phase<pg8::EpiQKV1, pg8::StaticOrder, true, true>(lds, g, S, E, tid);
        }
        {
            const int rem = ((MTOK / 256) * ((N_BP - 6144) / 256)) % G, cb = rem ? bid - rem : bid, cg = rem ? G - rem : G;
            if (cb >= 0) { __syncthreads();
#if FFN1_FP8
                wt_matrix8(ARG_IN(19), DFF, DM, (unsigned char*)(ws + W1DN), MapId{}, (LAS float*)lds, tid, cb, cg, 128.0f);
#else
                wt_matrix(ARG_IN(19), DFF, DM, (bf16_t*)(ws + W1DN), MapId{}, (LAS float*)lds, tid, cb, cg);
#endif
            }
        }
    }
    SEAM(9);
    if (IN(10)) REP(10) kidx_phase((const float*)(ws + B_KIR), ARG_IN(5), ARG_IN(6), CS, SN, (unsigned short*)(ws + B_KI16), tid, bid, G);
    SEAM(10);
    if (IN(11)) REP(11) indexer_phase((const unsigned short*)(ws + B_QI), (const unsigned short*)(ws + B_KI16), (const float*)(ws + B_WI), (float*)(ws + B_SC), lds, tid, bid, G);
    SEAM(11);
    if (IN(12)) REP(12) topk_phase((const float*)(ws + B_SC), (unsigned short*)(ws + B_IDX), lds, tid, bid, G);
    SEAM(12);
    if (IN(13)) REP(13) dsa_attn_phase((const bf16_t*)(ws + B_Q1), (const bf16_t*)(ws + B_K1), (const bf16_t*)(ws + B_V1), (const unsigned short*)(ws + B_IDX), (unsigned char*)(ws + B_AO1), lds, tid, bid, G);
    SEAM(13);
    if (IN(14)) REP(14) {
        pg8::Gemm g{(const bf16_t*)(ws + B_AO1), (const bf16_t*)(ws + W1OUT), MTOK, DM, DM / 2}; pg8::StaticOrder S; S.init(MTOK, DM, G, bid, WGM_Y);
        pg8::EpiY<true> E{RSRC256M(XH), RSRC256M(Y), ALPHA, 1.0f / 1024.0f};
        pg8::gemm_phase<pg8::EpiY<true>, pg8::StaticOrder, true, true, true>(lds, g, S, E, tid);
    }
    SEAM(14);
    if (IN(15)) REP(15) ln_phase(Y, ARG_IN(15), ARG_IN(16), nullptr, XH, XB, tid, bid, G);
    SEAM(15);
    if (IN(16)) REP(16) {
        pg8::Gemm g{XB, (const bf16_t*)(ws + W1GU), MTOK, 2 * DFF, DM}; pg8::StaticOrder S; S.init(MTOK, 2 * DFF, G, bid, WGM_F);
        pg8::EpiSwiGLU<FFN1_FP8 != 0> E{Hh, DFF};
        pg8::gemm_phase<pg8::EpiSwiGLU<FFN1_FP8 != 0>, pg8::StaticOrder, true, true>(lds, g, S, E, tid);
    }
    SEAM(16);
    if (IN(17)) REP(17) {
#if FFN1_FP8
        pg8::Gemm g{Hh, (const bf16_t*)(ws + W1DN), MTOK, DM, DFF / 2}; pg8::StaticOrder S; S.init(MTOK, DM, G, bid, WGM_Y);
        pg8::EpiY<true> E{RSRC256M(XH), RSRC256M(Y), ALPHA, 1.0f / 2048.0f};
        pg8::gemm_phase<pg8::EpiY<true>, pg8::StaticOrder, true, true, true>(lds, g, S, E, tid);
#else
        pg8::Gemm g{Hh, (const bf16_t*)(ws + W1DN), MTOK, DM, DFF}; pg8::StaticOrder S; S.init(MTOK, DM, G, bid, WGM_Y);
        pg8::EpiY<true> E{RSRC256M(XH), RSRC256M(Y), ALPHA, 1.0f};
        pg8::gemm_phase<pg8::EpiY<true>, pg8::StaticOrder, true, true>(lds, g, S, E, tid);
#endif
    }
    SEAM(17);
    if (IN(18)) REP(18) ln_phase(Y, ARG_IN(20), ARG_IN(21), OUT, nullptr, nullptr, tid, bid, G);
    if (PROBE_PH >= 0 && bid == 0) { const unsigned long long t1_ = __builtin_amdgcn_s_memrealtime(); while (__builtin_amdgcn_s_memrealtime() - t1_ < pr_acc) __builtin_amdgcn_s_sleep(8); }
#undef IN
#undef ARG_IN
#undef tid
#undef SEAM
#undef REP
}

extern "C" void kernel_launch(void* const* d_in, const int* in_sizes, int n_in, void* d_out, int out_size, void* d_ws, size_t ws_size, hipStream_t stream) {
    static int grid = 0;
    if (grid == 0) {
        if (n_in != 22 || out_size != MTOK * DM || ws_size < WS_END) { fprintf(stderr, "kernel_launch: unexpected problem (n_in %d, out %d, ws %zu < %zu); nothing launched\n", n_in, out_size, ws_size, (size_t)WS_END); grid = -1; return; }
        int dev = 0, cus = 0, per_cu = 0;
        if (hipGetDevice(&dev) != hipSuccess || hipDeviceGetAttribute(&cus, hipDeviceAttributeMultiprocessorCount, dev) != hipSuccess) { grid = -1; return; }
        if (hipFuncSetAttribute((const void*)mk_fwd, hipFuncAttributeMaxDynamicSharedMemorySize, LDS_BYTES) != hipSuccess) { fprintf(stderr, "kernel_launch: hipFuncSetAttribute failed\n"); grid = -1; return; }
        if (hipOccupancyMaxActiveBlocksPerMultiprocessor(&per_cu, (const void*)mk_fwd, NTHR, LDS_BYTES) != hipSuccess || per_cu < 1) { fprintf(stderr, "kernel_launch: occupancy query reports %d\n", per_cu); (void)hipGetLastError(); per_cu = 1; }
        grid = cus;
    }
    if (grid < 0) return;
    (void)in_sizes;
    if (hipMemsetAsync((char*)d_ws + WS_CTL, 0, CTL_ZERO_BYTES, stream) != hipSuccess) return;
    Args a{};
    for (int i = 0; i < 22; ++i) a.in[i] = (const float*)d_in[i];
    a.out = (float*)d_out; a.ws = (unsigned char*)d_ws;
#if MK_ONE_LAUNCH
    a.ph_lo = 0; a.ph_hi = N_PHASES;
    hipLaunchKernelGGL(mk_fwd, dim3(grid), dim3(NTHR), LDS_BYTES, stream, a);
#else
    for (int p = 0; p < N_PHASES; ++p) { a.ph_lo = p; a.ph_hi = p + 1; hipLaunchKernelGGL(mk_fwd, dim3(grid), dim3(NTHR), LDS_BYTES, stream, a); }
#endif
}
```
